# Optimizing an MI355X kernel written in HIP

```python
import jax, jax.numpy as jnp
from jax import lax
import numpy as np

D_MODEL = 1024
BATCH = 32
SEQ = 2048
DEPTH = 2
DEC_BATCH = 4
DEC_SEQ = 8192
PAST_LEN = 128

GRID_W = 64
WIN_R = 8
WIN_C = 16
NA_HEADS = 8
NA_HEAD_DIM = 64
NA_WIDTH = NA_HEADS * NA_HEAD_DIM
FT_GROUPS = 4
FT_GROUP_DIM = 64
FT_WIDTH = FT_GROUPS * FT_GROUP_DIM
CV_WIDTH = 256
CV_KERNEL = 31
N_BRANCH = 3
NORM_EPS = 1e-6
NEG_INF = -1e30
SPLIT_SIZES = (NA_WIDTH, NA_WIDTH, NA_WIDTH, NA_WIDTH,
               FT_WIDTH, FT_WIDTH,
               CV_WIDTH, CV_WIDTH, CV_WIDTH,
               D_MODEL, D_MODEL, D_MODEL)
D_IN = sum(SPLIT_SIZES)

kernel_name = "hybrid_natten_fnet_conformer_encoder"


def rms_norm(x, g):
    x32 = x.astype(jnp.float32)
    y = x32 * lax.rsqrt(jnp.mean(x32 * x32, axis=-1, keepdims=True) + NORM_EPS)
    return (y * g.astype(jnp.float32)).astype(x.dtype)


def layer_norm(x, g, b):
    x32 = x.astype(jnp.float32)
    mu = jnp.mean(x32, axis=-1, keepdims=True)
    xc = x32 - mu
    var = jnp.mean(xc * xc, axis=-1, keepdims=True)
    y = xc * lax.rsqrt(var + NORM_EPS) * g.astype(jnp.float32) + b.astype(jnp.float32)
    return y.astype(x.dtype)


def neighbourhood_attention(q, k, v, rel_pos_bias):
    b, l = q.shape[0], q.shape[1]
    rows = l // GRID_W
    wr = min(WIN_R, rows)
    qg = q.reshape(b, rows, GRID_W, NA_HEADS, NA_HEAD_DIM) * (NA_HEAD_DIM ** -0.5)
    kg = k.reshape(b, rows, GRID_W, NA_HEADS, NA_HEAD_DIM)
    vg = v.reshape(b, rows, GRID_W, NA_HEADS, NA_HEAD_DIM)
    col = jnp.arange(GRID_W)
    c_start = jnp.clip(col - WIN_C // 2, 0, GRID_W - WIN_C)
    col_valid = (col[None, :] >= c_start[:, None]) & (col[None, :] < c_start[:, None] + WIN_C)
    dc_idx = jnp.clip(col[None, :] - col[:, None] + WIN_C - 1, 0, 2 * WIN_C - 2)
    bias_c = rel_pos_bias[:, :, dc_idx]

    def row_block(r):
        r_start = jnp.clip(r - wr // 2, 0, rows - wr)
        k_blk = lax.dynamic_slice_in_dim(kg, r_start, wr, axis=1)
        v_blk = lax.dynamic_slice_in_dim(vg, r_start, wr, axis=1)
        q_row = lax.dynamic_index_in_dim(qg, r, axis=1, keepdims=False)
        dr_idx = r_start + jnp.arange(wr) - r + WIN_R - 1
        bias = jnp.take(bias_c, dr_idx, axis=1).transpose(0, 2, 1, 3)
        s = jnp.einsum('bqhd,bikhd->bhqik', q_row, k_blk).astype(jnp.float32)
        s = s + bias[None].astype(jnp.float32)
        s = jnp.where(col_valid[None, None, :, None, :], s, NEG_INF)
        p = jax.nn.softmax(s.reshape(b, NA_HEADS, GRID_W, wr * GRID_W), axis=-1)
        p = p.reshape(b, NA_HEADS, GRID_W, wr, GRID_W).astype(v.dtype)
        return jnp.einsum('bhqik,bikhd->bqhd', p, v_blk)

    out = lax.map(row_block, jnp.arange(rows))
    return out.transpose(1, 0, 2, 3, 4).reshape(b, l, NA_WIDTH)


def fourier_mix(u):
    b, l, _ = u.shape
    ug = u.reshape(b, l, FT_GROUPS, FT_GROUP_DIM).astype(jnp.float32)
    f = jnp.fft.fft2(ug, axes=(1, 3), norm="ortho").real
    return f.reshape(b, l, FT_WIDTH).astype(u.dtype)


def conformer_conv(u_val, u_glu_gate, dw_w, dw_b, ln_g, ln_b):
    h = u_val * jax.nn.sigmoid(u_glu_gate)
    h = lax.conv_general_dilated(
        h, dw_w.astype(h.dtype)[:, None, :], window_strides=(1,),
        padding=[(CV_KERNEL // 2, CV_KERNEL // 2)],
        dimension_numbers=('NWC', 'WIO', 'NWC'), feature_group_count=CV_WIDTH) + dw_b
    return jax.nn.silu(layer_norm(h, ln_g, ln_b))


def encoder_layer(x, pre_g, post_g, w_in, rpb, dw_w, dw_b, cn_g, cn_b, w_a, w_b, w_c, w_o):
    b, l, _ = x.shape
    h = rms_norm(x, pre_g)
    z = h @ w_in
    split_pts = np.cumsum(SPLIT_SIZES)[:-1].tolist()
    (q, k, v, gate_a, u_b, gate_b, c_val, c_glu, gate_c,
     merge_a, merge_b, merge_c) = jnp.split(z, split_pts, axis=-1)
    heads = lambda t: t.reshape(b, l, NA_HEADS, NA_HEAD_DIM)
    y_a = neighbourhood_attention(heads(q), heads(k), heads(v), rpb) * jax.nn.silu(gate_a)
    y_b = fourier_mix(u_b) * jax.nn.silu(gate_b)
    y_c = conformer_conv(c_val, c_glu, dw_w, dw_b, cn_g, cn_b) * jax.nn.silu(gate_c)
    merged = (jax.nn.sigmoid(merge_a) * (y_a @ w_a)
              + jax.nn.sigmoid(merge_b) * (y_b @ w_b)
              + jax.nn.sigmoid(merge_c) * (y_c @ w_c))
    return x + rms_norm(merged @ w_o, post_g)


def setup_inputs(seed: int = 0) -> dict:
    key = jax.random.key(seed)
    ks = jax.random.split(key, 16)
    f32 = jnp.float32
    nrm = lambda k, shape, scale: (jax.random.normal(k, shape, f32) * scale).astype(f32)
    return {
        "x_prompt": nrm(ks[0], (BATCH, SEQ, D_MODEL), 1.0),
        "x_sample": nrm(ks[1], (DEC_BATCH, DEC_SEQ, D_MODEL), 1.0),
        "pre_norm_g": 1.0 + nrm(ks[2], (DEPTH, D_MODEL), 0.05),
        "post_norm_g": 1.0 + nrm(ks[3], (DEPTH, D_MODEL), 0.05),
        "w_in": nrm(ks[4], (DEPTH, D_MODEL, D_IN), D_MODEL ** -0.5),
        "rel_pos_bias": nrm(ks[5], (DEPTH, NA_HEADS, 2 * WIN_R - 1, 2 * WIN_C - 1), 0.5),
        "c_dw_w": nrm(ks[6], (DEPTH, CV_KERNEL, CV_WIDTH), CV_KERNEL ** -0.5),
        "c_dw_b": nrm(ks[7], (DEPTH, CV_WIDTH), 0.02),
        "c_norm_g": 1.0 + nrm(ks[8], (DEPTH, CV_WIDTH), 0.05),
        "c_norm_b": nrm(ks[9], (DEPTH, CV_WIDTH), 0.02),
        "w_a_out": nrm(ks[10], (DEPTH, NA_WIDTH, D_MODEL), NA_WIDTH ** -0.5),
        "w_b_out": nrm(ks[11], (DEPTH, FT_WIDTH, D_MODEL), FT_WIDTH ** -0.5),
        "w_c_out": nrm(ks[12], (DEPTH, CV_WIDTH, D_MODEL), CV_WIDTH ** -0.5),
        "w_o": nrm(ks[13], (DEPTH, D_MODEL, D_MODEL), D_MODEL ** -0.5),
    }


def reference(x_prompt, x_sample, pre_norm_g, post_norm_g, w_in, rel_pos_bias, c_dw_w, c_dw_b,
              c_norm_g, c_norm_b, w_a_out, w_b_out, w_c_out, w_o):
    y_prompt = x_prompt
    y_sample = x_sample
    for i in range(DEPTH):
        params = (pre_norm_g[i], post_norm_g[i], w_in[i], rel_pos_bias[i], c_dw_w[i], c_dw_b[i],
                  c_norm_g[i], c_norm_b[i], w_a_out[i], w_b_out[i], w_c_out[i], w_o[i])
        y_prompt = encoder_layer(y_prompt, *params)
        y_sample = encoder_layer(y_sample, *params)
    return (y_prompt, y_sample)
```

```cpp
#include <hip/hip_runtime.h>
#include <hip/hip_cooperative_groups.h>
#include <cstdio>
#include <cstdint>
namespace cg = cooperative_groups;

#ifndef MK_ONE_LAUNCH
#define MK_ONE_LAUNCH 1
#endif

#ifndef PH_MASK
#define PH_MASK 0xFFFF
#endif
#define PHON(k) (((PH_MASK) >> (k)) & 1)
#define LAS __attribute__((address_space(3)))
typedef unsigned short bf16_t;
typedef short bf16x8 __attribute__((ext_vector_type(8)));
typedef short s16x4 __attribute__((ext_vector_type(4)));
typedef float f32x4 __attribute__((ext_vector_type(4)));
typedef unsigned u32x4 __attribute__((ext_vector_type(4)));
typedef unsigned u32x2 __attribute__((ext_vector_type(2)));

constexpr int DM = 1024;
constexpr int MP = 65536;
constexpr int MTOK = 98304;
constexpr int DIN = 6400;
constexpr int NG1 = 2560;
constexpr int ZMW = 1536;
constexpr int NYQ = 49152;
constexpr float EPS = 1e-6f;

constexpr size_t MiB = 1u << 20;
constexpr size_t WS_WIN = 0;
constexpr size_t WS_WG = 10 * MiB;
constexpr size_t WS_WM = 14 * MiB;
constexpr size_t WS_WA = 26 * MiB;
constexpr size_t WS_WB = 28 * MiB;
constexpr size_t WS_WC = 29 * MiB;
constexpr size_t WS_WO = 30 * MiB;
constexpr size_t WS_T = 34 * MiB;
constexpr size_t WS_RS = 35 * MiB;
constexpr size_t WS_SS = 35 * MiB + 512 * 1024;
constexpr size_t WS_XB = 36 * MiB;
constexpr size_t WS_ZM = 228 * MiB;
constexpr size_t WS_ZT = 516 * MiB;
constexpr size_t WS_YQ = 708 * MiB;
constexpr size_t WS_Y = 804 * MiB;
constexpr size_t WS_END = 996 * MiB;

constexpr int NWAVES = 8;
constexpr int LDS_BYTES = 147456;

__device__ __forceinline__ unsigned f2bf(float f) { unsigned u = __builtin_bit_cast(unsigned, f); return (u + 0x7fffu + ((u >> 16) & 1u)) >> 16; }
__device__ __forceinline__ unsigned pk2(float lo, float hi) { return f2bf(lo) | (f2bf(hi) << 16); }
__device__ __forceinline__ float bf2f(unsigned b) { return __builtin_bit_cast(float, b << 16); }
__device__ __forceinline__ float bflo(unsigned w) { return __builtin_bit_cast(float, w << 16); }
__device__ __forceinline__ float bfhi(unsigned w) { return __builtin_bit_cast(float, w & 0xffff0000u); }
__device__ __forceinline__ float sigmoidf_(float x) { return 1.0f / (1.0f + __expf(-x)); }
__device__ __forceinline__ float siluf_(float x) { return x / (1.0f + __expf(-x)); }
__device__ __forceinline__ float wave_sum(float v) {
#pragma unroll
    for (int o = 1; o < 64; o <<= 1) v += __shfl_xor(v, o);
    return v;
}
#define LDS_WAIT() asm volatile("s_waitcnt lgkmcnt(0)" ::: "memory")

namespace pg8 {
constexpr int BM = 256, BK = 64, HALF = 128, HTB = HALF * BK * 2, STAGE_BYTES = 8 * HTB, NXCD = 8, WGM = 8;
__device__ __forceinline__ int lds_byte(int r, int c) { const int st = (r >> 4) * 2 + (c >> 5), rr = r & 15, cc = c & 31, ob = rr * 64 + cc * 2; return st * 1024 + (ob ^ (((ob >> 9) & 1) << 5)); }
__device__ __forceinline__ void stage_rc(int b, int& R, int& C) { const int st = b / 1024, sb = b % 1024, swz = sb ^ (((sb >> 9) & 1) << 5); R = (st >> 1) * 16 + swz / 64; C = (st & 1) * 32 + (swz % 64) / 2; }

struct Unit { int pm, pn; };
struct Gemm { const bf16_t* A; const bf16_t* Bt; int M, N, K, lda, ldb; };

struct StaticOrder {
    int nM, nN, nwg, G, c;
    __device__ void init(int M, int N, int G_, int c_) { nM = M / BM; nN = N / BM; nwg = nM * nN; G = G_; c = c_; }
    __device__ bool next(int i, Unit& u) const {
        const long L = (long)i * G + c; if (L >= nwg) return false;
        int wgid = (int)L; { const int q = nwg / NXCD, r = nwg % NXCD, xcd = wgid % NXCD, off = wgid / NXCD; wgid = (xcd < r ? xcd * (q + 1) : r * (q + 1) + (xcd - r) * q) + off; }
        const int nig = WGM * nN, gid = wgid / nig, fm = gid * WGM, gsz = (nM - fm) < WGM ? (nM - fm) : WGM;
        u.pm = fm + ((wgid % nig) % gsz); u.pn = (wgid % nig) / gsz; return true;
    }
};

template <class Epi, bool ALIGN_EPI>
__device__ __forceinline__ void gemm_phase(LAS unsigned char* lds, const Gemm g, const StaticOrder& S, const Epi& E) {
    int tid = threadIdx.x; asm volatile("" : "+v"(tid));
    const int wid = __builtin_amdgcn_readfirstlane(tid >> 6), lane = tid & 63, wr = wid >> 2, wc = wid & 3, fr = lane & 15, fq = lane >> 4;
    const int K = g.K, nt = K / BK;
    unsigned voffA[2], voffB[2];
#pragma unroll
    for (int i = 0; i < 2; ++i) { int R, C; stage_rc(tid * 16 + i * 8192, R, C);
        voffA[i] = (unsigned)(R * g.lda + C) * 2u; voffB[i] = (unsigned)(R * g.ldb + C) * 2u; }
    const size_t kstep = (size_t)(BK * 2);
    const size_t hstepA = (size_t)HALF * g.lda * 2, hstepB = (size_t)HALF * g.ldb * 2;
    const size_t tstepA = 2 * hstepA, tstepB = 2 * hstepB;
    const unsigned ldsw = (unsigned)wid * 1024u;
    const int aoff = lds_byte(wr * 64 + fr, fq * 8), boff = lds_byte(wc * 32 + fr, fq * 8);
#define PG8_SA(b, h) (((b) * 2 + (h)) * HTB)
#define PG8_SB(b, h) ((4 + (b) * 2 + (h)) * HTB)
#define PG8_STAGE(bufoff, gbase, voff) do { _Pragma("unroll") for (int _i = 0; _i < 2; ++_i) \
        __builtin_amdgcn_global_load_lds((const unsigned*)((const char*)(gbase) + (voff)[_i]), (LAS unsigned*)(lds + (bufoff) + ldsw + _i * 8192), 16, 0, 0); } while (0)
#define PG8_LDA(dst, b, h) do { _Pragma("unroll") for (int m = 0; m < 4; ++m) _Pragma("unroll") for (int k = 0; k < 2; ++k) dst[m][k] = *(const LAS bf16x8*)(lds + PG8_SA(b, h) + aoff + m * 2048 + k * 1024); } while (0)
#define PG8_LDB(dst, b, h) do { _Pragma("unroll") for (int n = 0; n < 2; ++n) _Pragma("unroll") for (int k = 0; k < 2; ++k) dst[n][k] = *(const LAS bf16x8*)(lds + PG8_SB(b, h) + boff + n * 2048 + k * 1024); } while (0)
#define PG8_MMA(ai, bj, At, Bt) do { __builtin_amdgcn_s_setprio(1); _Pragma("unroll") for (int m = 0; m < 4; ++m) _Pragma("unroll") for (int n = 0; n < 2; ++n) _Pragma("unroll") for (int k = 0; k < 2; ++k) \
        acc[ai][bj][m][n] = __builtin_amdgcn_mfma_f32_16x16x32_bf16(Bt[n][k], At[m][k], acc[ai][bj][m][n], 0, 0, 0); __builtin_amdgcn_s_setprio(0); } while (0)
#define PG8_WAIT_V(n) asm volatile("s_waitcnt vmcnt(" #n ")" ::: "memory")
#define PG8_WAIT_L(n) asm volatile("s_waitcnt lgkmcnt(" #n ")" ::: "memory")
#define PG8_BAR __builtin_amdgcn_s_barrier()
#define PG8_SCHED __builtin_amdgcn_sched_barrier(0)
    Unit cur, nxt; int ui = 0;
    if (!S.next(0, cur)) return;
    f32x4 acc[2][2][4][2];
#pragma unroll
    for (int a = 0; a < 2; ++a)
#pragma unroll
        for (int b = 0; b < 2; ++b)
#pragma unroll
            for (int m = 0; m < 4; ++m)
#pragma unroll
                for (int n = 0; n < 2; ++n) acc[a][b][m][n] = (f32x4){0.f, 0.f, 0.f, 0.f};
    bf16x8 At[4][2], B0[2][2], B1[2][2];
    const char* cA = (const char*)g.A + (size_t)cur.pm * tstepA; const char* cB = (const char*)g.Bt + (size_t)cur.pn * tstepB;
    PG8_STAGE(PG8_SB(0, 0), cB, voffB); PG8_STAGE(PG8_SB(0, 1), cB + hstepB, voffB); PG8_STAGE(PG8_SA(0, 0), cA, voffA); PG8_STAGE(PG8_SA(0, 1), cA + hstepA, voffA);
    if (wr == 1) PG8_BAR;
    PG8_WAIT_V(2); PG8_BAR;
    PG8_STAGE(PG8_SB(1, 0), cB + kstep, voffB); PG8_STAGE(PG8_SA(1, 0), cA + kstep, voffA); PG8_STAGE(PG8_SB(1, 1), cB + hstepB + kstep, voffB);
    PG8_WAIT_V(6); PG8_BAR;
    for (;;) {
        const bool has_next = S.next(ui + 1, nxt);
        const char* nA = has_next ? (const char*)g.A + (size_t)nxt.pm * tstepA : cA; const char* nB = has_next ? (const char*)g.Bt + (size_t)nxt.pn * tstepB : cB;
        for (int t = 0; t < nt; t += 2) {
            const bool last = (t == nt - 2);
            const char* a1 = cA + (size_t)(t + 1) * kstep;
            const char* a2 = last ? nA : cA + (size_t)(t + 2) * kstep; const char* b2 = last ? nB : cB + (size_t)(t + 2) * kstep;
            const char* a3 = a2 + kstep; const char* b3 = b2 + kstep;
            PG8_LDB(B0, 0, 0); PG8_LDB(B1, 0, 1); PG8_SCHED; PG8_LDA(At, 0, 0); PG8_STAGE(PG8_SA(1, 1), a1 + hstepA, voffA);
            PG8_WAIT_V(8); PG8_WAIT_L(0); PG8_BAR; PG8_MMA(0, 0, At, B0); PG8_MMA(0, 1, At, B1); PG8_BAR; PG8_SCHED;
            PG8_LDA(At, 0, 1); PG8_STAGE(PG8_SB(0, 0), b2, voffB); PG8_STAGE(PG8_SB(0, 1), b2 + hstepB, voffB); PG8_STAGE(PG8_SA(0, 0), a2, voffA);
            PG8_WAIT_V(8); PG8_WAIT_L(0); PG8_BAR; PG8_MMA(1, 0, At, B0); PG8_MMA(1, 1, At, B1); PG8_BAR; PG8_SCHED;
            PG8_LDB(B0, 1, 0); PG8_LDB(B1, 1, 1); PG8_SCHED; PG8_LDA(At, 1, 0); PG8_STAGE(PG8_SA(0, 1), a2 + hstepA, voffA);
            PG8_WAIT_V(8); PG8_WAIT_L(0); PG8_BAR; PG8_MMA(0, 0, At, B0); PG8_MMA(0, 1, At, B1); PG8_BAR; PG8_SCHED;
            PG8_LDA(At, 1, 1); PG8_STAGE(PG8_SB(1, 0), b3, voffB); PG8_STAGE(PG8_SB(1, 1), b3 + hstepB, voffB); PG8_STAGE(PG8_SA(1, 0), a3, voffA);
            PG8_WAIT_V(8); PG8_WAIT_L(0); PG8_BAR; PG8_MMA(1, 0, At, B0); PG8_MMA(1, 1, At, B1); PG8_BAR; PG8_SCHED;
        }
        if constexpr (ALIGN_EPI) { if (wr == 0) PG8_BAR; }
        E(acc, cur, wr, wc, fr, fq);
        if (!has_next) break;
#pragma unroll
        for (int a = 0; a < 2; ++a)
#pragma unroll
            for (int b = 0; b < 2; ++b)
#pragma unroll
                for (int m = 0; m < 4; ++m)
#pragma unroll
                    for (int n = 0; n < 2; ++n) acc[a][b][m][n] = (f32x4){0.f, 0.f, 0.f, 0.f};
        cur = nxt; cA = nA; cB = nB; ++ui;
        if constexpr (ALIGN_EPI) { if (wr == 1) PG8_BAR; }
    }
    PG8_WAIT_V(0);
    if constexpr (!ALIGN_EPI) { if (wr == 0) PG8_BAR; }
    PG8_BAR;
#undef PG8_SA
#undef PG8_SB
#undef PG8_STAGE
#undef PG8_LDA
#undef PG8_LDB
#undef PG8_MMA
#undef PG8_WAIT_V
#undef PG8_WAIT_L
#undef PG8_BAR
#undef PG8_SCHED
}

#define EPI_ROWS_BEGIN  _Pragma("unroll") for (int ai = 0; ai < 2; ++ai) _Pragma("unroll") for (int m = 0; m < 4; ++m) { const int row = u.pm * BM + ai * HALF + wr * 64 + m * 16 + fr;
#define EPI_COLS_BEGIN  _Pragma("unroll") for (int bj = 0; bj < 2; ++bj) _Pragma("unroll") for (int n = 0; n < 2; ++n) { const int col = bj * HALF + wc * 32 + n * 16 + 4 * fq; f32x4 v = acc[ai][bj][m][n];
#define EPI_END } }

struct EpiG1 {
    const float* rs; bf16_t* ZM; bf16_t* ZT;
    __device__ __forceinline__ void operator()(const f32x4 (&acc)[2][2][4][2], const Unit& u, int wr, int wc, int fr, int fq) const {
        const int pn = u.pn;
        if (pn >= 4 && pn < 8) {
            const int trow0 = (pn - 4) * 256;
            EPI_ROWS_BEGIN const float s = rs[row];
            EPI_COLS_BEGIN
                bf16_t* d = ZT + (size_t)(trow0 + col) * MTOK + row;
                d[0] = (bf16_t)f2bf(v[0] * s); d[(size_t)MTOK] = (bf16_t)f2bf(v[1] * s); d[(size_t)2 * MTOK] = (bf16_t)f2bf(v[2] * s); d[(size_t)3 * MTOK] = (bf16_t)f2bf(v[3] * s);
            EPI_END
        } else {
            const int cm = (pn < 4 ? pn : pn - 4) * 256;
            EPI_ROWS_BEGIN const float s = rs[row];
            EPI_COLS_BEGIN
                u32x2 w; w.x = pk2(v[0] * s, v[1] * s); w.y = pk2(v[2] * s, v[3] * s);
                *(u32x2*)(ZM + (size_t)row * ZMW + cm + col) = w;
            EPI_END
        }
    }
};
struct EpiDFT {
    bf16_t* Y;
    __device__ __forceinline__ void operator()(const f32x4 (&acc)[2][2][4][2], const Unit& u, int wr, int wc, int fr, int fq) const {
        int tok0, R, q;
        if (u.pm < 128) { tok0 = (u.pm >> 2) * 2048; R = 4; q = u.pm & 3; } else { const int t = u.pm - 128; tok0 = MP + (t >> 4) * 8192; R = 16; q = t & 15; }
        EPI_ROWS_BEGIN const int p = row - u.pm * BM;
        EPI_COLS_BEGIN
            const int k0 = u.pn * BM + col;
            bf16_t* d = Y + (size_t)(tok0 + R * k0 + q) * DM + 512 + p;
            d[0] = (bf16_t)f2bf(v[0]); d[(size_t)R * DM] = (bf16_t)f2bf(v[1]); d[(size_t)2 * R * DM] = (bf16_t)f2bf(v[2]); d[(size_t)3 * R * DM] = (bf16_t)f2bf(v[3]);
        EPI_END
    }
};
struct EpiG2 {
    const float* rs; bf16_t* Y;
    __device__ __forceinline__ void operator()(const f32x4 (&acc)[2][2][4][2], const Unit& u, int wr, int wc, int fr, int fq) const {
        EPI_ROWS_BEGIN const float s = rs[row];
        EPI_COLS_BEGIN
            u32x2* p = (u32x2*)(Y + (size_t)row * DM + u.pn * BM + col);
            const u32x2 y = *p; u32x2 w;
            w.x = pk2(bflo(y.x) * siluf_(v[0] * s), bfhi(y.x) * siluf_(v[1] * s)); w.y = pk2(bflo(y.y) * siluf_(v[2] * s), bfhi(y.y) * siluf_(v[3] * s));
            *p = w;
        EPI_END
    }
};
struct EpiStore {
    bf16_t* O;
    __device__ __forceinline__ void operator()(const f32x4 (&acc)[2][2][4][2], const Unit& u, int wr, int wc, int fr, int fq) const {
        EPI_ROWS_BEGIN
        EPI_COLS_BEGIN
            u32x2 w; w.x = pk2(v[0], v[1]); w.y = pk2(v[2], v[3]);
            *(u32x2*)(O + (size_t)row * DM + u.pn * BM + col) = w;
        EPI_END
    }
};
struct EpiMerge {
    const float* rs; const bf16_t* P; bf16_t* MG; int add;
    __device__ __forceinline__ void operator()(const f32x4 (&acc)[2][2][4][2], const Unit& u, int wr, int wc, int fr, int fq) const {
        EPI_ROWS_BEGIN const float s = rs[row];
        EPI_COLS_BEGIN
            const size_t off = (size_t)row * DM + u.pn * BM + col;
            const u32x2 pv = *(const u32x2*)(P + off);
            float r0 = bflo(pv.x) * sigmoidf_(v[0] * s), r1 = bfhi(pv.x) * sigmoidf_(v[1] * s), r2 = bflo(pv.y) * sigmoidf_(v[2] * s), r3 = bfhi(pv.y) * sigmoidf_(v[3] * s);
            if (add) { const u32x2 mv = *(const u32x2*)(MG + off); r0 += bflo(mv.x); r1 += bfhi(mv.x); r2 += bflo(mv.y); r3 += bfhi(mv.y); }
            u32x2 w; w.x = pk2(r0, r1); w.y = pk2(r2, r3);
            *(u32x2*)(MG + off) = w;
        EPI_END
    }
};
struct EpiG5 {
    bf16_t* O; float* ss;
    __device__ __forceinline__ void operator()(const f32x4 (&acc)[2][2][4][2], const Unit& u, int wr, int wc, int fr, int fq) const {
        EPI_ROWS_BEGIN float q = 0.f;
        EPI_COLS_BEGIN
            u32x2 w; w.x = pk2(v[0], v[1]); w.y = pk2(v[2], v[3]);
            *(u32x2*)(O + (size_t)row * DM + u.pn * BM + col) = w;
            q += (v[0] * v[0] + v[1] * v[1]) + (v[2] * v[2] + v[3] * v[3]);
        }
            q += __shfl_xor(q, 16); q += __shfl_xor(q, 32);
            if (fq == 0) atomicAdd(ss + row, q);
        }
    }
};
}

__device__ __forceinline__ void transpose_item(const float* W, int K, int pitch, int c0, int ncols, bf16_t* WT, int row_off, const float* g, float scale, LAS float* scr, int item, int lane) {
    const int nblk = ncols / 32, kb = item / nblk, nb = item % nblk, k0 = 64 * kb, n0 = 32 * nb;
#pragma unroll 8
    for (int i = 0; i < 32; ++i) { const int kk = 2 * i + (lane >> 5); float w = W[(size_t)(k0 + kk) * pitch + c0 + n0 + (lane & 31)] * scale; if (g) w *= g[k0 + kk]; scr[kk * 33 + (lane & 31)] = w; }
    LDS_WAIT(); asm volatile("" ::: "memory");
    const int c = lane & 7;
#pragma unroll
    for (int j = 0; j < 4; ++j) { const int n = (lane >> 3) + 8 * j; const LAS float* s = scr + (8 * c) * 33 + n;
        u32x4 o; o.x = pk2(s[0 * 33], s[1 * 33]); o.y = pk2(s[2 * 33], s[3 * 33]); o.z = pk2(s[4 * 33], s[5 * 33]); o.w = pk2(s[6 * 33], s[7 * 33]);
        *(u32x4*)(WT + (size_t)(row_off + n0 + n) * K + k0 + 8 * c) = o; }
    LDS_WAIT(); asm volatile("" ::: "memory");
}

struct Args { const float* in[14]; float* out; unsigned char* ws; int ph_lo, ph_hi; };

__device__ __forceinline__ void grid_row_info(int gr, int& seqbase, int& r, int& nrows) {
    if (gr < 1024) { seqbase = (gr >> 5) << 11; r = gr & 31; nrows = 32; } else { const int g2 = gr - 1024; seqbase = MP + ((g2 >> 7) << 13); r = g2 & 127; nrows = 128; }
}

__device__ __forceinline__ void attn_row(int gr, int head, int lane, const bf16_t* ZM, const bf16_t* ZT, bf16_t* Y, const LAS float* bias  ) {
    int seqbase, r, nrows; grid_row_info(gr, seqbase, r, nrows);
    int rstart = r - 4; rstart = rstart < 0 ? 0 : rstart; rstart = rstart > nrows - 8 ? nrows - 8 : rstart;
    const int qi = lane & 15, h4 = lane >> 4;
#pragma unroll 1
    for (int g = 0; g < 4; ++g) {
        const int cs = (g == 0) ? 0 : (g == 1) ? 8 : (g == 2) ? 24 : 32;
        const int qc = 16 * g + qi;
        const int qtok = seqbase + r * 64 + qc;
        const bf16x8 bq0 = *(const bf16x8*)(ZM + (size_t)qtok * ZMW + head * 64 + 8 * h4);
        const bf16x8 bq1 = *(const bf16x8*)(ZM + (size_t)qtok * ZMW + head * 64 + 32 + 8 * h4);
        int cst = qc - 8; cst = cst < 0 ? 0 : cst; cst = cst > 48 ? 48 : cst;
        f32x4 S[16];
        float mx = -3.0e38f;
#pragma unroll
        for (int kr = 0; kr < 8; ++kr) {
            const LAS float* brow = bias + (rstart + kr - r + 7) * 31;
#pragma unroll
            for (int hf = 0; hf < 2; ++hf) {
                const int ktok = seqbase + (rstart + kr) * 64 + cs + 16 * hf + qi;
                const bf16x8 ak0 = *(const bf16x8*)(ZM + (size_t)ktok * ZMW + 512 + head * 64 + 8 * h4);
                const bf16x8 ak1 = *(const bf16x8*)(ZM + (size_t)ktok * ZMW + 512 + head * 64 + 32 + 8 * h4);
                f32x4 s = {0.f, 0.f, 0.f, 0.f};
                s = __builtin_amdgcn_mfma_f32_16x16x32_bf16(ak0, bq0, s, 0, 0, 0);
                s = __builtin_amdgcn_mfma_f32_16x16x32_bf16(ak1, bq1, s, 0, 0, 0);
#pragma unroll
                for (int e = 0; e < 4; ++e) {
                    const int kc = cs + 16 * hf + 4 * h4 + e;
                    const bool valid = (kc >= cst) && (kc < cst + 16);
                    int dc = kc - qc + 15; dc = dc < 0 ? 0 : dc; dc = dc > 30 ? 30 : dc;
                    const float val = valid ? s[e] + brow[dc] : -1.0e30f;
                    s[e] = val; mx = fmaxf(mx, val);
                }
                S[kr * 2 + hf] = s;
            }
        }
        mx = fmaxf(mx, __shfl_xor(mx, 16)); mx = fmaxf(mx, __shfl_xor(mx, 32));
        float sum = 0.f;
        bf16x8 pf[8];
#pragma unroll
        for (int kr = 0; kr < 8; ++kr) {
            const f32x4 a = S[kr * 2], b = S[kr * 2 + 1];
            const float p0 = __expf(a[0] - mx), p1 = __expf(a[1] - mx), p2 = __expf(a[2] - mx), p3 = __expf(a[3] - mx);
            const float p4 = __expf(b[0] - mx), p5 = __expf(b[1] - mx), p6 = __expf(b[2] - mx), p7 = __expf(b[3] - mx);
            sum += ((p0 + p1) + (p2 + p3)) + ((p4 + p5) + (p6 + p7));
            u32x4 w; w.x = pk2(p0, p1); w.y = pk2(p2, p3); w.z = pk2(p4, p5); w.w = pk2(p6, p7);
            pf[kr] = __builtin_bit_cast(bf16x8, w);
        }
        sum += __shfl_xor(sum, 16); sum += __shfl_xor(sum, 32);
        const float inv = 1.0f / sum;
#pragma unroll
        for (int dt = 0; dt < 4; ++dt) {
            f32x4 o = {0.f, 0.f, 0.f, 0.f};
            const bf16_t* vrow = ZT + (size_t)(head * 64 + dt * 16 + qi) * MTOK + seqbase + cs + 4 * h4;
#pragma unroll
            for (int kr = 0; kr < 8; ++kr) {
                const u32x2 lo = *(const u32x2*)(vrow + (rstart + kr) * 64);
                const u32x2 hi = *(const u32x2*)(vrow + (rstart + kr) * 64 + 16);
                u32x4 w; w.x = lo.x; w.y = lo.y; w.z = hi.x; w.w = hi.y;
                o = __builtin_amdgcn_mfma_f32_16x16x32_bf16(__builtin_bit_cast(bf16x8, w), pf[kr], o, 0, 0, 0);
            }
            u32x2 w; w.x = pk2(o[0] * inv, o[1] * inv); w.y = pk2(o[2] * inv, o[3] * inv);
            *(u32x2*)(Y + (size_t)qtok * DM + head * 64 + dt * 16 + 4 * h4) = w;
        }
    }
}

template <int R>
__device__ __forceinline__ void butterfly_unit(int tok0, int rowbase  , int p, int lp, const bf16_t* ZT, bf16_t* YQ) {
    constexpr int L = 512 * R;
    const bf16_t* zre = ZT + (size_t)(512 + p) * MTOK + tok0 + lp;
    const bf16_t* zim = ZT + (size_t)(768 + p) * MTOK + tok0 + lp;
    float xr[R], xi[R];
#pragma unroll
    for (int s = 0; s < R; ++s) { xr[s] = bf2f(zre[512 * s]); xi[s] = bf2f(zim[512 * s]); }
    const float scale = rsqrtf(64.0f * (float)L);
#pragma unroll 1
    for (int q = 0; q < R; ++q) {
        float wr_, wi_; sincospif(-2.0f * (float)q / (float)R, &wi_, &wr_);
        float yr = xr[R - 1], yi = xi[R - 1];
#pragma unroll
        for (int s = R - 2; s >= 0; --s) { const float tr = yr * wr_ - yi * wi_ + xr[s], ti = yr * wi_ + yi * wr_ + xi[s]; yr = tr; yi = ti; }
        float tr_, ti_; sincospif(-2.0f * (float)(q * lp) / (float)L, &ti_, &tr_);
        const float orr = (yr * tr_ - yi * ti_) * scale, oi = (yr * ti_ + yi * tr_) * scale;
        bf16_t* d = YQ + (size_t)(rowbase + q * 256) * 1024 + lp;
        d[0] = (bf16_t)f2bf(orr); d[512] = (bf16_t)f2bf(oi);
    }
}

__global__ void __launch_bounds__(NWAVES * 64, 2) fwd_kernel(Args args) {
    extern __shared__ __attribute__((aligned(16))) unsigned char lds_raw[];
    LAS unsigned char* lds = (LAS unsigned char*)lds_raw;
    const int G = gridDim.x, bx = blockIdx.x;
    for (int ph = args.ph_lo; ph < args.ph_hi; ++ph) {
        if (ph > args.ph_lo) { cg::this_grid().sync(); }
        int tid = threadIdx.x; asm volatile("" : "+v"(tid));
        const int lane = tid & 63, wave = __builtin_amdgcn_readfirstlane(tid >> 6);
        const int gw = bx * NWAVES + wave, NGW = G * NWAVES;
        unsigned char* ws = args.ws; asm volatile("" : "+s"(ws));
        const float* x_prompt = args.in[0]; const float* x_sample = args.in[1];
        float* out = args.out;
        bf16_t* XB = (bf16_t*)(ws + WS_XB); bf16_t* OB = XB;
        bf16_t* ZM = (bf16_t*)(ws + WS_ZM); bf16_t* PB = ZM;
        bf16_t* ZT = (bf16_t*)(ws + WS_ZT); bf16_t* MG = ZT;
        bf16_t* YQ = (bf16_t*)(ws + WS_YQ);
        bf16_t* Y = (bf16_t*)(ws + WS_Y);
        bf16_t* TT = (bf16_t*)(ws + WS_T);
        float* RS = (float*)(ws + WS_RS); float* SS = (float*)(ws + WS_SS);
        const int layer = (ph == 0) ? 0 : (ph - 1) / 7;
        const int sub = (ph == 0) ? -1 : (ph - 1) % 7;
        const bf16_t* WIN = (const bf16_t*)(ws + WS_WIN) + (size_t)layer * NG1 * DM;
        const bf16_t* WG = (const bf16_t*)(ws + WS_WG) + (size_t)layer * DM * DM;
        const bf16_t* WM = (const bf16_t*)(ws + WS_WM) + (size_t)layer * 3072 * DM;
        const bf16_t* WA = (const bf16_t*)(ws + WS_WA) + (size_t)layer * DM * 512;
        const bf16_t* WB = (const bf16_t*)(ws + WS_WB) + (size_t)layer * DM * 256;
        const bf16_t* WC = (const bf16_t*)(ws + WS_WC) + (size_t)layer * DM * 256;
        const bf16_t* WO = (const bf16_t*)(ws + WS_WO) + (size_t)layer * DM * DM;

        if (PHON(0) && ph == 0) {
            LAS float* scr = (LAS float*)(lds + wave * 16384);
            for (int l = 0; l < 2; ++l) {
                const float* w_in = args.in[4] + (size_t)l * DM * DIN;
                const float* gpre = args.in[2] + l * DM;
                bf16_t* win = (bf16_t*)(ws + WS_WIN) + (size_t)l * NG1 * DM;
                bf16_t* wg = (bf16_t*)(ws + WS_WG) + (size_t)l * DM * DM;
                bf16_t* wm = (bf16_t*)(ws + WS_WM) + (size_t)l * 3072 * DM;
                for (int job = 0; job < 7; ++job) {
                    int c0, nc, ro; bf16_t* dst; float sc = 1.f;
                    switch (job) {
                        case 0: c0 = 0; nc = 512; dst = win; ro = 0; sc = 0.125f; break;
                        case 1: c0 = 512; nc = 1024; dst = win; ro = 512; break;
                        case 2: c0 = 2560; nc = 512; dst = win; ro = 2048; break;
                        case 3: c0 = 1536; nc = 512; dst = wg; ro = 0; break;
                        case 4: c0 = 2304; nc = 256; dst = wg; ro = 512; break;
                        case 5: c0 = 3072; nc = 256; dst = wg; ro = 768; break;
                        default: c0 = 3328; nc = 3072; dst = wm; ro = 0; break;
                    }
                    const int nitems = (DM / 64) * (nc / 32);
                    for (int it = gw; it < nitems; it += NGW) transpose_item(w_in, DM, DIN, c0, nc, dst, ro, gpre, sc, scr, it, lane);
                }
                {   const int ni = (512 / 64) * (DM / 32);
                    for (int it = gw; it < ni; it += NGW) transpose_item(args.in[10] + (size_t)l * 512 * DM, 512, DM, 0, DM, (bf16_t*)(ws + WS_WA) + (size_t)l * DM * 512, 0, nullptr, 1.f, scr, it, lane); }
                {   const int ni = (256 / 64) * (DM / 32);
                    for (int it = gw; it < ni; it += NGW) transpose_item(args.in[11] + (size_t)l * 256 * DM, 256, DM, 0, DM, (bf16_t*)(ws + WS_WB) + (size_t)l * DM * 256, 0, nullptr, 1.f, scr, it, lane);
                    for (int it = gw; it < ni; it += NGW) transpose_item(args.in[12] + (size_t)l * 256 * DM, 256, DM, 0, DM, (bf16_t*)(ws + WS_WC) + (size_t)l * DM * 256, 0, nullptr, 1.f, scr, it, lane); }
                {   const int ni = (DM / 64) * (DM / 32);
                    for (int it = gw; it < ni; it += NGW) transpose_item(args.in[13] + (size_t)l * DM * DM, DM, DM, 0, DM, (bf16_t*)(ws + WS_WO) + (size_t)l * DM * DM, 0, nullptr, 1.f, scr, it, lane); }
                for (int idx = bx * 512 + tid; idx < DM * 256; idx += G * 512) {
                    const int k = idx >> 8, p = idx & 255, grp = p >> 6, mm = p & 63;
                    const float* wrow = w_in + (size_t)k * DIN + 2048 + grp * 64;
                    float are = 0.f, aim = 0.f;
                    for (int c = 0; c < 64; ++c) { float sn, cs; sincospif((float)((mm * c) & 63) * (1.0f / 32.0f), &sn, &cs); const float w = wrow[c]; are += w * cs; aim -= w * sn; }
                    const float gk = gpre[k];
                    win[(size_t)(1536 + p) * DM + k] = (bf16_t)f2bf(are * gk);
                    win[(size_t)(1536 + 256 + p) * DM + k] = (bf16_t)f2bf(aim * gk);
                }
            }
            for (int idx = bx * 512 + tid; idx < 512 * 512; idx += G * 512) {
                const int kp = idx >> 9, lp = idx & 511; float sn, cs; sincospif((float)((kp * lp) & 511) * (1.0f / 256.0f), &sn, &cs);
                TT[(size_t)kp * 1024 + lp] = (bf16_t)f2bf(cs); TT[(size_t)kp * 1024 + 512 + lp] = (bf16_t)f2bf(sn);
            }
        }
        if (PHON(1) && (ph == 0 || sub == 6)) {
            const int mode = (ph == 0) ? 0 : (layer == 0 ? 1 : 2);
            const float* gpost = args.in[3] + layer * DM;
            for (int m = gw; m < MTOK; m += NGW) {
                const float* xin = (mode == 2) ? (out + (size_t)m * DM) : ((m < MP) ? x_prompt + (size_t)m * DM : x_sample + (size_t)(m - MP) * DM);
                const f32x4* xr = (const f32x4*)xin + lane;
                f32x4 v[4];
#pragma unroll
                for (int j = 0; j < 4; ++j) v[j] = xr[64 * j];
                if (mode != 0) {
                    const float rq = rsqrtf(SS[m] * (1.0f / DM) + EPS);
                    const u32x2* orow = (const u32x2*)(OB + (size_t)m * DM) + lane;
#pragma unroll
                    for (int j = 0; j < 4; ++j) { const u32x2 ov = orow[64 * j]; const f32x4 gp = *((const f32x4*)gpost + lane + 64 * j);
                        v[j][0] += bflo(ov.x) * rq * gp[0]; v[j][1] += bfhi(ov.x) * rq * gp[1]; v[j][2] += bflo(ov.y) * rq * gp[2]; v[j][3] += bfhi(ov.y) * rq * gp[3]; }
                    f32x4* orow2 = (f32x4*)(out + (size_t)m * DM) + lane;
#pragma unroll
                    for (int j = 0; j < 4; ++j) orow2[64 * j] = v[j];
                }
                if (mode != 2) {
                    float s = 0.f;
#pragma unroll
                    for (int j = 0; j < 4; ++j) s += (v[j][0] * v[j][0] + v[j][1] * v[j][1]) + (v[j][2] * v[j][2] + v[j][3] * v[j][3]);
                    s = wave_sum(s);
                    u32x2* o8 = (u32x2*)(XB + (size_t)m * DM) + lane;
#pragma unroll
                    for (int j = 0; j < 4; ++j) { u32x2 w; w.x = pk2(v[j][0], v[j][1]); w.y = pk2(v[j][2], v[j][3]); o8[64 * j] = w; }
                    if (lane == 0) { RS[m] = rsqrtf(s * (1.0f / DM) + EPS); SS[m] = 0.f; }
                }
            }
        } else if (PHON(2) && sub == 0) {
            pg8::Gemm g{XB, WIN, MTOK, NG1, DM, DM, DM}; pg8::StaticOrder S; S.init(MTOK, NG1, G, bx);
            pg8::EpiG1 E{RS, ZM, ZT};
            pg8::gemm_phase<pg8::EpiG1, true>(lds, g, S, E);
        } else if (sub == 1) {
            if (PHON(3)) {
                LAS float* bt = (LAS float*)lds;
                const float* rpb = args.in[5] + (size_t)layer * 8 * 15 * 31;
                for (int i = tid; i < 8 * 15 * 31; i += 512) bt[i] = rpb[i];
                __syncthreads();
                const int per = (1536 + G - 1) / G;
                for (int i = 0; i < per; ++i) { const int gr = bx * per + i; if (gr < 1536) attn_row(gr, wave, lane, ZM, ZT, Y, bt + wave * 465); }
                __syncthreads();
            }
            if (PHON(4)) {
                LAS float* hbuf = (LAS float*)lds; LAS float* cbuf = (LAS float*)(lds + 65536);
                const float* dww = args.in[6] + (size_t)layer * 31 * 256; const float* dwb = args.in[7] + layer * 256;
                const float* lng = args.in[8] + layer * 256; const float* lnb = args.in[9] + layer * 256;
                const int c = tid & 255, half = tid >> 8;
                float w[31];
#pragma unroll
                for (int j = 0; j < 31; ++j) w[j] = dww[j * 256 + c];
                const float bc = dwb[c];
                const f32x4 lg = *((const f32x4*)lng + lane), lb = *((const f32x4*)lnb + lane);
                for (int cu = bx; cu < MTOK / 32; cu += G) {
                    const int t0g = cu * 32;
                    int sbeg, send; if (t0g < MP) { sbeg = t0g & ~2047; send = sbeg + 2048; } else { sbeg = MP + ((t0g - MP) & ~8191); send = sbeg + 8192; }
                    for (int it = tid; it < 62 * 32; it += 512) {
                        const int i = it >> 5, c8 = (it & 31) * 8; const int tok = t0g - 15 + i;
                        f32x4 h0 = {0.f, 0.f, 0.f, 0.f}, h1 = {0.f, 0.f, 0.f, 0.f};
                        if (tok >= sbeg && tok < send) {
                            const u32x4 a = *(const u32x4*)(ZM + (size_t)tok * ZMW + 1024 + c8), b = *(const u32x4*)(ZM + (size_t)tok * ZMW + 1280 + c8);
                            h0[0] = bflo(a.x) * sigmoidf_(bflo(b.x)); h0[1] = bfhi(a.x) * sigmoidf_(bfhi(b.x)); h0[2] = bflo(a.y) * sigmoidf_(bflo(b.y)); h0[3] = bfhi(a.y) * sigmoidf_(bfhi(b.y));
                            h1[0] = bflo(a.z) * sigmoidf_(bflo(b.z)); h1[1] = bfhi(a.z) * sigmoidf_(bfhi(b.z)); h1[2] = bflo(a.w) * sigmoidf_(bflo(b.w)); h1[3] = bfhi(a.w) * sigmoidf_(bfhi(b.w));
                        }
                        *(LAS f32x4*)(hbuf + i * 256 + c8) = h0; *(LAS f32x4*)(hbuf + i * 256 + c8 + 4) = h1;
                    }
                    __syncthreads();
#pragma unroll 1
                    for (int tt = 0; tt < 16; ++tt) {
                        const int t = half * 16 + tt; float a = bc;
#pragma unroll
                        for (int j = 0; j < 31; ++j) a += w[j] * hbuf[(t + j) * 256 + c];
                        cbuf[t * 256 + c] = a;
                    }
                    __syncthreads();
#pragma unroll 1
                    for (int tt = 0; tt < 4; ++tt) {
                        const int t = wave * 4 + tt;
                        const f32x4 xv = *(const LAS f32x4*)(cbuf + t * 256 + 4 * lane);
                        const float mean = wave_sum((xv[0] + xv[1]) + (xv[2] + xv[3])) * (1.0f / 256.0f);
                        const f32x4 d = xv - mean;
                        const float var = wave_sum((d[0] * d[0] + d[1] * d[1]) + (d[2] * d[2] + d[3] * d[3])) * (1.0f / 256.0f);
                        const float rstd = rsqrtf(var + EPS);
                        const float y0 = siluf_(d[0] * rstd * lg[0] + lb[0]), y1 = siluf_(d[1] * rstd * lg[1] + lb[1]), y2 = siluf_(d[2] * rstd * lg[2] + lb[2]), y3 = siluf_(d[3] * rstd * lg[3] + lb[3]);
                        u32x2 wv; wv.x = pk2(y0, y1); wv.y = pk2(y2, y3);
                        *(u32x2*)(Y + (size_t)(t0g + t) * DM + 768 + 4 * lane) = wv;
                    }
                    __syncthreads();
                }
            }
            if (PHON(5)) {
                for (int un = bx; un < 32 * 256; un += G) { const int seq = un >> 8, p = un & 255; butterfly_unit<4>(seq * 2048, seq * 1024 + p, p, tid, ZT, YQ); }
                for (int un = bx; un < 4 * 256; un += G) { const int seq = un >> 8, p = un & 255; butterfly_unit<16>(MP + seq * 8192, 32768 + seq * 4096 + p, p, tid, ZT, YQ); }
            }
        } else if (PHON(6) && sub == 2) {
            pg8::Gemm g{YQ, TT, NYQ, 512, 1024, 1024, 1024}; pg8::StaticOrder S; S.init(NYQ, 512, G, bx);
            pg8::EpiDFT E{Y};
            pg8::gemm_phase<pg8::EpiDFT, true>(lds, g, S, E);
        } else if (PHON(7) && sub == 3) {
            pg8::Gemm g{XB, WG, MTOK, DM, DM, DM, DM}; pg8::StaticOrder S; S.init(MTOK, DM, G, bx);
            pg8::EpiG2 E{RS, Y};
            pg8::gemm_phase<pg8::EpiG2, true>(lds, g, S, E);
        } else if (sub == 4) {
            pg8::StaticOrder S; S.init(MTOK, DM, G, bx);
#pragma unroll 1
            for (int b = 0; b < 3; ++b) {
                const int kb = (b == 0) ? 512 : 256, aoffc = (b == 0) ? 0 : (b == 1 ? 512 : 768);
                const bf16_t* wb = (b == 0) ? WA : (b == 1 ? WB : WC);
                pg8::Gemm gp{Y + aoffc, wb, MTOK, DM, kb, DM, kb};
                pg8::EpiStore EP{PB};
                if (PHON(8)) pg8::gemm_phase<pg8::EpiStore, true>(lds, gp, S, EP);
                pg8::Gemm gm{XB, WM + (size_t)b * DM * DM, MTOK, DM, DM, DM, DM};
                pg8::EpiMerge EM{RS, PB, MG, b};
                if (PHON(9)) pg8::gemm_phase<pg8::EpiMerge, true>(lds, gm, S, EM);
            }
        } else if (PHON(10) && sub == 5) {
            pg8::Gemm g{MG, WO, MTOK, DM, DM, DM, DM}; pg8::StaticOrder S; S.init(MTOK, DM, G, bx);
            pg8::EpiG5 E{OB, SS};
            pg8::gemm_phase<pg8::EpiG5, true>(lds, g, S, E);
        }
    }
}

extern "C" void kernel_launch(void* const* d_in, const int* in_sizes, int n_in, void* d_out, int out_size, void* d_ws, size_t ws_size, hipStream_t stream) {
    static int grid = 0;
    if (grid == 0) {
        if (n_in != 14 || ws_size < WS_END) { fprintf(stderr, "kernel_launch: bad inputs (n_in %d, ws %zu < %zu)\n", n_in, ws_size, (size_t)WS_END); grid = -1; return; }
        int dev = 0, cus = 0, per_cu = 0;
        hipGetDevice(&dev); hipDeviceGetAttribute(&cus, hipDeviceAttributeMultiprocessorCount, dev);
        if (hipFuncSetAttribute((const void*)fwd_kernel, hipFuncAttributeMaxDynamicSharedMemorySize, LDS_BYTES) != hipSuccess) { fprintf(stderr, "hipFuncSetAttribute failed\n"); grid = -1; return; }
        hipOccupancyMaxActiveBlocksPerMultiprocessor(&per_cu, (const void*)fwd_kernel, NWAVES * 64, LDS_BYTES);
        (void)hipGetLastError();
        if (per_cu < 1) { fprintf(stderr, "occupancy query says 0 blocks per CU\n"); }
        grid = cus;
    }
    if (grid < 0) return;
    Args a{};
    for (int i = 0; i < 14; ++i) a.in[i] = (const float*)d_in[i];
    a.out = (float*)d_out; a.ws = (unsigned char*)d_ws;
#if MK_ONE_LAUNCH
    a.ph_lo = 0; a.ph_hi = 15;
    void* kargs[] = {&a};
    hipError_t e = hipLaunchCooperativeKernel((const void*)fwd_kernel, dim3(grid), dim3(NWAVES * 64), kargs, LDS_BYTES, stream);
    if (e != hipSuccess) fprintf(stderr, "cooperative launch failed: %s (grid %d)\n", hipGetErrorString(e), grid);
#else
    for (int ph = 0; ph < 15; ++ph) {
        a.ph_lo = ph; a.ph_hi = ph + 1;
        hipLaunchKernelGGL(fwd_kernel, dim3(grid), dim3(NWAVES * 64), LDS_BYTES, stream, a);
    }
#endif
}
```

```cpp
#include <hip/hip_runtime.h>
#include <hip/hip_cooperative_groups.h>
#include <cstdio>
#include <cstdint>
namespace cg = cooperative_groups;

#ifndef MK_ONE_LAUNCH
#define MK_ONE_LAUNCH 1
#endif

#ifndef PH_MASK
#define PH_MASK 0xFFFF
#endif
#define PHON(k) (((PH_MASK) >> (k)) & 1)
#define LAS __attribute__((address_space(3)))
typedef unsigned short bf16_t;
typedef short bf16x8 __attribute__((ext_vector_type(8)));
typedef short s16x4 __attribute__((ext_vector_type(4)));
typedef float f32x4 __attribute__((ext_vector_type(4)));
typedef unsigned u32x4 __attribute__((ext_vector_type(4)));
typedef unsigned u32x2 __attribute__((ext_vector_type(2)));

constexpr int DM = 1024;
constexpr int MP = 65536;
constexpr int MTOK = 98304;
constexpr int DIN = 6400;
constexpr int NG1 = 2560;
constexpr int ZMW = 1536;
constexpr int NYQ = 49152;
constexpr float EPS = 1e-6f;

constexpr size_t MiB = 1u << 20;
constexpr size_t WS_WIN = 0;
constexpr size_t WS_WG = 10 * MiB;
constexpr size_t WS_WM = 14 * MiB;
constexpr size_t WS_WA = 26 * MiB;
constexpr size_t WS_WB = 28 * MiB;
constexpr size_t WS_WC = 29 * MiB;
constexpr size_t WS_WO = 30 * MiB;
constexpr size_t WS_T = 34 * MiB;
constexpr size_t WS_RS = 35 * MiB;
constexpr size_t WS_SS = 35 * MiB + 512 * 1024;
constexpr size_t WS_XB = 36 * MiB;
constexpr size_t WS_ZM = 228 * MiB;
constexpr size_t WS_ZT = 516 * MiB;
constexpr size_t WS_YQ = 708 * MiB;
constexpr size_t WS_Y = 804 * MiB;
constexpr size_t WS_END = 996 * MiB;

constexpr int NWAVES = 8;
constexpr int LDS_BYTES = 147456;

__device__ __forceinline__ unsigned f2bf(float f) { unsigned u = __builtin_bit_cast(unsigned, f); return (u + 0x7fffu + ((u >> 16) & 1u)) >> 16; }
__device__ __forceinline__ unsigned pk2(float lo, float hi) { return f2bf(lo) | (f2bf(hi) << 16); }
__device__ __forceinline__ float bf2f(unsigned b) { return __builtin_bit_cast(float, b << 16); }
__device__ __forceinline__ float bflo(unsigned w) { return __builtin_bit_cast(float, w << 16); }
__device__ __forceinline__ float bfhi(unsigned w) { return __builtin_bit_cast(float, w & 0xffff0000u); }
__device__ __forceinline__ float sigmoidf_(float x) { return 1.0f / (1.0f + __expf(-x)); }
__device__ __forceinline__ float siluf_(float x) { return x / (1.0f + __expf(-x)); }
__device__ __forceinline__ float wave_sum(float v) {
#pragma unroll
    for (int o = 1; o < 64; o <<= 1) v += __shfl_xor(v, o);
    return v;
}
#define LDS_WAIT() asm volatile("s_waitcnt lgkmcnt(0)" ::: "memory")

namespace pg8 {
constexpr int BM = 256, BK = 64, HALF = 128, HTB = HALF * BK * 2, STAGE_BYTES = 8 * HTB, NXCD = 8, WGM = 8;
__device__ __forceinline__ int lds_byte(int r, int c) { const int st = (r >> 4) * 2 + (c >> 5), rr = r & 15, cc = c & 31, ob = rr * 64 + cc * 2; return st * 1024 + (ob ^ (((ob >> 9) & 1) << 5)); }
__device__ __forceinline__ void stage_rc(int b, int& R, int& C) { const int st = b / 1024, sb = b % 1024, swz = sb ^ (((sb >> 9) & 1) << 5); R = (st >> 1) * 16 + swz / 64; C = (st & 1) * 32 + (swz % 64) / 2; }

struct Unit { int pm, pn; };
struct Gemm { const bf16_t* A; const bf16_t* Bt; int M, N, K, lda, ldb; };

struct StaticOrder {
    int nM, nN, nwg, G, c;
    __device__ void init(int M, int N, int G_, int c_) { nM = M / BM; nN = N / BM; nwg = nM * nN; G = G_; c = c_; }
    __device__ bool next(int i, Unit& u) const {
        const long L = (long)i * G + c; if (L >= nwg) return false;
        int wgid = (int)L; { const int q = nwg / NXCD, r = nwg % NXCD, xcd = wgid % NXCD, off = wgid / NXCD; wgid = (xcd < r ? xcd * (q + 1) : r * (q + 1) + (xcd - r) * q) + off; }
        const int nig = WGM * nN, gid = wgid / nig, fm = gid * WGM, gsz = (nM - fm) < WGM ? (nM - fm) : WGM;
        u.pm = fm + ((wgid % nig) % gsz); u.pn = (wgid % nig) / gsz; return true;
    }
};

struct SingleUnit { Unit u; __device__ bool next(int i, Unit& o) const { if (i) return false; o = u; return true; } };
template <class Epi, class Sched, bool ALIGN_EPI>
__device__ __forceinline__ void gemm_phase(LAS unsigned char* lds, const Gemm g, const Sched& S, const Epi& E) {
    int tid = threadIdx.x; asm volatile("" : "+v"(tid));
    const int wid = __builtin_amdgcn_readfirstlane(tid >> 6), lane = tid & 63, wr = wid >> 2, wc = wid & 3, fr = lane & 15, fq = lane >> 4;
    const int K = g.K, nt = K / BK;
    unsigned voffA[2], voffB[2];
#pragma unroll
    for (int i = 0; i < 2; ++i) { int R, C; stage_rc(tid * 16 + i * 8192, R, C);
        voffA[i] = (unsigned)(R * g.lda + C) * 2u; voffB[i] = (unsigned)(R * g.ldb + C) * 2u; }
    const size_t kstep = (size_t)(BK * 2);
    const size_t hstepA = (size_t)HALF * g.lda * 2, hstepB = (size_t)HALF * g.ldb * 2;
    const size_t tstepA = 2 * hstepA, tstepB = 2 * hstepB;
    const unsigned ldsw = (unsigned)wid * 1024u;
    const int aoff = lds_byte(wr * 64 + fr, fq * 8), boff = lds_byte(wc * 32 + fr, fq * 8);
#define PG8_SA(b, h) (((b) * 2 + (h)) * HTB)
#define PG8_SB(b, h) ((4 + (b) * 2 + (h)) * HTB)
#define PG8_STAGE(bufoff, gbase, voff) do { _Pragma("unroll") for (int _i = 0; _i < 2; ++_i) \
        __builtin_amdgcn_global_load_lds((const unsigned*)((const char*)(gbase) + (voff)[_i]), (LAS unsigned*)(lds + (bufoff) + ldsw + _i * 8192), 16, 0, 0); } while (0)
#define PG8_LDA(dst, b, h) do { _Pragma("unroll") for (int m = 0; m < 4; ++m) _Pragma("unroll") for (int k = 0; k < 2; ++k) dst[m][k] = *(const LAS bf16x8*)(lds + PG8_SA(b, h) + aoff + m * 2048 + k * 1024); } while (0)
#define PG8_LDB(dst, b, h) do { _Pragma("unroll") for (int n = 0; n < 2; ++n) _Pragma("unroll") for (int k = 0; k < 2; ++k) dst[n][k] = *(const LAS bf16x8*)(lds + PG8_SB(b, h) + boff + n * 2048 + k * 1024); } while (0)
#define PG8_MMA(ai, bj, At, Bt) do { __builtin_amdgcn_s_setprio(1); _Pragma("unroll") for (int m = 0; m < 4; ++m) _Pragma("unroll") for (int n = 0; n < 2; ++n) _Pragma("unroll") for (int k = 0; k < 2; ++k) \
        acc[ai][bj][m][n] = __builtin_amdgcn_mfma_f32_16x16x32_bf16(Bt[n][k], At[m][k], acc[ai][bj][m][n], 0, 0, 0); __builtin_amdgcn_s_setprio(0); } while (0)
#define PG8_WAIT_V(n) asm volatile("s_waitcnt vmcnt(" #n ")" ::: "memory")
#define PG8_WAIT_L(n) asm volatile("s_waitcnt lgkmcnt(" #n ")" ::: "memory")
#define PG8_BAR __builtin_amdgcn_s_barrier()
#define PG8_SCHED __builtin_amdgcn_sched_barrier(0)
    Unit cur, nxt; int ui = 0;
    if (!S.next(0, cur)) return;
    f32x4 acc[2][2][4][2];
#pragma unroll
    for (int a = 0; a < 2; ++a)
#pragma unroll
        for (int b = 0; b < 2; ++b)
#pragma unroll
            for (int m = 0; m < 4; ++m)
#pragma unroll
                for (int n = 0; n < 2; ++n) acc[a][b][m][n] = (f32x4){0.f, 0.f, 0.f, 0.f};
    bf16x8 At[4][2], B0[2][2], B1[2][2];
    const char* cA = (const char*)g.A + (size_t)cur.pm * tstepA; const char* cB = (const char*)g.Bt + (size_t)cur.pn * tstepB;
    PG8_STAGE(PG8_SB(0, 0), cB, voffB); PG8_STAGE(PG8_SB(0, 1), cB + hstepB, voffB); PG8_STAGE(PG8_SA(0, 0), cA, voffA); PG8_STAGE(PG8_SA(0, 1), cA + hstepA, voffA);
    if (wr == 1) PG8_BAR;
    PG8_WAIT_V(2); PG8_BAR;
    PG8_STAGE(PG8_SB(1, 0), cB + kstep, voffB); PG8_STAGE(PG8_SA(1, 0), cA + kstep, voffA); PG8_STAGE(PG8_SB(1, 1), cB + hstepB + kstep, voffB);
    PG8_WAIT_V(6); PG8_BAR;
    for (;;) {
        const bool has_next = S.next(ui + 1, nxt);
        const char* nA = has_next ? (const char*)g.A + (size_t)nxt.pm * tstepA : cA; const char* nB = has_next ? (const char*)g.Bt + (size_t)nxt.pn * tstepB : cB;
        for (int t = 0; t < nt; t += 2) {
            const bool last = (t == nt - 2);
            const char* a1 = cA + (size_t)(t + 1) * kstep;
            const char* a2 = last ? nA : cA + (size_t)(t + 2) * kstep; const char* b2 = last ? nB : cB + (size_t)(t + 2) * kstep;
            const char* a3 = a2 + kstep; const char* b3 = b2 + kstep;
            PG8_LDB(B0, 0, 0); PG8_LDB(B1, 0, 1); PG8_SCHED; PG8_LDA(At, 0, 0); PG8_STAGE(PG8_SA(1, 1), a1 + hstepA, voffA);
            PG8_WAIT_V(8); PG8_WAIT_L(0); PG8_BAR; PG8_MMA(0, 0, At, B0); PG8_MMA(0, 1, At, B1); PG8_BAR; PG8_SCHED;
            PG8_LDA(At, 0, 1); PG8_STAGE(PG8_SB(0, 0), b2, voffB); PG8_STAGE(PG8_SB(0, 1), b2 + hstepB, voffB); PG8_STAGE(PG8_SA(0, 0), a2, voffA);
            PG8_WAIT_V(8); PG8_WAIT_L(0); PG8_BAR; PG8_MMA(1, 0, At, B0); PG8_MMA(1, 1, At, B1); PG8_BAR; PG8_SCHED;
            PG8_LDB(B0, 1, 0); PG8_LDB(B1, 1, 1); PG8_SCHED; PG8_LDA(At, 1, 0); PG8_STAGE(PG8_SA(0, 1), a2 + hstepA, voffA);
            PG8_WAIT_V(8); PG8_WAIT_L(0); PG8_BAR; PG8_MMA(0, 0, At, B0); PG8_MMA(0, 1, At, B1); PG8_BAR; PG8_SCHED;
            PG8_LDA(At, 1, 1); PG8_STAGE(PG8_SB(1, 0), b3, voffB); PG8_STAGE(PG8_SB(1, 1), b3 + hstepB, voffB); PG8_STAGE(PG8_SA(1, 0), a3, voffA);
            PG8_WAIT_V(8); PG8_WAIT_L(0); PG8_BAR; PG8_MMA(1, 0, At, B0); PG8_MMA(1, 1, At, B1); PG8_BAR; PG8_SCHED;
        }
        if constexpr (ALIGN_EPI) { if (wr == 0) PG8_BAR; }
        E(acc, cur, wr, wc, fr, fq);
        if (!has_next) break;
#pragma unroll
        for (int a = 0; a < 2; ++a)
#pragma unroll
            for (int b = 0; b < 2; ++b)
#pragma unroll
                for (int m = 0; m < 4; ++m)
#pragma unroll
                    for (int n = 0; n < 2; ++n) acc[a][b][m][n] = (f32x4){0.f, 0.f, 0.f, 0.f};
        cur = nxt; cA = nA; cB = nB; ++ui;
        if constexpr (ALIGN_EPI) { if (wr == 1) PG8_BAR; }
    }
    PG8_WAIT_V(0);
    if constexpr (!ALIGN_EPI) { if (wr == 0) PG8_BAR; }
    PG8_BAR;
#undef PG8_SA
#undef PG8_SB
#undef PG8_STAGE
#undef PG8_LDA
#undef PG8_LDB
#undef PG8_MMA
#undef PG8_WAIT_V
#undef PG8_WAIT_L
#undef PG8_BAR
#undef PG8_SCHED
}

#define EPI_ROWS_BEGIN  _Pragma("unroll") for (int ai = 0; ai < 2; ++ai) _Pragma("unroll") for (int m = 0; m < 4; ++m) { const int row = u.pm * BM + ai * HALF + wr * 64 + m * 16 + fr;
#define EPI_COLS_BEGIN  _Pragma("unroll") for (int bj = 0; bj < 2; ++bj) _Pragma("unroll") for (int n = 0; n < 2; ++n) { const int col = bj * HALF + wc * 32 + n * 16 + 4 * fq; f32x4 v = acc[ai][bj][m][n];
#define EPI_END } }

struct EpiG1 {
    const float* rs; bf16_t* ZM; bf16_t* ZT;
    __device__ __forceinline__ void operator()(const f32x4 (&acc)[2][2][4][2], const Unit& u, int wr, int wc, int fr, int fq) const {
        const int pn = u.pn;
        if (pn >= 4 && pn < 6) {
            const int d0 = (pn - 4) * 256;
            EPI_ROWS_BEGIN const float s = rs[row];
            EPI_COLS_BEGIN
                bf16_t* d = ZT + ((size_t)(row >> 6) * 512 + d0 + col) * 64 + (row & 63);
                d[0] = (bf16_t)f2bf(v[0] * s); d[64] = (bf16_t)f2bf(v[1] * s); d[128] = (bf16_t)f2bf(v[2] * s); d[192] = (bf16_t)f2bf(v[3] * s);
            EPI_END
        } else if (pn >= 6 && pn < 8) {
            const int j0 = (pn - 6) * 256;
            EPI_ROWS_BEGIN const float s = rs[row];
            EPI_COLS_BEGIN
                bf16_t* d = ZT + (size_t)MTOK * 512 + ((size_t)(row >> 9) * 512 + j0 + col) * 512 + (row & 511);
                d[0] = (bf16_t)f2bf(v[0] * s); d[512] = (bf16_t)f2bf(v[1] * s); d[1024] = (bf16_t)f2bf(v[2] * s); d[1536] = (bf16_t)f2bf(v[3] * s);
            EPI_END
        } else {
            const int cm = (pn < 4 ? pn : pn - 4) * 256;
            EPI_ROWS_BEGIN const float s = rs[row];
            EPI_COLS_BEGIN
                u32x2 w; w.x = pk2(v[0] * s, v[1] * s); w.y = pk2(v[2] * s, v[3] * s);
                *(u32x2*)(ZM + (size_t)row * ZMW + cm + col) = w;
            EPI_END
        }
    }
};
struct EpiDFT {
    bf16_t* Y;
    __device__ __forceinline__ void operator()(const f32x4 (&acc)[2][2][4][2], const Unit& u, int wr, int wc, int fr, int fq) const {
        int tok0, R, q;
        if (u.pm < 128) { tok0 = (u.pm >> 2) * 2048; R = 4; q = u.pm & 3; } else { const int t = u.pm - 128; tok0 = MP + (t >> 4) * 8192; R = 16; q = t & 15; }
        EPI_ROWS_BEGIN const int p = row - u.pm * BM;
        EPI_COLS_BEGIN
            const int k0 = u.pn * BM + col;
            bf16_t* d = Y + (size_t)(tok0 + R * k0 + q) * DM + 512 + p;
            d[0] = (bf16_t)f2bf(v[0]); d[(size_t)R * DM] = (bf16_t)f2bf(v[1]); d[(size_t)2 * R * DM] = (bf16_t)f2bf(v[2]); d[(size_t)3 * R * DM] = (bf16_t)f2bf(v[3]);
        EPI_END
    }
};
struct EpiG2 {
    const float* rs; bf16_t* Y;
    __device__ __forceinline__ void operator()(const f32x4 (&acc)[2][2][4][2], const Unit& u, int wr, int wc, int fr, int fq) const {
        EPI_ROWS_BEGIN const float s = rs[row];
        EPI_COLS_BEGIN
            u32x2* p = (u32x2*)(Y + (size_t)row * DM + u.pn * BM + col);
            const u32x2 y = *p; u32x2 w;
            w.x = pk2(bflo(y.x) * siluf_(v[0] * s), bfhi(y.x) * siluf_(v[1] * s)); w.y = pk2(bflo(y.y) * siluf_(v[2] * s), bfhi(y.y) * siluf_(v[3] * s));
            *p = w;
        EPI_END
    }
};
struct EpiStoreT {
    bf16_t* PT;
    __device__ __forceinline__ void operator()(const f32x4 (&acc)[2][2][4][2], const Unit& u, int wr, int wc, int fr, int fq) const {
        EPI_ROWS_BEGIN
        EPI_COLS_BEGIN
            u32x2 w; w.x = pk2(v[0], v[1]); w.y = pk2(v[2], v[3]);
            *(u32x2*)(PT + (size_t)(row - u.pm * BM) * 256 + col) = w;
        EPI_END
    }
};
struct EpiMergeT {
    const float* rs; const bf16_t* PT; bf16_t* MT; bf16_t* MG; int mode;
    __device__ __forceinline__ void operator()(const f32x4 (&acc)[2][2][4][2], const Unit& u, int wr, int wc, int fr, int fq) const {
        EPI_ROWS_BEGIN const float s = rs[row];
        EPI_COLS_BEGIN
            const size_t toff = (size_t)(row - u.pm * BM) * 256 + col;
            const u32x2 pv = *(const u32x2*)(PT + toff);
            float r0 = bflo(pv.x) * sigmoidf_(v[0] * s), r1 = bfhi(pv.x) * sigmoidf_(v[1] * s), r2 = bflo(pv.y) * sigmoidf_(v[2] * s), r3 = bfhi(pv.y) * sigmoidf_(v[3] * s);
            if (mode) { const u32x2 mv = *(const u32x2*)(MT + toff); r0 += bflo(mv.x); r1 += bfhi(mv.x); r2 += bflo(mv.y); r3 += bfhi(mv.y); }
            u32x2 w; w.x = pk2(r0, r1); w.y = pk2(r2, r3);
            if (mode == 2) *(u32x2*)(MG + (size_t)row * DM + u.pn * BM + col) = w; else *(u32x2*)(MT + toff) = w;
        EPI_END
    }
};
struct EpiG5 {
    bf16_t* O; float* ss;
    __device__ __forceinline__ void operator()(const f32x4 (&acc)[2][2][4][2], const Unit& u, int wr, int wc, int fr, int fq) const {
        EPI_ROWS_BEGIN float q = 0.f;
        EPI_COLS_BEGIN
            u32x2 w; w.x = pk2(v[0], v[1]); w.y = pk2(v[2], v[3]);
            *(u32x2*)(O + (size_t)row * DM + u.pn * BM + col) = w;
            q += (v[0] * v[0] + v[1] * v[1]) + (v[2] * v[2] + v[3] * v[3]);
        }
            q += __shfl_xor(q, 16); q += __shfl_xor(q, 32);
            if (fq == 0) atomicAdd(ss + row, q);
        }
    }
};
}

__device__ __forceinline__ void transpose_item(const float* W, int K, int pitch, int c0, int ncols, bf16_t* WT, int row_off, const float* g, float scale, LAS float* scr, int item, int lane) {
    const int nblk = ncols / 32, kb = item / nblk, nb = item % nblk, k0 = 64 * kb, n0 = 32 * nb;
#pragma unroll 8
    for (int i = 0; i < 32; ++i) { const int kk = 2 * i + (lane >> 5); float w = W[(size_t)(k0 + kk) * pitch + c0 + n0 + (lane & 31)] * scale; if (g) w *= g[k0 + kk]; scr[kk * 33 + (lane & 31)] = w; }
    LDS_WAIT(); asm volatile("" ::: "memory");
    const int c = lane & 7;
#pragma unroll
    for (int j = 0; j < 4; ++j) { const int n = (lane >> 3) + 8 * j; const LAS float* s = scr + (8 * c) * 33 + n;
        u32x4 o; o.x = pk2(s[0 * 33], s[1 * 33]); o.y = pk2(s[2 * 33], s[3 * 33]); o.z = pk2(s[4 * 33], s[5 * 33]); o.w = pk2(s[6 * 33], s[7 * 33]);
        *(u32x4*)(WT + (size_t)(row_off + n0 + n) * K + k0 + 8 * c) = o; }
    LDS_WAIT(); asm volatile("" ::: "memory");
}

struct Args { const float* in[14]; float* out; unsigned char* ws; int ph_lo, ph_hi; };

__device__ __forceinline__ void grid_row_info(int gr, int& seqbase, int& r, int& nrows) {
    if (gr < 1024) { seqbase = (gr >> 5) << 11; r = gr & 31; nrows = 32; } else { const int g2 = gr - 1024; seqbase = MP + ((g2 >> 7) << 13); r = g2 & 127; nrows = 128; }
}

__device__ __forceinline__ void attn_row(int gr, int head, int lane, const bf16_t* ZM, const bf16_t* ZT, bf16_t* Y, const LAS float* bias  ) {
    int seqbase, r, nrows; grid_row_info(gr, seqbase, r, nrows);
    int rstart = r - 4; rstart = rstart < 0 ? 0 : rstart; rstart = rstart > nrows - 8 ? nrows - 8 : rstart;
    const int qi = lane & 15, h4 = lane >> 4;
#pragma unroll 1
    for (int g = 0; g < 4; ++g) {
        const int cs = (g == 0) ? 0 : (g == 1) ? 8 : (g == 2) ? 24 : 32;
        const int qc = 16 * g + qi;
        const int qtok = seqbase + r * 64 + qc;
        const bf16x8 bq0 = *(const bf16x8*)(ZM + (size_t)qtok * ZMW + head * 64 + 8 * h4);
        const bf16x8 bq1 = *(const bf16x8*)(ZM + (size_t)qtok * ZMW + head * 64 + 32 + 8 * h4);
        int cst = qc - 8; cst = cst < 0 ? 0 : cst; cst = cst > 48 ? 48 : cst;
        f32x4 S[16];
        float mx = -3.0e38f;
#pragma unroll
        for (int kr = 0; kr < 8; ++kr) {
            const LAS float* brow = bias + (rstart + kr - r + 7) * 31;
#pragma unroll
            for (int hf = 0; hf < 2; ++hf) {
                const int ktok = seqbase + (rstart + kr) * 64 + cs + 16 * hf + qi;
                const bf16x8 ak0 = *(const bf16x8*)(ZM + (size_t)ktok * ZMW + 512 + head * 64 + 8 * h4);
                const bf16x8 ak1 = *(const bf16x8*)(ZM + (size_t)ktok * ZMW + 512 + head * 64 + 32 + 8 * h4);
                f32x4 s = {0.f, 0.f, 0.f, 0.f};
                s = __builtin_amdgcn_mfma_f32_16x16x32_bf16(ak0, bq0, s, 0, 0, 0);
                s = __builtin_amdgcn_mfma_f32_16x16x32_bf16(ak1, bq1, s, 0, 0, 0);
#pragma unroll
                for (int e = 0; e < 4; ++e) {
                    const int kc = cs + 16 * hf + 4 * h4 + e;
                    const bool valid = (kc >= cst) && (kc < cst + 16);
                    int dc = kc - qc + 15; dc = dc < 0 ? 0 : dc; dc = dc > 30 ? 30 : dc;
                    const float val = valid ? s[e] + brow[dc] : -1.0e30f;
                    s[e] = val; mx = fmaxf(mx, val);
                }
                S[kr * 2 + hf] = s;
            }
        }
        mx = fmaxf(mx, __shfl_xor(mx, 16)); mx = fmaxf(mx, __shfl_xor(mx, 32));
        float sum = 0.f;
        bf16x8 pf[8];
#pragma unroll
        for (int kr = 0; kr < 8; ++kr) {
            const f32x4 a = S[kr * 2], b = S[kr * 2 + 1];
            const float p0 = __expf(a[0] - mx), p1 = __expf(a[1] - mx), p2 = __expf(a[2] - mx), p3 = __expf(a[3] - mx);
            const float p4 = __expf(b[0] - mx), p5 = __expf(b[1] - mx), p6 = __expf(b[2] - mx), p7 = __expf(b[3] - mx);
            sum += ((p0 + p1) + (p2 + p3)) + ((p4 + p5) + (p6 + p7));
            u32x4 w; w.x = pk2(p0, p1); w.y = pk2(p2, p3); w.z = pk2(p4, p5); w.w = pk2(p6, p7);
            pf[kr] = __builtin_bit_cast(bf16x8, w);
        }
        sum += __shfl_xor(sum, 16); sum += __shfl_xor(sum, 32);
        const float inv = 1.0f / sum;
#pragma unroll
        for (int dt = 0; dt < 4; ++dt) {
            f32x4 o = {0.f, 0.f, 0.f, 0.f};
            const bf16_t* vrow = ZT + ((size_t)((seqbase >> 6) + rstart) * 512 + head * 64 + dt * 16 + qi) * 64 + cs + 4 * h4;
#pragma unroll
            for (int kr = 0; kr < 8; ++kr) {
                const u32x2 lo = *(const u32x2*)(vrow + kr * 32768);
                const u32x2 hi = *(const u32x2*)(vrow + kr * 32768 + 16);
                u32x4 w; w.x = lo.x; w.y = lo.y; w.z = hi.x; w.w = hi.y;
                o = __builtin_amdgcn_mfma_f32_16x16x32_bf16(__builtin_bit_cast(bf16x8, w), pf[kr], o, 0, 0, 0);
            }
            u32x2 w; w.x = pk2(o[0] * inv, o[1] * inv); w.y = pk2(o[2] * inv, o[3] * inv);
            *(u32x2*)(Y + (size_t)qtok * DM + head * 64 + dt * 16 + 4 * h4) = w;
        }
    }
}

template <int R>
__device__ __forceinline__ void butterfly_unit(int tok0, int rowbase  , int p, int lp, const bf16_t* ZT, bf16_t* YQ) {
    constexpr int L = 512 * R;
    const bf16_t* zre = ZT + (size_t)MTOK * 512 + ((size_t)(tok0 >> 9) * 512 + p) * 512 + lp;
    const bf16_t* zim = zre + 256 * 512;
    float xr[R], xi[R];
#pragma unroll
    for (int s = 0; s < R; ++s) { xr[s] = bf2f(zre[(size_t)s * 512 * 512]); xi[s] = bf2f(zim[(size_t)s * 512 * 512]); }
    const float scale = rsqrtf(64.0f * (float)L);
#pragma unroll 1
    for (int q = 0; q < R; ++q) {
        float wr_, wi_; sincospif(-2.0f * (float)q / (float)R, &wi_, &wr_);
        float yr = xr[R - 1], yi = xi[R - 1];
#pragma unroll
        for (int s = R - 2; s >= 0; --s) { const float tr = yr * wr_ - yi * wi_ + xr[s], ti = yr * wi_ + yi * wr_ + xi[s]; yr = tr; yi = ti; }
        float tr_, ti_; sincospif(-2.0f * (float)(q * lp) / (float)L, &ti_, &tr_);
        const float orr = (yr * tr_ - yi * ti_) * scale, oi = (yr * ti_ + yi * tr_) * scale;
        bf16_t* d = YQ + (size_t)(rowbase + q * 256) * 1024 + lp;
        d[0] = (bf16_t)f2bf(orr); d[512] = (bf16_t)f2bf(oi);
    }
}

__global__ void __launch_bounds__(NWAVES * 64, 2) fwd_kernel(Args args) {
    extern __shared__ __attribute__((aligned(16))) unsigned char lds_raw[];
    LAS unsigned char* lds = (LAS unsigned char*)lds_raw;
    const int G = gridDim.x, bx = blockIdx.x;
    for (int ph = args.ph_lo; ph < args.ph_hi; ++ph) {
        if (ph > args.ph_lo) { cg::this_grid().sync(); }
        int tid = threadIdx.x; asm volatile("" : "+v"(tid));
        const int lane = tid & 63, wave = __builtin_amdgcn_readfirstlane(tid >> 6);
        const int gw = bx * NWAVES + wave, NGW = G * NWAVES;
        unsigned char* ws = args.ws; asm volatile("" : "+s"(ws));
        const float* x_prompt = args.in[0]; const float* x_sample = args.in[1];
        float* out = args.out;
        bf16_t* XB = (bf16_t*)(ws + WS_XB); bf16_t* OB = XB;
        bf16_t* ZM = (bf16_t*)(ws + WS_ZM); bf16_t* PB = ZM;
        bf16_t* ZT = (bf16_t*)(ws + WS_ZT); bf16_t* MG = ZT;
        bf16_t* YQ = (bf16_t*)(ws + WS_YQ);
        bf16_t* Y = (bf16_t*)(ws + WS_Y);
        bf16_t* TT = (bf16_t*)(ws + WS_T);
        float* RS = (float*)(ws + WS_RS); float* SS = (float*)(ws + WS_SS);
        const int layer = (ph == 0) ? 0 : (ph - 1) / 7;
        const int sub = (ph == 0) ? -1 : (ph - 1) % 7;
        const bf16_t* WIN = (const bf16_t*)(ws + WS_WIN) + (size_t)layer * NG1 * DM;
        const bf16_t* WG = (const bf16_t*)(ws + WS_WG) + (size_t)layer * DM * DM;
        const bf16_t* WM = (const bf16_t*)(ws + WS_WM) + (size_t)layer * 3072 * DM;
        const bf16_t* WA = (const bf16_t*)(ws + WS_WA) + (size_t)layer * DM * 512;
        const bf16_t* WB = (const bf16_t*)(ws + WS_WB) + (size_t)layer * DM * 256;
        const bf16_t* WC = (const bf16_t*)(ws + WS_WC) + (size_t)layer * DM * 256;
        const bf16_t* WO = (const bf16_t*)(ws + WS_WO) + (size_t)layer * DM * DM;

        if (PHON(0) && ph == 0) {
            LAS float* scr = (LAS float*)(lds + wave * 16384);
            for (int l = 0; l < 2; ++l) {
                const float* w_in = args.in[4] + (size_t)l * DM * DIN;
                const float* gpre = args.in[2] + l * DM;
                bf16_t* win = (bf16_t*)(ws + WS_WIN) + (size_t)l * NG1 * DM;
                bf16_t* wg = (bf16_t*)(ws + WS_WG) + (size_t)l * DM * DM;
                bf16_t* wm = (bf16_t*)(ws + WS_WM) + (size_t)l * 3072 * DM;
                for (int job = 0; job < 7; ++job) {
                    int c0, nc, ro; bf16_t* dst; float sc = 1.f;
                    switch (job) {
                        case 0: c0 = 0; nc = 512; dst = win; ro = 0; sc = 0.125f; break;
                        case 1: c0 = 512; nc = 1024; dst = win; ro = 512; break;
                        case 2: c0 = 2560; nc = 512; dst = win; ro = 2048; break;
                        case 3: c0 = 1536; nc = 512; dst = wg; ro = 0; break;
                        case 4: c0 = 2304; nc = 256; dst = wg; ro = 512; break;
                        case 5: c0 = 3072; nc = 256; dst = wg; ro = 768; break;
                        default: c0 = 3328; nc = 3072; dst = wm; ro = 0; break;
                    }
                    const int nitems = (DM / 64) * (nc / 32);
                    for (int it = gw; it < nitems; it += NGW) transpose_item(w_in, DM, DIN, c0, nc, dst, ro, gpre, sc, scr, it, lane);
                }
                {   const int ni = (512 / 64) * (DM / 32);
                    for (int it = gw; it < ni; it += NGW) transpose_item(args.in[10] + (size_t)l * 512 * DM, 512, DM, 0, DM, (bf16_t*)(ws + WS_WA) + (size_t)l * DM * 512, 0, nullptr, 1.f, scr, it, lane); }
                {   const int ni = (256 / 64) * (DM / 32);
                    for (int it = gw; it < ni; it += NGW) transpose_item(args.in[11] + (size_t)l * 256 * DM, 256, DM, 0, DM, (bf16_t*)(ws + WS_WB) + (size_t)l * DM * 256, 0, nullptr, 1.f, scr, it, lane);
                    for (int it = gw; it < ni; it += NGW) transpose_item(args.in[12] + (size_t)l * 256 * DM, 256, DM, 0, DM, (bf16_t*)(ws + WS_WC) + (size_t)l * DM * 256, 0, nullptr, 1.f, scr, it, lane); }
                {   const int ni = (DM / 64) * (DM / 32);
                    for (int it = gw; it < ni; it += NGW) transpose_item(args.in[13] + (size_t)l * DM * DM, DM, DM, 0, DM, (bf16_t*)(ws + WS_WO) + (size_t)l * DM * DM, 0, nullptr, 1.f, scr, it, lane); }
                for (int idx = bx * 512 + tid; idx < DM * 256; idx += G * 512) {
                    const int k = idx >> 8, p = idx & 255, grp = p >> 6, mm = p & 63;
                    const float* wrow = w_in + (size_t)k * DIN + 2048 + grp * 64;
                    float are = 0.f, aim = 0.f;
                    for (int c = 0; c < 64; ++c) { float sn, cs; sincospif((float)((mm * c) & 63) * (1.0f / 32.0f), &sn, &cs); const float w = wrow[c]; are += w * cs; aim -= w * sn; }
                    const float gk = gpre[k];
                    win[(size_t)(1536 + p) * DM + k] = (bf16_t)f2bf(are * gk);
                    win[(size_t)(1536 + 256 + p) * DM + k] = (bf16_t)f2bf(aim * gk);
                }
            }
            for (int idx = bx * 512 + tid; idx < 512 * 512; idx += G * 512) {
                const int kp = idx >> 9, lp = idx & 511; float sn, cs; sincospif((float)((kp * lp) & 511) * (1.0f / 256.0f), &sn, &cs);
                TT[(size_t)kp * 1024 + lp] = (bf16_t)f2bf(cs); TT[(size_t)kp * 1024 + 512 + lp] = (bf16_t)f2bf(sn);
            }
        }
        if (PHON(1) && (ph == 0 || sub == 6)) {
            const int mode = (ph == 0) ? 0 : (layer == 0 ? 1 : 2);
            const float* gpost = args.in[3] + layer * DM;
            for (int m = gw; m < MTOK; m += NGW) {
                const float* xin = (mode == 2) ? (out + (size_t)m * DM) : ((m < MP) ? x_prompt + (size_t)m * DM : x_sample + (size_t)(m - MP) * DM);
                const f32x4* xr = (const f32x4*)xin + lane;
                f32x4 v[4];
#pragma unroll
                for (int j = 0; j < 4; ++j) v[j] = xr[64 * j];
                if (mode != 0) {
                    const float rq = rsqrtf(SS[m] * (1.0f / DM) + EPS);
                    const u32x2* orow = (const u32x2*)(OB + (size_t)m * DM) + lane;
#pragma unroll
                    for (int j = 0; j < 4; ++j) { const u32x2 ov = orow[64 * j]; const f32x4 gp = *((const f32x4*)gpost + lane + 64 * j);
                        v[j][0] += bflo(ov.x) * rq * gp[0]; v[j][1] += bfhi(ov.x) * rq * gp[1]; v[j][2] += bflo(ov.y) * rq * gp[2]; v[j][3] += bfhi(ov.y) * rq * gp[3]; }
                    f32x4* orow2 = (f32x4*)(out + (size_t)m * DM) + lane;
#pragma unroll
                    for (int j = 0; j < 4; ++j) orow2[64 * j] = v[j];
                }
                if (mode != 2) {
                    float s = 0.f;
#pragma unroll
                    for (int j = 0; j < 4; ++j) s += (v[j][0] * v[j][0] + v[j][1] * v[j][1]) + (v[j][2] * v[j][2] + v[j][3] * v[j][3]);
                    s = wave_sum(s);
                    u32x2* o8 = (u32x2*)(XB + (size_t)m * DM) + lane;
#pragma unroll
                    for (int j = 0; j < 4; ++j) { u32x2 w; w.x = pk2(v[j][0], v[j][1]); w.y = pk2(v[j][2], v[j][3]); o8[64 * j] = w; }
                    if (lane == 0) { RS[m] = rsqrtf(s * (1.0f / DM) + EPS); SS[m] = 0.f; }
                }
            }
        } else if (PHON(2) && sub == 0) {
            pg8::Gemm g{XB, WIN, MTOK, NG1, DM, DM, DM}; pg8::StaticOrder S; S.init(MTOK, NG1, G, bx);
            pg8::EpiG1 E{RS, ZM, ZT};
            pg8::gemm_phase<pg8::EpiG1, pg8::StaticOrder, true>(lds, g, S, E);
        } else if (sub == 1) {
            if (PHON(3)) {
                LAS float* bt = (LAS float*)lds;
                const float* rpb = args.in[5] + (size_t)layer * 8 * 15 * 31;
                for (int i = tid; i < 8 * 15 * 31; i += 512) bt[i] = rpb[i];
                __syncthreads();
                const int per = (1536 + G - 1) / G;
                for (int i = 0; i < per; ++i) { const int gr = bx * per + i; if (gr < 1536) attn_row(gr, wave, lane, ZM, ZT, Y, bt + wave * 465); }
                __syncthreads();
            }
            if (PHON(4)) {
                LAS float* hbuf = (LAS float*)lds; LAS float* cbuf = (LAS float*)(lds + 65536);
                const float* dww = args.in[6] + (size_t)layer * 31 * 256; const float* dwb = args.in[7] + layer * 256;
                const float* lng = args.in[8] + layer * 256; const float* lnb = args.in[9] + layer * 256;
                const int c = tid & 255, half = tid >> 8;
                float w[31];
#pragma unroll
                for (int j = 0; j < 31; ++j) w[j] = dww[j * 256 + c];
                const float bc = dwb[c];
                const f32x4 lg = *((const f32x4*)lng + lane), lb = *((const f32x4*)lnb + lane);
                for (int cu = bx; cu < MTOK / 32; cu += G) {
                    const int t0g = cu * 32;
                    int sbeg, send; if (t0g < MP) { sbeg = t0g & ~2047; send = sbeg + 2048; } else { sbeg = MP + ((t0g - MP) & ~8191); send = sbeg + 8192; }
#pragma unroll
                    for (int it0 = 0; it0 < 4; ++it0) {
                        const int it = tid + it0 * 512; if (it >= 62 * 32) break;
                        const int i = it >> 5, c8 = (it & 31) * 8; const int tok = t0g - 15 + i;
                        f32x4 h0 = {0.f, 0.f, 0.f, 0.f}, h1 = {0.f, 0.f, 0.f, 0.f};
                        if (tok >= sbeg && tok < send) {
                            const u32x4 a = *(const u32x4*)(ZM + (size_t)tok * ZMW + 1024 + c8), b = *(const u32x4*)(ZM + (size_t)tok * ZMW + 1280 + c8);
                            h0[0] = bflo(a.x) * sigmoidf_(bflo(b.x)); h0[1] = bfhi(a.x) * sigmoidf_(bfhi(b.x)); h0[2] = bflo(a.y) * sigmoidf_(bflo(b.y)); h0[3] = bfhi(a.y) * sigmoidf_(bfhi(b.y));
                            h1[0] = bflo(a.z) * sigmoidf_(bflo(b.z)); h1[1] = bfhi(a.z) * sigmoidf_(bfhi(b.z)); h1[2] = bflo(a.w) * sigmoidf_(bflo(b.w)); h1[3] = bfhi(a.w) * sigmoidf_(bfhi(b.w));
                        }
                        *(LAS f32x4*)(hbuf + i * 256 + c8) = h0; *(LAS f32x4*)(hbuf + i * 256 + c8 + 4) = h1;
                    }
                    __syncthreads();
#pragma unroll 1
                    for (int tt = 0; tt < 16; ++tt) {
                        const int t = half * 16 + tt; float a = bc;
#pragma unroll
                        for (int j = 0; j < 31; ++j) a += w[j] * hbuf[(t + j) * 256 + c];
                        cbuf[t * 256 + c] = a;
                    }
                    __syncthreads();
#pragma unroll 1
                    for (int tt = 0; tt < 4; ++tt) {
                        const int t = wave * 4 + tt;
                        const f32x4 xv = *(const LAS f32x4*)(cbuf + t * 256 + 4 * lane);
                        const float mean = wave_sum((xv[0] + xv[1]) + (xv[2] + xv[3])) * (1.0f / 256.0f);
                        const f32x4 d = xv - mean;
                        const float var = wave_sum((d[0] * d[0] + d[1] * d[1]) + (d[2] * d[2] + d[3] * d[3])) * (1.0f / 256.0f);
                        const float rstd = rsqrtf(var + EPS);
                        const float y0 = siluf_(d[0] * rstd * lg[0] + lb[0]), y1 = siluf_(d[1] * rstd * lg[1] + lb[1]), y2 = siluf_(d[2] * rstd * lg[2] + lb[2]), y3 = siluf_(d[3] * rstd * lg[3] + lb[3]);
                        u32x2 wv; wv.x = pk2(y0, y1); wv.y = pk2(y2, y3);
                        *(u32x2*)(Y + (size_t)(t0g + t) * DM + 768 + 4 * lane) = wv;
                    }
                    __syncthreads();
                }
            }
            if (PHON(5)) {
                for (int un = bx; un < 32 * 256; un += G) { const int seq = un >> 8, p = un & 255; butterfly_unit<4>(seq * 2048, seq * 1024 + p, p, tid, ZT, YQ); }
                for (int un = bx; un < 4 * 256; un += G) { const int seq = un >> 8, p = un & 255; butterfly_unit<16>(MP + seq * 8192, 32768 + seq * 4096 + p, p, tid, ZT, YQ); }
            }
        } else if (PHON(6) && sub == 2) {
            pg8::Gemm g{YQ, TT, NYQ, 512, 1024, 1024, 1024}; pg8::StaticOrder S; S.init(NYQ, 512, G, bx);
            pg8::EpiDFT E{Y};
            pg8::gemm_phase<pg8::EpiDFT, pg8::StaticOrder, true>(lds, g, S, E);
        } else if (PHON(7) && sub == 3) {
            pg8::Gemm g{XB, WG, MTOK, DM, DM, DM, DM}; pg8::StaticOrder S; S.init(MTOK, DM, G, bx);
            pg8::EpiG2 E{RS, Y};
            pg8::gemm_phase<pg8::EpiG2, pg8::StaticOrder, true>(lds, g, S, E);
        } else if (sub == 4) {
            pg8::StaticOrder S; S.init(MTOK, DM, G, bx);
            bf16_t* PT = PB + (size_t)bx * 65536; bf16_t* MT = PB + (size_t)(256 + bx) * 65536;
#pragma unroll 1
            for (int i = 0; ; ++i) {
                pg8::SingleUnit SU; if (!S.next(i, SU.u)) break;
#pragma unroll 1
                for (int b = 0; b < 3; ++b) {
                    const int kb = (b == 0) ? 512 : 256, aoffc = (b == 0) ? 0 : (b == 1 ? 512 : 768);
                    const bf16_t* wb = (b == 0) ? WA : (b == 1 ? WB : WC);
                    pg8::Gemm gp{Y + aoffc, wb, MTOK, DM, kb, DM, kb};
                    pg8::EpiStoreT EP{PT};
                    if (PHON(8)) pg8::gemm_phase<pg8::EpiStoreT, pg8::SingleUnit, true>(lds, gp, SU, EP);
                    pg8::Gemm gm{XB, WM + (size_t)b * DM * DM, MTOK, DM, DM, DM, DM};
                    pg8::EpiMergeT EM{RS, PT, MT, MG, b};
                    if (PHON(9)) pg8::gemm_phase<pg8::EpiMergeT, pg8::SingleUnit, true>(lds, gm, SU, EM);
                }
            }
        } else if (PHON(10) && sub == 5) {
            pg8::Gemm g{MG, WO, MTOK, DM, DM, DM, DM}; pg8::StaticOrder S; S.init(MTOK, DM, G, bx);
            pg8::EpiG5 E{OB, SS};
            pg8::gemm_phase<pg8::EpiG5, pg8::StaticOrder, true>(lds, g, S, E);
        }
    }
}

extern "C" void kernel_launch(void* const* d_in, const int* in_sizes, int n_in, void* d_out, int out_size, void* d_ws, size_t ws_size, hipStream_t stream) {
    static int grid = 0;
    if (grid == 0) {
        if (n_in != 14 || ws_size < WS_END) { fprintf(stderr, "kernel_launch: bad inputs (n_in %d, ws %zu < %zu)\n", n_in, ws_size, (size_t)WS_END); grid = -1; return; }
        int dev = 0, cus = 0, per_cu = 0;
        hipGetDevice(&dev); hipDeviceGetAttribute(&cus, hipDeviceAttributeMultiprocessorCount, dev);
        if (hipFuncSetAttribute((const void*)fwd_kernel, hipFuncAttributeMaxDynamicSharedMemorySize, LDS_BYTES) != hipSuccess) { fprintf(stderr, "hipFuncSetAttribute failed\n"); grid = -1; return; }
        hipOccupancyMaxActiveBlocksPerMultiprocessor(&per_cu, (const void*)fwd_kernel, NWAVES * 64, LDS_BYTES);
        (void)hipGetLastError();
        if (per_cu < 1) { fprintf(stderr, "occupancy query says 0 blocks per CU\n"); }
        grid = cus;
    }
    if (grid < 0) return;
    Args a{};
    for (int i = 0; i < 14; ++i) a.in[i] = (const float*)d_in[i];
    a.out = (float*)d_out; a.ws = (unsigned char*)d_ws;
#if MK_ONE_LAUNCH
    a.ph_lo = 0; a.ph_hi = 15;
    void* kargs[] = {&a};
    hipError_t e = hipLaunchCooperativeKernel((const void*)fwd_kernel, dim3(grid), dim3(NWAVES * 64), kargs, LDS_BYTES, stream);
    if (e != hipSuccess) fprintf(stderr, "cooperative launch failed: %s (grid %d)\n", hipGetErrorString(e), grid);
#else
    for (int ph = 0; ph < 15; ++ph) {
        a.ph_lo = ph; a.ph_hi = ph + 1;
        hipLaunchKernelGGL(fwd_kernel, dim3(grid), dim3(NWAVES * 64), LDS_BYTES, stream, a);
    }
#endif
}
```

```cpp
#include <hip/hip_runtime.h>
#include <hip/hip_cooperative_groups.h>
#include <cstdio>
#include <cstdint>
namespace cg = cooperative_groups;

#ifndef MK_ONE_LAUNCH
#define MK_ONE_LAUNCH 1
#endif

#ifndef PH_MASK
#define PH_MASK 0xFFFF
#endif
#define PHON(k) (((PH_MASK) >> (k)) & 1)
#define LAS __attribute__((address_space(3)))
typedef unsigned short bf16_t;
typedef short bf16x8 __attribute__((ext_vector_type(8)));
typedef short s16x4 __attribute__((ext_vector_type(4)));
typedef float f32x4 __attribute__((ext_vector_type(4)));
typedef unsigned u32x4 __attribute__((ext_vector_type(4)));
typedef unsigned u32x2 __attribute__((ext_vector_type(2)));

constexpr int DM = 1024;
constexpr int MP = 65536;
constexpr int MTOK = 98304;
constexpr int DIN = 6400;
constexpr int NG1 = 2560;
constexpr int ZMW = 1536;
constexpr int NYQ = 49152;
constexpr float EPS = 1e-6f;

constexpr size_t MiB = 1u << 20;
constexpr size_t WS_WIN = 0;
constexpr size_t WS_WG = 10 * MiB;
constexpr size_t WS_WM = 14 * MiB;
constexpr size_t WS_WA = 26 * MiB;
constexpr size_t WS_WB = 28 * MiB;
constexpr size_t WS_WC = 29 * MiB;
constexpr size_t WS_WO = 30 * MiB;
constexpr size_t WS_T = 34 * MiB;
constexpr size_t WS_RS = 35 * MiB;
constexpr size_t WS_SS = 35 * MiB + 512 * 1024;
constexpr size_t WS_XB = 36 * MiB;
constexpr size_t WS_ZM = 228 * MiB;
constexpr size_t WS_ZT = 516 * MiB;
constexpr size_t WS_YQ = 708 * MiB;
constexpr size_t WS_Y = 804 * MiB;
constexpr size_t WS_END = 996 * MiB;

constexpr int NWAVES = 8;
constexpr int LDS_BYTES = 147456;

__device__ __forceinline__ unsigned f2bf(float f) { unsigned u = __builtin_bit_cast(unsigned, f); return (u + 0x7fffu + ((u >> 16) & 1u)) >> 16; }
__device__ __forceinline__ unsigned pk2(float lo, float hi) { return f2bf(lo) | (f2bf(hi) << 16); }
__device__ __forceinline__ float bf2f(unsigned b) { return __builtin_bit_cast(float, b << 16); }
__device__ __forceinline__ float bflo(unsigned w) { return __builtin_bit_cast(float, w << 16); }
__device__ __forceinline__ float bfhi(unsigned w) { return __builtin_bit_cast(float, w & 0xffff0000u); }
__device__ __forceinline__ float sigmoidf_(float x) { return 1.0f / (1.0f + __expf(-x)); }
__device__ __forceinline__ float siluf_(float x) { return x / (1.0f + __expf(-x)); }
__device__ __forceinline__ float wave_sum(float v) {
#pragma unroll
    for (int o = 1; o < 64; o <<= 1) v += __shfl_xor(v, o);
    return v;
}
#define LDS_WAIT() asm volatile("s_waitcnt lgkmcnt(0)" ::: "memory")

namespace pg8 {
constexpr int BM = 256, BK = 64, HALF = 128, HTB = HALF * BK * 2, STAGE_BYTES = 8 * HTB, NXCD = 8, WGM = 8;
__device__ __forceinline__ int lds_byte(int r, int c) { const int st = (r >> 4) * 2 + (c >> 5), rr = r & 15, cc = c & 31, ob = rr * 64 + cc * 2; return st * 1024 + (ob ^ (((ob >> 9) & 1) << 5)); }
__device__ __forceinline__ void stage_rc(int b, int& R, int& C) { const int st = b / 1024, sb = b % 1024, swz = sb ^ (((sb >> 9) & 1) << 5); R = (st >> 1) * 16 + swz / 64; C = (st & 1) * 32 + (swz % 64) / 2; }

struct Unit { int pm, pn; };
struct Gemm { const bf16_t* A; const bf16_t* Bt; int M, N, K, lda, ldb; };

struct StaticOrder {
    int nM, nN, nwg, G, c;
    __device__ void init(int M, int N, int G_, int c_) { nM = M / BM; nN = N / BM; nwg = nM * nN; G = G_; c = c_; }
    __device__ bool next(int i, Unit& u) const {
        const long L = (long)i * G + c; if (L >= nwg) return false;
        int wgid = (int)L; { const int q = nwg / NXCD, r = nwg % NXCD, xcd = wgid % NXCD, off = wgid / NXCD; wgid = (xcd < r ? xcd * (q + 1) : r * (q + 1) + (xcd - r) * q) + off; }
        const int nig = WGM * nN, gid = wgid / nig, fm = gid * WGM, gsz = (nM - fm) < WGM ? (nM - fm) : WGM;
        u.pm = fm + ((wgid % nig) % gsz); u.pn = (wgid % nig) / gsz; return true;
    }
};

struct SingleUnit { Unit u; __device__ bool next(int i, Unit& o) const { if (i) return false; o = u; return true; } };
template <class Epi, class Sched, bool ALIGN_EPI>
__device__ __forceinline__ void gemm_phase(LAS unsigned char* lds, const Gemm g, const Sched& S, const Epi& E) {
    int tid = threadIdx.x; asm volatile("" : "+v"(tid));
    const int wid = __builtin_amdgcn_readfirstlane(tid >> 6), lane = tid & 63, wr = wid >> 2, wc = wid & 3, fr = lane & 15, fq = lane >> 4;
    const int K = g.K, nt = K / BK;
    unsigned voffA[2], voffB[2];
#pragma unroll
    for (int i = 0; i < 2; ++i) { int R, C; stage_rc(tid * 16 + i * 8192, R, C);
        voffA[i] = (unsigned)(R * g.lda + C) * 2u; voffB[i] = (unsigned)(R * g.ldb + C) * 2u; }
    const size_t kstep = (size_t)(BK * 2);
    const size_t hstepA = (size_t)HALF * g.lda * 2, hstepB = (size_t)HALF * g.ldb * 2;
    const size_t tstepA = 2 * hstepA, tstepB = 2 * hstepB;
    const unsigned ldsw = (unsigned)wid * 1024u;
    const int aoff = lds_byte(wr * 64 + fr, fq * 8), boff = lds_byte(wc * 32 + fr, fq * 8);
#define PG8_SA(b, h) (((b) * 2 + (h)) * HTB)
#define PG8_SB(b, h) ((4 + (b) * 2 + (h)) * HTB)
#define PG8_STAGE(bufoff, gbase, voff) do { _Pragma("unroll") for (int _i = 0; _i < 2; ++_i) \
        __builtin_amdgcn_global_load_lds((const unsigned*)((const char*)(gbase) + (voff)[_i]), (LAS unsigned*)(lds + (bufoff) + ldsw + _i * 8192), 16, 0, 0); } while (0)
#define PG8_LDA(dst, b, h) do { _Pragma("unroll") for (int m = 0; m < 4; ++m) _Pragma("unroll") for (int k = 0; k < 2; ++k) dst[m][k] = *(const LAS bf16x8*)(lds + PG8_SA(b, h) + aoff + m * 2048 + k * 1024); } while (0)
#define PG8_LDB(dst, b, h) do { _Pragma("unroll") for (int n = 0; n < 2; ++n) _Pragma("unroll") for (int k = 0; k < 2; ++k) dst[n][k] = *(const LAS bf16x8*)(lds + PG8_SB(b, h) + boff + n * 2048 + k * 1024); } while (0)
#define PG8_MMA(ai, bj, At, Bt) do { __builtin_amdgcn_s_setprio(1); _Pragma("unroll") for (int m = 0; m < 4; ++m) _Pragma("unroll") for (int n = 0; n < 2; ++n) _Pragma("unroll") for (int k = 0; k < 2; ++k) \
        acc[ai][bj][m][n] = __builtin_amdgcn_mfma_f32_16x16x32_bf16(Bt[n][k], At[m][k], acc[ai][bj][m][n], 0, 0, 0); __builtin_amdgcn_s_setprio(0); } while (0)
#define PG8_WAIT_V(n) asm volatile("s_waitcnt vmcnt(" #n ")" ::: "memory")
#define PG8_WAIT_L(n) asm volatile("s_waitcnt lgkmcnt(" #n ")" ::: "memory")
#define PG8_BAR __builtin_amdgcn_s_barrier()
#define PG8_SCHED __builtin_amdgcn_sched_barrier(0)
    Unit cur, nxt; int ui = 0;
    if (!S.next(0, cur)) return;
    f32x4 acc[2][2][4][2];
#pragma unroll
    for (int a = 0; a < 2; ++a)
#pragma unroll
        for (int b = 0; b < 2; ++b)
#pragma unroll
            for (int m = 0; m < 4; ++m)
#pragma unroll
                for (int n = 0; n < 2; ++n) acc[a][b][m][n] = (f32x4){0.f, 0.f, 0.f, 0.f};
    bf16x8 At[4][2], B0[2][2], B1[2][2];
    const char* cA = (const char*)g.A + (size_t)cur.pm * tstepA; const char* cB = (const char*)g.Bt + (size_t)cur.pn * tstepB;
    PG8_STAGE(PG8_SB(0, 0), cB, voffB); PG8_STAGE(PG8_SB(0, 1), cB + hstepB, voffB); PG8_STAGE(PG8_SA(0, 0), cA, voffA); PG8_STAGE(PG8_SA(0, 1), cA + hstepA, voffA);
    if (wr == 1) PG8_BAR;
    PG8_WAIT_V(2); PG8_BAR;
    PG8_STAGE(PG8_SB(1, 0), cB + kstep, voffB); PG8_STAGE(PG8_SA(1, 0), cA + kstep, voffA); PG8_STAGE(PG8_SB(1, 1), cB + hstepB + kstep, voffB);
    PG8_WAIT_V(6); PG8_BAR;
    for (;;) {
        const bool has_next = S.next(ui + 1, nxt);
        const char* nA = has_next ? (const char*)g.A + (size_t)nxt.pm * tstepA : cA; const char* nB = has_next ? (const char*)g.Bt + (size_t)nxt.pn * tstepB : cB;
        for (int t = 0; t < nt; t += 2) {
            const bool last = (t == nt - 2);
            const char* a1 = cA + (size_t)(t + 1) * kstep;
            const char* a2 = last ? nA : cA + (size_t)(t + 2) * kstep; const char* b2 = last ? nB : cB + (size_t)(t + 2) * kstep;
            const char* a3 = a2 + kstep; const char* b3 = b2 + kstep;
            PG8_LDB(B0, 0, 0); PG8_LDB(B1, 0, 1); PG8_SCHED; PG8_LDA(At, 0, 0); PG8_STAGE(PG8_SA(1, 1), a1 + hstepA, voffA);
            PG8_WAIT_V(8); PG8_WAIT_L(0); PG8_BAR; PG8_MMA(0, 0, At, B0); PG8_MMA(0, 1, At, B1); PG8_BAR; PG8_SCHED;
            PG8_LDA(At, 0, 1); PG8_STAGE(PG8_SB(0, 0), b2, voffB); PG8_STAGE(PG8_SB(0, 1), b2 + hstepB, voffB); PG8_STAGE(PG8_SA(0, 0), a2, voffA);
            PG8_WAIT_V(8); PG8_WAIT_L(0); PG8_BAR; PG8_MMA(1, 0, At, B0); PG8_MMA(1, 1, At, B1); PG8_BAR; PG8_SCHED;
            PG8_LDB(B0, 1, 0); PG8_LDB(B1, 1, 1); PG8_SCHED; PG8_LDA(At, 1, 0); PG8_STAGE(PG8_SA(0, 1), a2 + hstepA, voffA);
            PG8_WAIT_V(8); PG8_WAIT_L(0); PG8_BAR; PG8_MMA(0, 0, At, B0); PG8_MMA(0, 1, At, B1); PG8_BAR; PG8_SCHED;
            PG8_LDA(At, 1, 1); PG8_STAGE(PG8_SB(1, 0), b3, voffB); PG8_STAGE(PG8_SB(1, 1), b3 + hstepB, voffB); PG8_STAGE(PG8_SA(1, 0), a3, voffA);
            PG8_WAIT_V(8); PG8_WAIT_L(0); PG8_BAR; PG8_MMA(1, 0, At, B0); PG8_MMA(1, 1, At, B1); PG8_BAR; PG8_SCHED;
        }
        if constexpr (ALIGN_EPI) { if (wr == 0) PG8_BAR; }
        E(acc, cur, wr, wc, fr, fq);
        if (!has_next) break;
#pragma unroll
        for (int a = 0; a < 2; ++a)
#pragma unroll
            for (int b = 0; b < 2; ++b)
#pragma unroll
                for (int m = 0; m < 4; ++m)
#pragma unroll
                    for (int n = 0; n < 2; ++n) acc[a][b][m][n] = (f32x4){0.f, 0.f, 0.f, 0.f};
        cur = nxt; cA = nA; cB = nB; ++ui;
        if constexpr (ALIGN_EPI) { if (wr == 1) PG8_BAR; }
    }
    PG8_WAIT_V(0);
    if constexpr (!ALIGN_EPI) { if (wr == 0) PG8_BAR; }
    PG8_BAR;
#undef PG8_SA
#undef PG8_SB
#undef PG8_STAGE
#undef PG8_LDA
#undef PG8_LDB
#undef PG8_MMA
#undef PG8_WAIT_V
#undef PG8_WAIT_L
#undef PG8_BAR
#undef PG8_SCHED
}

#define EPI_ROWS_BEGIN  _Pragma("unroll") for (int ai = 0; ai < 2; ++ai) _Pragma("unroll") for (int m = 0; m < 4; ++m) { const int row = u.pm * BM + ai * HALF + wr * 64 + m * 16 + fr;
#define EPI_COLS_BEGIN  _Pragma("unroll") for (int bj = 0; bj < 2; ++bj) _Pragma("unroll") for (int n = 0; n < 2; ++n) { const int col = bj * HALF + wc * 32 + n * 16 + 4 * fq; f32x4 v = acc[ai][bj][m][n];
#define EPI_END } }

struct EpiG1 {
    const float* rs; bf16_t* ZM; bf16_t* ZT;
    __device__ __forceinline__ void operator()(const f32x4 (&acc)[2][2][4][2], const Unit& u, int wr, int wc, int fr, int fq) const {
        const int pn = u.pn;
        if (pn >= 4 && pn < 6) {
            const int d0 = (pn - 4) * 256;
            EPI_ROWS_BEGIN const float s = rs[row];
            EPI_COLS_BEGIN
                bf16_t* d = ZT + ((size_t)(row >> 6) * 512 + d0 + col) * 64 + (row & 63);
                d[0] = (bf16_t)f2bf(v[0] * s); d[64] = (bf16_t)f2bf(v[1] * s); d[128] = (bf16_t)f2bf(v[2] * s); d[192] = (bf16_t)f2bf(v[3] * s);
            EPI_END
        } else if (pn >= 6 && pn < 8) {
            const int j0 = (pn - 6) * 256;
            EPI_ROWS_BEGIN const float s = rs[row];
            EPI_COLS_BEGIN
                bf16_t* d = ZT + (size_t)MTOK * 512 + ((size_t)(row >> 9) * 512 + j0 + col) * 512 + (row & 511);
                d[0] = (bf16_t)f2bf(v[0] * s); d[512] = (bf16_t)f2bf(v[1] * s); d[1024] = (bf16_t)f2bf(v[2] * s); d[1536] = (bf16_t)f2bf(v[3] * s);
            EPI_END
        } else {
            const int cm = (pn < 4 ? pn : pn - 4) * 256;
            EPI_ROWS_BEGIN const float s = rs[row];
            EPI_COLS_BEGIN
                u32x2 w; w.x = pk2(v[0] * s, v[1] * s); w.y = pk2(v[2] * s, v[3] * s);
                *(u32x2*)(ZM + (size_t)row * ZMW + cm + col) = w;
            EPI_END
        }
    }
};
struct EpiDFT {
    bf16_t* Y;
    __device__ __forceinline__ void operator()(const f32x4 (&acc)[2][2][4][2], const Unit& u, int wr, int wc, int fr, int fq) const {
        int tok0, R, q;
        if (u.pm < 128) { tok0 = (u.pm >> 2) * 2048; R = 4; q = u.pm & 3; } else { const int t = u.pm - 128; tok0 = MP + (t >> 4) * 8192; R = 16; q = t & 15; }
        EPI_ROWS_BEGIN const int p = row - u.pm * BM;
        EPI_COLS_BEGIN
            const int k0 = u.pn * BM + col;
            bf16_t* d = Y + (size_t)(tok0 + R * k0 + q) * DM + 512 + p;
            d[0] = (bf16_t)f2bf(v[0]); d[(size_t)R * DM] = (bf16_t)f2bf(v[1]); d[(size_t)2 * R * DM] = (bf16_t)f2bf(v[2]); d[(size_t)3 * R * DM] = (bf16_t)f2bf(v[3]);
        EPI_END
    }
};
struct EpiG2 {
    const float* rs; bf16_t* Y;
    __device__ __forceinline__ void operator()(const f32x4 (&acc)[2][2][4][2], const Unit& u, int wr, int wc, int fr, int fq) const {
        EPI_ROWS_BEGIN const float s = rs[row];
        EPI_COLS_BEGIN
            u32x2* p = (u32x2*)(Y + (size_t)row * DM + u.pn * BM + col);
            const u32x2 y = *p; u32x2 w;
            w.x = pk2(bflo(y.x) * siluf_(v[0] * s), bfhi(y.x) * siluf_(v[1] * s)); w.y = pk2(bflo(y.y) * siluf_(v[2] * s), bfhi(y.y) * siluf_(v[3] * s));
            *p = w;
        EPI_END
    }
};
struct EpiStoreT {
    bf16_t* PT;
    __device__ __forceinline__ void operator()(const f32x4 (&acc)[2][2][4][2], const Unit& u, int wr, int wc, int fr, int fq) const {
        EPI_ROWS_BEGIN
        EPI_COLS_BEGIN
            u32x2 w; w.x = pk2(v[0], v[1]); w.y = pk2(v[2], v[3]);
            *(u32x2*)(PT + (size_t)(row - u.pm * BM) * 256 + col) = w;
        EPI_END
    }
};
struct EpiMergeT {
    const float* rs; const bf16_t* PT; bf16_t* MT; bf16_t* MG; int mode;
    __device__ __forceinline__ void operator()(const f32x4 (&acc)[2][2][4][2], const Unit& u, int wr, int wc, int fr, int fq) const {
        EPI_ROWS_BEGIN const float s = rs[row];
        EPI_COLS_BEGIN
            const size_t toff = (size_t)(row - u.pm * BM) * 256 + col;
            const u32x2 pv = *(const u32x2*)(PT + toff);
            float r0 = bflo(pv.x) * sigmoidf_(v[0] * s), r1 = bfhi(pv.x) * sigmoidf_(v[1] * s), r2 = bflo(pv.y) * sigmoidf_(v[2] * s), r3 = bfhi(pv.y) * sigmoidf_(v[3] * s);
            if (mode) { const u32x2 mv = *(const u32x2*)(MT + toff); r0 += bflo(mv.x); r1 += bfhi(mv.x); r2 += bflo(mv.y); r3 += bfhi(mv.y); }
            u32x2 w; w.x = pk2(r0, r1); w.y = pk2(r2, r3);
            if (mode == 2) *(u32x2*)(MG + (size_t)row * DM + u.pn * BM + col) = w; else *(u32x2*)(MT + toff) = w;
        EPI_END
    }
};
struct EpiG5 {
    bf16_t* O; float* ss;
    __device__ __forceinline__ void operator()(const f32x4 (&acc)[2][2][4][2], const Unit& u, int wr, int wc, int fr, int fq) const {
        EPI_ROWS_BEGIN float q = 0.f;
        EPI_COLS_BEGIN
            u32x2 w; w.x = pk2(v[0], v[1]); w.y = pk2(v[2], v[3]);
            *(u32x2*)(O + (size_t)row * DM + u.pn * BM + col) = w;
            q += (v[0] * v[0] + v[1] * v[1]) + (v[2] * v[2] + v[3] * v[3]);
        }
            q += __shfl_xor(q, 16); q += __shfl_xor(q, 32);
            if (fq == 0) atomicAdd(ss + row, q);
        }
    }
};
}

__device__ __forceinline__ void transpose_item(const float* W, int K, int pitch, int c0, int ncols, bf16_t* WT, int row_off, const float* g, float scale, LAS float* scr, int item, int lane) {
    const int nblk = ncols / 32, kb = item / nblk, nb = item % nblk, k0 = 64 * kb, n0 = 32 * nb;
#pragma unroll 8
    for (int i = 0; i < 32; ++i) { const int kk = 2 * i + (lane >> 5); float w = W[(size_t)(k0 + kk) * pitch + c0 + n0 + (lane & 31)] * scale; if (g) w *= g[k0 + kk]; scr[kk * 33 + (lane & 31)] = w; }
    LDS_WAIT(); asm volatile("" ::: "memory");
    const int c = lane & 7;
#pragma unroll
    for (int j = 0; j < 4; ++j) { const int n = (lane >> 3) + 8 * j; const LAS float* s = scr + (8 * c) * 33 + n;
        u32x4 o; o.x = pk2(s[0 * 33], s[1 * 33]); o.y = pk2(s[2 * 33], s[3 * 33]); o.z = pk2(s[4 * 33], s[5 * 33]); o.w = pk2(s[6 * 33], s[7 * 33]);
        *(u32x4*)(WT + (size_t)(row_off + n0 + n) * K + k0 + 8 * c) = o; }
    LDS_WAIT(); asm volatile("" ::: "memory");
}

struct Args { const float* in[14]; float* out; unsigned char* ws; int ph_lo, ph_hi; };

__device__ __forceinline__ void grid_row_info(int gr, int& seqbase, int& r, int& nrows) {
    if (gr < 1024) { seqbase = (gr >> 5) << 11; r = gr & 31; nrows = 32; } else { const int g2 = gr - 1024; seqbase = MP + ((g2 >> 7) << 13); r = g2 & 127; nrows = 128; }
}

#define GAS __attribute__((address_space(1)))
constexpr int AT_KSLOT = 9216, AT_VSLOT = 8704, AT_VOFF = 73728, AT_BOFF = 143360;
__device__ __forceinline__ void attn_fill_issue(const GAS bf16_t* ZM, const GAS bf16_t* ZT, int tok0, int head, int tid, u32x4& kreg, u32x4& vreg) {
    kreg = *(const GAS u32x4*)(ZM + (size_t)(tok0 + (tid >> 3)) * ZMW + 512 + head * 64 + (tid & 7) * 8);
    vreg = *(const GAS u32x4*)(ZT + ((size_t)(tok0 >> 6) * 512 + head * 64) * 64 + tid * 8);
}
__device__ __forceinline__ void attn_fill_write(LAS unsigned char* lds, int slot, int tid, const u32x4 kreg, const u32x4 vreg) {
    *(LAS u32x4*)(lds + slot * AT_KSLOT + (tid >> 3) * 144 + (tid & 7) * 16) = kreg;
    LAS u32x2* vp = (LAS u32x2*)(lds + AT_VOFF + slot * AT_VSLOT + (tid >> 3) * 136 + (tid & 7) * 16);
    u32x2 a; a.x = vreg.x; a.y = vreg.y; u32x2 b; b.x = vreg.z; b.y = vreg.w;
    vp[0] = a; vp[1] = b;
}
__device__ __forceinline__ void attn_row_lds(LAS unsigned char* lds, int seqbase, int r, int rs, int head, int lane, int wave, const GAS bf16_t* ZM, GAS bf16_t* Y) {
    const LAS float* bias = (const LAS float*)(lds + AT_BOFF);
    const int g = wave & 3, dh = wave >> 2;
    const int qi = lane & 15, h4 = lane >> 4;
    const int cs = (g == 0) ? 0 : (g == 1) ? 8 : (g == 2) ? 24 : 32;
    const int qc = 16 * g + qi;
    const int qtok = seqbase + r * 64 + qc;
    const GAS bf16_t* qp = ZM + (size_t)qtok * ZMW + head * 64 + 8 * h4;
    const bf16x8 bq0 = *(const GAS bf16x8*)qp;
    const bf16x8 bq1 = *(const GAS bf16x8*)(qp + 32);
    int cst = qc - 8; cst = cst < 0 ? 0 : cst; cst = cst > 48 ? 48 : cst;
    f32x4 S[16];
    float mx = -3.0e38f;
#pragma unroll
    for (int t = 0; t < 16; ++t) {
        const int kr = t >> 1, hf = t & 1;
        const int slot = (rs + kr) & 7;
        const LAS unsigned char* kp = lds + slot * AT_KSLOT + (cs + 16 * hf + qi) * 144 + h4 * 16;
        const bf16x8 ak0 = *(const LAS bf16x8*)kp, ak1 = *(const LAS bf16x8*)(kp + 64);
        const LAS float* brow = bias + (rs + kr - r + 7) * 31;
        float bv[4];
#pragma unroll
        for (int e = 0; e < 4; ++e) { int dc = cs + 16 * hf + 4 * h4 + e - qc + 15; dc = dc < 0 ? 0 : dc; dc = dc > 30 ? 30 : dc; bv[e] = brow[dc]; }
        f32x4 s = {0.f, 0.f, 0.f, 0.f};
        s = __builtin_amdgcn_mfma_f32_16x16x32_bf16(ak0, bq0, s, 0, 0, 0);
        s = __builtin_amdgcn_mfma_f32_16x16x32_bf16(ak1, bq1, s, 0, 0, 0);
        asm volatile("" : "+v"(bv[0]), "+v"(bv[1]), "+v"(bv[2]), "+v"(bv[3]));
#pragma unroll
        for (int e = 0; e < 4; ++e) {
            const int kc = cs + 16 * hf + 4 * h4 + e;
            const bool valid = (kc >= cst) && (kc < cst + 16);
            const float val = valid ? s[e] + bv[e] : -1.0e30f;
            s[e] = val; mx = fmaxf(mx, val);
        }
        S[t] = s;
    }
    mx = fmaxf(mx, __shfl_xor(mx, 16)); mx = fmaxf(mx, __shfl_xor(mx, 32));
    float sum = 0.f;
    bf16x8 pf[8];
#pragma unroll
    for (int kr = 0; kr < 8; ++kr) {
        const f32x4 a = S[kr * 2], b = S[kr * 2 + 1];
        const float p0 = __expf(a[0] - mx), p1 = __expf(a[1] - mx), p2 = __expf(a[2] - mx), p3 = __expf(a[3] - mx);
        const float p4 = __expf(b[0] - mx), p5 = __expf(b[1] - mx), p6 = __expf(b[2] - mx), p7 = __expf(b[3] - mx);
        sum += ((p0 + p1) + (p2 + p3)) + ((p4 + p5) + (p6 + p7));
        u32x4 w; w.x = pk2(p0, p1); w.y = pk2(p2, p3); w.z = pk2(p4, p5); w.w = pk2(p6, p7);
        pf[kr] = __builtin_bit_cast(bf16x8, w);
    }
    sum += __shfl_xor(sum, 16); sum += __shfl_xor(sum, 32);
    const float inv = 1.0f / sum;
    GAS bf16_t* yp = Y + (size_t)qtok * DM + head * 64 + 4 * h4;
#pragma unroll
    for (int dti = 0; dti < 2; ++dti) {
        const int dt = 2 * dh + dti;
        f32x4 o = {0.f, 0.f, 0.f, 0.f};
#pragma unroll
        for (int kr = 0; kr < 8; ++kr) {
            const int slot = (rs + kr) & 7;
            const LAS unsigned char* vp = lds + AT_VOFF + slot * AT_VSLOT + (dt * 16 + qi) * 136 + (cs + 4 * h4) * 2;
            const u32x2 lo = *(const LAS u32x2*)vp, hi = *(const LAS u32x2*)(vp + 32);
            u32x4 w; w.x = lo.x; w.y = lo.y; w.z = hi.x; w.w = hi.y;
            o = __builtin_amdgcn_mfma_f32_16x16x32_bf16(__builtin_bit_cast(bf16x8, w), pf[kr], o, 0, 0, 0);
        }
        u32x2 w; w.x = pk2(o[0] * inv, o[1] * inv); w.y = pk2(o[2] * inv, o[3] * inv);
        *(GAS u32x2*)(yp + dt * 16) = w;
    }
}
__device__ __forceinline__ void attn_unit(LAS unsigned char* lds, int seqbase, int nrows, int ra, int rb, int head, int tid, int lane, int wave,
                                          const bf16_t* ZM_, const bf16_t* ZT_, bf16_t* Y_, const float* rpb) {
    const GAS bf16_t* ZM = (const GAS bf16_t*)ZM_; const GAS bf16_t* ZT = (const GAS bf16_t*)ZT_; GAS bf16_t* Y = (GAS bf16_t*)Y_;
    int rs = ra - 4; rs = rs < 0 ? 0 : rs; rs = rs > nrows - 8 ? nrows - 8 : rs;
    {   u32x4 kreg[8], vreg[8];
#pragma unroll
        for (int k = 0; k < 8; ++k) attn_fill_issue(ZM, ZT, seqbase + (rs + k) * 64, head, tid, kreg[k], vreg[k]);
        LAS float* bw = (LAS float*)(lds + AT_BOFF);
        if (tid < 465) bw[tid] = rpb[head * 465 + tid];
#pragma unroll
        for (int k = 0; k < 8; ++k) attn_fill_write(lds, (rs + k) & 7, tid, kreg[k], vreg[k]);
    }
    __syncthreads();
#pragma unroll 1
    for (int r = ra; r < rb; ++r) {
        int rsn = r + 1 - 4; rsn = rsn < 0 ? 0 : rsn; rsn = rsn > nrows - 8 ? nrows - 8 : rsn;
        const bool adv = (r + 1 < rb) && (rsn != rs);
        u32x4 kreg = {0u, 0u, 0u, 0u}, vreg = {0u, 0u, 0u, 0u};
        if (adv) attn_fill_issue(ZM, ZT, seqbase + (rsn + 7) * 64, head, tid, kreg, vreg);
        attn_row_lds(lds, seqbase, r, rs, head, lane, wave, ZM, Y);
        __syncthreads();
        if (adv) attn_fill_write(lds, (rsn + 7) & 7, tid, kreg, vreg);
        __syncthreads();
        rs = rsn;
    }
}

template <int R>
__device__ __forceinline__ void butterfly_unit(int tok0, int rowbase  , int p, int lp, const bf16_t* ZT, bf16_t* YQ) {
    constexpr int L = 512 * R;
    const bf16_t* zre = ZT + (size_t)MTOK * 512 + ((size_t)(tok0 >> 9) * 512 + p) * 512 + lp;
    const bf16_t* zim = zre + 256 * 512;
    float xr[R], xi[R];
#pragma unroll
    for (int s = 0; s < R; ++s) { xr[s] = bf2f(zre[(size_t)s * 512 * 512]); xi[s] = bf2f(zim[(size_t)s * 512 * 512]); }
    const float scale = rsqrtf(64.0f * (float)L);
#pragma unroll 1
    for (int q = 0; q < R; ++q) {
        float wr_, wi_; sincospif(-2.0f * (float)q / (float)R, &wi_, &wr_);
        float yr = xr[R - 1], yi = xi[R - 1];
#pragma unroll
        for (int s = R - 2; s >= 0; --s) { const float tr = yr * wr_ - yi * wi_ + xr[s], ti = yr * wi_ + yi * wr_ + xi[s]; yr = tr; yi = ti; }
        float tr_, ti_; sincospif(-2.0f * (float)(q * lp) / (float)L, &ti_, &tr_);
        const float orr = (yr * tr_ - yi * ti_) * scale, oi = (yr * ti_ + yi * tr_) * scale;
        bf16_t* d = YQ + (size_t)(rowbase + q * 256) * 1024 + lp;
        d[0] = (bf16_t)f2bf(orr); d[512] = (bf16_t)f2bf(oi);
    }
}

__global__ void __launch_bounds__(NWAVES * 64, 2) fwd_kernel(Args args) {
    extern __shared__ __attribute__((aligned(16))) unsigned char lds_raw[];
    LAS unsigned char* lds = (LAS unsigned char*)lds_raw;
    const int G = gridDim.x, bx = blockIdx.x;
    for (int ph = args.ph_lo; ph < args.ph_hi; ++ph) {
        if (ph > args.ph_lo) { cg::this_grid().sync(); }
        int tid = threadIdx.x; asm volatile("" : "+v"(tid));
        const int lane = tid & 63, wave = __builtin_amdgcn_readfirstlane(tid >> 6);
        const int gw = bx * NWAVES + wave, NGW = G * NWAVES;
        unsigned char* ws = args.ws; asm volatile("" : "+s"(ws));
        const float* x_prompt = args.in[0]; const float* x_sample = args.in[1];
        float* out = args.out;
        bf16_t* XB = (bf16_t*)(ws + WS_XB); bf16_t* OB = XB;
        bf16_t* ZM = (bf16_t*)(ws + WS_ZM); bf16_t* PB = ZM;
        bf16_t* ZT = (bf16_t*)(ws + WS_ZT); bf16_t* MG = ZT;
        bf16_t* YQ = (bf16_t*)(ws + WS_YQ);
        bf16_t* Y = (bf16_t*)(ws + WS_Y);
        bf16_t* TT = (bf16_t*)(ws + WS_T);
        float* RS = (float*)(ws + WS_RS); float* SS = (float*)(ws + WS_SS);
        const int layer = (ph == 0) ? 0 : (ph - 1) / 7;
        const int sub = (ph == 0) ? -1 : (ph - 1) % 7;
        const bf16_t* WIN = (const bf16_t*)(ws + WS_WIN) + (size_t)layer * NG1 * DM;
        const bf16_t* WG = (const bf16_t*)(ws + WS_WG) + (size_t)layer * DM * DM;
        const bf16_t* WM = (const bf16_t*)(ws + WS_WM) + (size_t)layer * 3072 * DM;
        const bf16_t* WA = (const bf16_t*)(ws + WS_WA) + (size_t)layer * DM * 512;
        const bf16_t* WB = (const bf16_t*)(ws + WS_WB) + (size_t)layer * DM * 256;
        const bf16_t* WC = (const bf16_t*)(ws + WS_WC) + (size_t)layer * DM * 256;
        const bf16_t* WO = (const bf16_t*)(ws + WS_WO) + (size_t)layer * DM * DM;

        if (PHON(0) && ph == 0) {
            LAS float* scr = (LAS float*)(lds + wave * 16384);
            for (int l = 0; l < 2; ++l) {
                const float* w_in = args.in[4] + (size_t)l * DM * DIN;
                const float* gpre = args.in[2] + l * DM;
                bf16_t* win = (bf16_t*)(ws + WS_WIN) + (size_t)l * NG1 * DM;
                bf16_t* wg = (bf16_t*)(ws + WS_WG) + (size_t)l * DM * DM;
                bf16_t* wm = (bf16_t*)(ws + WS_WM) + (size_t)l * 3072 * DM;
                for (int job = 0; job < 7; ++job) {
                    int c0, nc, ro; bf16_t* dst; float sc = 1.f;
                    switch (job) {
                        case 0: c0 = 0; nc = 512; dst = win; ro = 0; sc = 0.125f; break;
                        case 1: c0 = 512; nc = 1024; dst = win; ro = 512; break;
                        case 2: c0 = 2560; nc = 512; dst = win; ro = 2048; break;
                        case 3: c0 = 1536; nc = 512; dst = wg; ro = 0; break;
                        case 4: c0 = 2304; nc = 256; dst = wg; ro = 512; break;
                        case 5: c0 = 3072; nc = 256; dst = wg; ro = 768; break;
                        default: c0 = 3328; nc = 3072; dst = wm; ro = 0; break;
                    }
                    const int nitems = (DM / 64) * (nc / 32);
                    for (int it = gw; it < nitems; it += NGW) transpose_item(w_in, DM, DIN, c0, nc, dst, ro, gpre, sc, scr, it, lane);
                }
                {   const int ni = (512 / 64) * (DM / 32);
                    for (int it = gw; it < ni; it += NGW) transpose_item(args.in[10] + (size_t)l * 512 * DM, 512, DM, 0, DM, (bf16_t*)(ws + WS_WA) + (size_t)l * DM * 512, 0, nullptr, 1.f, scr, it, lane); }
                {   const int ni = (256 / 64) * (DM / 32);
                    for (int it = gw; it < ni; it += NGW) transpose_item(args.in[11] + (size_t)l * 256 * DM, 256, DM, 0, DM, (bf16_t*)(ws + WS_WB) + (size_t)l * DM * 256, 0, nullptr, 1.f, scr, it, lane);
                    for (int it = gw; it < ni; it += NGW) transpose_item(args.in[12] + (size_t)l * 256 * DM, 256, DM, 0, DM, (bf16_t*)(ws + WS_WC) + (size_t)l * DM * 256, 0, nullptr, 1.f, scr, it, lane); }
                {   const int ni = (DM / 64) * (DM / 32);
                    for (int it = gw; it < ni; it += NGW) transpose_item(args.in[13] + (size_t)l * DM * DM, DM, DM, 0, DM, (bf16_t*)(ws + WS_WO) + (size_t)l * DM * DM, 0, nullptr, 1.f, scr, it, lane); }
                for (int idx = bx * 512 + tid; idx < DM * 256; idx += G * 512) {
                    const int k = idx >> 8, p = idx & 255, grp = p >> 6, mm = p & 63;
                    const float* wrow = w_in + (size_t)k * DIN + 2048 + grp * 64;
                    float are = 0.f, aim = 0.f;
                    for (int c = 0; c < 64; ++c) { float sn, cs; sincospif((float)((mm * c) & 63) * (1.0f / 32.0f), &sn, &cs); const float w = wrow[c]; are += w * cs; aim -= w * sn; }
                    const float gk = gpre[k];
                    win[(size_t)(1536 + p) * DM + k] = (bf16_t)f2bf(are * gk);
                    win[(size_t)(1536 + 256 + p) * DM + k] = (bf16_t)f2bf(aim * gk);
                }
            }
            for (int idx = bx * 512 + tid; idx < 512 * 512; idx += G * 512) {
                const int kp = idx >> 9, lp = idx & 511; float sn, cs; sincospif((float)((kp * lp) & 511) * (1.0f / 256.0f), &sn, &cs);
                TT[(size_t)kp * 1024 + lp] = (bf16_t)f2bf(cs); TT[(size_t)kp * 1024 + 512 + lp] = (bf16_t)f2bf(sn);
            }
        }
        if (PHON(1) && (ph == 0 || sub == 6)) {
            const int mode = (ph == 0) ? 0 : (layer == 0 ? 1 : 2);
            const float* gpost = args.in[3] + layer * DM;
            for (int m = gw; m < MTOK; m += NGW) {
                const float* xin = (mode == 2) ? (out + (size_t)m * DM) : ((m < MP) ? x_prompt + (size_t)m * DM : x_sample + (size_t)(m - MP) * DM);
                const f32x4* xr = (const f32x4*)xin + lane;
                f32x4 v[4];
#pragma unroll
                for (int j = 0; j < 4; ++j) v[j] = xr[64 * j];
                if (mode != 0) {
                    const float rq = rsqrtf(SS[m] * (1.0f / DM) + EPS);
                    const u32x2* orow = (const u32x2*)(OB + (size_t)m * DM) + lane;
#pragma unroll
                    for (int j = 0; j < 4; ++j) { const u32x2 ov = orow[64 * j]; const f32x4 gp = *((const f32x4*)gpost + lane + 64 * j);
                        v[j][0] += bflo(ov.x) * rq * gp[0]; v[j][1] += bfhi(ov.x) * rq * gp[1]; v[j][2] += bflo(ov.y) * rq * gp[2]; v[j][3] += bfhi(ov.y) * rq * gp[3]; }
                    f32x4* orow2 = (f32x4*)(out + (size_t)m * DM) + lane;
#pragma unroll
                    for (int j = 0; j < 4; ++j) orow2[64 * j] = v[j];
                }
                if (mode != 2) {
                    float s = 0.f;
#pragma unroll
                    for (int j = 0; j < 4; ++j) s += (v[j][0] * v[j][0] + v[j][1] * v[j][1]) + (v[j][2] * v[j][2] + v[j][3] * v[j][3]);
                    s = wave_sum(s);
                    u32x2* o8 = (u32x2*)(XB + (size_t)m * DM) + lane;
#pragma unroll
                    for (int j = 0; j < 4; ++j) { u32x2 w; w.x = pk2(v[j][0], v[j][1]); w.y = pk2(v[j][2], v[j][3]); o8[64 * j] = w; }
                    if (lane == 0) { RS[m] = rsqrtf(s * (1.0f / DM) + EPS); SS[m] = 0.f; }
                }
            }
        } else if (PHON(2) && sub == 0) {
            pg8::Gemm g{XB, WIN, MTOK, NG1, DM, DM, DM}; pg8::StaticOrder S; S.init(MTOK, NG1, G, bx);
            pg8::EpiG1 E{RS, ZM, ZT};
            pg8::gemm_phase<pg8::EpiG1, pg8::StaticOrder, true>(lds, g, S, E);
        } else if (sub == 1) {
            if (PHON(3)) {
                const float* rpb = args.in[5] + (size_t)layer * 8 * 15 * 31;
                for (int un = bx; un < 512; un += G) {
                    if (un < 256) attn_unit(lds, (un >> 3) * 2048, 32, 0, 32, un & 7, tid, lane, wave, ZM, ZT, Y, rpb);
                    else { const int v = un - 256, st = v & 7; attn_unit(lds, MP + (v >> 6) * 8192, 128, st * 16, st * 16 + 16, (v >> 3) & 7, tid, lane, wave, ZM, ZT, Y, rpb); }
                }
            }
            if (PHON(4)) {
                LAS float* hbuf = (LAS float*)lds; LAS float* cbuf = (LAS float*)(lds + 65536);
                const float* dww = args.in[6] + (size_t)layer * 31 * 256; const float* dwb = args.in[7] + layer * 256;
                const float* lng = args.in[8] + layer * 256; const float* lnb = args.in[9] + layer * 256;
                const int c = tid & 255, half = tid >> 8;
                float w[31];
#pragma unroll
                for (int j = 0; j < 31; ++j) w[j] = dww[j * 256 + c];
                const float bc = dwb[c];
                const f32x4 lg = *((const f32x4*)lng + lane), lb = *((const f32x4*)lnb + lane);
                for (int cu = bx; cu < MTOK / 32; cu += G) {
                    const int t0g = cu * 32;
                    int sbeg, send; if (t0g < MP) { sbeg = t0g & ~2047; send = sbeg + 2048; } else { sbeg = MP + ((t0g - MP) & ~8191); send = sbeg + 8192; }
#pragma unroll
                    for (int it0 = 0; it0 < 4; ++it0) {
                        const int it = tid + it0 * 512; if (it >= 62 * 32) break;
                        const int i = it >> 5, c8 = (it & 31) * 8; const int tok = t0g - 15 + i;
                        f32x4 h0 = {0.f, 0.f, 0.f, 0.f}, h1 = {0.f, 0.f, 0.f, 0.f};
                        if (tok >= sbeg && tok < send) {
                            const u32x4 a = *(const u32x4*)(ZM + (size_t)tok * ZMW + 1024 + c8), b = *(const u32x4*)(ZM + (size_t)tok * ZMW + 1280 + c8);
                            h0[0] = bflo(a.x) * sigmoidf_(bflo(b.x)); h0[1] = bfhi(a.x) * sigmoidf_(bfhi(b.x)); h0[2] = bflo(a.y) * sigmoidf_(bflo(b.y)); h0[3] = bfhi(a.y) * sigmoidf_(bfhi(b.y));
                            h1[0] = bflo(a.z) * sigmoidf_(bflo(b.z)); h1[1] = bfhi(a.z) * sigmoidf_(bfhi(b.z)); h1[2] = bflo(a.w) * sigmoidf_(bflo(b.w)); h1[3] = bfhi(a.w) * sigmoidf_(bfhi(b.w));
                        }
                        *(LAS f32x4*)(hbuf + i * 256 + c8) = h0; *(LAS f32x4*)(hbuf + i * 256 + c8 + 4) = h1;
                    }
                    __syncthreads();
#pragma unroll 1
                    for (int tt = 0; tt < 16; ++tt) {
                        const int t = half * 16 + tt; float a = bc;
#pragma unroll
                        for (int j = 0; j < 31; ++j) a += w[j] * hbuf[(t + j) * 256 + c];
                        cbuf[t * 256 + c] = a;
                    }
                    __syncthreads();
#pragma unroll 1
                    for (int tt = 0; tt < 4; ++tt) {
                        const int t = wave * 4 + tt;
                        const f32x4 xv = *(const LAS f32x4*)(cbuf + t * 256 + 4 * lane);
                        const float mean = wave_sum((xv[0] + xv[1]) + (xv[2] + xv[3])) * (1.0f / 256.0f);
                        const f32x4 d = xv - mean;
                        const float var = wave_sum((d[0] * d[0] + d[1] * d[1]) + (d[2] * d[2] + d[3] * d[3])) * (1.0f / 256.0f);
                        const float rstd = rsqrtf(var + EPS);
                        const float y0 = siluf_(d[0] * rstd * lg[0] + lb[0]), y1 = siluf_(d[1] * rstd * lg[1] + lb[1]), y2 = siluf_(d[2] * rstd * lg[2] + lb[2]), y3 = siluf_(d[3] * rstd * lg[3] + lb[3]);
                        u32x2 wv; wv.x = pk2(y0, y1); wv.y = pk2(y2, y3);
                        *(u32x2*)(Y + (size_t)(t0g + t) * DM + 768 + 4 * lane) = wv;
                    }
                    __syncthreads();
                }
            }
            if (PHON(5)) {
                for (int un = bx; un < 32 * 256; un += G) { const int seq = un >> 8, p = un & 255; butterfly_unit<4>(seq * 2048, seq * 1024 + p, p, tid, ZT, YQ); }
                for (int un = bx; un < 4 * 256; un += G) { const int seq = un >> 8, p = un & 255; butterfly_unit<16>(MP + seq * 8192, 32768 + seq * 4096 + p, p, tid, ZT, YQ); }
            }
        } else if (PHON(6) && sub == 2) {
            pg8::Gemm g{YQ, TT, NYQ, 512, 1024, 1024, 1024}; pg8::StaticOrder S; S.init(NYQ, 512, G, bx);
            pg8::EpiDFT E{Y};
            pg8::gemm_phase<pg8::EpiDFT, pg8::StaticOrder, true>(lds, g, S, E);
        } else if (PHON(7) && sub == 3) {
            pg8::Gemm g{XB, WG, MTOK, DM, DM, DM, DM}; pg8::StaticOrder S; S.init(MTOK, DM, G, bx);
            pg8::EpiG2 E{RS, Y};
            pg8::gemm_phase<pg8::EpiG2, pg8::StaticOrder, true>(lds, g, S, E);
        } else if (sub == 4) {
            pg8::StaticOrder S; S.init(MTOK, DM, G, bx);
            bf16_t* PT = PB + (size_t)bx * 65536; bf16_t* MT = PB + (size_t)(256 + bx) * 65536;
#pragma unroll 1
            for (int i = 0; ; ++i) {
                pg8::SingleUnit SU; if (!S.next(i, SU.u)) break;
#pragma unroll 1
                for (int b = 0; b < 3; ++b) {
                    const int kb = (b == 0) ? 512 : 256, aoffc = (b == 0) ? 0 : (b == 1 ? 512 : 768);
                    const bf16_t* wb = (b == 0) ? WA : (b == 1 ? WB : WC);
                    pg8::Gemm gp{Y + aoffc, wb, MTOK, DM, kb, DM, kb};
                    pg8::EpiStoreT EP{PT};
                    if (PHON(8)) pg8::gemm_phase<pg8::EpiStoreT, pg8::SingleUnit, true>(lds, gp, SU, EP);
                    pg8::Gemm gm{XB, WM + (size_t)b * DM * DM, MTOK, DM, DM, DM, DM};
                    pg8::EpiMergeT EM{RS, PT, MT, MG, b};
                    if (PHON(9)) pg8::gemm_phase<pg8::EpiMergeT, pg8::SingleUnit, true>(lds, gm, SU, EM);
                }
            }
        } else if (PHON(10) && sub == 5) {
            pg8::Gemm g{MG, WO, MTOK, DM, DM, DM, DM}; pg8::StaticOrder S; S.init(MTOK, DM, G, bx);
            pg8::EpiG5 E{OB, SS};
            pg8::gemm_phase<pg8::EpiG5, pg8::StaticOrder, true>(lds, g, S, E);
        }
    }
}

extern "C" void kernel_launch(void* const* d_in, const int* in_sizes, int n_in, void* d_out, int out_size, void* d_ws, size_t ws_size, hipStream_t stream) {
    static int grid = 0;
    if (grid == 0) {
        if (n_in != 14 || ws_size < WS_END) { fprintf(stderr, "kernel_launch: bad inputs (n_in %d, ws %zu < %zu)\n", n_in, ws_size, (size_t)WS_END); grid = -1; return; }
        int dev = 0, cus = 0, per_cu = 0;
        hipGetDevice(&dev); hipDeviceGetAttribute(&cus, hipDeviceAttributeMultiprocessorCount, dev);
        if (hipFuncSetAttribute((const void*)fwd_kernel, hipFuncAttributeMaxDynamicSharedMemorySize, LDS_BYTES) != hipSuccess) { fprintf(stderr, "hipFuncSetAttribute failed\n"); grid = -1; return; }
        hipOccupancyMaxActiveBlocksPerMultiprocessor(&per_cu, (const void*)fwd_kernel, NWAVES * 64, LDS_BYTES);
        (void)hipGetLastError();
        if (per_cu < 1) { fprintf(stderr, "occupancy query says 0 blocks per CU\n"); }
        grid = cus;
    }
    if (grid < 0) return;
    Args a{};
    for (int i = 0; i < 14; ++i) a.in[i] = (const float*)d_in[i];
    a.out = (float*)d_out; a.ws = (unsigned char*)d_ws;
#if MK_ONE_LAUNCH
    a.ph_lo = 0; a.ph_hi = 15;
    void* kargs[] = {&a};
    hipError_t e = hipLaunchCooperativeKernel((const void*)fwd_kernel, dim3(grid), dim3(NWAVES * 64), kargs, LDS_BYTES, stream);
    if (e != hipSuccess) fprintf(stderr, "cooperative launch failed: %s (grid %d)\n", hipGetErrorString(e), grid);
#else
    for (int ph = 0; ph < 15; ++ph) {
        a.ph_lo = ph; a.ph_hi = ph + 1;
        hipLaunchKernelGGL(fwd_kernel, dim3(grid), dim3(NWAVES * 64), LDS_BYTES, stream, a);
    }
#endif
}
```

```cpp
#include <hip/hip_runtime.h>
#include <hip/hip_cooperative_groups.h>
#include <cstdio>
#include <cstdint>
namespace cg = cooperative_groups;

#ifndef MK_ONE_LAUNCH
#define MK_ONE_LAUNCH 1
#endif

#ifndef PH_MASK
#define PH_MASK 0xFFFF
#endif
#define PHON(k) (((PH_MASK) >> (k)) & 1)
#define LAS __attribute__((address_space(3)))
typedef unsigned short bf16_t;
typedef short bf16x8 __attribute__((ext_vector_type(8)));
typedef short s16x4 __attribute__((ext_vector_type(4)));
typedef float f32x4 __attribute__((ext_vector_type(4)));
typedef unsigned u32x4 __attribute__((ext_vector_type(4)));
typedef unsigned u32x2 __attribute__((ext_vector_type(2)));

constexpr int DM = 1024;
constexpr int MP = 65536;
constexpr int MTOK = 98304;
constexpr int DIN = 6400;
constexpr int NG1 = 2560;
constexpr int ZMW = 1536;
constexpr int NYQ = 49152;
constexpr float EPS = 1e-6f;

constexpr size_t MiB = 1u << 20;
constexpr size_t WS_WIN = 0;
constexpr size_t WS_WG = 10 * MiB;
constexpr size_t WS_WM = 14 * MiB;
constexpr size_t WS_WA = 26 * MiB;
constexpr size_t WS_WB = 28 * MiB;
constexpr size_t WS_WC = 29 * MiB;
constexpr size_t WS_WO = 30 * MiB;
constexpr size_t WS_T = 34 * MiB;
constexpr size_t WS_RS = 35 * MiB;
constexpr size_t WS_SS = 35 * MiB + 512 * 1024;
constexpr size_t WS_XB = 36 * MiB;
constexpr size_t WS_ZM = 228 * MiB;
constexpr size_t WS_ZT = 516 * MiB;
constexpr size_t WS_YQ = 708 * MiB;
constexpr size_t WS_Y = 804 * MiB;
constexpr size_t WS_END = 996 * MiB;

constexpr int NWAVES = 8;
constexpr int LDS_BYTES = 147456;

__device__ __forceinline__ unsigned f2bf(float f) { unsigned u = __builtin_bit_cast(unsigned, f); return (u + 0x7fffu + ((u >> 16) & 1u)) >> 16; }
__device__ __forceinline__ unsigned pk2(float lo, float hi) { return f2bf(lo) | (f2bf(hi) << 16); }
__device__ __forceinline__ float bf2f(unsigned b) { return __builtin_bit_cast(float, b << 16); }
__device__ __forceinline__ float bflo(unsigned w) { return __builtin_bit_cast(float, w << 16); }
__device__ __forceinline__ float bfhi(unsigned w) { return __builtin_bit_cast(float, w & 0xffff0000u); }
__device__ __forceinline__ float sigmoidf_(float x) { return 1.0f / (1.0f + __expf(-x)); }
__device__ __forceinline__ float siluf_(float x) { return x / (1.0f + __expf(-x)); }
__device__ __forceinline__ float wave_sum(float v) {
#pragma unroll
    for (int o = 1; o < 64; o <<= 1) v += __shfl_xor(v, o);
    return v;
}
#define LDS_WAIT() asm volatile("s_waitcnt lgkmcnt(0)" ::: "memory")
#define GAS __attribute__((address_space(1)))

namespace pg8 {
constexpr int BM = 256, BK = 64, HALF = 128, HTB = HALF * BK * 2, STAGE_BYTES = 8 * HTB, NXCD = 8, WGM = 8;
__device__ __forceinline__ int lds_byte(int r, int c) { const int st = (r >> 4) * 2 + (c >> 5), rr = r & 15, cc = c & 31, ob = rr * 64 + cc * 2; return st * 1024 + (ob ^ (((ob >> 9) & 1) << 5)); }
__device__ __forceinline__ void stage_rc(int b, int& R, int& C) { const int st = b / 1024, sb = b % 1024, swz = sb ^ (((sb >> 9) & 1) << 5); R = (st >> 1) * 16 + swz / 64; C = (st & 1) * 32 + (swz % 64) / 2; }

struct Unit { int pm, pn; };
struct Gemm { const bf16_t* A; const bf16_t* Bt; int M, N, K, lda, ldb; };

struct StaticOrder {
    int nM, nN, nwg, G, c;
    __device__ __forceinline__ void init(int M, int N, int G_, int c_) { nM = M / BM; nN = N / BM; nwg = nM * nN; G = G_; c = c_; }
    __device__ __forceinline__ bool next(int i, Unit& u) const {
        const long L = (long)i * G + c; if (L >= nwg) return false;
        int wgid = (int)L; { const int q = nwg / NXCD, r = nwg % NXCD, xcd = wgid % NXCD, off = wgid / NXCD; wgid = (xcd < r ? xcd * (q + 1) : r * (q + 1) + (xcd - r) * q) + off; }
        const int nig = WGM * nN, gid = wgid / nig, fm = gid * WGM, gsz = (nM - fm) < WGM ? (nM - fm) : WGM;
        u.pm = fm + ((wgid % nig) % gsz); u.pn = (wgid % nig) / gsz; return true;
    }
};

struct SingleUnit { Unit u; __device__ bool next(int i, Unit& o) const { if (i) return false; o = u; return true; } };
template <class Epi, class Sched, bool ALIGN_EPI>
__device__ __forceinline__ void gemm_phase(LAS unsigned char* lds, const Gemm g, const Sched& S, const Epi& E) {
    int tid = threadIdx.x; asm volatile("" : "+v"(tid));
    const int wid = __builtin_amdgcn_readfirstlane(tid >> 6), lane = tid & 63, wr = wid >> 2, wc = wid & 3, fr = lane & 15, fq = lane >> 4;
    const int K = g.K, nt = K / BK;
    unsigned voffA[2], voffB[2];
#pragma unroll
    for (int i = 0; i < 2; ++i) { int R, C; stage_rc(tid * 16 + i * 8192, R, C);
        voffA[i] = (unsigned)(R * g.lda + C) * 2u; voffB[i] = (unsigned)(R * g.ldb + C) * 2u; }
    const size_t kstep = (size_t)(BK * 2);
    const size_t hstepA = (size_t)HALF * g.lda * 2, hstepB = (size_t)HALF * g.ldb * 2;
    const size_t tstepA = 2 * hstepA, tstepB = 2 * hstepB;
    const unsigned ldsw = (unsigned)wid * 1024u;
    const int aoff = lds_byte(wr * 64 + fr, fq * 8), boff = lds_byte(wc * 32 + fr, fq * 8);
#define PG8_SA(b, h) (((b) * 2 + (h)) * HTB)
#define PG8_SB(b, h) ((4 + (b) * 2 + (h)) * HTB)
#define PG8_STAGE(bufoff, gbase, voff) do { _Pragma("unroll") for (int _i = 0; _i < 2; ++_i) \
        __builtin_amdgcn_global_load_lds((const unsigned*)((const char*)(gbase) + (voff)[_i]), (LAS unsigned*)(lds + (bufoff) + ldsw + _i * 8192), 16, 0, 0); } while (0)
#define PG8_LDA(dst, b, h) do { _Pragma("unroll") for (int m = 0; m < 4; ++m) _Pragma("unroll") for (int k = 0; k < 2; ++k) dst[m][k] = *(const LAS bf16x8*)(lds + PG8_SA(b, h) + aoff + m * 2048 + k * 1024); } while (0)
#define PG8_LDB(dst, b, h) do { _Pragma("unroll") for (int n = 0; n < 2; ++n) _Pragma("unroll") for (int k = 0; k < 2; ++k) dst[n][k] = *(const LAS bf16x8*)(lds + PG8_SB(b, h) + boff + n * 2048 + k * 1024); } while (0)
#define PG8_MMA(ai, bj, At, Bt) do { __builtin_amdgcn_s_setprio(1); _Pragma("unroll") for (int m = 0; m < 4; ++m) _Pragma("unroll") for (int n = 0; n < 2; ++n) _Pragma("unroll") for (int k = 0; k < 2; ++k) \
        acc[ai][bj][m][n] = __builtin_amdgcn_mfma_f32_16x16x32_bf16(Bt[n][k], At[m][k], acc[ai][bj][m][n], 0, 0, 0); __builtin_amdgcn_s_setprio(0); } while (0)
#define PG8_WAIT_V(n) asm volatile("s_waitcnt vmcnt(" #n ")" ::: "memory")
#define PG8_WAIT_L(n) asm volatile("s_waitcnt lgkmcnt(" #n ")" ::: "memory")
#define PG8_BAR __builtin_amdgcn_s_barrier()
#define PG8_SCHED __builtin_amdgcn_sched_barrier(0)
    Unit cur, nxt; int ui = 0;
    if (!S.next(0, cur)) return;
    f32x4 acc[2][2][4][2];
#pragma unroll
    for (int a = 0; a < 2; ++a)
#pragma unroll
        for (int b = 0; b < 2; ++b)
#pragma unroll
            for (int m = 0; m < 4; ++m)
#pragma unroll
                for (int n = 0; n < 2; ++n) acc[a][b][m][n] = (f32x4){0.f, 0.f, 0.f, 0.f};
    bf16x8 At[4][2], B0[2][2], B1[2][2];
    const char* cA = (const char*)g.A + (size_t)cur.pm * tstepA; const char* cB = (const char*)g.Bt + (size_t)cur.pn * tstepB;
    PG8_STAGE(PG8_SB(0, 0), cB, voffB); PG8_STAGE(PG8_SB(0, 1), cB + hstepB, voffB); PG8_STAGE(PG8_SA(0, 0), cA, voffA); PG8_STAGE(PG8_SA(0, 1), cA + hstepA, voffA);
    if (wr == 1) PG8_BAR;
    PG8_WAIT_V(2); PG8_BAR;
    PG8_STAGE(PG8_SB(1, 0), cB + kstep, voffB); PG8_STAGE(PG8_SA(1, 0), cA + kstep, voffA); PG8_STAGE(PG8_SB(1, 1), cB + hstepB + kstep, voffB);
    PG8_WAIT_V(6); PG8_BAR;
    for (;;) {
        const bool has_next = S.next(ui + 1, nxt);
        const char* nA = has_next ? (const char*)g.A + (size_t)nxt.pm * tstepA : cA; const char* nB = has_next ? (const char*)g.Bt + (size_t)nxt.pn * tstepB : cB;
        for (int t = 0; t < nt; t += 2) {
            const bool last = (t == nt - 2);
            const char* a1 = cA + (size_t)(t + 1) * kstep;
            const char* a2 = last ? nA : cA + (size_t)(t + 2) * kstep; const char* b2 = last ? nB : cB + (size_t)(t + 2) * kstep;
            const char* a3 = a2 + kstep; const char* b3 = b2 + kstep;
            PG8_LDB(B0, 0, 0); PG8_LDB(B1, 0, 1); PG8_SCHED; PG8_LDA(At, 0, 0); PG8_STAGE(PG8_SA(1, 1), a1 + hstepA, voffA);
            PG8_WAIT_V(8); PG8_WAIT_L(0); PG8_BAR; PG8_MMA(0, 0, At, B0); PG8_MMA(0, 1, At, B1); PG8_BAR; PG8_SCHED;
            PG8_LDA(At, 0, 1); PG8_STAGE(PG8_SB(0, 0), b2, voffB); PG8_STAGE(PG8_SB(0, 1), b2 + hstepB, voffB); PG8_STAGE(PG8_SA(0, 0), a2, voffA);
            PG8_WAIT_V(8); PG8_WAIT_L(0); PG8_BAR; PG8_MMA(1, 0, At, B0); PG8_MMA(1, 1, At, B1); PG8_BAR; PG8_SCHED;
            PG8_LDB(B0, 1, 0); PG8_LDB(B1, 1, 1); PG8_SCHED; PG8_LDA(At, 1, 0); PG8_STAGE(PG8_SA(0, 1), a2 + hstepA, voffA);
            PG8_WAIT_V(8); PG8_WAIT_L(0); PG8_BAR; PG8_MMA(0, 0, At, B0); PG8_MMA(0, 1, At, B1); PG8_BAR; PG8_SCHED;
            PG8_LDA(At, 1, 1); PG8_STAGE(PG8_SB(1, 0), b3, voffB); PG8_STAGE(PG8_SB(1, 1), b3 + hstepB, voffB); PG8_STAGE(PG8_SA(1, 0), a3, voffA);
            PG8_WAIT_V(8); PG8_WAIT_L(0); PG8_BAR; PG8_MMA(1, 0, At, B0); PG8_MMA(1, 1, At, B1); PG8_BAR; PG8_SCHED;
        }
        if constexpr (ALIGN_EPI) { if (wr == 0) PG8_BAR; }
        E(acc, cur, wr, wc, fr, fq);
        if (!has_next) break;
#pragma unroll
        for (int a = 0; a < 2; ++a)
#pragma unroll
            for (int b = 0; b < 2; ++b)
#pragma unroll
                for (int m = 0; m < 4; ++m)
#pragma unroll
                    for (int n = 0; n < 2; ++n) acc[a][b][m][n] = (f32x4){0.f, 0.f, 0.f, 0.f};
        cur = nxt; cA = nA; cB = nB; ++ui;
        if constexpr (ALIGN_EPI) { if (wr == 1) PG8_BAR; }
    }
    PG8_WAIT_V(0);
    if constexpr (!ALIGN_EPI) { if (wr == 0) PG8_BAR; }
    PG8_BAR;
#undef PG8_SA
#undef PG8_SB
#undef PG8_STAGE
#undef PG8_LDA
#undef PG8_LDB
#undef PG8_MMA
#undef PG8_WAIT_V
#undef PG8_WAIT_L
#undef PG8_BAR
#undef PG8_SCHED
}

struct UnitX { int pm, pn, seg; };
__device__ __forceinline__ int uni(int v) { return __builtin_amdgcn_readfirstlane(v); }
__device__ __forceinline__ const char* unip(const char* p) { const unsigned long long v = (unsigned long long)p; const unsigned lo = (unsigned)__builtin_amdgcn_readfirstlane((int)(unsigned)v), hi = (unsigned)__builtin_amdgcn_readfirstlane((int)(unsigned)(v >> 32)); return (const char*)(((unsigned long long)hi << 32) | lo); }
template <class Epi, class Prog>
__device__ __forceinline__ void gemm_multi(LAS unsigned char* lds, const Prog& P, const Epi& E) {
    int tid = threadIdx.x; asm volatile("" : "+v"(tid));
    const int wid = __builtin_amdgcn_readfirstlane(tid >> 6), lane = tid & 63, wr = wid >> 2, wc = wid & 3, fr = lane & 15, fq = lane >> 4;
    unsigned Rr[2], Cc2[2];
#pragma unroll
    for (int i = 0; i < 2; ++i) { int R, C; stage_rc(tid * 16 + i * 8192, R, C); Rr[i] = (unsigned)R * 2u; Cc2[i] = (unsigned)C * 2u; }
    const size_t kstep = (size_t)(BK * 2);
    const unsigned ldsw = (unsigned)wid * 1024u;
    const int aoff = lds_byte(wr * 64 + fr, fq * 8), boff = lds_byte(wc * 32 + fr, fq * 8);
#define PG8_SA(b, h) (((b) * 2 + (h)) * HTB)
#define PG8_SB(b, h) ((4 + (b) * 2 + (h)) * HTB)
#define PG8_STAGE(bufoff, gbase, ld) do { _Pragma("unroll") for (int _i = 0; _i < 2; ++_i) \
        __builtin_amdgcn_global_load_lds((const unsigned*)((const char*)(gbase) + (Rr[_i] * (unsigned)(ld) + Cc2[_i])), (LAS unsigned*)(lds + (bufoff) + ldsw + _i * 8192), 16, 0, 0); } while (0)
#define PG8_LDA(dst, b, h) do { _Pragma("unroll") for (int m = 0; m < 4; ++m) _Pragma("unroll") for (int k = 0; k < 2; ++k) dst[m][k] = *(const LAS bf16x8*)(lds + PG8_SA(b, h) + aoff + m * 2048 + k * 1024); } while (0)
#define PG8_LDB(dst, b, h) do { _Pragma("unroll") for (int n = 0; n < 2; ++n) _Pragma("unroll") for (int k = 0; k < 2; ++k) dst[n][k] = *(const LAS bf16x8*)(lds + PG8_SB(b, h) + boff + n * 2048 + k * 1024); } while (0)
#define PG8_MMA(ai, bj, At, Bt) do { __builtin_amdgcn_s_setprio(1); _Pragma("unroll") for (int m = 0; m < 4; ++m) _Pragma("unroll") for (int n = 0; n < 2; ++n) _Pragma("unroll") for (int k = 0; k < 2; ++k) \
        acc[ai][bj][m][n] = __builtin_amdgcn_mfma_f32_16x16x32_bf16(Bt[n][k], At[m][k], acc[ai][bj][m][n], 0, 0, 0); __builtin_amdgcn_s_setprio(0); } while (0)
#define PG8_WAIT_V(n) asm volatile("s_waitcnt vmcnt(" #n ")" ::: "memory")
#define PG8_WAIT_L(n) asm volatile("s_waitcnt lgkmcnt(" #n ")" ::: "memory")
#define PG8_BAR __builtin_amdgcn_s_barrier()
#define PG8_SCHED __builtin_amdgcn_sched_barrier(0)
    UnitX cur, nxt; int ui = 0;
    if (!P.next(0, cur)) return;
    f32x4 acc[2][2][4][2];
#pragma unroll
    for (int a = 0; a < 2; ++a)
#pragma unroll
        for (int b = 0; b < 2; ++b)
#pragma unroll
            for (int m = 0; m < 4; ++m)
#pragma unroll
                for (int n = 0; n < 2; ++n) acc[a][b][m][n] = (f32x4){0.f, 0.f, 0.f, 0.f};
    bf16x8 At[4][2], B0[2][2], B1[2][2];
    const char* cA; const char* cB; int lda, ldb, nt;
    P.desc(cur, cA, cB, lda, ldb, nt); cA = unip(cA); cB = unip(cB); lda = uni(lda); ldb = uni(ldb); nt = uni(nt);
    {   const size_t hA = (size_t)HALF * lda * 2, hB = (size_t)HALF * ldb * 2;
        PG8_STAGE(PG8_SB(0, 0), cB, ldb); PG8_STAGE(PG8_SB(0, 1), cB + hB, ldb); PG8_STAGE(PG8_SA(0, 0), cA, lda); PG8_STAGE(PG8_SA(0, 1), cA + hA, lda);
        if (wr == 1) PG8_BAR;
        PG8_WAIT_V(2); PG8_BAR;
        PG8_STAGE(PG8_SB(1, 0), cB + kstep, ldb); PG8_STAGE(PG8_SA(1, 0), cA + kstep, lda); PG8_STAGE(PG8_SB(1, 1), cB + hB + kstep, ldb);
        PG8_WAIT_V(6); PG8_BAR; }
    for (;;) {
        const bool has_next = P.next(ui + 1, nxt);
        const char* nA = cA; const char* nB = cB; int ldan = lda, ldbn = ldb, ntn = nt;
        if (has_next) P.desc(nxt, nA, nB, ldan, ldbn, ntn);
        nA = unip(nA); nB = unip(nB); ldan = uni(ldan); ldbn = uni(ldbn); ntn = uni(ntn);
        const size_t hAc = (size_t)HALF * lda * 2;
        for (int t = 0; t < nt; t += 2) {
            const bool last = (t == nt - 2);
            const char* a1 = cA + (size_t)(t + 1) * kstep;
            const char* a2 = last ? nA : cA + (size_t)(t + 2) * kstep; const char* b2 = last ? nB : cB + (size_t)(t + 2) * kstep;
            const int lda2 = last ? ldan : lda, ldb2 = last ? ldbn : ldb;
            const size_t hA2 = (size_t)HALF * lda2 * 2, hB2 = (size_t)HALF * ldb2 * 2;
            const char* a3 = a2 + kstep; const char* b3 = b2 + kstep;
            PG8_LDB(B0, 0, 0); PG8_LDB(B1, 0, 1); PG8_SCHED; PG8_LDA(At, 0, 0); PG8_STAGE(PG8_SA(1, 1), a1 + hAc, lda);
            PG8_WAIT_V(8); PG8_WAIT_L(0); PG8_BAR; PG8_MMA(0, 0, At, B0); PG8_MMA(0, 1, At, B1); PG8_BAR; PG8_SCHED;
            PG8_LDA(At, 0, 1); PG8_STAGE(PG8_SB(0, 0), b2, ldb2); PG8_STAGE(PG8_SB(0, 1), b2 + hB2, ldb2); PG8_STAGE(PG8_SA(0, 0), a2, lda2);
            PG8_WAIT_V(8); PG8_WAIT_L(0); PG8_BAR; PG8_MMA(1, 0, At, B0); PG8_MMA(1, 1, At, B1); PG8_BAR; PG8_SCHED;
            PG8_LDB(B0, 1, 0); PG8_LDB(B1, 1, 1); PG8_SCHED; PG8_LDA(At, 1, 0); PG8_STAGE(PG8_SA(0, 1), a2 + hA2, lda2);
            PG8_WAIT_V(8); PG8_WAIT_L(0); PG8_BAR; PG8_MMA(0, 0, At, B0); PG8_MMA(0, 1, At, B1); PG8_BAR; PG8_SCHED;
            PG8_LDA(At, 1, 1); PG8_STAGE(PG8_SB(1, 0), b3, ldb2); PG8_STAGE(PG8_SB(1, 1), b3 + hB2, ldb2); PG8_STAGE(PG8_SA(1, 0), a3, lda2);
            PG8_WAIT_V(8); PG8_WAIT_L(0); PG8_BAR; PG8_MMA(1, 0, At, B0); PG8_MMA(1, 1, At, B1); PG8_BAR; PG8_SCHED;
        }
        if (wr == 0) PG8_BAR;
        E(acc, cur, wr, wc, fr, fq);
        if (!has_next) break;
#pragma unroll
        for (int a = 0; a < 2; ++a)
#pragma unroll
            for (int b = 0; b < 2; ++b)
#pragma unroll
                for (int m = 0; m < 4; ++m)
#pragma unroll
                    for (int n = 0; n < 2; ++n) acc[a][b][m][n] = (f32x4){0.f, 0.f, 0.f, 0.f};
        cur = nxt; cA = nA; cB = nB; lda = ldan; ldb = ldbn; nt = ntn; ++ui;
        if (wr == 1) PG8_BAR;
    }
    PG8_WAIT_V(0);
    PG8_BAR;
#undef PG8_SA
#undef PG8_SB
#undef PG8_STAGE
#undef PG8_LDA
#undef PG8_LDB
#undef PG8_MMA
#undef PG8_WAIT_V
#undef PG8_WAIT_L
#undef PG8_BAR
#undef PG8_SCHED
}

#define EPI_ROWS_BEGIN  _Pragma("unroll") for (int ai = 0; ai < 2; ++ai) _Pragma("unroll") for (int m = 0; m < 4; ++m) { const int row = u.pm * BM + ai * HALF + wr * 64 + m * 16 + fr;
#define EPI_COLS_BEGIN  _Pragma("unroll") for (int bj = 0; bj < 2; ++bj) _Pragma("unroll") for (int n = 0; n < 2; ++n) { const int col = bj * HALF + wc * 32 + n * 16 + 4 * fq; f32x4 v = acc[ai][bj][m][n];
#define EPI_END } }

struct EpiG1 {
    const float* rs; bf16_t* ZM; bf16_t* ZT;
    __device__ __forceinline__ void operator()(const f32x4 (&acc)[2][2][4][2], const Unit& u, int wr, int wc, int fr, int fq) const {
        const int pn = u.pn;
        if (pn >= 4 && pn < 6) {
            const int d0 = (pn - 4) * 256;
            EPI_ROWS_BEGIN const float s = rs[row];
            EPI_COLS_BEGIN
                bf16_t* d = ZT + ((size_t)(row >> 6) * 512 + d0 + col) * 64 + (row & 63);
                d[0] = (bf16_t)f2bf(v[0] * s); d[64] = (bf16_t)f2bf(v[1] * s); d[128] = (bf16_t)f2bf(v[2] * s); d[192] = (bf16_t)f2bf(v[3] * s);
            EPI_END
        } else if (pn >= 6 && pn < 8) {
            const int j0 = (pn - 6) * 256;
            EPI_ROWS_BEGIN const float s = rs[row];
            EPI_COLS_BEGIN
                bf16_t* d = ZT + (size_t)MTOK * 512 + ((size_t)(row >> 9) * 512 + j0 + col) * 512 + (row & 511);
                d[0] = (bf16_t)f2bf(v[0] * s); d[512] = (bf16_t)f2bf(v[1] * s); d[1024] = (bf16_t)f2bf(v[2] * s); d[1536] = (bf16_t)f2bf(v[3] * s);
            EPI_END
        } else {
            const int cm = (pn < 4 ? pn : pn - 4) * 256;
            EPI_ROWS_BEGIN const float s = rs[row];
            EPI_COLS_BEGIN
                u32x2 w; w.x = pk2(v[0] * s, v[1] * s); w.y = pk2(v[2] * s, v[3] * s);
                *(u32x2*)(ZM + (size_t)row * ZMW + cm + col) = w;
            EPI_END
        }
    }
};
struct EpiDFT {
    bf16_t* Y;
    __device__ __forceinline__ void operator()(const f32x4 (&acc)[2][2][4][2], const Unit& u, int wr, int wc, int fr, int fq) const {
        int tok0, R, q;
        if (u.pm < 128) { tok0 = (u.pm >> 2) * 2048; R = 4; q = u.pm & 3; } else { const int t = u.pm - 128; tok0 = MP + (t >> 4) * 8192; R = 16; q = t & 15; }
        EPI_ROWS_BEGIN const int p = row - u.pm * BM;
        EPI_COLS_BEGIN
            const int k0 = u.pn * BM + col;
            bf16_t* d = Y + (size_t)(tok0 + R * k0 + q) * DM + 512 + p;
            d[0] = (bf16_t)f2bf(v[0]); d[(size_t)R * DM] = (bf16_t)f2bf(v[1]); d[(size_t)2 * R * DM] = (bf16_t)f2bf(v[2]); d[(size_t)3 * R * DM] = (bf16_t)f2bf(v[3]);
        EPI_END
    }
};
struct EpiG2 {
    const float* rs; bf16_t* Y;
    __device__ __forceinline__ void operator()(const f32x4 (&acc)[2][2][4][2], const Unit& u, int wr, int wc, int fr, int fq) const {
        EPI_ROWS_BEGIN const float s = rs[row];
        EPI_COLS_BEGIN
            u32x2* p = (u32x2*)(Y + (size_t)row * DM + u.pn * BM + col);
            const u32x2 y = *p; u32x2 w;
            w.x = pk2(bflo(y.x) * siluf_(v[0] * s), bfhi(y.x) * siluf_(v[1] * s)); w.y = pk2(bflo(y.y) * siluf_(v[2] * s), bfhi(y.y) * siluf_(v[3] * s));
            *p = w;
        EPI_END
    }
};
struct ProgG34 {
    StaticOrder S; const bf16_t* Y; const bf16_t* XB; const char* wsb; const bf16_t* WM; int layer;
    __device__ __forceinline__ bool next(int i, UnitX& u) const { Unit t; if (!S.next(i / 6, t)) return false; u.pm = t.pm; u.pn = t.pn; u.seg = i % 6; return true; }
    __device__ __forceinline__ void desc(const UnitX& u, const char*& A, const char*& B, int& lda, int& ldb, int& nt) const {
        const int b = u.seg >> 1; lda = DM;
        if (u.seg & 1) { A = (const char*)(XB + (size_t)u.pm * BM * DM); B = (const char*)(WM + (size_t)b * DM * DM + (size_t)u.pn * BM * DM); ldb = DM; nt = DM / BK; }
        else { const int kb = (b == 0) ? 512 : 256, ac = (b == 0) ? 0 : (b == 1 ? 512 : 768);
            const size_t woff = (size_t)((b == 0) ? 26 : 27 + b) * MiB + (size_t)layer * ((b == 0) ? MiB : MiB / 2);
            const bf16_t* w = (const bf16_t*)(wsb + woff);
            A = (const char*)(Y + (size_t)u.pm * BM * DM + ac); B = (const char*)(w + (size_t)u.pn * BM * kb); ldb = kb; nt = kb / BK; }
    }
};
struct EpiG34 {
    const float* rs; bf16_t* PT; bf16_t* MT; bf16_t* MG;
    __device__ __forceinline__ void operator()(const f32x4 (&acc)[2][2][4][2], const UnitX& u, int wr, int wc, int fr_, int fq_) const {
        int fr = fr_, fq = fq_; asm volatile("" : "+v"(fr), "+v"(fq));
        if ((u.seg & 1) == 0) {
            EPI_ROWS_BEGIN
            EPI_COLS_BEGIN
                u32x2 w; w.x = pk2(v[0], v[1]); w.y = pk2(v[2], v[3]);
                *(GAS u32x2*)(PT + (size_t)(row - u.pm * BM) * 256 + col) = w;
            EPI_END
        } else {
            const int mode = u.seg >> 1;
            EPI_ROWS_BEGIN const float s = rs[row];
            EPI_COLS_BEGIN
                const size_t toff = (size_t)(row - u.pm * BM) * 256 + col;
                const u32x2 pv = *(const GAS u32x2*)(PT + toff);
                float r0 = bflo(pv.x) * sigmoidf_(v[0] * s), r1 = bfhi(pv.x) * sigmoidf_(v[1] * s), r2 = bflo(pv.y) * sigmoidf_(v[2] * s), r3 = bfhi(pv.y) * sigmoidf_(v[3] * s);
                if (mode) { const u32x2 mv = *(const GAS u32x2*)(MT + toff); r0 += bflo(mv.x); r1 += bfhi(mv.x); r2 += bflo(mv.y); r3 += bfhi(mv.y); }
                u32x2 w; w.x = pk2(r0, r1); w.y = pk2(r2, r3);
                if (mode == 2) *(GAS u32x2*)(MG + (size_t)row * DM + u.pn * BM + col) = w; else *(GAS u32x2*)(MT + toff) = w;
            EPI_END
        }
    }
};
struct EpiG5 {
    bf16_t* O; float* ss;
    __device__ __forceinline__ void operator()(const f32x4 (&acc)[2][2][4][2], const Unit& u, int wr, int wc, int fr, int fq) const {
        EPI_ROWS_BEGIN float q = 0.f;
        EPI_COLS_BEGIN
            u32x2 w; w.x = pk2(v[0], v[1]); w.y = pk2(v[2], v[3]);
            *(u32x2*)(O + (size_t)row * DM + u.pn * BM + col) = w;
            q += (v[0] * v[0] + v[1] * v[1]) + (v[2] * v[2] + v[3] * v[3]);
        }
            q += __shfl_xor(q, 16); q += __shfl_xor(q, 32);
            if (fq == 0) atomicAdd(ss + row, q);
        }
    }
};
}

__device__ __forceinline__ void transpose_item(const float* W, int K, int pitch, int c0, int ncols, bf16_t* WT, int row_off, const float* g, float scale, LAS float* scr, int item, int lane) {
    const int nblk = ncols / 32, kb = item / nblk, nb = item % nblk, k0 = 64 * kb, n0 = 32 * nb;
#pragma unroll 8
    for (int i = 0; i < 32; ++i) { const int kk = 2 * i + (lane >> 5); float w = W[(size_t)(k0 + kk) * pitch + c0 + n0 + (lane & 31)] * scale; if (g) w *= g[k0 + kk]; scr[kk * 33 + (lane & 31)] = w; }
    LDS_WAIT(); asm volatile("" ::: "memory");
    const int c = lane & 7;
#pragma unroll
    for (int j = 0; j < 4; ++j) { const int n = (lane >> 3) + 8 * j; const LAS float* s = scr + (8 * c) * 33 + n;
        u32x4 o; o.x = pk2(s[0 * 33], s[1 * 33]); o.y = pk2(s[2 * 33], s[3 * 33]); o.z = pk2(s[4 * 33], s[5 * 33]); o.w = pk2(s[6 * 33], s[7 * 33]);
        *(u32x4*)(WT + (size_t)(row_off + n0 + n) * K + k0 + 8 * c) = o; }
    LDS_WAIT(); asm volatile("" ::: "memory");
}

struct Args { const float* in[14]; float* out; unsigned char* ws; int ph_lo, ph_hi; };

__device__ __forceinline__ void grid_row_info(int gr, int& seqbase, int& r, int& nrows) {
    if (gr < 1024) { seqbase = (gr >> 5) << 11; r = gr & 31; nrows = 32; } else { const int g2 = gr - 1024; seqbase = MP + ((g2 >> 7) << 13); r = g2 & 127; nrows = 128; }
}

constexpr int AT_KSLOT = 9216, AT_VSLOT = 8704, AT_VOFF = 73728, AT_BOFF = 143360;
__device__ __forceinline__ void attn_fill_issue(const GAS bf16_t* ZM, const GAS bf16_t* ZT, int tok0, int head, int tid, u32x4& kreg, u32x4& vreg) {
    kreg = *(const GAS u32x4*)(ZM + (size_t)(tok0 + (tid >> 3)) * ZMW + 512 + head * 64 + (tid & 7) * 8);
    vreg = *(const GAS u32x4*)(ZT + ((size_t)(tok0 >> 6) * 512 + head * 64) * 64 + tid * 8);
}
__device__ __forceinline__ void attn_fill_write(LAS unsigned char* lds, int slot, int tid, const u32x4 kreg, const u32x4 vreg) {
    *(LAS u32x4*)(lds + slot * AT_KSLOT + (tid >> 3) * 144 + (tid & 7) * 16) = kreg;
    LAS u32x2* vp = (LAS u32x2*)(lds + AT_VOFF + slot * AT_VSLOT + (tid >> 3) * 136 + (tid & 7) * 16);
    u32x2 a; a.x = vreg.x; a.y = vreg.y; u32x2 b; b.x = vreg.z; b.y = vreg.w;
    vp[0] = a; vp[1] = b;
}
__device__ __forceinline__ void attn_row_lds(LAS unsigned char* lds, int seqbase, int r, int rs, int head, int lane, int wave, const GAS bf16_t* ZM, GAS bf16_t* Y) {
    const LAS float* bias = (const LAS float*)(lds + AT_BOFF);
    const int g = wave & 3, dh = wave >> 2;
    const int qi = lane & 15, h4 = lane >> 4;
    const int cs = (g == 0) ? 0 : (g == 1) ? 8 : (g == 2) ? 24 : 32;
    const int qc = 16 * g + qi;
    const int qtok = seqbase + r * 64 + qc;
    const GAS bf16_t* qp = ZM + (size_t)qtok * ZMW + head * 64 + 8 * h4;
    const bf16x8 bq0 = *(const GAS bf16x8*)qp;
    const bf16x8 bq1 = *(const GAS bf16x8*)(qp + 32);
    int cst = qc - 8; cst = cst < 0 ? 0 : cst; cst = cst > 48 ? 48 : cst;
    f32x4 S[16];
    float mx = -3.0e38f;
#pragma unroll
    for (int t = 0; t < 16; ++t) {
        const int kr = t >> 1, hf = t & 1;
        const int slot = (rs + kr) & 7;
        const LAS unsigned char* kp = lds + slot * AT_KSLOT + (cs + 16 * hf + qi) * 144 + h4 * 16;
        const bf16x8 ak0 = *(const LAS bf16x8*)kp, ak1 = *(const LAS bf16x8*)(kp + 64);
        const LAS float* brow = bias + (rs + kr - r + 7) * 31;
        float bv[4];
#pragma unroll
        for (int e = 0; e < 4; ++e) { int dc = cs + 16 * hf + 4 * h4 + e - qc + 15; dc = dc < 0 ? 0 : dc; dc = dc > 30 ? 30 : dc; bv[e] = brow[dc]; }
        f32x4 s = {0.f, 0.f, 0.f, 0.f};
        s = __builtin_amdgcn_mfma_f32_16x16x32_bf16(ak0, bq0, s, 0, 0, 0);
        s = __builtin_amdgcn_mfma_f32_16x16x32_bf16(ak1, bq1, s, 0, 0, 0);
        asm volatile("" : "+v"(bv[0]), "+v"(bv[1]), "+v"(bv[2]), "+v"(bv[3]));
#pragma unroll
        for (int e = 0; e < 4; ++e) {
            const int kc = cs + 16 * hf + 4 * h4 + e;
            const bool valid = (kc >= cst) && (kc < cst + 16);
            const float val = valid ? s[e] + bv[e] : -1.0e30f;
            s[e] = val; mx = fmaxf(mx, val);
        }
        S[t] = s;
    }
    mx = fmaxf(mx, __shfl_xor(mx, 16)); mx = fmaxf(mx, __shfl_xor(mx, 32));
    float sum = 0.f;
    bf16x8 pf[8];
#pragma unroll
    for (int kr = 0; kr < 8; ++kr) {
        const f32x4 a = S[kr * 2], b = S[kr * 2 + 1];
        const float p0 = __expf(a[0] - mx), p1 = __expf(a[1] - mx), p2 = __expf(a[2] - mx), p3 = __expf(a[3] - mx);
        const float p4 = __expf(b[0] - mx), p5 = __expf(b[1] - mx), p6 = __expf(b[2] - mx), p7 = __expf(b[3] - mx);
        sum += ((p0 + p1) + (p2 + p3)) + ((p4 + p5) + (p6 + p7));
        u32x4 w; w.x = pk2(p0, p1); w.y = pk2(p2, p3); w.z = pk2(p4, p5); w.w = pk2(p6, p7);
        pf[kr] = __builtin_bit_cast(bf16x8, w);
    }
    sum += __shfl_xor(sum, 16); sum += __shfl_xor(sum, 32);
    const float inv = 1.0f / sum;
    GAS bf16_t* yp = Y + (size_t)qtok * DM + head * 64 + 4 * h4;
#pragma unroll
    for (int dti = 0; dti < 2; ++dti) {
        const int dt = 2 * dh + dti;
        f32x4 o = {0.f, 0.f, 0.f, 0.f};
#pragma unroll
        for (int kr = 0; kr < 8; ++kr) {
            const int slot = (rs + kr) & 7;
            const LAS unsigned char* vp = lds + AT_VOFF + slot * AT_VSLOT + (dt * 16 + qi) * 136 + (cs + 4 * h4) * 2;
            const u32x2 lo = *(const LAS u32x2*)vp, hi = *(const LAS u32x2*)(vp + 32);
            u32x4 w; w.x = lo.x; w.y = lo.y; w.z = hi.x; w.w = hi.y;
            o = __builtin_amdgcn_mfma_f32_16x16x32_bf16(__builtin_bit_cast(bf16x8, w), pf[kr], o, 0, 0, 0);
        }
        u32x2 w; w.x = pk2(o[0] * inv, o[1] * inv); w.y = pk2(o[2] * inv, o[3] * inv);
        *(GAS u32x2*)(yp + dt * 16) = w;
    }
}
__device__ __forceinline__ void attn_unit(LAS unsigned char* lds, int seqbase, int nrows, int ra, int rb, int head, int tid, int lane, int wave,
                                          const bf16_t* ZM_, const bf16_t* ZT_, bf16_t* Y_, const float* rpb) {
    const GAS bf16_t* ZM = (const GAS bf16_t*)ZM_; const GAS bf16_t* ZT = (const GAS bf16_t*)ZT_; GAS bf16_t* Y = (GAS bf16_t*)Y_;
    int rs = ra - 4; rs = rs < 0 ? 0 : rs; rs = rs > nrows - 8 ? nrows - 8 : rs;
    {   u32x4 kreg[8], vreg[8];
#pragma unroll
        for (int k = 0; k < 8; ++k) attn_fill_issue(ZM, ZT, seqbase + (rs + k) * 64, head, tid, kreg[k], vreg[k]);
        LAS float* bw = (LAS float*)(lds + AT_BOFF);
        if (tid < 465) bw[tid] = rpb[head * 465 + tid];
#pragma unroll
        for (int k = 0; k < 8; ++k) attn_fill_write(lds, (rs + k) & 7, tid, kreg[k], vreg[k]);
    }
    __syncthreads();
#pragma unroll 1
    for (int r = ra; r < rb; ++r) {
        int rsn = r + 1 - 4; rsn = rsn < 0 ? 0 : rsn; rsn = rsn > nrows - 8 ? nrows - 8 : rsn;
        const bool adv = (r + 1 < rb) && (rsn != rs);
        u32x4 kreg = {0u, 0u, 0u, 0u}, vreg = {0u, 0u, 0u, 0u};
        if (adv) attn_fill_issue(ZM, ZT, seqbase + (rsn + 7) * 64, head, tid, kreg, vreg);
        attn_row_lds(lds, seqbase, r, rs, head, lane, wave, ZM, Y);
        __syncthreads();
        if (adv) attn_fill_write(lds, (rsn + 7) & 7, tid, kreg, vreg);
        __syncthreads();
        rs = rsn;
    }
}

template <int R>
__device__ __forceinline__ void butterfly_unit(int tok0, int rowbase  , int p, int lp, const bf16_t* ZT, bf16_t* YQ) {
    constexpr int L = 512 * R;
    const bf16_t* zre = ZT + (size_t)MTOK * 512 + ((size_t)(tok0 >> 9) * 512 + p) * 512 + lp;
    const bf16_t* zim = zre + 256 * 512;
    float xr[R], xi[R];
#pragma unroll
    for (int s = 0; s < R; ++s) { xr[s] = bf2f(zre[(size_t)s * 512 * 512]); xi[s] = bf2f(zim[(size_t)s * 512 * 512]); }
    const float scale = rsqrtf(64.0f * (float)L);
#pragma unroll 1
    for (int q = 0; q < R; ++q) {
        float wr_, wi_; sincospif(-2.0f * (float)q / (float)R, &wi_, &wr_);
        float yr = xr[R - 1], yi = xi[R - 1];
#pragma unroll
        for (int s = R - 2; s >= 0; --s) { const float tr = yr * wr_ - yi * wi_ + xr[s], ti = yr * wi_ + yi * wr_ + xi[s]; yr = tr; yi = ti; }
        float tr_, ti_; sincospif(-2.0f * (float)(q * lp) / (float)L, &ti_, &tr_);
        const float orr = (yr * tr_ - yi * ti_) * scale, oi = (yr * ti_ + yi * tr_) * scale;
        bf16_t* d = YQ + (size_t)(rowbase + q * 256) * 1024 + lp;
        d[0] = (bf16_t)f2bf(orr); d[512] = (bf16_t)f2bf(oi);
    }
}

__global__ void __launch_bounds__(NWAVES * 64, 2) fwd_kernel(Args args) {
    extern __shared__ __attribute__((aligned(16))) unsigned char lds_raw[];
    LAS unsigned char* lds = (LAS unsigned char*)lds_raw;
    const int G = gridDim.x, bx = blockIdx.x;
    for (int ph = args.ph_lo; ph < args.ph_hi; ++ph) {
        if (ph > args.ph_lo) { cg::this_grid().sync(); }
        int tid = threadIdx.x; asm volatile("" : "+v"(tid));
        const int lane = tid & 63, wave = __builtin_amdgcn_readfirstlane(tid >> 6);
        const int gw = bx * NWAVES + wave, NGW = G * NWAVES;
        unsigned char* ws = args.ws; asm volatile("" : "+s"(ws));
        const float* x_prompt = args.in[0]; const float* x_sample = args.in[1];
        float* out = args.out;
        bf16_t* XB = (bf16_t*)(ws + WS_XB); bf16_t* OB = XB;
        bf16_t* ZM = (bf16_t*)(ws + WS_ZM); bf16_t* PB = ZM;
        bf16_t* ZT = (bf16_t*)(ws + WS_ZT); bf16_t* MG = ZT;
        bf16_t* YQ = (bf16_t*)(ws + WS_YQ);
        bf16_t* Y = (bf16_t*)(ws + WS_Y);
        bf16_t* TT = (bf16_t*)(ws + WS_T);
        float* RS = (float*)(ws + WS_RS); float* SS = (float*)(ws + WS_SS);
        const int layer = (ph == 0) ? 0 : (ph - 1) / 7;
        const int sub = (ph == 0) ? -1 : (ph - 1) % 7;
        const bf16_t* WIN = (const bf16_t*)(ws + WS_WIN) + (size_t)layer * NG1 * DM;
        const bf16_t* WG = (const bf16_t*)(ws + WS_WG) + (size_t)layer * DM * DM;
        const bf16_t* WM = (const bf16_t*)(ws + WS_WM) + (size_t)layer * 3072 * DM;
        const bf16_t* WA = (const bf16_t*)(ws + WS_WA) + (size_t)layer * DM * 512;
        const bf16_t* WB = (const bf16_t*)(ws + WS_WB) + (size_t)layer * DM * 256;
        const bf16_t* WC = (const bf16_t*)(ws + WS_WC) + (size_t)layer * DM * 256;
        const bf16_t* WO = (const bf16_t*)(ws + WS_WO) + (size_t)layer * DM * DM;

        if (PHON(0) && ph == 0) {
            LAS float* scr = (LAS float*)(lds + wave * 16384);
            for (int l = 0; l < 2; ++l) {
                const float* w_in = args.in[4] + (size_t)l * DM * DIN;
                const float* gpre = args.in[2] + l * DM;
                bf16_t* win = (bf16_t*)(ws + WS_WIN) + (size_t)l * NG1 * DM;
                bf16_t* wg = (bf16_t*)(ws + WS_WG) + (size_t)l * DM * DM;
                bf16_t* wm = (bf16_t*)(ws + WS_WM) + (size_t)l * 3072 * DM;
                for (int job = 0; job < 7; ++job) {
                    int c0, nc, ro; bf16_t* dst; float sc = 1.f;
                    switch (job) {
                        case 0: c0 = 0; nc = 512; dst = win; ro = 0; sc = 0.125f; break;
                        case 1: c0 = 512; nc = 1024; dst = win; ro = 512; break;
                        case 2: c0 = 2560; nc = 512; dst = win; ro = 2048; break;
                        case 3: c0 = 1536; nc = 512; dst = wg; ro = 0; break;
                        case 4: c0 = 2304; nc = 256; dst = wg; ro = 512; break;
                        case 5: c0 = 3072; nc = 256; dst = wg; ro = 768; break;
                        default: c0 = 3328; nc = 3072; dst = wm; ro = 0; break;
                    }
                    const int nitems = (DM / 64) * (nc / 32);
                    for (int it = gw; it < nitems; it += NGW) transpose_item(w_in, DM, DIN, c0, nc, dst, ro, gpre, sc, scr, it, lane);
                }
                {   const int ni = (512 / 64) * (DM / 32);
                    for (int it = gw; it < ni; it += NGW) transpose_item(args.in[10] + (size_t)l * 512 * DM, 512, DM, 0, DM, (bf16_t*)(ws + WS_WA) + (size_t)l * DM * 512, 0, nullptr, 1.f, scr, it, lane); }
                {   const int ni = (256 / 64) * (DM / 32);
                    for (int it = gw; it < ni; it += NGW) transpose_item(args.in[11] + (size_t)l * 256 * DM, 256, DM, 0, DM, (bf16_t*)(ws + WS_WB) + (size_t)l * DM * 256, 0, nullptr, 1.f, scr, it, lane);
                    for (int it = gw; it < ni; it += NGW) transpose_item(args.in[12] + (size_t)l * 256 * DM, 256, DM, 0, DM, (bf16_t*)(ws + WS_WC) + (size_t)l * DM * 256, 0, nullptr, 1.f, scr, it, lane); }
                {   const int ni = (DM / 64) * (DM / 32);
                    for (int it = gw; it < ni; it += NGW) transpose_item(args.in[13] + (size_t)l * DM * DM, DM, DM, 0, DM, (bf16_t*)(ws + WS_WO) + (size_t)l * DM * DM, 0, nullptr, 1.f, scr, it, lane); }
                for (int idx = bx * 512 + tid; idx < DM * 256; idx += G * 512) {
                    const int k = idx >> 8, p = idx & 255, grp = p >> 6, mm = p & 63;
                    const float* wrow = w_in + (size_t)k * DIN + 2048 + grp * 64;
                    float are = 0.f, aim = 0.f;
                    for (int c = 0; c < 64; ++c) { float sn, cs; sincospif((float)((mm * c) & 63) * (1.0f / 32.0f), &sn, &cs); const float w = wrow[c]; are += w * cs; aim -= w * sn; }
                    const float gk = gpre[k];
                    win[(size_t)(1536 + p) * DM + k] = (bf16_t)f2bf(are * gk);
                    win[(size_t)(1536 + 256 + p) * DM + k] = (bf16_t)f2bf(aim * gk);
                }
            }
            for (int idx = bx * 512 + tid; idx < 512 * 512; idx += G * 512) {
                const int kp = idx >> 9, lp = idx & 511; float sn, cs; sincospif((float)((kp * lp) & 511) * (1.0f / 256.0f), &sn, &cs);
                TT[(size_t)kp * 1024 + lp] = (bf16_t)f2bf(cs); TT[(size_t)kp * 1024 + 512 + lp] = (bf16_t)f2bf(sn);
            }
        }
        if (PHON(1) && (ph == 0 || sub == 6)) {
            const int mode = (ph == 0) ? 0 : (layer == 0 ? 1 : 2);
            const float* gpost = args.in[3] + layer * DM;
            for (int m = gw; m < MTOK; m += NGW) {
                const float* xin = (mode == 2) ? (out + (size_t)m * DM) : ((m < MP) ? x_prompt + (size_t)m * DM : x_sample + (size_t)(m - MP) * DM);
                const f32x4* xr = (const f32x4*)xin + lane;
                f32x4 v[4];
#pragma unroll
                for (int j = 0; j < 4; ++j) v[j] = xr[64 * j];
                if (mode != 0) {
                    const float rq = rsqrtf(SS[m] * (1.0f / DM) + EPS);
                    const u32x2* orow = (const u32x2*)(OB + (size_t)m * DM) + lane;
#pragma unroll
                    for (int j = 0; j < 4; ++j) { const u32x2 ov = orow[64 * j]; const f32x4 gp = *((const f32x4*)gpost + lane + 64 * j);
                        v[j][0] += bflo(ov.x) * rq * gp[0]; v[j][1] += bfhi(ov.x) * rq * gp[1]; v[j][2] += bflo(ov.y) * rq * gp[2]; v[j][3] += bfhi(ov.y) * rq * gp[3]; }
                    f32x4* orow2 = (f32x4*)(out + (size_t)m * DM) + lane;
#pragma unroll
                    for (int j = 0; j < 4; ++j) orow2[64 * j] = v[j];
                }
                if (mode != 2) {
                    float s = 0.f;
#pragma unroll
                    for (int j = 0; j < 4; ++j) s += (v[j][0] * v[j][0] + v[j][1] * v[j][1]) + (v[j][2] * v[j][2] + v[j][3] * v[j][3]);
                    s = wave_sum(s);
                    u32x2* o8 = (u32x2*)(XB + (size_t)m * DM) + lane;
#pragma unroll
                    for (int j = 0; j < 4; ++j) { u32x2 w; w.x = pk2(v[j][0], v[j][1]); w.y = pk2(v[j][2], v[j][3]); o8[64 * j] = w; }
                    if (lane == 0) { RS[m] = rsqrtf(s * (1.0f / DM) + EPS); SS[m] = 0.f; }
                }
            }
        } else if (PHON(2) && sub == 0) {
            pg8::Gemm g{XB, WIN, MTOK, NG1, DM, DM, DM}; pg8::StaticOrder S; S.init(MTOK, NG1, G, bx);
            pg8::EpiG1 E{RS, ZM, ZT};
            pg8::gemm_phase<pg8::EpiG1, pg8::StaticOrder, true>(lds, g, S, E);
        } else if (sub == 1) {
            if (PHON(3)) {
                const float* rpb = args.in[5] + (size_t)layer * 8 * 15 * 31;
                for (int un = bx; un < 512; un += G) {
                    if (un < 256) attn_unit(lds, (un >> 3) * 2048, 32, 0, 32, un & 7, tid, lane, wave, ZM, ZT, Y, rpb);
                    else { const int v = un - 256, st = v & 7; attn_unit(lds, MP + (v >> 6) * 8192, 128, st * 16, st * 16 + 16, (v >> 3) & 7, tid, lane, wave, ZM, ZT, Y, rpb); }
                }
            }
            if (PHON(4)) {
                LAS float* hbuf = (LAS float*)lds; LAS float* cbuf = (LAS float*)(lds + 65536);
                const float* dww = args.in[6] + (size_t)layer * 31 * 256; const float* dwb = args.in[7] + layer * 256;
                const float* lng = args.in[8] + layer * 256; const float* lnb = args.in[9] + layer * 256;
                const int c = tid & 255, half = tid >> 8;
                float w[31];
#pragma unroll
                for (int j = 0; j < 31; ++j) w[j] = dww[j * 256 + c];
                const float bc = dwb[c];
                const f32x4 lg = *((const f32x4*)lng + lane), lb = *((const f32x4*)lnb + lane);
                u32x4 pa[4], pb[4];
#define CONV_ISSUE(cu_) do { const int t0g_ = (cu_) * 32; \
                    int sbeg_, send_; if (t0g_ < MP) { sbeg_ = t0g_ & ~2047; send_ = sbeg_ + 2048; } else { sbeg_ = MP + ((t0g_ - MP) & ~8191); send_ = sbeg_ + 8192; } \
                    _Pragma("unroll") for (int k = 0; k < 4; ++k) { \
                        const int it = tid + k * 512, i = it >> 5, c8 = (it & 31) * 8; const int tok = t0g_ - 15 + i; \
                        pa[k] = (u32x4){0u, 0u, 0u, 0u}; pb[k] = (u32x4){0u, 0u, 0u, 0u}; \
                        if (it < 62 * 32 && tok >= sbeg_ && tok < send_) { pa[k] = *(const GAS u32x4*)((const GAS bf16_t*)ZM + (size_t)tok * ZMW + 1024 + c8); pb[k] = *(const GAS u32x4*)((const GAS bf16_t*)ZM + (size_t)tok * ZMW + 1280 + c8); } \
                    } } while (0)
                for (int cu = bx; cu < MTOK / 32; cu += G) {
                    const int t0g = cu * 32;
                    CONV_ISSUE(cu);
#pragma unroll
                    for (int k = 0; k < 4; ++k) {
                        const int it = tid + k * 512, i = it >> 5, c8 = (it & 31) * 8;
                        if (it < 62 * 32) {
                            const u32x4 a = pa[k], b = pb[k]; f32x4 h0, h1;
                            h0[0] = bflo(a.x) * sigmoidf_(bflo(b.x)); h0[1] = bfhi(a.x) * sigmoidf_(bfhi(b.x)); h0[2] = bflo(a.y) * sigmoidf_(bflo(b.y)); h0[3] = bfhi(a.y) * sigmoidf_(bfhi(b.y));
                            h1[0] = bflo(a.z) * sigmoidf_(bflo(b.z)); h1[1] = bfhi(a.z) * sigmoidf_(bfhi(b.z)); h1[2] = bflo(a.w) * sigmoidf_(bflo(b.w)); h1[3] = bfhi(a.w) * sigmoidf_(bfhi(b.w));
                            *(LAS f32x4*)(hbuf + i * 256 + c8) = h0; *(LAS f32x4*)(hbuf + i * 256 + c8 + 4) = h1;
                        }
                    }
                    __syncthreads();
                    {   float hv[46];
#pragma unroll
                        for (int i = 0; i < 46; ++i) hv[i] = hbuf[(half * 16 + i) * 256 + c];
#pragma unroll
                        for (int tt = 0; tt < 16; ++tt) {
                            float a = bc;
#pragma unroll
                            for (int j = 0; j < 31; ++j) a += w[j] * hv[tt + j];
                            cbuf[(half * 16 + tt) * 256 + c] = a;
                        }
                    }
                    __syncthreads();
#pragma unroll 1
                    for (int tt = 0; tt < 4; ++tt) {
                        const int t = wave * 4 + tt;
                        const f32x4 xv = *(const LAS f32x4*)(cbuf + t * 256 + 4 * lane);
                        const float mean = wave_sum((xv[0] + xv[1]) + (xv[2] + xv[3])) * (1.0f / 256.0f);
                        const f32x4 d = xv - mean;
                        const float var = wave_sum((d[0] * d[0] + d[1] * d[1]) + (d[2] * d[2] + d[3] * d[3])) * (1.0f / 256.0f);
                        const float rstd = rsqrtf(var + EPS);
                        const float y0 = siluf_(d[0] * rstd * lg[0] + lb[0]), y1 = siluf_(d[1] * rstd * lg[1] + lb[1]), y2 = siluf_(d[2] * rstd * lg[2] + lb[2]), y3 = siluf_(d[3] * rstd * lg[3] + lb[3]);
                        u32x2 wv; wv.x = pk2(y0, y1); wv.y = pk2(y2, y3);
                        *(GAS u32x2*)((GAS bf16_t*)Y + (size_t)(t0g + t) * DM + 768 + 4 * lane) = wv;
                    }
                }
            }
            if (PHON(5)) {
                for (int un = bx; un < 32 * 256; un += G) { const int seq = un >> 8, p = un & 255; butterfly_unit<4>(seq * 2048, seq * 1024 + p, p, tid, ZT, YQ); }
                for (int un = bx; un < 4 * 256; un += G) { const int seq = un >> 8, p = un & 255; butterfly_unit<16>(MP + seq * 8192, 32768 + seq * 4096 + p, p, tid, ZT, YQ); }
            }
        } else if (PHON(6) && sub == 2) {
            pg8::Gemm g{YQ, TT, NYQ, 512, 1024, 1024, 1024}; pg8::StaticOrder S; S.init(NYQ, 512, G, bx);
            pg8::EpiDFT E{Y};
            pg8::gemm_phase<pg8::EpiDFT, pg8::StaticOrder, true>(lds, g, S, E);
        } else if (PHON(7) && sub == 3) {
            pg8::Gemm g{XB, WG, MTOK, DM, DM, DM, DM}; pg8::StaticOrder S; S.init(MTOK, DM, G, bx);
            pg8::EpiG2 E{RS, Y};
            pg8::gemm_phase<pg8::EpiG2, pg8::StaticOrder, true>(lds, g, S, E);
        } else if (sub == 4) {
            pg8::ProgG34 PG; PG.S.init(MTOK, DM, G, bx); PG.Y = Y; PG.XB = XB; PG.wsb = (const char*)ws; PG.WM = WM; PG.layer = layer;
            pg8::EpiG34 EG{RS, PB + (size_t)bx * 65536, PB + (size_t)(256 + bx) * 65536, MG};
            pg8::gemm_multi<pg8::EpiG34, pg8::ProgG34>(lds, PG, EG);
        } else if (PHON(10) && sub == 5) {
            pg8::Gemm g{MG, WO, MTOK, DM, DM, DM, DM}; pg8::StaticOrder S; S.init(MTOK, DM, G, bx);
            pg8::EpiG5 E{OB, SS};
            pg8::gemm_phase<pg8::EpiG5, pg8::StaticOrder, true>(lds, g, S, E);
        }
    }
}

extern "C" void kernel_launch(void* const* d_in, const int* in_sizes, int n_in, void* d_out, int out_size, void* d_ws, size_t ws_size, hipStream_t stream) {
    static int grid = 0;
    if (grid == 0) {
        if (n_in != 14 || ws_size < WS_END) { fprintf(stderr, "kernel_launch: bad inputs (n_in %d, ws %zu < %zu)\n", n_in, ws_size, (size_t)WS_END); grid = -1; return; }
        int dev = 0, cus = 0, per_cu = 0;
        hipGetDevice(&dev); hipDeviceGetAttribute(&cus, hipDeviceAttributeMultiprocessorCount, dev);
        if (hipFuncSetAttribute((const void*)fwd_kernel, hipFuncAttributeMaxDynamicSharedMemorySize, LDS_BYTES) != hipSuccess) { fprintf(stderr, "hipFuncSetAttribute failed\n"); grid = -1; return; }
        hipOccupancyMaxActiveBlocksPerMultiprocessor(&per_cu, (const void*)fwd_kernel, NWAVES * 64, LDS_BYTES);
        (void)hipGetLastError();
        if (per_cu < 1) { fprintf(stderr, "occupancy query says 0 blocks per CU\n"); }
        grid = cus;
    }
    if (grid < 0) return;
    Args a{};
    for (int i = 0; i < 14; ++i) a.in[i] = (const float*)d_in[i];
    a.out = (float*)d_out; a.ws = (unsigned char*)d_ws;
#if MK_ONE_LAUNCH
    a.ph_lo = 0; a.ph_hi = 15;
    void* kargs[] = {&a};
    hipError_t e = hipLaunchCooperativeKernel((const void*)fwd_kernel, dim3(grid), dim3(NWAVES * 64), kargs, LDS_BYTES, stream);
    if (e != hipSuccess) fprintf(stderr, "cooperative launch failed: %s (grid %d)\n", hipGetErrorString(e), grid);
#else
    for (int ph = 0; ph < 15; ++ph) {
        a.ph_lo = ph; a.ph_hi = ph + 1;
        hipLaunchKernelGGL(fwd_kernel, dim3(grid), dim3(NWAVES * 64), LDS_BYTES, stream, a);
    }
#endif
}
```

```cpp
#include <hip/hip_runtime.h>
#include <hip/hip_cooperative_groups.h>
#include <cstdio>
#include <cstdint>
namespace cg = cooperative_groups;

#ifndef MK_ONE_LAUNCH
#define MK_ONE_LAUNCH 1
#endif

#ifndef PH_MASK
#define PH_MASK 0xFFFF
#endif
#define PHON(k) (((PH_MASK) >> (k)) & 1)
#define LAS __attribute__((address_space(3)))
typedef unsigned short bf16_t;
typedef short bf16x8 __attribute__((ext_vector_type(8)));
typedef short s16x4 __attribute__((ext_vector_type(4)));
typedef float f32x4 __attribute__((ext_vector_type(4)));
typedef unsigned u32x4 __attribute__((ext_vector_type(4)));
typedef unsigned u32x2 __attribute__((ext_vector_type(2)));

constexpr int DM = 1024;
constexpr int MP = 65536;
constexpr int MTOK = 98304;
constexpr int DIN = 6400;
constexpr int NG1 = 2560;
constexpr int ZMW = 1536;
constexpr int NYQ = 49152;
constexpr float EPS = 1e-6f;

constexpr size_t MiB = 1u << 20;
constexpr size_t WS_WIN = 0;
constexpr size_t WS_WG = 10 * MiB;
constexpr size_t WS_WM = 14 * MiB;
constexpr size_t WS_WA = 26 * MiB;
constexpr size_t WS_WB = 28 * MiB;
constexpr size_t WS_WC = 29 * MiB;
constexpr size_t WS_WO = 30 * MiB;
constexpr size_t WS_T = 34 * MiB;
constexpr size_t WS_RS = 35 * MiB;
constexpr size_t WS_SS = 35 * MiB + 512 * 1024;
constexpr size_t WS_XB = 36 * MiB;
constexpr size_t WS_ZM = 228 * MiB;
constexpr size_t WS_ZT = 516 * MiB;
constexpr size_t WS_YQ = 708 * MiB;
constexpr size_t WS_Y = 804 * MiB;
constexpr size_t WS_END = 996 * MiB;

constexpr int NWAVES = 8;
constexpr int LDS_BYTES = 147456;

__device__ __forceinline__ unsigned f2bf(float f) { unsigned u = __builtin_bit_cast(unsigned, f); return (u + 0x7fffu + ((u >> 16) & 1u)) >> 16; }
__device__ __forceinline__ unsigned pk2(float lo, float hi) { unsigned r; asm("v_cvt_pk_bf16_f32 %0, %1, %2" : "=v"(r) : "v"(lo), "v"(hi)); return r; }
__device__ __forceinline__ float bf2f(unsigned b) { return __builtin_bit_cast(float, b << 16); }
__device__ __forceinline__ float bflo(unsigned w) { return __builtin_bit_cast(float, w << 16); }
__device__ __forceinline__ float bfhi(unsigned w) { return __builtin_bit_cast(float, w & 0xffff0000u); }
__device__ __forceinline__ float sigmoidf_(float x) { return __builtin_amdgcn_rcpf(1.0f + __expf(-x)); }
__device__ __forceinline__ float siluf_(float x) { return x * __builtin_amdgcn_rcpf(1.0f + __expf(-x)); }
__device__ __forceinline__ float wave_sum(float v) {
#pragma unroll
    for (int o = 1; o < 64; o <<= 1) v += __shfl_xor(v, o);
    return v;
}
#define LDS_WAIT() asm volatile("s_waitcnt lgkmcnt(0)" ::: "memory")
#define GAS __attribute__((address_space(1)))

namespace pg8 {
constexpr int BM = 256, BK = 64, HALF = 128, HTB = HALF * BK * 2, STAGE_BYTES = 8 * HTB, NXCD = 8, WGM = 8;
__device__ __forceinline__ int lds_byte(int r, int c) { const int st = (r >> 4) * 2 + (c >> 5), rr = r & 15, cc = c & 31, ob = rr * 64 + cc * 2; return st * 1024 + (ob ^ (((ob >> 9) & 1) << 5)); }
__device__ __forceinline__ void stage_rc(int b, int& R, int& C) { const int st = b / 1024, sb = b % 1024, swz = sb ^ (((sb >> 9) & 1) << 5); R = (st >> 1) * 16 + swz / 64; C = (st & 1) * 32 + (swz % 64) / 2; }

struct Unit { int pm, pn; };
struct Gemm { const bf16_t* A; const bf16_t* Bt; int M, N, K, lda, ldb; };

struct StaticOrder {
    int nM, nN, nwg, G, c;
    __device__ __forceinline__ void init(int M, int N, int G_, int c_) { nM = M / BM; nN = N / BM; nwg = nM * nN; G = G_; c = c_; }
    __device__ __forceinline__ bool next(int i, Unit& u) const {
        const long L = (long)i * G + c; if (L >= nwg) return false;
        int wgid = (int)L; { const int q = nwg / NXCD, r = nwg % NXCD, xcd = wgid % NXCD, off = wgid / NXCD; wgid = (xcd < r ? xcd * (q + 1) : r * (q + 1) + (xcd - r) * q) + off; }
        const int nig = WGM * nN, gid = wgid / nig, fm = gid * WGM, gsz = (nM - fm) < WGM ? (nM - fm) : WGM;
        u.pm = fm + ((wgid % nig) % gsz); u.pn = (wgid % nig) / gsz; return true;
    }
};

struct SingleUnit { Unit u; __device__ bool next(int i, Unit& o) const { if (i) return false; o = u; return true; } };
template <class Epi, class Sched, bool ALIGN_EPI>
__device__ __forceinline__ void gemm_phase(LAS unsigned char* lds, const Gemm g, const Sched& S, const Epi& E) {
    int tid = threadIdx.x; asm volatile("" : "+v"(tid));
    const int wid = __builtin_amdgcn_readfirstlane(tid >> 6), lane = tid & 63, wr = wid >> 2, wc = wid & 3, fr = lane & 15, fq = lane >> 4;
    const int K = g.K, nt = K / BK;
    unsigned voffA[2], voffB[2];
#pragma unroll
    for (int i = 0; i < 2; ++i) { int R, C; stage_rc(tid * 16 + i * 8192, R, C);
        voffA[i] = (unsigned)(R * g.lda + C) * 2u; voffB[i] = (unsigned)(R * g.ldb + C) * 2u; }
    const size_t kstep = (size_t)(BK * 2);
    const size_t hstepA = (size_t)HALF * g.lda * 2, hstepB = (size_t)HALF * g.ldb * 2;
    const size_t tstepA = 2 * hstepA, tstepB = 2 * hstepB;
    const unsigned ldsw = (unsigned)wid * 1024u;
    const int aoff = lds_byte(wr * 64 + fr, fq * 8), boff = lds_byte(wc * 32 + fr, fq * 8);
#define PG8_SA(b, h) (((b) * 2 + (h)) * HTB)
#define PG8_SB(b, h) ((4 + (b) * 2 + (h)) * HTB)
#define PG8_STAGE(bufoff, gbase, voff) do { _Pragma("unroll") for (int _i = 0; _i < 2; ++_i) \
        __builtin_amdgcn_global_load_lds((const unsigned*)((const char*)(gbase) + (voff)[_i]), (LAS unsigned*)(lds + (bufoff) + ldsw + _i * 8192), 16, 0, 0); } while (0)
#define PG8_LDA(dst, b, h) do { _Pragma("unroll") for (int m = 0; m < 4; ++m) _Pragma("unroll") for (int k = 0; k < 2; ++k) dst[m][k] = *(const LAS bf16x8*)(lds + PG8_SA(b, h) + aoff + m * 2048 + k * 1024); } while (0)
#define PG8_LDB(dst, b, h) do { _Pragma("unroll") for (int n = 0; n < 2; ++n) _Pragma("unroll") for (int k = 0; k < 2; ++k) dst[n][k] = *(const LAS bf16x8*)(lds + PG8_SB(b, h) + boff + n * 2048 + k * 1024); } while (0)
#define PG8_MMA(ai, bj, At, Bt) do { __builtin_amdgcn_s_setprio(1); _Pragma("unroll") for (int m = 0; m < 4; ++m) _Pragma("unroll") for (int n = 0; n < 2; ++n) _Pragma("unroll") for (int k = 0; k < 2; ++k) \
        acc[ai][bj][m][n] = __builtin_amdgcn_mfma_f32_16x16x32_bf16(Bt[n][k], At[m][k], acc[ai][bj][m][n], 0, 0, 0); __builtin_amdgcn_s_setprio(0); } while (0)
#define PG8_WAIT_V(n) asm volatile("s_waitcnt vmcnt(" #n ")" ::: "memory")
#define PG8_WAIT_L(n) asm volatile("s_waitcnt lgkmcnt(" #n ")" ::: "memory")
#define PG8_BAR __builtin_amdgcn_s_barrier()
#define PG8_SCHED __builtin_amdgcn_sched_barrier(0)
    Unit cur, nxt; int ui = 0;
    if (!S.next(0, cur)) return;
    f32x4 acc[2][2][4][2];
#pragma unroll
    for (int a = 0; a < 2; ++a)
#pragma unroll
        for (int b = 0; b < 2; ++b)
#pragma unroll
            for (int m = 0; m < 4; ++m)
#pragma unroll
                for (int n = 0; n < 2; ++n) acc[a][b][m][n] = (f32x4){0.f, 0.f, 0.f, 0.f};
    bf16x8 At[4][2], B0[2][2], B1[2][2];
    const char* cA = (const char*)g.A + (size_t)cur.pm * tstepA; const char* cB = (const char*)g.Bt + (size_t)cur.pn * tstepB;
    PG8_STAGE(PG8_SB(0, 0), cB, voffB); PG8_STAGE(PG8_SB(0, 1), cB + hstepB, voffB); PG8_STAGE(PG8_SA(0, 0), cA, voffA); PG8_STAGE(PG8_SA(0, 1), cA + hstepA, voffA);
    if (wr == 1) PG8_BAR;
    PG8_WAIT_V(2); PG8_BAR;
    PG8_STAGE(PG8_SB(1, 0), cB + kstep, voffB); PG8_STAGE(PG8_SA(1, 0), cA + kstep, voffA); PG8_STAGE(PG8_SB(1, 1), cB + hstepB + kstep, voffB);
    PG8_WAIT_V(6); PG8_BAR;
    for (;;) {
        const bool has_next = S.next(ui + 1, nxt);
        const char* nA = has_next ? (const char*)g.A + (size_t)nxt.pm * tstepA : cA; const char* nB = has_next ? (const char*)g.Bt + (size_t)nxt.pn * tstepB : cB;
        for (int t = 0; t < nt; t += 2) {
            const bool last = (t == nt - 2);
            const char* a1 = cA + (size_t)(t + 1) * kstep;
            const char* a2 = last ? nA : cA + (size_t)(t + 2) * kstep; const char* b2 = last ? nB : cB + (size_t)(t + 2) * kstep;
            const char* a3 = a2 + kstep; const char* b3 = b2 + kstep;
            PG8_LDB(B0, 0, 0); PG8_LDB(B1, 0, 1); PG8_SCHED; PG8_LDA(At, 0, 0); PG8_STAGE(PG8_SA(1, 1), a1 + hstepA, voffA);
            PG8_WAIT_V(8); PG8_WAIT_L(0); PG8_BAR; PG8_MMA(0, 0, At, B0); PG8_MMA(0, 1, At, B1); PG8_BAR; PG8_SCHED;
            PG8_LDA(At, 0, 1); PG8_STAGE(PG8_SB(0, 0), b2, voffB); PG8_STAGE(PG8_SB(0, 1), b2 + hstepB, voffB); PG8_STAGE(PG8_SA(0, 0), a2, voffA);
            PG8_WAIT_V(8); PG8_WAIT_L(0); PG8_BAR; PG8_MMA(1, 0, At, B0); PG8_MMA(1, 1, At, B1); PG8_BAR; PG8_SCHED;
            PG8_LDB(B0, 1, 0); PG8_LDB(B1, 1, 1); PG8_SCHED; PG8_LDA(At, 1, 0); PG8_STAGE(PG8_SA(0, 1), a2 + hstepA, voffA);
            PG8_WAIT_V(8); PG8_WAIT_L(0); PG8_BAR; PG8_MMA(0, 0, At, B0); PG8_MMA(0, 1, At, B1); PG8_BAR; PG8_SCHED;
            PG8_LDA(At, 1, 1); PG8_STAGE(PG8_SB(1, 0), b3, voffB); PG8_STAGE(PG8_SB(1, 1), b3 + hstepB, voffB); PG8_STAGE(PG8_SA(1, 0), a3, voffA);
            PG8_WAIT_V(8); PG8_WAIT_L(0); PG8_BAR; PG8_MMA(1, 0, At, B0); PG8_MMA(1, 1, At, B1); PG8_BAR; PG8_SCHED;
        }
        if constexpr (ALIGN_EPI) { if (wr == 0) PG8_BAR; }
        E(acc, cur, wr, wc, fr, fq);
        if (!has_next) break;
#pragma unroll
        for (int a = 0; a < 2; ++a)
#pragma unroll
            for (int b = 0; b < 2; ++b)
#pragma unroll
                for (int m = 0; m < 4; ++m)
#pragma unroll
                    for (int n = 0; n < 2; ++n) acc[a][b][m][n] = (f32x4){0.f, 0.f, 0.f, 0.f};
        cur = nxt; cA = nA; cB = nB; ++ui;
        if constexpr (ALIGN_EPI) { if (wr == 1) PG8_BAR; }
    }
    PG8_WAIT_V(0);
    if constexpr (!ALIGN_EPI) { if (wr == 0) PG8_BAR; }
    PG8_BAR;
#undef PG8_SA
#undef PG8_SB
#undef PG8_STAGE
#undef PG8_LDA
#undef PG8_LDB
#undef PG8_MMA
#undef PG8_WAIT_V
#undef PG8_WAIT_L
#undef PG8_BAR
#undef PG8_SCHED
}

struct UnitX { int pm, pn, seg; };
__device__ __forceinline__ int uni(int v) { return __builtin_amdgcn_readfirstlane(v); }
__device__ __forceinline__ const char* unip(const char* p) { const unsigned long long v = (unsigned long long)p; const unsigned lo = (unsigned)__builtin_amdgcn_readfirstlane((int)(unsigned)v), hi = (unsigned)__builtin_amdgcn_readfirstlane((int)(unsigned)(v >> 32)); return (const char*)(((unsigned long long)hi << 32) | lo); }
template <class Epi, class Prog>
__device__ __forceinline__ void gemm_multi(LAS unsigned char* lds, const Prog& P, const Epi& E) {
    int tid = threadIdx.x; asm volatile("" : "+v"(tid));
    const int wid = __builtin_amdgcn_readfirstlane(tid >> 6), lane = tid & 63, wr = wid >> 2, wc = wid & 3, fr = lane & 15, fq = lane >> 4;
    unsigned Rr[2], Cc2[2];
#pragma unroll
    for (int i = 0; i < 2; ++i) { int R, C; stage_rc(tid * 16 + i * 8192, R, C); Rr[i] = (unsigned)R * 2u; Cc2[i] = (unsigned)C * 2u; }
    const size_t kstep = (size_t)(BK * 2);
    const unsigned ldsw = (unsigned)wid * 1024u;
    const int aoff = lds_byte(wr * 64 + fr, fq * 8), boff = lds_byte(wc * 32 + fr, fq * 8);
#define PG8_SA(b, h) (((b) * 2 + (h)) * HTB)
#define PG8_SB(b, h) ((4 + (b) * 2 + (h)) * HTB)
#define PG8_STAGE(bufoff, gbase, ld) do { _Pragma("unroll") for (int _i = 0; _i < 2; ++_i) \
        __builtin_amdgcn_global_load_lds((const unsigned*)((const char*)(gbase) + (Rr[_i] * (unsigned)(ld) + Cc2[_i])), (LAS unsigned*)(lds + (bufoff) + ldsw + _i * 8192), 16, 0, 0); } while (0)
#define PG8_LDA(dst, b, h) do { _Pragma("unroll") for (int m = 0; m < 4; ++m) _Pragma("unroll") for (int k = 0; k < 2; ++k) dst[m][k] = *(const LAS bf16x8*)(lds + PG8_SA(b, h) + aoff + m * 2048 + k * 1024); } while (0)
#define PG8_LDB(dst, b, h) do { _Pragma("unroll") for (int n = 0; n < 2; ++n) _Pragma("unroll") for (int k = 0; k < 2; ++k) dst[n][k] = *(const LAS bf16x8*)(lds + PG8_SB(b, h) + boff + n * 2048 + k * 1024); } while (0)
#define PG8_MMA(ai, bj, At, Bt) do { __builtin_amdgcn_s_setprio(1); _Pragma("unroll") for (int m = 0; m < 4; ++m) _Pragma("unroll") for (int n = 0; n < 2; ++n) _Pragma("unroll") for (int k = 0; k < 2; ++k) \
        acc[ai][bj][m][n] = __builtin_amdgcn_mfma_f32_16x16x32_bf16(Bt[n][k], At[m][k], acc[ai][bj][m][n], 0, 0, 0); __builtin_amdgcn_s_setprio(0); } while (0)
#define PG8_WAIT_V(n) asm volatile("s_waitcnt vmcnt(" #n ")" ::: "memory")
#define PG8_WAIT_L(n) asm volatile("s_waitcnt lgkmcnt(" #n ")" ::: "memory")
#define PG8_BAR __builtin_amdgcn_s_barrier()
#define PG8_SCHED __builtin_amdgcn_sched_barrier(0)
    UnitX cur, nxt; int ui = 0;
    if (!P.next(0, cur)) return;
    f32x4 acc[2][2][4][2];
#pragma unroll
    for (int a = 0; a < 2; ++a)
#pragma unroll
        for (int b = 0; b < 2; ++b)
#pragma unroll
            for (int m = 0; m < 4; ++m)
#pragma unroll
                for (int n = 0; n < 2; ++n) acc[a][b][m][n] = (f32x4){0.f, 0.f, 0.f, 0.f};
    bf16x8 At[4][2], B0[2][2], B1[2][2];
    const char* cA; const char* cB; int lda, ldb, nt;
    P.desc(cur, cA, cB, lda, ldb, nt); cA = unip(cA); cB = unip(cB); lda = uni(lda); ldb = uni(ldb); nt = uni(nt);
    {   const size_t hA = (size_t)HALF * lda * 2, hB = (size_t)HALF * ldb * 2;
        PG8_STAGE(PG8_SB(0, 0), cB, ldb); PG8_STAGE(PG8_SB(0, 1), cB + hB, ldb); PG8_STAGE(PG8_SA(0, 0), cA, lda); PG8_STAGE(PG8_SA(0, 1), cA + hA, lda);
        if (wr == 1) PG8_BAR;
        PG8_WAIT_V(2); PG8_BAR;
        PG8_STAGE(PG8_SB(1, 0), cB + kstep, ldb); PG8_STAGE(PG8_SA(1, 0), cA + kstep, lda); PG8_STAGE(PG8_SB(1, 1), cB + hB + kstep, ldb);
        PG8_WAIT_V(6); PG8_BAR; }
    for (;;) {
        const bool has_next = P.next(ui + 1, nxt);
        const char* nA = cA; const char* nB = cB; int ldan = lda, ldbn = ldb, ntn = nt;
        if (has_next) P.desc(nxt, nA, nB, ldan, ldbn, ntn);
        nA = unip(nA); nB = unip(nB); ldan = uni(ldan); ldbn = uni(ldbn); ntn = uni(ntn);
        const size_t hAc = (size_t)HALF * lda * 2;
        for (int t = 0; t < nt; t += 2) {
            const bool last = (t == nt - 2);
            const char* a1 = cA + (size_t)(t + 1) * kstep;
            const char* a2 = last ? nA : cA + (size_t)(t + 2) * kstep; const char* b2 = last ? nB : cB + (size_t)(t + 2) * kstep;
            const int lda2 = last ? ldan : lda, ldb2 = last ? ldbn : ldb;
            const size_t hA2 = (size_t)HALF * lda2 * 2, hB2 = (size_t)HALF * ldb2 * 2;
            const char* a3 = a2 + kstep; const char* b3 = b2 + kstep;
            PG8_LDB(B0, 0, 0); PG8_LDB(B1, 0, 1); PG8_SCHED; PG8_LDA(At, 0, 0); PG8_STAGE(PG8_SA(1, 1), a1 + hAc, lda);
            PG8_WAIT_V(8); PG8_WAIT_L(0); PG8_BAR; PG8_MMA(0, 0, At, B0); PG8_MMA(0, 1, At, B1); PG8_BAR; PG8_SCHED;
            PG8_LDA(At, 0, 1); PG8_STAGE(PG8_SB(0, 0), b2, ldb2); PG8_STAGE(PG8_SB(0, 1), b2 + hB2, ldb2); PG8_STAGE(PG8_SA(0, 0), a2, lda2);
            PG8_WAIT_V(8); PG8_WAIT_L(0); PG8_BAR; PG8_MMA(1, 0, At, B0); PG8_MMA(1, 1, At, B1); PG8_BAR; PG8_SCHED;
            PG8_LDB(B0, 1, 0); PG8_LDB(B1, 1, 1); PG8_SCHED; PG8_LDA(At, 1, 0); PG8_STAGE(PG8_SA(0, 1), a2 + hA2, lda2);
            PG8_WAIT_V(8); PG8_WAIT_L(0); PG8_BAR; PG8_MMA(0, 0, At, B0); PG8_MMA(0, 1, At, B1); PG8_BAR; PG8_SCHED;
            PG8_LDA(At, 1, 1); PG8_STAGE(PG8_SB(1, 0), b3, ldb2); PG8_STAGE(PG8_SB(1, 1), b3 + hB2, ldb2); PG8_STAGE(PG8_SA(1, 0), a3, lda2);
            PG8_WAIT_V(8); PG8_WAIT_L(0); PG8_BAR; PG8_MMA(1, 0, At, B0); PG8_MMA(1, 1, At, B1); PG8_BAR; PG8_SCHED;
        }
        if (wr == 0) PG8_BAR;
        E(acc, cur, wr, wc, fr, fq);
        if (!has_next) break;
#pragma unroll
        for (int a = 0; a < 2; ++a)
#pragma unroll
            for (int b = 0; b < 2; ++b)
#pragma unroll
                for (int m = 0; m < 4; ++m)
#pragma unroll
                    for (int n = 0; n < 2; ++n) acc[a][b][m][n] = (f32x4){0.f, 0.f, 0.f, 0.f};
        cur = nxt; cA = nA; cB = nB; lda = ldan; ldb = ldbn; nt = ntn; ++ui;
        if (wr == 1) PG8_BAR;
    }
    PG8_WAIT_V(0);
    PG8_BAR;
#undef PG8_SA
#undef PG8_SB
#undef PG8_STAGE
#undef PG8_LDA
#undef PG8_LDB
#undef PG8_MMA
#undef PG8_WAIT_V
#undef PG8_WAIT_L
#undef PG8_BAR
#undef PG8_SCHED
}

#define EPI_ROWS_BEGIN  _Pragma("unroll") for (int ai = 0; ai < 2; ++ai) _Pragma("unroll") for (int m = 0; m < 4; ++m) { const int row = u.pm * BM + ai * HALF + wr * 64 + m * 16 + fr;
#define EPI_COLS_BEGIN  _Pragma("unroll") for (int bj = 0; bj < 2; ++bj) _Pragma("unroll") for (int n = 0; n < 2; ++n) { const int col = bj * HALF + wc * 32 + n * 16 + 4 * fq; f32x4 v = acc[ai][bj][m][n];
#define EPI_END } }

struct EpiG1 {
    const float* rs; bf16_t* ZM; bf16_t* ZT;
    __device__ __forceinline__ void operator()(const f32x4 (&acc)[2][2][4][2], const Unit& u, int wr, int wc, int fr, int fq) const {
        const int pn = u.pn;
        if (pn >= 4 && pn < 6) {
            const int d0 = (pn - 4) * 256;
            EPI_ROWS_BEGIN
            EPI_COLS_BEGIN
                GAS bf16_t* d = (GAS bf16_t*)ZT + ((size_t)(row >> 6) * 512 + d0 + col) * 64 + (row & 63);
                const unsigned w0 = pk2(v[0], v[1]), w1 = pk2(v[2], v[3]);
                d[0] = (bf16_t)w0; d[64] = (bf16_t)(w0 >> 16); d[128] = (bf16_t)w1; d[192] = (bf16_t)(w1 >> 16);
            EPI_END
        } else if (pn >= 6 && pn < 8) {
            const int j0 = (pn - 6) * 256;
            EPI_ROWS_BEGIN
            EPI_COLS_BEGIN
                GAS bf16_t* d = (GAS bf16_t*)ZT + (size_t)MTOK * 512 + ((size_t)(row >> 9) * 512 + j0 + col) * 512 + (row & 511);
                const unsigned w0 = pk2(v[0], v[1]), w1 = pk2(v[2], v[3]);
                d[0] = (bf16_t)w0; d[512] = (bf16_t)(w0 >> 16); d[1024] = (bf16_t)w1; d[1536] = (bf16_t)(w1 >> 16);
            EPI_END
        } else {
            const int cm = (pn < 4 ? pn : pn - 4) * 256;
            EPI_ROWS_BEGIN
            EPI_COLS_BEGIN
                u32x2 w; w.x = pk2(v[0], v[1]); w.y = pk2(v[2], v[3]);
                *(GAS u32x2*)((GAS bf16_t*)ZM + (size_t)row * ZMW + cm + col) = w;
            EPI_END
        }
    }
};
struct EpiDFT {
    bf16_t* Y;
    __device__ __forceinline__ void operator()(const f32x4 (&acc)[2][2][4][2], const Unit& u, int wr, int wc, int fr, int fq) const {
        int tok0, R, q;
        if (u.pm < 128) { tok0 = (u.pm >> 2) * 2048; R = 4; q = u.pm & 3; } else { const int t = u.pm - 128; tok0 = MP + (t >> 4) * 8192; R = 16; q = t & 15; }
        EPI_ROWS_BEGIN const int p = row - u.pm * BM;
        EPI_COLS_BEGIN
            const int k0 = u.pn * BM + col;
            GAS bf16_t* d = (GAS bf16_t*)Y + (size_t)(tok0 + R * k0 + q) * DM + 512 + p;
            const unsigned w0 = pk2(v[0], v[1]), w1 = pk2(v[2], v[3]);
            d[0] = (bf16_t)w0; d[(size_t)R * DM] = (bf16_t)(w0 >> 16); d[(size_t)2 * R * DM] = (bf16_t)w1; d[(size_t)3 * R * DM] = (bf16_t)(w1 >> 16);
        EPI_END
    }
};
struct EpiG2 {
    const float* rs; bf16_t* Y;
    __device__ __forceinline__ void operator()(const f32x4 (&acc)[2][2][4][2], const Unit& u, int wr, int wc, int fr, int fq) const {
        EPI_ROWS_BEGIN
        EPI_COLS_BEGIN
            GAS u32x2* p = (GAS u32x2*)((GAS bf16_t*)Y + (size_t)row * DM + u.pn * BM + col);
            const u32x2 y = *p; u32x2 w;
            w.x = pk2(bflo(y.x) * siluf_(v[0]), bfhi(y.x) * siluf_(v[1])); w.y = pk2(bflo(y.y) * siluf_(v[2]), bfhi(y.y) * siluf_(v[3]));
            *p = w;
        EPI_END
    }
};
struct ProgG34 {
    StaticOrder S; const bf16_t* Y; const bf16_t* XB; const char* wsb; const bf16_t* WM; int layer;
    __device__ __forceinline__ bool next(int i, UnitX& u) const { Unit t; if (!S.next(i / 6, t)) return false; u.pm = t.pm; u.pn = t.pn; u.seg = i % 6; return true; }
    __device__ __forceinline__ void desc(const UnitX& u, const char*& A, const char*& B, int& lda, int& ldb, int& nt) const {
        const int b = u.seg >> 1; lda = DM;
        if (u.seg & 1) { A = (const char*)(XB + (size_t)u.pm * BM * DM); B = (const char*)(WM + (size_t)b * DM * DM + (size_t)u.pn * BM * DM); ldb = DM; nt = DM / BK; }
        else { const int kb = (b == 0) ? 512 : 256, ac = (b == 0) ? 0 : (b == 1 ? 512 : 768);
            const size_t woff = (size_t)((b == 0) ? 26 : 27 + b) * MiB + (size_t)layer * ((b == 0) ? MiB : MiB / 2);
            const bf16_t* w = (const bf16_t*)(wsb + woff);
            A = (const char*)(Y + (size_t)u.pm * BM * DM + ac); B = (const char*)(w + (size_t)u.pn * BM * kb); ldb = kb; nt = kb / BK; }
    }
};
struct EpiG34 {
    const float* rs; bf16_t* PT; bf16_t* MT; bf16_t* MG;
    __device__ __forceinline__ void operator()(const f32x4 (&acc)[2][2][4][2], const UnitX& u, int wr, int wc, int fr_, int fq_) const {
        int fr = fr_, fq = fq_; asm volatile("" : "+v"(fr), "+v"(fq));
        if ((u.seg & 1) == 0) {
            EPI_ROWS_BEGIN
            EPI_COLS_BEGIN
                u32x2 w; w.x = pk2(v[0], v[1]); w.y = pk2(v[2], v[3]);
                *(GAS u32x2*)(PT + (size_t)(row - u.pm * BM) * 256 + col) = w;
            EPI_END
        } else {
            const int mode = u.seg >> 1;
            EPI_ROWS_BEGIN
            EPI_COLS_BEGIN
                const size_t toff = (size_t)(row - u.pm * BM) * 256 + col;
                const u32x2 pv = *(const GAS u32x2*)(PT + toff);
                float r0 = bflo(pv.x) * sigmoidf_(v[0]), r1 = bfhi(pv.x) * sigmoidf_(v[1]), r2 = bflo(pv.y) * sigmoidf_(v[2]), r3 = bfhi(pv.y) * sigmoidf_(v[3]);
                if (mode) { const u32x2 mv = *(const GAS u32x2*)(MT + toff); r0 += bflo(mv.x); r1 += bfhi(mv.x); r2 += bflo(mv.y); r3 += bfhi(mv.y); }
                u32x2 w; w.x = pk2(r0, r1); w.y = pk2(r2, r3);
                if (mode == 2) *(GAS u32x2*)(MG + (size_t)row * DM + u.pn * BM + col) = w; else *(GAS u32x2*)(MT + toff) = w;
            EPI_END
        }
    }
};
struct EpiG5 {
    bf16_t* O; float* ss;
    __device__ __forceinline__ void operator()(const f32x4 (&acc)[2][2][4][2], const Unit& u, int wr, int wc, int fr, int fq) const {
        EPI_ROWS_BEGIN float q = 0.f;
        EPI_COLS_BEGIN
            u32x2 w; w.x = pk2(v[0], v[1]); w.y = pk2(v[2], v[3]);
            *(GAS u32x2*)((GAS bf16_t*)O + (size_t)row * DM + u.pn * BM + col) = w;
            q += (v[0] * v[0] + v[1] * v[1]) + (v[2] * v[2] + v[3] * v[3]);
        }
            q += __shfl_xor(q, 16); q += __shfl_xor(q, 32);
            if (fq == 0) atomicAdd(ss + row, q);
        }
    }
};
}

__device__ __forceinline__ void transpose_item(const float* W, int K, int pitch, int c0, int ncols, bf16_t* WT, int row_off, const float* g, float scale, LAS float* scr, int item, int lane) {
    const int nblk = ncols / 32, kb = item / nblk, nb = item % nblk, k0 = 64 * kb, n0 = 32 * nb;
#pragma unroll 8
    for (int i = 0; i < 32; ++i) { const int kk = 2 * i + (lane >> 5); float w = W[(size_t)(k0 + kk) * pitch + c0 + n0 + (lane & 31)] * scale; if (g) w *= g[k0 + kk]; scr[kk * 33 + (lane & 31)] = w; }
    LDS_WAIT(); asm volatile("" ::: "memory");
    const int c = lane & 7;
#pragma unroll
    for (int j = 0; j < 4; ++j) { const int n = (lane >> 3) + 8 * j; const LAS float* s = scr + (8 * c) * 33 + n;
        u32x4 o; o.x = pk2(s[0 * 33], s[1 * 33]); o.y = pk2(s[2 * 33], s[3 * 33]); o.z = pk2(s[4 * 33], s[5 * 33]); o.w = pk2(s[6 * 33], s[7 * 33]);
        *(u32x4*)(WT + (size_t)(row_off + n0 + n) * K + k0 + 8 * c) = o; }
    LDS_WAIT(); asm volatile("" ::: "memory");
}

struct Args { const float* in[14]; float* out; unsigned char* ws; int ph_lo, ph_hi; };

__device__ __forceinline__ void grid_row_info(int gr, int& seqbase, int& r, int& nrows) {
    if (gr < 1024) { seqbase = (gr >> 5) << 11; r = gr & 31; nrows = 32; } else { const int g2 = gr - 1024; seqbase = MP + ((g2 >> 7) << 13); r = g2 & 127; nrows = 128; }
}

constexpr int AT_KSLOT = 9216, AT_VSLOT = 8704, AT_VOFF = 73728, AT_BOFF = 143360;
__device__ __forceinline__ void attn_fill_issue(const GAS bf16_t* ZM, const GAS bf16_t* ZT, int tok0, int head, int tid, u32x4& kreg, u32x4& vreg) {
    kreg = *(const GAS u32x4*)(ZM + (size_t)(tok0 + (tid >> 3)) * ZMW + 512 + head * 64 + (tid & 7) * 8);
    vreg = *(const GAS u32x4*)(ZT + ((size_t)(tok0 >> 6) * 512 + head * 64) * 64 + tid * 8);
}
__device__ __forceinline__ void attn_fill_write(LAS unsigned char* lds, int slot, int tid, const u32x4 kreg, const u32x4 vreg) {
    *(LAS u32x4*)(lds + slot * AT_KSLOT + (tid >> 3) * 144 + (tid & 7) * 16) = kreg;
    LAS u32x2* vp = (LAS u32x2*)(lds + AT_VOFF + slot * AT_VSLOT + (tid >> 3) * 136 + (tid & 7) * 16);
    u32x2 a; a.x = vreg.x; a.y = vreg.y; u32x2 b; b.x = vreg.z; b.y = vreg.w;
    vp[0] = a; vp[1] = b;
}
__device__ __forceinline__ void attn_row_lds(LAS unsigned char* lds, int seqbase, int r, int rs, int head, int lane, int wave, const GAS bf16_t* ZM, GAS bf16_t* Y) {
    const LAS float* bias = (const LAS float*)(lds + AT_BOFF);
    const int g = wave & 3, dh = wave >> 2;
    const int qi = lane & 15, h4 = lane >> 4;
    const int cs = (g == 0) ? 0 : (g == 1) ? 8 : (g == 2) ? 24 : 32;
    const int qc = 16 * g + qi;
    const int qtok = seqbase + r * 64 + qc;
    const GAS bf16_t* qp = ZM + (size_t)qtok * ZMW + head * 64 + 8 * h4;
    const bf16x8 bq0 = *(const GAS bf16x8*)qp;
    const bf16x8 bq1 = *(const GAS bf16x8*)(qp + 32);
    int cst = qc - 8; cst = cst < 0 ? 0 : cst; cst = cst > 48 ? 48 : cst;
    f32x4 S[16];
    float mx = -3.0e38f;
#pragma unroll
    for (int t = 0; t < 16; ++t) {
        const int kr = t >> 1, hf = t & 1;
        const int slot = (rs + kr) & 7;
        const LAS unsigned char* kp = lds + slot * AT_KSLOT + (cs + 16 * hf + qi) * 144 + h4 * 16;
        const bf16x8 ak0 = *(const LAS bf16x8*)kp, ak1 = *(const LAS bf16x8*)(kp + 64);
        const LAS float* brow = bias + (rs + kr - r + 7) * 31;
        float bv[4];
#pragma unroll
        for (int e = 0; e < 4; ++e) { int dc = cs + 16 * hf + 4 * h4 + e - qc + 15; dc = dc < 0 ? 0 : dc; dc = dc > 30 ? 30 : dc; bv[e] = brow[dc]; }
        f32x4 s = {0.f, 0.f, 0.f, 0.f};
        s = __builtin_amdgcn_mfma_f32_16x16x32_bf16(ak0, bq0, s, 0, 0, 0);
        s = __builtin_amdgcn_mfma_f32_16x16x32_bf16(ak1, bq1, s, 0, 0, 0);
        asm volatile("" : "+v"(bv[0]), "+v"(bv[1]), "+v"(bv[2]), "+v"(bv[3]));
#pragma unroll
        for (int e = 0; e < 4; ++e) {
            const int kc = cs + 16 * hf + 4 * h4 + e;
            const bool valid = (kc >= cst) && (kc < cst + 16);
            const float val = valid ? s[e] + bv[e] : -1.0e30f;
            s[e] = val; mx = fmaxf(mx, val);
        }
        S[t] = s;
    }
    mx = fmaxf(mx, __shfl_xor(mx, 16)); mx = fmaxf(mx, __shfl_xor(mx, 32));
    float sum = 0.f;
    bf16x8 pf[8];
#pragma unroll
    for (int kr = 0; kr < 8; ++kr) {
        const f32x4 a = S[kr * 2], b = S[kr * 2 + 1];
        const float p0 = __expf(a[0] - mx), p1 = __expf(a[1] - mx), p2 = __expf(a[2] - mx), p3 = __expf(a[3] - mx);
        const float p4 = __expf(b[0] - mx), p5 = __expf(b[1] - mx), p6 = __expf(b[2] - mx), p7 = __expf(b[3] - mx);
        sum += ((p0 + p1) + (p2 + p3)) + ((p4 + p5) + (p6 + p7));
        u32x4 w; w.x = pk2(p0, p1); w.y = pk2(p2, p3); w.z = pk2(p4, p5); w.w = pk2(p6, p7);
        pf[kr] = __builtin_bit_cast(bf16x8, w);
    }
    sum += __shfl_xor(sum, 16); sum += __shfl_xor(sum, 32);
    const float inv = 1.0f / sum;
    GAS bf16_t* yp = Y + (size_t)qtok * DM + head * 64 + 4 * h4;
#pragma unroll
    for (int dti = 0; dti < 2; ++dti) {
        const int dt = 2 * dh + dti;
        f32x4 o = {0.f, 0.f, 0.f, 0.f};
#pragma unroll
        for (int kr = 0; kr < 8; ++kr) {
            const int slot = (rs + kr) & 7;
            const LAS unsigned char* vp = lds + AT_VOFF + slot * AT_VSLOT + (dt * 16 + qi) * 136 + (cs + 4 * h4) * 2;
            const u32x2 lo = *(const LAS u32x2*)vp, hi = *(const LAS u32x2*)(vp + 32);
            u32x4 w; w.x = lo.x; w.y = lo.y; w.z = hi.x; w.w = hi.y;
            o = __builtin_amdgcn_mfma_f32_16x16x32_bf16(__builtin_bit_cast(bf16x8, w), pf[kr], o, 0, 0, 0);
        }
        u32x2 w; w.x = pk2(o[0] * inv, o[1] * inv); w.y = pk2(o[2] * inv, o[3] * inv);
        *(GAS u32x2*)(yp + dt * 16) = w;
    }
}
__device__ __forceinline__ void attn_unit(LAS unsigned char* lds, int seqbase, int nrows, int ra, int rb, int head, int tid, int lane, int wave,
                                          const bf16_t* ZM_, const bf16_t* ZT_, bf16_t* Y_, const float* rpb) {
    const GAS bf16_t* ZM = (const GAS bf16_t*)ZM_; const GAS bf16_t* ZT = (const GAS bf16_t*)ZT_; GAS bf16_t* Y = (GAS bf16_t*)Y_;
    int rs = ra - 4; rs = rs < 0 ? 0 : rs; rs = rs > nrows - 8 ? nrows - 8 : rs;
    {   u32x4 kreg[8], vreg[8];
#pragma unroll
        for (int k = 0; k < 8; ++k) attn_fill_issue(ZM, ZT, seqbase + (rs + k) * 64, head, tid, kreg[k], vreg[k]);
        LAS float* bw = (LAS float*)(lds + AT_BOFF);
        if (tid < 465) bw[tid] = rpb[head * 465 + tid];
#pragma unroll
        for (int k = 0; k < 8; ++k) attn_fill_write(lds, (rs + k) & 7, tid, kreg[k], vreg[k]);
    }
    __syncthreads();
#pragma unroll 1
    for (int r = ra; r < rb; ++r) {
        int rsn = r + 1 - 4; rsn = rsn < 0 ? 0 : rsn; rsn = rsn > nrows - 8 ? nrows - 8 : rsn;
        const bool adv = (r + 1 < rb) && (rsn != rs);
        u32x4 kreg = {0u, 0u, 0u, 0u}, vreg = {0u, 0u, 0u, 0u};
        if (adv) attn_fill_issue(ZM, ZT, seqbase + (rsn + 7) * 64, head, tid, kreg, vreg);
        attn_row_lds(lds, seqbase, r, rs, head, lane, wave, ZM, Y);
        __syncthreads();
        if (adv) attn_fill_write(lds, (rsn + 7) & 7, tid, kreg, vreg);
        __syncthreads();
        rs = rsn;
    }
}

template <int R>
__device__ __forceinline__ void butterfly_unit(int tok0, int rowbase  , int p, int lp, const bf16_t* ZT, bf16_t* YQ) {
    constexpr int L = 512 * R;
    const bf16_t* zre = ZT + (size_t)MTOK * 512 + ((size_t)(tok0 >> 9) * 512 + p) * 512 + lp;
    const bf16_t* zim = zre + 256 * 512;
    float xr[R], xi[R];
#pragma unroll
    for (int s = 0; s < R; ++s) { xr[s] = bf2f(zre[(size_t)s * 512 * 512]); xi[s] = bf2f(zim[(size_t)s * 512 * 512]); }
    const float scale = rsqrtf(64.0f * (float)L);
#pragma unroll 1
    for (int q = 0; q < R; ++q) {
        float wr_, wi_; sincospif(-2.0f * (float)q / (float)R, &wi_, &wr_);
        float yr = xr[R - 1], yi = xi[R - 1];
#pragma unroll
        for (int s = R - 2; s >= 0; --s) { const float tr = yr * wr_ - yi * wi_ + xr[s], ti = yr * wi_ + yi * wr_ + xi[s]; yr = tr; yi = ti; }
        float tr_, ti_; sincospif(-2.0f * (float)(q * lp) / (float)L, &ti_, &tr_);
        const float orr = (yr * tr_ - yi * ti_) * scale, oi = (yr * ti_ + yi * tr_) * scale;
        bf16_t* d = YQ + (size_t)(rowbase + q * 256) * 1024 + lp;
        d[0] = (bf16_t)f2bf(orr); d[512] = (bf16_t)f2bf(oi);
    }
}

__global__ void __launch_bounds__(NWAVES * 64, 2) fwd_kernel(Args args) {
    extern __shared__ __attribute__((aligned(16))) unsigned char lds_raw[];
    LAS unsigned char* lds = (LAS unsigned char*)lds_raw;
    const int G = gridDim.x, bx = blockIdx.x;
    for (int ph = args.ph_lo; ph < args.ph_hi; ++ph) {
        if (ph > args.ph_lo) { cg::this_grid().sync(); }
        int tid = threadIdx.x; asm volatile("" : "+v"(tid));
        const int lane = tid & 63, wave = __builtin_amdgcn_readfirstlane(tid >> 6);
        const int gw = bx * NWAVES + wave, NGW = G * NWAVES;
        unsigned char* ws = args.ws; asm volatile("" : "+s"(ws));
        const float* x_prompt = args.in[0]; const float* x_sample = args.in[1];
        float* out = args.out;
        bf16_t* XB = (bf16_t*)(ws + WS_XB); bf16_t* OB = XB;
        bf16_t* ZM = (bf16_t*)(ws + WS_ZM); bf16_t* PB = ZM;
        bf16_t* ZT = (bf16_t*)(ws + WS_ZT); bf16_t* MG = ZT;
        bf16_t* YQ = (bf16_t*)(ws + WS_YQ);
        bf16_t* Y = (bf16_t*)(ws + WS_Y);
        bf16_t* TT = (bf16_t*)(ws + WS_T);
        float* RS = (float*)(ws + WS_RS); float* SS = (float*)(ws + WS_SS);
        const int layer = (ph == 0) ? 0 : (ph - 1) / 7;
        const int sub = (ph == 0) ? -1 : (ph - 1) % 7;
        const bf16_t* WIN = (const bf16_t*)(ws + WS_WIN) + (size_t)layer * NG1 * DM;
        const bf16_t* WG = (const bf16_t*)(ws + WS_WG) + (size_t)layer * DM * DM;
        const bf16_t* WM = (const bf16_t*)(ws + WS_WM) + (size_t)layer * 3072 * DM;
        const bf16_t* WA = (const bf16_t*)(ws + WS_WA) + (size_t)layer * DM * 512;
        const bf16_t* WB = (const bf16_t*)(ws + WS_WB) + (size_t)layer * DM * 256;
        const bf16_t* WC = (const bf16_t*)(ws + WS_WC) + (size_t)layer * DM * 256;
        const bf16_t* WO = (const bf16_t*)(ws + WS_WO) + (size_t)layer * DM * DM;

        if (PHON(0) && ph == 0) {
            LAS float* scr = (LAS float*)(lds + wave * 16384);
            for (int l = 0; l < 2; ++l) {
                const float* w_in = args.in[4] + (size_t)l * DM * DIN;
                const float* gpre = args.in[2] + l * DM;
                bf16_t* win = (bf16_t*)(ws + WS_WIN) + (size_t)l * NG1 * DM;
                bf16_t* wg = (bf16_t*)(ws + WS_WG) + (size_t)l * DM * DM;
                bf16_t* wm = (bf16_t*)(ws + WS_WM) + (size_t)l * 3072 * DM;
                for (int job = 0; job < 7; ++job) {
                    int c0, nc, ro; bf16_t* dst; float sc = 1.f;
                    switch (job) {
                        case 0: c0 = 0; nc = 512; dst = win; ro = 0; sc = 0.125f; break;
                        case 1: c0 = 512; nc = 1024; dst = win; ro = 512; break;
                        case 2: c0 = 2560; nc = 512; dst = win; ro = 2048; break;
                        case 3: c0 = 1536; nc = 512; dst = wg; ro = 0; break;
                        case 4: c0 = 2304; nc = 256; dst = wg; ro = 512; break;
                        case 5: c0 = 3072; nc = 256; dst = wg; ro = 768; break;
                        default: c0 = 3328; nc = 3072; dst = wm; ro = 0; break;
                    }
                    const int nitems = (DM / 64) * (nc / 32);
                    for (int it = gw; it < nitems; it += NGW) transpose_item(w_in, DM, DIN, c0, nc, dst, ro, gpre, sc, scr, it, lane);
                }
                {   const int ni = (512 / 64) * (DM / 32);
                    for (int it = gw; it < ni; it += NGW) transpose_item(args.in[10] + (size_t)l * 512 * DM, 512, DM, 0, DM, (bf16_t*)(ws + WS_WA) + (size_t)l * DM * 512, 0, nullptr, 1.f, scr, it, lane); }
                {   const int ni = (256 / 64) * (DM / 32);
                    for (int it = gw; it < ni; it += NGW) transpose_item(args.in[11] + (size_t)l * 256 * DM, 256, DM, 0, DM, (bf16_t*)(ws + WS_WB) + (size_t)l * DM * 256, 0, nullptr, 1.f, scr, it, lane);
                    for (int it = gw; it < ni; it += NGW) transpose_item(args.in[12] + (size_t)l * 256 * DM, 256, DM, 0, DM, (bf16_t*)(ws + WS_WC) + (size_t)l * DM * 256, 0, nullptr, 1.f, scr, it, lane); }
                {   const int ni = (DM / 64) * (DM / 32);
                    for (int it = gw; it < ni; it += NGW) transpose_item(args.in[13] + (size_t)l * DM * DM, DM, DM, 0, DM, (bf16_t*)(ws + WS_WO) + (size_t)l * DM * DM, 0, nullptr, 1.f, scr, it, lane); }
                for (int idx = bx * 512 + tid; idx < DM * 256; idx += G * 512) {
                    const int k = idx >> 8, p = idx & 255, grp = p >> 6, mm = p & 63;
                    const float* wrow = w_in + (size_t)k * DIN + 2048 + grp * 64;
                    float are = 0.f, aim = 0.f;
                    for (int c = 0; c < 64; ++c) { float sn, cs; sincospif((float)((mm * c) & 63) * (1.0f / 32.0f), &sn, &cs); const float w = wrow[c]; are += w * cs; aim -= w * sn; }
                    const float gk = gpre[k];
                    win[(size_t)(1536 + p) * DM + k] = (bf16_t)f2bf(are * gk);
                    win[(size_t)(1536 + 256 + p) * DM + k] = (bf16_t)f2bf(aim * gk);
                }
            }
            for (int idx = bx * 512 + tid; idx < 512 * 512; idx += G * 512) {
                const int kp = idx >> 9, lp = idx & 511; float sn, cs; sincospif((float)((kp * lp) & 511) * (1.0f / 256.0f), &sn, &cs);
                TT[(size_t)kp * 1024 + lp] = (bf16_t)f2bf(cs); TT[(size_t)kp * 1024 + 512 + lp] = (bf16_t)f2bf(sn);
            }
        }
        if (PHON(1) && (ph == 0 || sub == 6)) {
            const int mode = (ph == 0) ? 0 : (layer == 0 ? 1 : 2);
            const float* gpost = args.in[3] + layer * DM;
            for (int m = gw; m < MTOK; m += NGW) {
                const float* xin = (mode == 2) ? (out + (size_t)m * DM) : ((m < MP) ? x_prompt + (size_t)m * DM : x_sample + (size_t)(m - MP) * DM);
                const f32x4* xr = (const f32x4*)xin + lane;
                f32x4 v[4];
#pragma unroll
                for (int j = 0; j < 4; ++j) v[j] = xr[64 * j];
                if (mode != 0) {
                    const float rq = rsqrtf(SS[m] * (1.0f / DM) + EPS);
                    const u32x2* orow = (const u32x2*)(OB + (size_t)m * DM) + lane;
#pragma unroll
                    for (int j = 0; j < 4; ++j) { const u32x2 ov = orow[64 * j]; const f32x4 gp = *((const f32x4*)gpost + lane + 64 * j);
                        v[j][0] += bflo(ov.x) * rq * gp[0]; v[j][1] += bfhi(ov.x) * rq * gp[1]; v[j][2] += bflo(ov.y) * rq * gp[2]; v[j][3] += bfhi(ov.y) * rq * gp[3]; }
                    f32x4* orow2 = (f32x4*)(out + (size_t)m * DM) + lane;
#pragma unroll
                    for (int j = 0; j < 4; ++j) orow2[64 * j] = v[j];
                }
                if (mode != 2) {
                    float s = 0.f;
#pragma unroll
                    for (int j = 0; j < 4; ++j) s += (v[j][0] * v[j][0] + v[j][1] * v[j][1]) + (v[j][2] * v[j][2] + v[j][3] * v[j][3]);
                    s = wave_sum(s);
                    const float rsv = rsqrtf(s * (1.0f / DM) + EPS);
                    u32x2* o8 = (u32x2*)(XB + (size_t)m * DM) + lane;
#pragma unroll
                    for (int j = 0; j < 4; ++j) { u32x2 w; w.x = pk2(v[j][0] * rsv, v[j][1] * rsv); w.y = pk2(v[j][2] * rsv, v[j][3] * rsv); o8[64 * j] = w; }
                    if (lane == 0) { SS[m] = 0.f; }
                }
            }
        } else if (PHON(2) && sub == 0) {
            pg8::Gemm g{XB, WIN, MTOK, NG1, DM, DM, DM}; pg8::StaticOrder S; S.init(MTOK, NG1, G, bx);
            pg8::EpiG1 E{RS, ZM, ZT};
            pg8::gemm_phase<pg8::EpiG1, pg8::StaticOrder, true>(lds, g, S, E);
        } else if (sub == 1) {
            if (PHON(3)) {
                const float* rpb = args.in[5] + (size_t)layer * 8 * 15 * 31;
                for (int un = bx; un < 512; un += G) {
                    if (un < 256) attn_unit(lds, (un >> 3) * 2048, 32, 0, 32, un & 7, tid, lane, wave, ZM, ZT, Y, rpb);
                    else { const int v = un - 256, st = v & 7; attn_unit(lds, MP + (v >> 6) * 8192, 128, st * 16, st * 16 + 16, (v >> 3) & 7, tid, lane, wave, ZM, ZT, Y, rpb); }
                }
            }
            if (PHON(4)) {
                LAS float* hbuf = (LAS float*)lds; LAS float* cbuf = (LAS float*)(lds + 65536);
                const float* dww = args.in[6] + (size_t)layer * 31 * 256; const float* dwb = args.in[7] + layer * 256;
                const float* lng = args.in[8] + layer * 256; const float* lnb = args.in[9] + layer * 256;
                const int c = tid & 255, half = tid >> 8;
                float w[31];
#pragma unroll
                for (int j = 0; j < 31; ++j) w[j] = dww[j * 256 + c];
                const float bc = dwb[c];
                const f32x4 lg = *((const f32x4*)lng + lane), lb = *((const f32x4*)lnb + lane);
                u32x4 pa[4], pb[4];
#define CONV_ISSUE(cu_) do { const int t0g_ = (cu_) * 32; \
                    int sbeg_, send_; if (t0g_ < MP) { sbeg_ = t0g_ & ~2047; send_ = sbeg_ + 2048; } else { sbeg_ = MP + ((t0g_ - MP) & ~8191); send_ = sbeg_ + 8192; } \
                    _Pragma("unroll") for (int k = 0; k < 4; ++k) { \
                        const int it = tid + k * 512, i = it >> 5, c8 = (it & 31) * 8; const int tok = t0g_ - 15 + i; \
                        pa[k] = (u32x4){0u, 0u, 0u, 0u}; pb[k] = (u32x4){0u, 0u, 0u, 0u}; \
                        if (it < 62 * 32 && tok >= sbeg_ && tok < send_) { pa[k] = *(const GAS u32x4*)((const GAS bf16_t*)ZM + (size_t)tok * ZMW + 1024 + c8); pb[k] = *(const GAS u32x4*)((const GAS bf16_t*)ZM + (size_t)tok * ZMW + 1280 + c8); } \
                    } } while (0)
                for (int cu = bx; cu < MTOK / 32; cu += G) {
                    const int t0g = cu * 32;
                    CONV_ISSUE(cu);
#pragma unroll
                    for (int k = 0; k < 4; ++k) {
                        const int it = tid + k * 512, i = it >> 5, c8 = (it & 31) * 8;
                        if (it < 62 * 32) {
                            const u32x4 a = pa[k], b = pb[k]; f32x4 h0, h1;
                            h0[0] = bflo(a.x) * sigmoidf_(bflo(b.x)); h0[1] = bfhi(a.x) * sigmoidf_(bfhi(b.x)); h0[2] = bflo(a.y) * sigmoidf_(bflo(b.y)); h0[3] = bfhi(a.y) * sigmoidf_(bfhi(b.y));
                            h1[0] = bflo(a.z) * sigmoidf_(bflo(b.z)); h1[1] = bfhi(a.z) * sigmoidf_(bfhi(b.z)); h1[2] = bflo(a.w) * sigmoidf_(bflo(b.w)); h1[3] = bfhi(a.w) * sigmoidf_(bfhi(b.w));
                            *(LAS f32x4*)(hbuf + i * 256 + c8) = h0; *(LAS f32x4*)(hbuf + i * 256 + c8 + 4) = h1;
                        }
                    }
                    __syncthreads();
                    {   float hv[46];
#pragma unroll
                        for (int i = 0; i < 46; ++i) hv[i] = hbuf[(half * 16 + i) * 256 + c];
#pragma unroll
                        for (int tt = 0; tt < 16; ++tt) {
                            float a = bc;
#pragma unroll
                            for (int j = 0; j < 31; ++j) a += w[j] * hv[tt + j];
                            cbuf[(half * 16 + tt) * 256 + c] = a;
                        }
                    }
                    __syncthreads();
#pragma unroll 1
                    for (int tt = 0; tt < 4; ++tt) {
                        const int t = wave * 4 + tt;
                        const f32x4 xv = *(const LAS f32x4*)(cbuf + t * 256 + 4 * lane);
                        const float mean = wave_sum((xv[0] + xv[1]) + (xv[2] + xv[3])) * (1.0f / 256.0f);
                        const f32x4 d = xv - mean;
                        const float var = wave_sum((d[0] * d[0] + d[1] * d[1]) + (d[2] * d[2] + d[3] * d[3])) * (1.0f / 256.0f);
                        const float rstd = rsqrtf(var + EPS);
                        const float y0 = siluf_(d[0] * rstd * lg[0] + lb[0]), y1 = siluf_(d[1] * rstd * lg[1] + lb[1]), y2 = siluf_(d[2] * rstd * lg[2] + lb[2]), y3 = siluf_(d[3] * rstd * lg[3] + lb[3]);
                        u32x2 wv; wv.x = pk2(y0, y1); wv.y = pk2(y2, y3);
                        *(GAS u32x2*)((GAS bf16_t*)Y + (size_t)(t0g + t) * DM + 768 + 4 * lane) = wv;
                    }
                }
            }
            if (PHON(5)) {
                for (int un = bx; un < 32 * 256; un += G) { const int seq = un >> 8, p = un & 255; butterfly_unit<4>(seq * 2048, seq * 1024 + p, p, tid, ZT, YQ); }
                for (int un = bx; un < 4 * 256; un += G) { const int seq = un >> 8, p = un & 255; butterfly_unit<16>(MP + seq * 8192, 32768 + seq * 4096 + p, p, tid, ZT, YQ); }
            }
        } else if (PHON(6) && sub == 2) {
            pg8::Gemm g{YQ, TT, NYQ, 512, 1024, 1024, 1024}; pg8::StaticOrder S; S.init(NYQ, 512, G, bx);
            pg8::EpiDFT E{Y};
            pg8::gemm_phase<pg8::EpiDFT, pg8::StaticOrder, true>(lds, g, S, E);
        } else if (PHON(7) && sub == 3) {
            pg8::Gemm g{XB, WG, MTOK, DM, DM, DM, DM}; pg8::StaticOrder S; S.init(MTOK, DM, G, bx);
            pg8::EpiG2 E{RS, Y};
            pg8::gemm_phase<pg8::EpiG2, pg8::StaticOrder, true>(lds, g, S, E);
        } else if (sub == 4) {
            pg8::ProgG34 PG; PG.S.init(MTOK, DM, G, bx); PG.Y = Y; PG.XB = XB; PG.wsb = (const char*)ws; PG.WM = WM; PG.layer = layer;
            pg8::EpiG34 EG{RS, PB + (size_t)bx * 65536, PB + (size_t)(256 + bx) * 65536, MG};
            pg8::gemm_multi<pg8::EpiG34, pg8::ProgG34>(lds, PG, EG);
        } else if (PHON(10) && sub == 5) {
            pg8::Gemm g{MG, WO, MTOK, DM, DM, DM, DM}; pg8::StaticOrder S; S.init(MTOK, DM, G, bx);
            pg8::EpiG5 E{OB, SS};
            pg8::gemm_phase<pg8::EpiG5, pg8::StaticOrder, true>(lds, g, S, E);
        }
    }
}

extern "C" void kernel_launch(void* const* d_in, const int* in_sizes, int n_in, void* d_out, int out_size, void* d_ws, size_t ws_size, hipStream_t stream) {
    static int grid = 0;
    if (grid == 0) {
        if (n_in != 14 || ws_size < WS_END) { fprintf(stderr, "kernel_launch: bad inputs (n_in %d, ws %zu < %zu)\n", n_in, ws_size, (size_t)WS_END); grid = -1; return; }
        int dev = 0, cus = 0, per_cu = 0;
        hipGetDevice(&dev); hipDeviceGetAttribute(&cus, hipDeviceAttributeMultiprocessorCount, dev);
        if (hipFuncSetAttribute((const void*)fwd_kernel, hipFuncAttributeMaxDynamicSharedMemorySize, LDS_BYTES) != hipSuccess) { fprintf(stderr, "hipFuncSetAttribute failed\n"); grid = -1; return; }
        hipOccupancyMaxActiveBlocksPerMultiprocessor(&per_cu, (const void*)fwd_kernel, NWAVES * 64, LDS_BYTES);
        (void)hipGetLastError();
        if (per_cu < 1) { fprintf(stderr, "occupancy query says 0 blocks per CU\n"); }
        grid = cus;
    }
    if (grid < 0) return;
    Args a{};
    for (int i = 0; i < 14; ++i) a.in[i] = (const float*)d_in[i];
    a.out = (float*)d_out; a.ws = (unsigned char*)d_ws;
#if MK_ONE_LAUNCH
    a.ph_lo = 0; a.ph_hi = 15;
    void* kargs[] = {&a};
    hipError_t e = hipLaunchCooperativeKernel((const void*)fwd_kernel, dim3(grid), dim3(NWAVES * 64), kargs, LDS_BYTES, stream);
    if (e != hipSuccess) fprintf(stderr, "cooperative launch failed: %s (grid %d)\n", hipGetErrorString(e), grid);
#else
    for (int ph = 0; ph < 15; ++ph) {
        a.ph_lo = ph; a.ph_hi = ph + 1;
        hipLaunchKernelGGL(fwd_kernel, dim3(grid), dim3(NWAVES * 64), LDS_BYTES, stream, a);
    }
#endif
}
```

```cpp
#include <hip/hip_runtime.h>
#include <hip/hip_cooperative_groups.h>
#include <cstdio>
#include <cstdint>
namespace cg = cooperative_groups;

#ifndef MK_ONE_LAUNCH
#define MK_ONE_LAUNCH 1
#endif

#ifndef PH_MASK
#define PH_MASK 0xFFFF
#endif
#define PHON(k) (((PH_MASK) >> (k)) & 1)
#define LAS __attribute__((address_space(3)))
typedef unsigned short bf16_t;
typedef short bf16x8 __attribute__((ext_vector_type(8)));
typedef short s16x4 __attribute__((ext_vector_type(4)));
typedef float f32x4 __attribute__((ext_vector_type(4)));
typedef unsigned u32x4 __attribute__((ext_vector_type(4)));
typedef unsigned u32x2 __attribute__((ext_vector_type(2)));

constexpr int DM = 1024;
constexpr int MP = 65536;
constexpr int MTOK = 98304;
constexpr int DIN = 6400;
constexpr int NG1 = 2560;
constexpr int ZMW = 1536;
constexpr int NYQ = 49152;
constexpr float EPS = 1e-6f;

constexpr size_t MiB = 1u << 20;
constexpr size_t WS_WIN = 0;
constexpr size_t WS_WG = 10 * MiB;
constexpr size_t WS_WM = 14 * MiB;
constexpr size_t WS_WA = 26 * MiB;
constexpr size_t WS_WB = 28 * MiB;
constexpr size_t WS_WC = 29 * MiB;
constexpr size_t WS_WO = 30 * MiB;
constexpr size_t WS_T = 34 * MiB;
constexpr size_t WS_RS = 35 * MiB;
constexpr size_t WS_SS = 35 * MiB + 512 * 1024;
constexpr size_t WS_XB = 36 * MiB;
constexpr size_t WS_ZM = 228 * MiB;
constexpr size_t WS_ZT = 516 * MiB;
constexpr size_t WS_YQ = 708 * MiB;
constexpr size_t WS_Y = 804 * MiB;
constexpr size_t WS_END = 996 * MiB;

constexpr int NWAVES = 8;
constexpr int LDS_BYTES = 147456;

__device__ __forceinline__ unsigned f2bf(float f) { unsigned u = __builtin_bit_cast(unsigned, f); return (u + 0x7fffu + ((u >> 16) & 1u)) >> 16; }
__device__ __forceinline__ unsigned pk2(float lo, float hi) { unsigned r; asm("v_cvt_pk_bf16_f32 %0, %1, %2" : "=v"(r) : "v"(lo), "v"(hi)); return r; }
__device__ __forceinline__ float bf2f(unsigned b) { return __builtin_bit_cast(float, b << 16); }
__device__ __forceinline__ float bflo(unsigned w) { return __builtin_bit_cast(float, w << 16); }
__device__ __forceinline__ float bfhi(unsigned w) { return __builtin_bit_cast(float, w & 0xffff0000u); }
__device__ __forceinline__ float sigmoidf_(float x) { return __builtin_amdgcn_rcpf(1.0f + __expf(-x)); }
__device__ __forceinline__ float siluf_(float x) { return x * __builtin_amdgcn_rcpf(1.0f + __expf(-x)); }
__device__ __forceinline__ float wave_sum(float v) {
#pragma unroll
    for (int o = 1; o < 64; o <<= 1) v += __shfl_xor(v, o);
    return v;
}
#define LDS_WAIT() asm volatile("s_waitcnt lgkmcnt(0)" ::: "memory")
#define GAS __attribute__((address_space(1)))

namespace pg8 {
constexpr int BM = 256, BK = 64, HALF = 128, HTB = HALF * BK * 2, STAGE_BYTES = 8 * HTB, NXCD = 8, WGM = 8;
__device__ __forceinline__ int lds_byte(int r, int c) { const int st = (r >> 4) * 2 + (c >> 5), rr = r & 15, cc = c & 31, ob = rr * 64 + cc * 2; return st * 1024 + (ob ^ (((ob >> 9) & 1) << 5)); }
__device__ __forceinline__ void stage_rc(int b, int& R, int& C) { const int st = b / 1024, sb = b % 1024, swz = sb ^ (((sb >> 9) & 1) << 5); R = (st >> 1) * 16 + swz / 64; C = (st & 1) * 32 + (swz % 64) / 2; }

__device__ __forceinline__ int perm32(int rho) { const int n = rho >> 4, i = rho & 15; return 8 * (i >> 2) + 4 * n + (i & 3); }
struct Unit { int pm, pn; };
struct Gemm { const bf16_t* A; const bf16_t* Bt; int M, N, K, lda, ldb; };

struct StaticOrder {
    int nM, nN, nwg, G, c;
    __device__ __forceinline__ void init(int M, int N, int G_, int c_) { nM = M / BM; nN = N / BM; nwg = nM * nN; G = G_; c = c_; }
    __device__ __forceinline__ bool next(int i, Unit& u) const {
        const long L = (long)i * G + c; if (L >= nwg) return false;
        int wgid = (int)L; { const int q = nwg / NXCD, r = nwg % NXCD, xcd = wgid % NXCD, off = wgid / NXCD; wgid = (xcd < r ? xcd * (q + 1) : r * (q + 1) + (xcd - r) * q) + off; }
        const int nig = WGM * nN, gid = wgid / nig, fm = gid * WGM, gsz = (nM - fm) < WGM ? (nM - fm) : WGM;
        u.pm = fm + ((wgid % nig) % gsz); u.pn = (wgid % nig) / gsz; return true;
    }
};

struct SingleUnit { Unit u; __device__ bool next(int i, Unit& o) const { if (i) return false; o = u; return true; } };
template <class Epi, class Sched, bool ALIGN_EPI>
__device__ __forceinline__ void gemm_phase(LAS unsigned char* lds, const Gemm g, const Sched& S, const Epi& E) {
    int tid = threadIdx.x; asm volatile("" : "+v"(tid));
    const int wid = __builtin_amdgcn_readfirstlane(tid >> 6), lane = tid & 63, wr = wid >> 2, wc = wid & 3, fr = lane & 15, fq = lane >> 4;
    const int K = g.K, nt = K / BK;
    unsigned voffA[2], voffB[2];
#pragma unroll
    for (int i = 0; i < 2; ++i) { int R, C; stage_rc(tid * 16 + i * 8192, R, C);
        const int Rb = (R & ~31) + perm32(R & 31);
        voffA[i] = (unsigned)(R * g.lda + C) * 2u; voffB[i] = (unsigned)(Rb * g.ldb + C) * 2u; }
    const size_t kstep = (size_t)(BK * 2);
    const size_t hstepA = (size_t)HALF * g.lda * 2, hstepB = (size_t)HALF * g.ldb * 2;
    const size_t tstepA = 2 * hstepA, tstepB = 2 * hstepB;
    const unsigned ldsw = (unsigned)wid * 1024u;
    const int aoff = lds_byte(wr * 64 + fr, fq * 8), boff = lds_byte(wc * 32 + fr, fq * 8);
#define PG8_SA(b, h) (((b) * 2 + (h)) * HTB)
#define PG8_SB(b, h) ((4 + (b) * 2 + (h)) * HTB)
#define PG8_STAGE(bufoff, gbase, voff) do { _Pragma("unroll") for (int _i = 0; _i < 2; ++_i) \
        __builtin_amdgcn_global_load_lds((const unsigned*)((const char*)(gbase) + (voff)[_i]), (LAS unsigned*)(lds + (bufoff) + ldsw + _i * 8192), 16, 0, 0); } while (0)
#define PG8_LDA(dst, b, h) do { _Pragma("unroll") for (int m = 0; m < 4; ++m) _Pragma("unroll") for (int k = 0; k < 2; ++k) dst[m][k] = *(const LAS bf16x8*)(lds + PG8_SA(b, h) + aoff + m * 2048 + k * 1024); } while (0)
#define PG8_LDB(dst, b, h) do { _Pragma("unroll") for (int n = 0; n < 2; ++n) _Pragma("unroll") for (int k = 0; k < 2; ++k) dst[n][k] = *(const LAS bf16x8*)(lds + PG8_SB(b, h) + boff + n * 2048 + k * 1024); } while (0)
#define PG8_MMA(ai, bj, At, Bt) do { __builtin_amdgcn_s_setprio(1); _Pragma("unroll") for (int m = 0; m < 4; ++m) _Pragma("unroll") for (int n = 0; n < 2; ++n) _Pragma("unroll") for (int k = 0; k < 2; ++k) \
        acc[ai][bj][m][n] = __builtin_amdgcn_mfma_f32_16x16x32_bf16(Bt[n][k], At[m][k], acc[ai][bj][m][n], 0, 0, 0); __builtin_amdgcn_s_setprio(0); } while (0)
#define PG8_WAIT_V(n) asm volatile("s_waitcnt vmcnt(" #n ")" ::: "memory")
#define PG8_WAIT_L(n) asm volatile("s_waitcnt lgkmcnt(" #n ")" ::: "memory")
#define PG8_BAR __builtin_amdgcn_s_barrier()
#define PG8_SCHED __builtin_amdgcn_sched_barrier(0)
    Unit cur, nxt; int ui = 0;
    if (!S.next(0, cur)) return;
    f32x4 acc[2][2][4][2];
#pragma unroll
    for (int a = 0; a < 2; ++a)
#pragma unroll
        for (int b = 0; b < 2; ++b)
#pragma unroll
            for (int m = 0; m < 4; ++m)
#pragma unroll
                for (int n = 0; n < 2; ++n) acc[a][b][m][n] = (f32x4){0.f, 0.f, 0.f, 0.f};
    bf16x8 At[4][2], B0[2][2], B1[2][2];
    const char* cA = (const char*)g.A + (size_t)cur.pm * tstepA; const char* cB = (const char*)g.Bt + (size_t)cur.pn * tstepB;
    PG8_STAGE(PG8_SB(0, 0), cB, voffB); PG8_STAGE(PG8_SB(0, 1), cB + hstepB, voffB); PG8_STAGE(PG8_SA(0, 0), cA, voffA); PG8_STAGE(PG8_SA(0, 1), cA + hstepA, voffA);
    if (wr == 1) PG8_BAR;
    PG8_WAIT_V(2); PG8_BAR;
    PG8_STAGE(PG8_SB(1, 0), cB + kstep, voffB); PG8_STAGE(PG8_SA(1, 0), cA + kstep, voffA); PG8_STAGE(PG8_SB(1, 1), cB + hstepB + kstep, voffB);
    PG8_WAIT_V(6); PG8_BAR;
    for (;;) {
        const bool has_next = S.next(ui + 1, nxt);
        const char* nA = has_next ? (const char*)g.A + (size_t)nxt.pm * tstepA : cA; const char* nB = has_next ? (const char*)g.Bt + (size_t)nxt.pn * tstepB : cB;
        for (int t = 0; t < nt; t += 2) {
            const bool last = (t == nt - 2);
            const char* a1 = cA + (size_t)(t + 1) * kstep;
            const char* a2 = last ? nA : cA + (size_t)(t + 2) * kstep; const char* b2 = last ? nB : cB + (size_t)(t + 2) * kstep;
            const char* a3 = a2 + kstep; const char* b3 = b2 + kstep;
            PG8_LDB(B0, 0, 0); PG8_LDB(B1, 0, 1); PG8_SCHED; PG8_LDA(At, 0, 0); PG8_STAGE(PG8_SA(1, 1), a1 + hstepA, voffA);
            PG8_WAIT_V(8); PG8_WAIT_L(0); PG8_BAR; PG8_MMA(0, 0, At, B0); PG8_MMA(0, 1, At, B1); PG8_BAR; PG8_SCHED;
            PG8_LDA(At, 0, 1); PG8_STAGE(PG8_SB(0, 0), b2, voffB); PG8_STAGE(PG8_SB(0, 1), b2 + hstepB, voffB); PG8_STAGE(PG8_SA(0, 0), a2, voffA);
            PG8_WAIT_V(8); PG8_WAIT_L(0); PG8_BAR; PG8_MMA(1, 0, At, B0); PG8_MMA(1, 1, At, B1); PG8_BAR; PG8_SCHED;
            PG8_LDB(B0, 1, 0); PG8_LDB(B1, 1, 1); PG8_SCHED; PG8_LDA(At, 1, 0); PG8_STAGE(PG8_SA(0, 1), a2 + hstepA, voffA);
            PG8_WAIT_V(8); PG8_WAIT_L(0); PG8_BAR; PG8_MMA(0, 0, At, B0); PG8_MMA(0, 1, At, B1); PG8_BAR; PG8_SCHED;
            PG8_LDA(At, 1, 1); PG8_STAGE(PG8_SB(1, 0), b3, voffB); PG8_STAGE(PG8_SB(1, 1), b3 + hstepB, voffB); PG8_STAGE(PG8_SA(1, 0), a3, voffA);
            PG8_WAIT_V(8); PG8_WAIT_L(0); PG8_BAR; PG8_MMA(1, 0, At, B0); PG8_MMA(1, 1, At, B1); PG8_BAR; PG8_SCHED;
        }
        if constexpr (ALIGN_EPI) { if (wr == 0) PG8_BAR; }
        E(acc, cur, wr, wc, fr, fq);
        if (!has_next) break;
#pragma unroll
        for (int a = 0; a < 2; ++a)
#pragma unroll
            for (int b = 0; b < 2; ++b)
#pragma unroll
                for (int m = 0; m < 4; ++m)
#pragma unroll
                    for (int n = 0; n < 2; ++n) acc[a][b][m][n] = (f32x4){0.f, 0.f, 0.f, 0.f};
        cur = nxt; cA = nA; cB = nB; ++ui;
        if constexpr (ALIGN_EPI) { if (wr == 1) PG8_BAR; }
    }
    PG8_WAIT_V(0);
    if constexpr (!ALIGN_EPI) { if (wr == 0) PG8_BAR; }
    PG8_BAR;
#undef PG8_SA
#undef PG8_SB
#undef PG8_STAGE
#undef PG8_LDA
#undef PG8_LDB
#undef PG8_MMA
#undef PG8_WAIT_V
#undef PG8_WAIT_L
#undef PG8_BAR
#undef PG8_SCHED
}

struct UnitX { int pm, pn, seg; };
__device__ __forceinline__ int uni(int v) { return __builtin_amdgcn_readfirstlane(v); }
__device__ __forceinline__ const char* unip(const char* p) { const unsigned long long v = (unsigned long long)p; const unsigned lo = (unsigned)__builtin_amdgcn_readfirstlane((int)(unsigned)v), hi = (unsigned)__builtin_amdgcn_readfirstlane((int)(unsigned)(v >> 32)); return (const char*)(((unsigned long long)hi << 32) | lo); }
template <class Epi, class Prog>
__device__ __forceinline__ void gemm_multi(LAS unsigned char* lds, const Prog& P, const Epi& E) {
    int tid = threadIdx.x; asm volatile("" : "+v"(tid));
    const int wid = __builtin_amdgcn_readfirstlane(tid >> 6), lane = tid & 63, wr = wid >> 2, wc = wid & 3, fr = lane & 15, fq = lane >> 4;
    unsigned Rr[2], RrB[2], Cc2[2];
#pragma unroll
    for (int i = 0; i < 2; ++i) { int R, C; stage_rc(tid * 16 + i * 8192, R, C); Rr[i] = (unsigned)R * 2u; RrB[i] = (unsigned)((R & ~31) + perm32(R & 31)) * 2u; Cc2[i] = (unsigned)C * 2u; }
    const size_t kstep = (size_t)(BK * 2);
    const unsigned ldsw = (unsigned)wid * 1024u;
    const int aoff = lds_byte(wr * 64 + fr, fq * 8), boff = lds_byte(wc * 32 + fr, fq * 8);
#define PG8_SA(b, h) (((b) * 2 + (h)) * HTB)
#define PG8_SB(b, h) ((4 + (b) * 2 + (h)) * HTB)
#define PG8_STAGE_X(RR, bufoff, gbase, ld) do { _Pragma("unroll") for (int _i = 0; _i < 2; ++_i) \
        __builtin_amdgcn_global_load_lds((const unsigned*)((const char*)(gbase) + (RR[_i] * (unsigned)(ld) + Cc2[_i])), (LAS unsigned*)(lds + (bufoff) + ldsw + _i * 8192), 16, 0, 0); } while (0)
#define PG8_STAGE(bufoff, gbase, ld) PG8_STAGE_X(Rr, bufoff, gbase, ld)
#define PG8_STAGEB(bufoff, gbase, ld) PG8_STAGE_X(RrB, bufoff, gbase, ld)
#define PG8_LDA(dst, b, h) do { _Pragma("unroll") for (int m = 0; m < 4; ++m) _Pragma("unroll") for (int k = 0; k < 2; ++k) dst[m][k] = *(const LAS bf16x8*)(lds + PG8_SA(b, h) + aoff + m * 2048 + k * 1024); } while (0)
#define PG8_LDB(dst, b, h) do { _Pragma("unroll") for (int n = 0; n < 2; ++n) _Pragma("unroll") for (int k = 0; k < 2; ++k) dst[n][k] = *(const LAS bf16x8*)(lds + PG8_SB(b, h) + boff + n * 2048 + k * 1024); } while (0)
#define PG8_MMA(ai, bj, At, Bt) do { __builtin_amdgcn_s_setprio(1); _Pragma("unroll") for (int m = 0; m < 4; ++m) _Pragma("unroll") for (int n = 0; n < 2; ++n) _Pragma("unroll") for (int k = 0; k < 2; ++k) \
        acc[ai][bj][m][n] = __builtin_amdgcn_mfma_f32_16x16x32_bf16(Bt[n][k], At[m][k], acc[ai][bj][m][n], 0, 0, 0); __builtin_amdgcn_s_setprio(0); } while (0)
#define PG8_WAIT_V(n) asm volatile("s_waitcnt vmcnt(" #n ")" ::: "memory")
#define PG8_WAIT_L(n) asm volatile("s_waitcnt lgkmcnt(" #n ")" ::: "memory")
#define PG8_BAR __builtin_amdgcn_s_barrier()
#define PG8_SCHED __builtin_amdgcn_sched_barrier(0)
    UnitX cur, nxt; int ui = 0;
    if (!P.next(0, cur)) return;
    f32x4 acc[2][2][4][2];
#pragma unroll
    for (int a = 0; a < 2; ++a)
#pragma unroll
        for (int b = 0; b < 2; ++b)
#pragma unroll
            for (int m = 0; m < 4; ++m)
#pragma unroll
                for (int n = 0; n < 2; ++n) acc[a][b][m][n] = (f32x4){0.f, 0.f, 0.f, 0.f};
    bf16x8 At[4][2], B0[2][2], B1[2][2];
    const char* cA; const char* cB; int lda, ldb, nt;
    P.desc(cur, cA, cB, lda, ldb, nt); cA = unip(cA); cB = unip(cB); lda = uni(lda); ldb = uni(ldb); nt = uni(nt);
    {   const size_t hA = (size_t)HALF * lda * 2, hB = (size_t)HALF * ldb * 2;
        PG8_STAGEB(PG8_SB(0, 0), cB, ldb); PG8_STAGEB(PG8_SB(0, 1), cB + hB, ldb); PG8_STAGE(PG8_SA(0, 0), cA, lda); PG8_STAGE(PG8_SA(0, 1), cA + hA, lda);
        if (wr == 1) PG8_BAR;
        PG8_WAIT_V(2); PG8_BAR;
        PG8_STAGEB(PG8_SB(1, 0), cB + kstep, ldb); PG8_STAGE(PG8_SA(1, 0), cA + kstep, lda); PG8_STAGEB(PG8_SB(1, 1), cB + hB + kstep, ldb);
        PG8_WAIT_V(6); PG8_BAR; }
    for (;;) {
        const bool has_next = P.next(ui + 1, nxt);
        const char* nA = cA; const char* nB = cB; int ldan = lda, ldbn = ldb, ntn = nt;
        if (has_next) P.desc(nxt, nA, nB, ldan, ldbn, ntn);
        nA = unip(nA); nB = unip(nB); ldan = uni(ldan); ldbn = uni(ldbn); ntn = uni(ntn);
        const size_t hAc = (size_t)HALF * lda * 2;
        for (int t = 0; t < nt; t += 2) {
            const bool last = (t == nt - 2);
            const char* a1 = cA + (size_t)(t + 1) * kstep;
            const char* a2 = last ? nA : cA + (size_t)(t + 2) * kstep; const char* b2 = last ? nB : cB + (size_t)(t + 2) * kstep;
            const int lda2 = last ? ldan : lda, ldb2 = last ? ldbn : ldb;
            const size_t hA2 = (size_t)HALF * lda2 * 2, hB2 = (size_t)HALF * ldb2 * 2;
            const char* a3 = a2 + kstep; const char* b3 = b2 + kstep;
            PG8_LDB(B0, 0, 0); PG8_LDB(B1, 0, 1); PG8_SCHED; PG8_LDA(At, 0, 0); PG8_STAGE(PG8_SA(1, 1), a1 + hAc, lda);
            PG8_WAIT_V(8); PG8_WAIT_L(0); PG8_BAR; PG8_MMA(0, 0, At, B0); PG8_MMA(0, 1, At, B1); PG8_BAR; PG8_SCHED;
            PG8_LDA(At, 0, 1); PG8_STAGEB(PG8_SB(0, 0), b2, ldb2); PG8_STAGEB(PG8_SB(0, 1), b2 + hB2, ldb2); PG8_STAGE(PG8_SA(0, 0), a2, lda2);
            PG8_WAIT_V(8); PG8_WAIT_L(0); PG8_BAR; PG8_MMA(1, 0, At, B0); PG8_MMA(1, 1, At, B1); PG8_BAR; PG8_SCHED;
            PG8_LDB(B0, 1, 0); PG8_LDB(B1, 1, 1); PG8_SCHED; PG8_LDA(At, 1, 0); PG8_STAGE(PG8_SA(0, 1), a2 + hA2, lda2);
            PG8_WAIT_V(8); PG8_WAIT_L(0); PG8_BAR; PG8_MMA(0, 0, At, B0); PG8_MMA(0, 1, At, B1); PG8_BAR; PG8_SCHED;
            PG8_LDA(At, 1, 1); PG8_STAGEB(PG8_SB(1, 0), b3, ldb2); PG8_STAGEB(PG8_SB(1, 1), b3 + hB2, ldb2); PG8_STAGE(PG8_SA(1, 0), a3, lda2);
            PG8_WAIT_V(8); PG8_WAIT_L(0); PG8_BAR; PG8_MMA(1, 0, At, B0); PG8_MMA(1, 1, At, B1); PG8_BAR; PG8_SCHED;
        }
        if (wr == 0) PG8_BAR;
        E(acc, cur, wr, wc, fr, fq);
        if (!has_next) break;
#pragma unroll
        for (int a = 0; a < 2; ++a)
#pragma unroll
            for (int b = 0; b < 2; ++b)
#pragma unroll
                for (int m = 0; m < 4; ++m)
#pragma unroll
                    for (int n = 0; n < 2; ++n) acc[a][b][m][n] = (f32x4){0.f, 0.f, 0.f, 0.f};
        cur = nxt; cA = nA; cB = nB; lda = ldan; ldb = ldbn; nt = ntn; ++ui;
        if (wr == 1) PG8_BAR;
    }
    PG8_WAIT_V(0);
    PG8_BAR;
#undef PG8_SA
#undef PG8_SB
#undef PG8_STAGE
#undef PG8_STAGEB
#undef PG8_STAGE_X
#undef PG8_LDA
#undef PG8_LDB
#undef PG8_MMA
#undef PG8_WAIT_V
#undef PG8_WAIT_L
#undef PG8_BAR
#undef PG8_SCHED
}

#define EPI_ROWS_BEGIN  _Pragma("unroll") for (int ai = 0; ai < 2; ++ai) _Pragma("unroll") for (int m = 0; m < 4; ++m) { const int row = u.pm * BM + ai * HALF + wr * 64 + m * 16 + fr;
#define EPI_COLS_BEGIN  _Pragma("unroll") for (int bj = 0; bj < 2; ++bj) _Pragma("unroll") for (int n = 0; n < 2; ++n) { const int col = bj * HALF + wc * 32 + 8 * fq + 4 * n; f32x4 v = acc[ai][bj][m][n];
#define EPI_END } }
#define EPI_COLS8_BEGIN  _Pragma("unroll") for (int bj = 0; bj < 2; ++bj) { const int col = bj * HALF + wc * 32 + 8 * fq; const f32x4 v0 = acc[ai][bj][m][0], v1 = acc[ai][bj][m][1];

struct EpiG1 {
    const float* rs; bf16_t* ZM; bf16_t* ZT;
    __device__ __forceinline__ void operator()(const f32x4 (&acc)[2][2][4][2], const Unit& u, int wr, int wc, int fr, int fq) const {
        const int pn = u.pn;
        if (pn >= 4 && pn < 6) {
            const int d0 = (pn - 4) * 256;
            EPI_ROWS_BEGIN
            EPI_COLS_BEGIN
                GAS bf16_t* d = (GAS bf16_t*)ZT + ((size_t)(row >> 6) * 512 + d0 + col) * 64 + (row & 63);
                const unsigned w0 = pk2(v[0], v[1]), w1 = pk2(v[2], v[3]);
                d[0] = (bf16_t)w0; d[64] = (bf16_t)(w0 >> 16); d[128] = (bf16_t)w1; d[192] = (bf16_t)(w1 >> 16);
            EPI_END
        } else if (pn >= 6 && pn < 8) {
            const int j0 = (pn - 6) * 256;
            EPI_ROWS_BEGIN
            EPI_COLS_BEGIN
                GAS bf16_t* d = (GAS bf16_t*)ZT + (size_t)MTOK * 512 + ((size_t)(row >> 9) * 512 + j0 + col) * 512 + (row & 511);
                const unsigned w0 = pk2(v[0], v[1]), w1 = pk2(v[2], v[3]);
                d[0] = (bf16_t)w0; d[512] = (bf16_t)(w0 >> 16); d[1024] = (bf16_t)w1; d[1536] = (bf16_t)(w1 >> 16);
            EPI_END
        } else {
            const int cm = (pn < 4 ? pn : pn - 4) * 256;
            EPI_ROWS_BEGIN
            EPI_COLS8_BEGIN
                u32x4 w; w.x = pk2(v0[0], v0[1]); w.y = pk2(v0[2], v0[3]); w.z = pk2(v1[0], v1[1]); w.w = pk2(v1[2], v1[3]);
                *(GAS u32x4*)((GAS bf16_t*)ZM + (size_t)row * ZMW + cm + col) = w;
            EPI_END
        }
    }
};
struct EpiDFT {
    bf16_t* Y;
    __device__ __forceinline__ void operator()(const f32x4 (&acc)[2][2][4][2], const Unit& u, int wr, int wc, int fr, int fq) const {
        int tok0, R, q;
        if (u.pm < 128) { tok0 = (u.pm >> 2) * 2048; R = 4; q = u.pm & 3; } else { const int t = u.pm - 128; tok0 = MP + (t >> 4) * 8192; R = 16; q = t & 15; }
        EPI_ROWS_BEGIN const int p = row - u.pm * BM;
        EPI_COLS_BEGIN
            const int k0 = u.pn * BM + col;
            GAS bf16_t* d = (GAS bf16_t*)Y + (size_t)(tok0 + R * k0 + q) * DM + 512 + p;
            const unsigned w0 = pk2(v[0], v[1]), w1 = pk2(v[2], v[3]);
            d[0] = (bf16_t)w0; d[(size_t)R * DM] = (bf16_t)(w0 >> 16); d[(size_t)2 * R * DM] = (bf16_t)w1; d[(size_t)3 * R * DM] = (bf16_t)(w1 >> 16);
        EPI_END
    }
};
struct EpiG2 {
    const float* rs; bf16_t* Y;
    __device__ __forceinline__ void operator()(const f32x4 (&acc)[2][2][4][2], const Unit& u, int wr, int wc, int fr, int fq) const {
        EPI_ROWS_BEGIN
        EPI_COLS8_BEGIN
            GAS u32x4* p = (GAS u32x4*)((GAS bf16_t*)Y + (size_t)row * DM + u.pn * BM + col);
            const u32x4 y = *p; u32x4 w;
            w.x = pk2(bflo(y.x) * siluf_(v0[0]), bfhi(y.x) * siluf_(v0[1])); w.y = pk2(bflo(y.y) * siluf_(v0[2]), bfhi(y.y) * siluf_(v0[3]));
            w.z = pk2(bflo(y.z) * siluf_(v1[0]), bfhi(y.z) * siluf_(v1[1])); w.w = pk2(bflo(y.w) * siluf_(v1[2]), bfhi(y.w) * siluf_(v1[3]));
            *p = w;
        EPI_END
    }
};
struct ProgG34 {
    StaticOrder S; const bf16_t* Y; const bf16_t* XB; const char* wsb; const bf16_t* WM; int layer;
    __device__ __forceinline__ bool next(int i, UnitX& u) const { Unit t; if (!S.next(i / 6, t)) return false; u.pm = t.pm; u.pn = t.pn; u.seg = i % 6; return true; }
    __device__ __forceinline__ void desc(const UnitX& u, const char*& A, const char*& B, int& lda, int& ldb, int& nt) const {
        const int b = u.seg >> 1; lda = DM;
        if (u.seg & 1) { A = (const char*)(XB + (size_t)u.pm * BM * DM); B = (const char*)(WM + (size_t)b * DM * DM + (size_t)u.pn * BM * DM); ldb = DM; nt = DM / BK; }
        else { const int kb = (b == 0) ? 512 : 256, ac = (b == 0) ? 0 : (b == 1 ? 512 : 768);
            const size_t woff = (size_t)((b == 0) ? 26 : 27 + b) * MiB + (size_t)layer * ((b == 0) ? MiB : MiB / 2);
            const bf16_t* w = (const bf16_t*)(wsb + woff);
            A = (const char*)(Y + (size_t)u.pm * BM * DM + ac); B = (const char*)(w + (size_t)u.pn * BM * kb); ldb = kb; nt = kb / BK; }
    }
};
struct EpiG34 {
    const float* rs; bf16_t* PT; bf16_t* MT; bf16_t* MG;
    __device__ __forceinline__ void operator()(const f32x4 (&acc)[2][2][4][2], const UnitX& u, int wr, int wc, int fr_, int fq_) const {
        int fr = fr_, fq = fq_; asm volatile("" : "+v"(fr), "+v"(fq));
        if ((u.seg & 1) == 0) {
            EPI_ROWS_BEGIN
            EPI_COLS8_BEGIN
                u32x4 w; w.x = pk2(v0[0], v0[1]); w.y = pk2(v0[2], v0[3]); w.z = pk2(v1[0], v1[1]); w.w = pk2(v1[2], v1[3]);
                *(GAS u32x4*)(PT + (size_t)(row - u.pm * BM) * 256 + col) = w;
            EPI_END
        } else {
            const int mode = u.seg >> 1;
            EPI_ROWS_BEGIN
            EPI_COLS8_BEGIN
                const size_t toff = (size_t)(row - u.pm * BM) * 256 + col;
                const u32x4 pv = *(const GAS u32x4*)(PT + toff);
                float r0 = bflo(pv.x) * sigmoidf_(v0[0]), r1 = bfhi(pv.x) * sigmoidf_(v0[1]), r2 = bflo(pv.y) * sigmoidf_(v0[2]), r3 = bfhi(pv.y) * sigmoidf_(v0[3]);
                float r4 = bflo(pv.z) * sigmoidf_(v1[0]), r5 = bfhi(pv.z) * sigmoidf_(v1[1]), r6 = bflo(pv.w) * sigmoidf_(v1[2]), r7 = bfhi(pv.w) * sigmoidf_(v1[3]);
                if (mode) { const u32x4 mv = *(const GAS u32x4*)(MT + toff); r0 += bflo(mv.x); r1 += bfhi(mv.x); r2 += bflo(mv.y); r3 += bfhi(mv.y); r4 += bflo(mv.z); r5 += bfhi(mv.z); r6 += bflo(mv.w); r7 += bfhi(mv.w); }
                u32x4 w; w.x = pk2(r0, r1); w.y = pk2(r2, r3); w.z = pk2(r4, r5); w.w = pk2(r6, r7);
                if (mode == 2) *(GAS u32x4*)(MG + (size_t)row * DM + u.pn * BM + col) = w; else *(GAS u32x4*)(MT + toff) = w;
            EPI_END
        }
    }
};
struct EpiG5 {
    bf16_t* O; float* ss;
    __device__ __forceinline__ void operator()(const f32x4 (&acc)[2][2][4][2], const Unit& u, int wr, int wc, int fr, int fq) const {
        EPI_ROWS_BEGIN float q = 0.f;
        EPI_COLS8_BEGIN
            u32x4 w; w.x = pk2(v0[0], v0[1]); w.y = pk2(v0[2], v0[3]); w.z = pk2(v1[0], v1[1]); w.w = pk2(v1[2], v1[3]);
            *(GAS u32x4*)((GAS bf16_t*)O + (size_t)row * DM + u.pn * BM + col) = w;
            q += ((v0[0] * v0[0] + v0[1] * v0[1]) + (v0[2] * v0[2] + v0[3] * v0[3])) + ((v1[0] * v1[0] + v1[1] * v1[1]) + (v1[2] * v1[2] + v1[3] * v1[3]));
        }
            q += __shfl_xor(q, 16); q += __shfl_xor(q, 32);
            if (fq == 0) atomicAdd(ss + row, q);
        }
    }
};
}

__device__ __forceinline__ void transpose_item(const float* W, int K, int pitch, int c0, int ncols, bf16_t* WT, int row_off, const float* g, float scale, LAS float* scr, int item, int lane) {
    const int nblk = ncols / 32, kb = item / nblk, nb = item % nblk, k0 = 64 * kb, n0 = 32 * nb;
#pragma unroll 8
    for (int i = 0; i < 32; ++i) { const int kk = 2 * i + (lane >> 5); float w = W[(size_t)(k0 + kk) * pitch + c0 + n0 + (lane & 31)] * scale; if (g) w *= g[k0 + kk]; scr[kk * 33 + (lane & 31)] = w; }
    LDS_WAIT(); asm volatile("" ::: "memory");
    const int c = lane & 7;
#pragma unroll
    for (int j = 0; j < 4; ++j) { const int n = (lane >> 3) + 8 * j; const LAS float* s = scr + (8 * c) * 33 + n;
        u32x4 o; o.x = pk2(s[0 * 33], s[1 * 33]); o.y = pk2(s[2 * 33], s[3 * 33]); o.z = pk2(s[4 * 33], s[5 * 33]); o.w = pk2(s[6 * 33], s[7 * 33]);
        *(u32x4*)(WT + (size_t)(row_off + n0 + n) * K + k0 + 8 * c) = o; }
    LDS_WAIT(); asm volatile("" ::: "memory");
}

struct Args { const float* in[14]; float* out; unsigned char* ws; int ph_lo, ph_hi; };

__device__ __forceinline__ void grid_row_info(int gr, int& seqbase, int& r, int& nrows) {
    if (gr < 1024) { seqbase = (gr >> 5) << 11; r = gr & 31; nrows = 32; } else { const int g2 = gr - 1024; seqbase = MP + ((g2 >> 7) << 13); r = g2 & 127; nrows = 128; }
}

constexpr int AT_KSLOT = 9216, AT_VSLOT = 8704, AT_VOFF = 73728, AT_BOFF = 143360;
__device__ __forceinline__ void attn_fill_issue(const GAS bf16_t* ZM, const GAS bf16_t* ZT, int tok0, int head, int tid, u32x4& kreg, u32x4& vreg) {
    kreg = *(const GAS u32x4*)(ZM + (size_t)(tok0 + (tid >> 3)) * ZMW + 512 + head * 64 + (tid & 7) * 8);
    vreg = *(const GAS u32x4*)(ZT + ((size_t)(tok0 >> 6) * 512 + head * 64) * 64 + tid * 8);
}
__device__ __forceinline__ void attn_fill_write(LAS unsigned char* lds, int slot, int tid, const u32x4 kreg, const u32x4 vreg) {
    *(LAS u32x4*)(lds + slot * AT_KSLOT + (tid >> 3) * 144 + (tid & 7) * 16) = kreg;
    LAS u32x2* vp = (LAS u32x2*)(lds + AT_VOFF + slot * AT_VSLOT + (tid >> 3) * 136 + (tid & 7) * 16);
    u32x2 a; a.x = vreg.x; a.y = vreg.y; u32x2 b; b.x = vreg.z; b.y = vreg.w;
    vp[0] = a; vp[1] = b;
}
__device__ __forceinline__ void attn_row_lds(LAS unsigned char* lds, int seqbase, int r, int rs, int head, int lane, int wave, const bf16x8 bq0, const bf16x8 bq1, GAS bf16_t* Y) {
    const LAS float* bias = (const LAS float*)(lds + AT_BOFF);
    const int g = wave & 3, dh = wave >> 2;
    const int qi = lane & 15, h4 = lane >> 4;
    const int cs = (g == 0) ? 0 : (g == 1) ? 8 : (g == 2) ? 24 : 32;
    const int qc = 16 * g + qi;
    const int qtok = seqbase + r * 64 + qc;
    int cst = qc - 8; cst = cst < 0 ? 0 : cst; cst = cst > 48 ? 48 : cst;
    f32x4 S[16];
    float mx = -3.0e38f;
#pragma unroll
    for (int t = 0; t < 16; ++t) {
        const int kr = t >> 1, hf = t & 1;
        const int slot = (rs + kr) & 7;
        const LAS unsigned char* kp = lds + slot * AT_KSLOT + (cs + 16 * hf + qi) * 144 + h4 * 16;
        const bf16x8 ak0 = *(const LAS bf16x8*)kp, ak1 = *(const LAS bf16x8*)(kp + 64);
        const LAS float* brow = bias + (rs + kr - r + 7) * 31;
        float bv[4];
#pragma unroll
        for (int e = 0; e < 4; ++e) { int dc = cs + 16 * hf + 4 * h4 + e - qc + 15; dc = dc < 0 ? 0 : dc; dc = dc > 30 ? 30 : dc; bv[e] = brow[dc]; }
        f32x4 s = {0.f, 0.f, 0.f, 0.f};
        s = __builtin_amdgcn_mfma_f32_16x16x32_bf16(ak0, bq0, s, 0, 0, 0);
        s = __builtin_amdgcn_mfma_f32_16x16x32_bf16(ak1, bq1, s, 0, 0, 0);
        asm volatile("" : "+v"(bv[0]), "+v"(bv[1]), "+v"(bv[2]), "+v"(bv[3]));
#pragma unroll
        for (int e = 0; e < 4; ++e) {
            const int kc = cs + 16 * hf + 4 * h4 + e;
            const bool valid = (kc >= cst) && (kc < cst + 16);
            const float val = valid ? s[e] + bv[e] : -1.0e30f;
            s[e] = val; mx = fmaxf(mx, val);
        }
        S[t] = s;
    }
    mx = fmaxf(mx, __shfl_xor(mx, 16)); mx = fmaxf(mx, __shfl_xor(mx, 32));
    float sum = 0.f;
    bf16x8 pf[8];
#pragma unroll
    for (int kr = 0; kr < 8; ++kr) {
        const f32x4 a = S[kr * 2], b = S[kr * 2 + 1];
        const float p0 = __expf(a[0] - mx), p1 = __expf(a[1] - mx), p2 = __expf(a[2] - mx), p3 = __expf(a[3] - mx);
        const float p4 = __expf(b[0] - mx), p5 = __expf(b[1] - mx), p6 = __expf(b[2] - mx), p7 = __expf(b[3] - mx);
        sum += ((p0 + p1) + (p2 + p3)) + ((p4 + p5) + (p6 + p7));
        u32x4 w; w.x = pk2(p0, p1); w.y = pk2(p2, p3); w.z = pk2(p4, p5); w.w = pk2(p6, p7);
        pf[kr] = __builtin_bit_cast(bf16x8, w);
    }
    sum += __shfl_xor(sum, 16); sum += __shfl_xor(sum, 32);
    const float inv = 1.0f / sum;
    GAS bf16_t* yp = Y + (size_t)qtok * DM + head * 64 + 4 * h4;
#pragma unroll
    for (int dti = 0; dti < 2; ++dti) {
        const int dt = 2 * dh + dti;
        f32x4 o = {0.f, 0.f, 0.f, 0.f};
#pragma unroll
        for (int kr = 0; kr < 8; ++kr) {
            const int slot = (rs + kr) & 7;
            const LAS unsigned char* vp = lds + AT_VOFF + slot * AT_VSLOT + (dt * 16 + qi) * 136 + (cs + 4 * h4) * 2;
            const u32x2 lo = *(const LAS u32x2*)vp, hi = *(const LAS u32x2*)(vp + 32);
            u32x4 w; w.x = lo.x; w.y = lo.y; w.z = hi.x; w.w = hi.y;
            o = __builtin_amdgcn_mfma_f32_16x16x32_bf16(__builtin_bit_cast(bf16x8, w), pf[kr], o, 0, 0, 0);
        }
        u32x2 w; w.x = pk2(o[0] * inv, o[1] * inv); w.y = pk2(o[2] * inv, o[3] * inv);
        *(GAS u32x2*)(yp + dt * 16) = w;
    }
}
__device__ __forceinline__ void attn_unit(LAS unsigned char* lds, int seqbase, int nrows, int ra, int rb, int head, int tid, int lane, int wave,
                                          const bf16_t* ZM_, const bf16_t* ZT_, bf16_t* Y_, const float* rpb) {
    const GAS bf16_t* ZM = (const GAS bf16_t*)ZM_; const GAS bf16_t* ZT = (const GAS bf16_t*)ZT_; GAS bf16_t* Y = (GAS bf16_t*)Y_;
    int rs = ra - 4; rs = rs < 0 ? 0 : rs; rs = rs > nrows - 8 ? nrows - 8 : rs;
    {   u32x4 kreg[8], vreg[8];
#pragma unroll
        for (int k = 0; k < 8; ++k) attn_fill_issue(ZM, ZT, seqbase + (rs + k) * 64, head, tid, kreg[k], vreg[k]);
        LAS float* bw = (LAS float*)(lds + AT_BOFF);
        if (tid < 465) bw[tid] = rpb[head * 465 + tid];
#pragma unroll
        for (int k = 0; k < 8; ++k) attn_fill_write(lds, (rs + k) & 7, tid, kreg[k], vreg[k]);
    }
    const GAS bf16_t* qbase = ZM + (size_t)(seqbase + 16 * (wave & 3) + (lane & 15)) * ZMW + head * 64 + 8 * (lane >> 4);
    bf16x8 q0 = *(const GAS bf16x8*)(qbase + (size_t)ra * 64 * ZMW), q1 = *(const GAS bf16x8*)(qbase + (size_t)ra * 64 * ZMW + 32);
    __syncthreads();
#pragma unroll 1
    for (int r = ra; r < rb; ++r) {
        const int rq = (r + 1 < rb) ? r + 1 : r;
        const bf16x8 nq0 = *(const GAS bf16x8*)(qbase + (size_t)rq * 64 * ZMW), nq1 = *(const GAS bf16x8*)(qbase + (size_t)rq * 64 * ZMW + 32);
        int rsn = r + 1 - 4; rsn = rsn < 0 ? 0 : rsn; rsn = rsn > nrows - 8 ? nrows - 8 : rsn;
        const bool adv = (r + 1 < rb) && (rsn != rs);
        u32x4 kreg = {0u, 0u, 0u, 0u}, vreg = {0u, 0u, 0u, 0u};
        if (adv) attn_fill_issue(ZM, ZT, seqbase + (rsn + 7) * 64, head, tid, kreg, vreg);
        attn_row_lds(lds, seqbase, r, rs, head, lane, wave, q0, q1, Y);
        __syncthreads();
        if (adv) attn_fill_write(lds, (rsn + 7) & 7, tid, kreg, vreg);
        __syncthreads();
        rs = rsn; q0 = nq0; q1 = nq1;
    }
}

template <int R>
__device__ __forceinline__ void butterfly_unit(int tok0, int rowbase  , int p, int lp, const bf16_t* ZT, bf16_t* YQ) {
    constexpr int L = 512 * R;
    const bf16_t* zre = ZT + (size_t)MTOK * 512 + ((size_t)(tok0 >> 9) * 512 + p) * 512 + lp;
    const bf16_t* zim = zre + 256 * 512;
    float xr[R], xi[R];
#pragma unroll
    for (int s = 0; s < R; ++s) { xr[s] = bf2f(zre[(size_t)s * 512 * 512]); xi[s] = bf2f(zim[(size_t)s * 512 * 512]); }
    const float scale = rsqrtf(64.0f * (float)L);
#pragma unroll 1
    for (int q = 0; q < R; ++q) {
        float wr_, wi_; sincospif(-2.0f * (float)q / (float)R, &wi_, &wr_);
        float yr = xr[R - 1], yi = xi[R - 1];
#pragma unroll
        for (int s = R - 2; s >= 0; --s) { const float tr = yr * wr_ - yi * wi_ + xr[s], ti = yr * wi_ + yi * wr_ + xi[s]; yr = tr; yi = ti; }
        float tr_, ti_; sincospif(-2.0f * (float)(q * lp) / (float)L, &ti_, &tr_);
        const float orr = (yr * tr_ - yi * ti_) * scale, oi = (yr * ti_ + yi * tr_) * scale;
        bf16_t* d = YQ + (size_t)(rowbase + q * 256) * 1024 + lp;
        d[0] = (bf16_t)f2bf(orr); d[512] = (bf16_t)f2bf(oi);
    }
}

__global__ void __launch_bounds__(NWAVES * 64, 2) fwd_kernel(Args args) {
    extern __shared__ __attribute__((aligned(16))) unsigned char lds_raw[];
    LAS unsigned char* lds = (LAS unsigned char*)lds_raw;
    const int G = gridDim.x, bx = blockIdx.x;
    for (int ph = args.ph_lo; ph < args.ph_hi; ++ph) {
        if (ph > args.ph_lo) { cg::this_grid().sync(); }
        int tid = threadIdx.x; asm volatile("" : "+v"(tid));
        const int lane = tid & 63, wave = __builtin_amdgcn_readfirstlane(tid >> 6);
        const int gw = bx * NWAVES + wave, NGW = G * NWAVES;
        unsigned char* ws = args.ws; asm volatile("" : "+s"(ws));
        const float* x_prompt = args.in[0]; const float* x_sample = args.in[1];
        float* out = args.out;
        bf16_t* XB = (bf16_t*)(ws + WS_XB); bf16_t* OB = XB;
        bf16_t* ZM = (bf16_t*)(ws + WS_ZM); bf16_t* PB = ZM;
        bf16_t* ZT = (bf16_t*)(ws + WS_ZT); bf16_t* MG = ZT;
        bf16_t* YQ = (bf16_t*)(ws + WS_YQ);
        bf16_t* Y = (bf16_t*)(ws + WS_Y);
        bf16_t* TT = (bf16_t*)(ws + WS_T);
        float* RS = (float*)(ws + WS_RS); float* SS = (float*)(ws + WS_SS);
        const int layer = (ph == 0) ? 0 : (ph - 1) / 7;
        const int sub = (ph == 0) ? -1 : (ph - 1) % 7;
        const bf16_t* WIN = (const bf16_t*)(ws + WS_WIN) + (size_t)layer * NG1 * DM;
        const bf16_t* WG = (const bf16_t*)(ws + WS_WG) + (size_t)layer * DM * DM;
        const bf16_t* WM = (const bf16_t*)(ws + WS_WM) + (size_t)layer * 3072 * DM;
        const bf16_t* WA = (const bf16_t*)(ws + WS_WA) + (size_t)layer * DM * 512;
        const bf16_t* WB = (const bf16_t*)(ws + WS_WB) + (size_t)layer * DM * 256;
        const bf16_t* WC = (const bf16_t*)(ws + WS_WC) + (size_t)layer * DM * 256;
        const bf16_t* WO = (const bf16_t*)(ws + WS_WO) + (size_t)layer * DM * DM;

        if (PHON(0) && ph == 0) {
            LAS float* scr = (LAS float*)(lds + wave * 16384);
            for (int l = 0; l < 2; ++l) {
                const float* w_in = args.in[4] + (size_t)l * DM * DIN;
                const float* gpre = args.in[2] + l * DM;
                bf16_t* win = (bf16_t*)(ws + WS_WIN) + (size_t)l * NG1 * DM;
                bf16_t* wg = (bf16_t*)(ws + WS_WG) + (size_t)l * DM * DM;
                bf16_t* wm = (bf16_t*)(ws + WS_WM) + (size_t)l * 3072 * DM;
                for (int job = 0; job < 7; ++job) {
                    int c0, nc, ro; bf16_t* dst; float sc = 1.f;
                    switch (job) {
                        case 0: c0 = 0; nc = 512; dst = win; ro = 0; sc = 0.125f; break;
                        case 1: c0 = 512; nc = 1024; dst = win; ro = 512; break;
                        case 2: c0 = 2560; nc = 512; dst = win; ro = 2048; break;
                        case 3: c0 = 1536; nc = 512; dst = wg; ro = 0; break;
                        case 4: c0 = 2304; nc = 256; dst = wg; ro = 512; break;
                        case 5: c0 = 3072; nc = 256; dst = wg; ro = 768; break;
                        default: c0 = 3328; nc = 3072; dst = wm; ro = 0; break;
                    }
                    const int nitems = (DM / 64) * (nc / 32);
                    for (int it = gw; it < nitems; it += NGW) transpose_item(w_in, DM, DIN, c0, nc, dst, ro, gpre, sc, scr, it, lane);
                }
                {   const int ni = (512 / 64) * (DM / 32);
                    for (int it = gw; it < ni; it += NGW) transpose_item(args.in[10] + (size_t)l * 512 * DM, 512, DM, 0, DM, (bf16_t*)(ws + WS_WA) + (size_t)l * DM * 512, 0, nullptr, 1.f, scr, it, lane); }
                {   const int ni = (256 / 64) * (DM / 32);
                    for (int it = gw; it < ni; it += NGW) transpose_item(args.in[11] + (size_t)l * 256 * DM, 256, DM, 0, DM, (bf16_t*)(ws + WS_WB) + (size_t)l * DM * 256, 0, nullptr, 1.f, scr, it, lane);
                    for (int it = gw; it < ni; it += NGW) transpose_item(args.in[12] + (size_t)l * 256 * DM, 256, DM, 0, DM, (bf16_t*)(ws + WS_WC) + (size_t)l * DM * 256, 0, nullptr, 1.f, scr, it, lane); }
                {   const int ni = (DM / 64) * (DM / 32);
                    for (int it = gw; it < ni; it += NGW) transpose_item(args.in[13] + (size_t)l * DM * DM, DM, DM, 0, DM, (bf16_t*)(ws + WS_WO) + (size_t)l * DM * DM, 0, nullptr, 1.f, scr, it, lane); }
                for (int idx = bx * 512 + tid; idx < DM * 256; idx += G * 512) {
                    const int k = idx >> 8, p = idx & 255, grp = p >> 6, mm = p & 63;
                    const float* wrow = w_in + (size_t)k * DIN + 2048 + grp * 64;
                    float are = 0.f, aim = 0.f;
                    for (int c = 0; c < 64; ++c) { float sn, cs; sincospif((float)((mm * c) & 63) * (1.0f / 32.0f), &sn, &cs); const float w = wrow[c]; are += w * cs; aim -= w * sn; }
                    const float gk = gpre[k];
                    win[(size_t)(1536 + p) * DM + k] = (bf16_t)f2bf(are * gk);
                    win[(size_t)(1536 + 256 + p) * DM + k] = (bf16_t)f2bf(aim * gk);
                }
            }
            for (int idx = bx * 512 + tid; idx < 512 * 512; idx += G * 512) {
                const int kp = idx >> 9, lp = idx & 511; float sn, cs; sincospif((float)((kp * lp) & 511) * (1.0f / 256.0f), &sn, &cs);
                TT[(size_t)kp * 1024 + lp] = (bf16_t)f2bf(cs); TT[(size_t)kp * 1024 + 512 + lp] = (bf16_t)f2bf(sn);
            }
        }
        if (PHON(1) && (ph == 0 || sub == 6)) {
            const int mode = (ph == 0) ? 0 : (layer == 0 ? 1 : 2);
            const float* gpost = args.in[3] + layer * DM;
            for (int m = gw; m < MTOK; m += NGW) {
                const float* xin = (mode == 2) ? (out + (size_t)m * DM) : ((m < MP) ? x_prompt + (size_t)m * DM : x_sample + (size_t)(m - MP) * DM);
                const f32x4* xr = (const f32x4*)xin + lane;
                f32x4 v[4];
#pragma unroll
                for (int j = 0; j < 4; ++j) v[j] = xr[64 * j];
                if (mode != 0) {
                    const float rq = rsqrtf(SS[m] * (1.0f / DM) + EPS);
                    const u32x2* orow = (const u32x2*)(OB + (size_t)m * DM) + lane;
#pragma unroll
                    for (int j = 0; j < 4; ++j) { const u32x2 ov = orow[64 * j]; const f32x4 gp = *((const f32x4*)gpost + lane + 64 * j);
                        v[j][0] += bflo(ov.x) * rq * gp[0]; v[j][1] += bfhi(ov.x) * rq * gp[1]; v[j][2] += bflo(ov.y) * rq * gp[2]; v[j][3] += bfhi(ov.y) * rq * gp[3]; }
                    f32x4* orow2 = (f32x4*)(out + (size_t)m * DM) + lane;
#pragma unroll
                    for (int j = 0; j < 4; ++j) orow2[64 * j] = v[j];
                }
                if (mode != 2) {
                    float s = 0.f;
#pragma unroll
                    for (int j = 0; j < 4; ++j) s += (v[j][0] * v[j][0] + v[j][1] * v[j][1]) + (v[j][2] * v[j][2] + v[j][3] * v[j][3]);
                    s = wave_sum(s);
                    const float rsv = rsqrtf(s * (1.0f / DM) + EPS);
                    u32x2* o8 = (u32x2*)(XB + (size_t)m * DM) + lane;
#pragma unroll
                    for (int j = 0; j < 4; ++j) { u32x2 w; w.x = pk2(v[j][0] * rsv, v[j][1] * rsv); w.y = pk2(v[j][2] * rsv, v[j][3] * rsv); o8[64 * j] = w; }
                    if (lane == 0) { SS[m] = 0.f; }
                }
            }
        } else if (PHON(2) && sub == 0) {
            pg8::Gemm g{XB, WIN, MTOK, NG1, DM, DM, DM}; pg8::StaticOrder S; S.init(MTOK, NG1, G, bx);
            pg8::EpiG1 E{RS, ZM, ZT};
            pg8::gemm_phase<pg8::EpiG1, pg8::StaticOrder, true>(lds, g, S, E);
        } else if (sub == 1) {
            if (PHON(3)) {
                const float* rpb = args.in[5] + (size_t)layer * 8 * 15 * 31;
                for (int un = bx; un < 512; un += G) {
                    if (un < 256) attn_unit(lds, (un >> 3) * 2048, 32, 0, 32, un & 7, tid, lane, wave, ZM, ZT, Y, rpb);
                    else { const int v = un - 256, st = v & 7; attn_unit(lds, MP + (v >> 6) * 8192, 128, st * 16, st * 16 + 16, (v >> 3) & 7, tid, lane, wave, ZM, ZT, Y, rpb); }
                }
            }
            if (PHON(4)) {
                LAS float* hbuf = (LAS float*)lds; LAS float* cbuf = (LAS float*)(lds + 65536);
                const float* dww = args.in[6] + (size_t)layer * 31 * 256; const float* dwb = args.in[7] + layer * 256;
                const float* lng = args.in[8] + layer * 256; const float* lnb = args.in[9] + layer * 256;
                const int c = tid & 255, half = tid >> 8;
                float w[31];
#pragma unroll
                for (int j = 0; j < 31; ++j) w[j] = dww[j * 256 + c];
                const float bc = dwb[c];
                const f32x4 lg = *((const f32x4*)lng + lane), lb = *((const f32x4*)lnb + lane);
                u32x4 pa[4], pb[4];
#define CONV_ISSUE(cu_) do { const int t0g_ = (cu_) * 32; \
                    int sbeg_, send_; if (t0g_ < MP) { sbeg_ = t0g_ & ~2047; send_ = sbeg_ + 2048; } else { sbeg_ = MP + ((t0g_ - MP) & ~8191); send_ = sbeg_ + 8192; } \
                    _Pragma("unroll") for (int k = 0; k < 4; ++k) { \
                        const int it = tid + k * 512, i = it >> 5, c8 = (it & 31) * 8; const int tok = t0g_ - 15 + i; \
                        pa[k] = (u32x4){0u, 0u, 0u, 0u}; pb[k] = (u32x4){0u, 0u, 0u, 0u}; \
                        if (it < 62 * 32 && tok >= sbeg_ && tok < send_) { pa[k] = *(const GAS u32x4*)((const GAS bf16_t*)ZM + (size_t)tok * ZMW + 1024 + c8); pb[k] = *(const GAS u32x4*)((const GAS bf16_t*)ZM + (size_t)tok * ZMW + 1280 + c8); } \
                    } } while (0)
                for (int cu = bx; cu < MTOK / 32; cu += G) {
                    const int t0g = cu * 32;
                    CONV_ISSUE(cu);
#pragma unroll
                    for (int k = 0; k < 4; ++k) {
                        const int it = tid + k * 512, i = it >> 5, c8 = (it & 31) * 8;
                        if (it < 62 * 32) {
                            const u32x4 a = pa[k], b = pb[k]; f32x4 h0, h1;
                            h0[0] = bflo(a.x) * sigmoidf_(bflo(b.x)); h0[1] = bfhi(a.x) * sigmoidf_(bfhi(b.x)); h0[2] = bflo(a.y) * sigmoidf_(bflo(b.y)); h0[3] = bfhi(a.y) * sigmoidf_(bfhi(b.y));
                            h1[0] = bflo(a.z) * sigmoidf_(bflo(b.z)); h1[1] = bfhi(a.z) * sigmoidf_(bfhi(b.z)); h1[2] = bflo(a.w) * sigmoidf_(bflo(b.w)); h1[3] = bfhi(a.w) * sigmoidf_(bfhi(b.w));
                            *(LAS f32x4*)(hbuf + i * 256 + c8) = h0; *(LAS f32x4*)(hbuf + i * 256 + c8 + 4) = h1;
                        }
                    }
                    __syncthreads();
                    {   float hv[46];
#pragma unroll
                        for (int i = 0; i < 46; ++i) hv[i] = hbuf[(half * 16 + i) * 256 + c];
#pragma unroll
                        for (int tt = 0; tt < 16; ++tt) {
                            float a = bc;
#pragma unroll
                            for (int j = 0; j < 31; ++j) a += w[j] * hv[tt + j];
                            cbuf[(half * 16 + tt) * 256 + c] = a;
                        }
                    }
                    __syncthreads();
#pragma unroll 1
                    for (int tt = 0; tt < 4; ++tt) {
                        const int t = wave * 4 + tt;
                        const f32x4 xv = *(const LAS f32x4*)(cbuf + t * 256 + 4 * lane);
                        const float mean = wave_sum((xv[0] + xv[1]) + (xv[2] + xv[3])) * (1.0f / 256.0f);
                        const f32x4 d = xv - mean;
                        const float var = wave_sum((d[0] * d[0] + d[1] * d[1]) + (d[2] * d[2] + d[3] * d[3])) * (1.0f / 256.0f);
                        const float rstd = rsqrtf(var + EPS);
                        const float y0 = siluf_(d[0] * rstd * lg[0] + lb[0]), y1 = siluf_(d[1] * rstd * lg[1] + lb[1]), y2 = siluf_(d[2] * rstd * lg[2] + lb[2]), y3 = siluf_(d[3] * rstd * lg[3] + lb[3]);
                        u32x2 wv; wv.x = pk2(y0, y1); wv.y = pk2(y2, y3);
                        *(GAS u32x2*)((GAS bf16_t*)Y + (size_t)(t0g + t) * DM + 768 + 4 * lane) = wv;
                    }
                }
            }
            if (PHON(5)) {
                for (int un = bx; un < 32 * 256; un += G) { const int seq = un >> 8, p = un & 255; butterfly_unit<4>(seq * 2048, seq * 1024 + p, p, tid, ZT, YQ); }
                for (int un = bx; un < 4 * 256; un += G) { const int seq = un >> 8, p = un & 255; butterfly_unit<16>(MP + seq * 8192, 32768 + seq * 4096 + p, p, tid, ZT, YQ); }
            }
        } else if (PHON(6) && sub == 2) {
            pg8::Gemm g{YQ, TT, NYQ, 512, 1024, 1024, 1024}; pg8::StaticOrder S; S.init(NYQ, 512, G, bx);
            pg8::EpiDFT E{Y};
            pg8::gemm_phase<pg8::EpiDFT, pg8::StaticOrder, true>(lds, g, S, E);
        } else if (PHON(7) && sub == 3) {
            pg8::Gemm g{XB, WG, MTOK, DM, DM, DM, DM}; pg8::StaticOrder S; S.init(MTOK, DM, G, bx);
            pg8::EpiG2 E{RS, Y};
            pg8::gemm_phase<pg8::EpiG2, pg8::StaticOrder, true>(lds, g, S, E);
        } else if (sub == 4) {
            pg8::ProgG34 PG; PG.S.init(MTOK, DM, G, bx); PG.Y = Y; PG.XB = XB; PG.wsb = (const char*)ws; PG.WM = WM; PG.layer = layer;
            pg8::EpiG34 EG{RS, PB + (size_t)bx * 65536, PB + (size_t)(256 + bx) * 65536, MG};
            pg8::gemm_multi<pg8::EpiG34, pg8::ProgG34>(lds, PG, EG);
        } else if (PHON(10) && sub == 5) {
            pg8::Gemm g{MG, WO, MTOK, DM, DM, DM, DM}; pg8::StaticOrder S; S.init(MTOK, DM, G, bx);
            pg8::EpiG5 E{OB, SS};
            pg8::gemm_phase<pg8::EpiG5, pg8::StaticOrder, true>(lds, g, S, E);
        }
    }
}

extern "C" void kernel_launch(void* const* d_in, const int* in_sizes, int n_in, void* d_out, int out_size, void* d_ws, size_t ws_size, hipStream_t stream) {
    static int grid = 0;
    if (grid == 0) {
        if (n_in != 14 || ws_size < WS_END) { fprintf(stderr, "kernel_launch: bad inputs (n_in %d, ws %zu < %zu)\n", n_in, ws_size, (size_t)WS_END); grid = -1; return; }
        int dev = 0, cus = 0, per_cu = 0;
        hipGetDevice(&dev); hipDeviceGetAttribute(&cus, hipDeviceAttributeMultiprocessorCount, dev);
        if (hipFuncSetAttribute((const void*)fwd_kernel, hipFuncAttributeMaxDynamicSharedMemorySize, LDS_BYTES) != hipSuccess) { fprintf(stderr, "hipFuncSetAttribute failed\n"); grid = -1; return; }
        hipOccupancyMaxActiveBlocksPerMultiprocessor(&per_cu, (const void*)fwd_kernel, NWAVES * 64, LDS_BYTES);
        (void)hipGetLastError();
        if (per_cu < 1) { fprintf(stderr, "occupancy query says 0 blocks per CU\n"); }
        grid = cus;
    }
    if (grid < 0) return;
    Args a{};
    for (int i = 0; i < 14; ++i) a.in[i] = (const float*)d_in[i];
    a.out = (float*)d_out; a.ws = (unsigned char*)d_ws;
#if MK_ONE_LAUNCH
    a.ph_lo = 0; a.ph_hi = 15;
    void* kargs[] = {&a};
    hipError_t e = hipLaunchCooperativeKernel((const void*)fwd_kernel, dim3(grid), dim3(NWAVES * 64), kargs, LDS_BYTES, stream);
    if (e != hipSuccess) fprintf(stderr, "cooperative launch failed: %s (grid %d)\n", hipGetErrorString(e), grid);
#else
    for (int ph = 0; ph < 15; ++ph) {
        a.ph_lo = ph; a.ph_hi = ph + 1;
        hipLaunchKernelGGL(fwd_kernel, dim3(grid), dim3(NWAVES * 64), LDS_BYTES, stream, a);
    }
#endif
}
```

```cpp
#include <hip/hip_runtime.h>
#include <hip/hip_cooperative_groups.h>
#include <cstdio>
#include <cstdint>
namespace cg = cooperative_groups;

#ifndef MK_ONE_LAUNCH
#define MK_ONE_LAUNCH 1
#endif

#ifndef PH_MASK
#define PH_MASK 0xFFFF
#endif
#define PHON(k) (((PH_MASK) >> (k)) & 1)
#define LAS __attribute__((address_space(3)))
typedef unsigned short bf16_t;
typedef short bf16x8 __attribute__((ext_vector_type(8)));
typedef short s16x4 __attribute__((ext_vector_type(4)));
typedef float f32x4 __attribute__((ext_vector_type(4)));
typedef unsigned u32x4 __attribute__((ext_vector_type(4)));
typedef unsigned u32x2 __attribute__((ext_vector_type(2)));

constexpr int DM = 1024;
constexpr int MP = 65536;
constexpr int MTOK = 98304;
constexpr int DIN = 6400;
constexpr int NG1 = 2560;
constexpr int ZMW = 1536;
constexpr int NYQ = 49152;
constexpr float EPS = 1e-6f;

constexpr size_t MiB = 1u << 20;
constexpr size_t WS_WIN = 0;
constexpr size_t WS_WG = 10 * MiB;
constexpr size_t WS_WM = 14 * MiB;
constexpr size_t WS_WA = 26 * MiB;
constexpr size_t WS_WB = 28 * MiB;
constexpr size_t WS_WC = 29 * MiB;
constexpr size_t WS_WO = 30 * MiB;
constexpr size_t WS_T = 34 * MiB;
constexpr size_t WS_RS = 35 * MiB;
constexpr size_t WS_SS = 35 * MiB + 512 * 1024;
constexpr size_t WS_XB = 36 * MiB;
constexpr size_t WS_ZM = 228 * MiB;
constexpr size_t WS_ZT = 516 * MiB;
constexpr size_t WS_YQ = 708 * MiB;
constexpr size_t WS_Y = 804 * MiB;
constexpr size_t WS_END = 996 * MiB;

constexpr int NWAVES = 8;
constexpr int LDS_BYTES = 147456;

__device__ __forceinline__ unsigned f2bf(float f) { unsigned u = __builtin_bit_cast(unsigned, f); return (u + 0x7fffu + ((u >> 16) & 1u)) >> 16; }
__device__ __forceinline__ unsigned pk2(float lo, float hi) { unsigned r; asm("v_cvt_pk_bf16_f32 %0, %1, %2" : "=v"(r) : "v"(lo), "v"(hi)); return r; }
__device__ __forceinline__ float bf2f(unsigned b) { return __builtin_bit_cast(float, b << 16); }
__device__ __forceinline__ float bflo(unsigned w) { return __builtin_bit_cast(float, w << 16); }
__device__ __forceinline__ float bfhi(unsigned w) { return __builtin_bit_cast(float, w & 0xffff0000u); }
__device__ __forceinline__ float sigmoidf_(float x) { return __builtin_amdgcn_rcpf(1.0f + __expf(-x)); }
__device__ __forceinline__ float siluf_(float x) { return x * __builtin_amdgcn_rcpf(1.0f + __expf(-x)); }
__device__ __forceinline__ float wave_sum(float v) {
#pragma unroll
    for (int o = 1; o < 64; o <<= 1) v += __shfl_xor(v, o);
    return v;
}
#define LDS_WAIT() asm volatile("s_waitcnt lgkmcnt(0)" ::: "memory")
#define GAS __attribute__((address_space(1)))

namespace pg8 {
constexpr int BM = 256, BK = 64, HALF = 128, HTB = HALF * BK * 2, STAGE_BYTES = 8 * HTB, NXCD = 8, WGM = 8;
__device__ __forceinline__ int lds_byte(int r, int c) { const int st = (r >> 4) * 2 + (c >> 5), rr = r & 15, cc = c & 31, ob = rr * 64 + cc * 2; return st * 1024 + (ob ^ (((ob >> 9) & 1) << 5)); }
__device__ __forceinline__ void stage_rc(int b, int& R, int& C) { const int st = b / 1024, sb = b % 1024, swz = sb ^ (((sb >> 9) & 1) << 5); R = (st >> 1) * 16 + swz / 64; C = (st & 1) * 32 + (swz % 64) / 2; }

__device__ __forceinline__ int perm32(int rho) { const int n = rho >> 4, i = rho & 15; return 8 * (i >> 2) + 4 * n + (i & 3); }
struct Unit { int pm, pn; };
struct Gemm { const bf16_t* A; const bf16_t* Bt; int M, N, K, lda, ldb; };

struct StaticOrder {
    int nM, nN, nwg, G, c;
    __device__ __forceinline__ void init(int M, int N, int G_, int c_) { nM = M / BM; nN = N / BM; nwg = nM * nN; G = G_; c = c_; }
    __device__ __forceinline__ bool next(int i, Unit& u) const {
        const long L = (long)i * G + c; if (L >= nwg) return false;
        int wgid = (int)L; { const int q = nwg / NXCD, r = nwg % NXCD, xcd = wgid % NXCD, off = wgid / NXCD; wgid = (xcd < r ? xcd * (q + 1) : r * (q + 1) + (xcd - r) * q) + off; }
        const int nig = WGM * nN, gid = wgid / nig, fm = gid * WGM, gsz = (nM - fm) < WGM ? (nM - fm) : WGM;
        u.pm = fm + ((wgid % nig) % gsz); u.pn = (wgid % nig) / gsz; return true;
    }
};

struct SingleUnit { Unit u; __device__ bool next(int i, Unit& o) const { if (i) return false; o = u; return true; } };
template <class Epi, class Sched, bool ALIGN_EPI>
__device__ __forceinline__ void gemm_phase(LAS unsigned char* lds, const Gemm g, const Sched& S, const Epi& E) {
    int tid = threadIdx.x; asm volatile("" : "+v"(tid));
    const int wid = __builtin_amdgcn_readfirstlane(tid >> 6), lane = tid & 63, wr = wid >> 2, wc = wid & 3, fr = lane & 15, fq = lane >> 4;
    const int K = g.K, nt = K / BK;
    unsigned voffA[2], voffB[2];
#pragma unroll
    for (int i = 0; i < 2; ++i) { int R, C; stage_rc(tid * 16 + i * 8192, R, C);
        const int Rb = (R & ~31) + perm32(R & 31);
        voffA[i] = (unsigned)(R * g.lda + C) * 2u; voffB[i] = (unsigned)(Rb * g.ldb + C) * 2u; }
    const size_t kstep = (size_t)(BK * 2);
    const size_t hstepA = (size_t)HALF * g.lda * 2, hstepB = (size_t)HALF * g.ldb * 2;
    const size_t tstepA = 2 * hstepA, tstepB = 2 * hstepB;
    const unsigned ldsw = (unsigned)wid * 1024u;
    const int aoff = lds_byte(wr * 64 + fr, fq * 8), boff = lds_byte(wc * 32 + fr, fq * 8);
#define PG8_SA(b, h) (((b) * 2 + (h)) * HTB)
#define PG8_SB(b, h) ((4 + (b) * 2 + (h)) * HTB)
#define PG8_STAGE(bufoff, gbase, voff) do { _Pragma("unroll") for (int _i = 0; _i < 2; ++_i) \
        __builtin_amdgcn_global_load_lds((const unsigned*)((const char*)(gbase) + (voff)[_i]), (LAS unsigned*)(lds + (bufoff) + ldsw + _i * 8192), 16, 0, 0); } while (0)
#define PG8_LDA(dst, b, h) do { _Pragma("unroll") for (int m = 0; m < 4; ++m) _Pragma("unroll") for (int k = 0; k < 2; ++k) dst[m][k] = *(const LAS bf16x8*)(lds + PG8_SA(b, h) + aoff + m * 2048 + k * 1024); } while (0)
#define PG8_LDB(dst, b, h) do { _Pragma("unroll") for (int n = 0; n < 2; ++n) _Pragma("unroll") for (int k = 0; k < 2; ++k) dst[n][k] = *(const LAS bf16x8*)(lds + PG8_SB(b, h) + boff + n * 2048 + k * 1024); } while (0)
#define PG8_MMA(ai, bj, At, Bt) do { __builtin_amdgcn_s_setprio(1); _Pragma("unroll") for (int m = 0; m < 4; ++m) _Pragma("unroll") for (int n = 0; n < 2; ++n) _Pragma("unroll") for (int k = 0; k < 2; ++k) \
        acc[ai][bj][m][n] = __builtin_amdgcn_mfma_f32_16x16x32_bf16(Bt[n][k], At[m][k], acc[ai][bj][m][n], 0, 0, 0); __builtin_amdgcn_s_setprio(0); } while (0)
#define PG8_WAIT_V(n) asm volatile("s_waitcnt vmcnt(" #n ")" ::: "memory")
#define PG8_WAIT_L(n) asm volatile("s_waitcnt lgkmcnt(" #n ")" ::: "memory")
#define PG8_BAR __builtin_amdgcn_s_barrier()
#define PG8_SCHED __builtin_amdgcn_sched_barrier(0)
    Unit cur, nxt; int ui = 0;
    if (!S.next(0, cur)) return;
    f32x4 acc[2][2][4][2];
#pragma unroll
    for (int a = 0; a < 2; ++a)
#pragma unroll
        for (int b = 0; b < 2; ++b)
#pragma unroll
            for (int m = 0; m < 4; ++m)
#pragma unroll
                for (int n = 0; n < 2; ++n) acc[a][b][m][n] = (f32x4){0.f, 0.f, 0.f, 0.f};
    bf16x8 At[4][2], B0[2][2], B1[2][2];
    const char* cA = (const char*)g.A + (size_t)cur.pm * tstepA; const char* cB = (const char*)g.Bt + (size_t)cur.pn * tstepB;
    PG8_STAGE(PG8_SB(0, 0), cB, voffB); PG8_STAGE(PG8_SB(0, 1), cB + hstepB, voffB); PG8_STAGE(PG8_SA(0, 0), cA, voffA); PG8_STAGE(PG8_SA(0, 1), cA + hstepA, voffA);
    if (wr == 1) PG8_BAR;
    PG8_WAIT_V(2); PG8_BAR;
    PG8_STAGE(PG8_SB(1, 0), cB + kstep, voffB); PG8_STAGE(PG8_SA(1, 0), cA + kstep, voffA); PG8_STAGE(PG8_SB(1, 1), cB + hstepB + kstep, voffB);
    PG8_WAIT_V(6); PG8_BAR;
    for (;;) {
        const bool has_next = S.next(ui + 1, nxt);
        const char* nA = has_next ? (const char*)g.A + (size_t)nxt.pm * tstepA : cA; const char* nB = has_next ? (const char*)g.Bt + (size_t)nxt.pn * tstepB : cB;
        for (int t = 0; t < nt; t += 2) {
            const bool last = (t == nt - 2);
            const char* a1 = cA + (size_t)(t + 1) * kstep;
            const char* a2 = last ? nA : cA + (size_t)(t + 2) * kstep; const char* b2 = last ? nB : cB + (size_t)(t + 2) * kstep;
            const char* a3 = a2 + kstep; const char* b3 = b2 + kstep;
            PG8_LDB(B0, 0, 0); PG8_LDB(B1, 0, 1); PG8_SCHED; PG8_LDA(At, 0, 0); PG8_STAGE(PG8_SA(1, 1), a1 + hstepA, voffA);
            PG8_WAIT_V(8); PG8_WAIT_L(0); PG8_BAR; PG8_MMA(0, 0, At, B0); PG8_MMA(0, 1, At, B1); PG8_BAR; PG8_SCHED;
            PG8_LDA(At, 0, 1); PG8_STAGE(PG8_SB(0, 0), b2, voffB); PG8_STAGE(PG8_SB(0, 1), b2 + hstepB, voffB); PG8_STAGE(PG8_SA(0, 0), a2, voffA);
            PG8_WAIT_V(8); PG8_WAIT_L(0); PG8_BAR; PG8_MMA(1, 0, At, B0); PG8_MMA(1, 1, At, B1); PG8_BAR; PG8_SCHED;
            PG8_LDB(B0, 1, 0); PG8_LDB(B1, 1, 1); PG8_SCHED; PG8_LDA(At, 1, 0); PG8_STAGE(PG8_SA(0, 1), a2 + hstepA, voffA);
            PG8_WAIT_V(8); PG8_WAIT_L(0); PG8_BAR; PG8_MMA(0, 0, At, B0); PG8_MMA(0, 1, At, B1); PG8_BAR; PG8_SCHED;
            PG8_LDA(At, 1, 1); PG8_STAGE(PG8_SB(1, 0), b3, voffB); PG8_STAGE(PG8_SB(1, 1), b3 + hstepB, voffB); PG8_STAGE(PG8_SA(1, 0), a3, voffA);
            PG8_WAIT_V(8); PG8_WAIT_L(0); PG8_BAR; PG8_MMA(1, 0, At, B0); PG8_MMA(1, 1, At, B1); PG8_BAR; PG8_SCHED;
        }
        if constexpr (ALIGN_EPI) { if (wr == 0) PG8_BAR; }
        E(acc, cur, wr, wc, fr, fq);
        if (!has_next) break;
#pragma unroll
        for (int a = 0; a < 2; ++a)
#pragma unroll
            for (int b = 0; b < 2; ++b)
#pragma unroll
                for (int m = 0; m < 4; ++m)
#pragma unroll
                    for (int n = 0; n < 2; ++n) acc[a][b][m][n] = (f32x4){0.f, 0.f, 0.f, 0.f};
        cur = nxt; cA = nA; cB = nB; ++ui;
        if constexpr (ALIGN_EPI) { if (wr == 1) PG8_BAR; }
    }
    PG8_WAIT_V(0);
    if constexpr (!ALIGN_EPI) { if (wr == 0) PG8_BAR; }
    PG8_BAR;
#undef PG8_SA
#undef PG8_SB
#undef PG8_STAGE
#undef PG8_LDA
#undef PG8_LDB
#undef PG8_MMA
#undef PG8_WAIT_V
#undef PG8_WAIT_L
#undef PG8_BAR
#undef PG8_SCHED
}

struct UnitX { int pm, pn, seg; };
__device__ __forceinline__ int uni(int v) { return __builtin_amdgcn_readfirstlane(v); }
__device__ __forceinline__ const char* unip(const char* p) { const unsigned long long v = (unsigned long long)p; const unsigned lo = (unsigned)__builtin_amdgcn_readfirstlane((int)(unsigned)v), hi = (unsigned)__builtin_amdgcn_readfirstlane((int)(unsigned)(v >> 32)); return (const char*)(((unsigned long long)hi << 32) | lo); }
template <class Epi, class Prog>
__device__ __forceinline__ void gemm_multi(LAS unsigned char* lds, const Prog& P, const Epi& E) {
    int tid = threadIdx.x; asm volatile("" : "+v"(tid));
    const int wid = __builtin_amdgcn_readfirstlane(tid >> 6), lane = tid & 63, wr = wid >> 2, wc = wid & 3, fr = lane & 15, fq = lane >> 4;
    unsigned Rr[2], RrB[2], Cc2[2];
#pragma unroll
    for (int i = 0; i < 2; ++i) { int R, C; stage_rc(tid * 16 + i * 8192, R, C); Rr[i] = (unsigned)R * 2u; RrB[i] = (unsigned)((R & ~31) + perm32(R & 31)) * 2u; Cc2[i] = (unsigned)C * 2u; }
    const size_t kstep = (size_t)(BK * 2);
    const unsigned ldsw = (unsigned)wid * 1024u;
    const int aoff = lds_byte(wr * 64 + fr, fq * 8), boff = lds_byte(wc * 32 + fr, fq * 8);
#define PG8_SA(b, h) (((b) * 2 + (h)) * HTB)
#define PG8_SB(b, h) ((4 + (b) * 2 + (h)) * HTB)
#define PG8_STAGE_X(RR, bufoff, gbase, ld) do { _Pragma("unroll") for (int _i = 0; _i < 2; ++_i) \
        __builtin_amdgcn_global_load_lds((const unsigned*)((const char*)(gbase) + (RR[_i] * (unsigned)(ld) + Cc2[_i])), (LAS unsigned*)(lds + (bufoff) + ldsw + _i * 8192), 16, 0, 0); } while (0)
#define PG8_STAGE(bufoff, gbase, ld) PG8_STAGE_X(Rr, bufoff, gbase, ld)
#define PG8_STAGEB(bufoff, gbase, ld) PG8_STAGE_X(RrB, bufoff, gbase, ld)
#define PG8_LDA(dst, b, h) do { _Pragma("unroll") for (int m = 0; m < 4; ++m) _Pragma("unroll") for (int k = 0; k < 2; ++k) dst[m][k] = *(const LAS bf16x8*)(lds + PG8_SA(b, h) + aoff + m * 2048 + k * 1024); } while (0)
#define PG8_LDB(dst, b, h) do { _Pragma("unroll") for (int n = 0; n < 2; ++n) _Pragma("unroll") for (int k = 0; k < 2; ++k) dst[n][k] = *(const LAS bf16x8*)(lds + PG8_SB(b, h) + boff + n * 2048 + k * 1024); } while (0)
#define PG8_MMA(ai, bj, At, Bt) do { __builtin_amdgcn_s_setprio(1); _Pragma("unroll") for (int m = 0; m < 4; ++m) _Pragma("unroll") for (int n = 0; n < 2; ++n) _Pragma("unroll") for (int k = 0; k < 2; ++k) \
        acc[ai][bj][m][n] = __builtin_amdgcn_mfma_f32_16x16x32_bf16(Bt[n][k], At[m][k], acc[ai][bj][m][n], 0, 0, 0); __builtin_amdgcn_s_setprio(0); } while (0)
#define PG8_WAIT_V(n) asm volatile("s_waitcnt vmcnt(" #n ")" ::: "memory")
#define PG8_WAIT_L(n) asm volatile("s_waitcnt lgkmcnt(" #n ")" ::: "memory")
#define PG8_BAR __builtin_amdgcn_s_barrier()
#define PG8_SCHED __builtin_amdgcn_sched_barrier(0)
    UnitX cur, nxt; int ui = 0;
    if (!P.next(0, cur)) return;
    f32x4 acc[2][2][4][2];
#pragma unroll
    for (int a = 0; a < 2; ++a)
#pragma unroll
        for (int b = 0; b < 2; ++b)
#pragma unroll
            for (int m = 0; m < 4; ++m)
#pragma unroll
                for (int n = 0; n < 2; ++n) acc[a][b][m][n] = (f32x4){0.f, 0.f, 0.f, 0.f};
    bf16x8 At[4][2], B0[2][2], B1[2][2];
    const char* cA; const char* cB; int lda, ldb, nt;
    P.desc(cur, cA, cB, lda, ldb, nt); cA = unip(cA); cB = unip(cB); lda = uni(lda); ldb = uni(ldb); nt = uni(nt);
    {   const size_t hA = (size_t)HALF * lda * 2, hB = (size_t)HALF * ldb * 2;
        PG8_STAGEB(PG8_SB(0, 0), cB, ldb); PG8_STAGEB(PG8_SB(0, 1), cB + hB, ldb); PG8_STAGE(PG8_SA(0, 0), cA, lda); PG8_STAGE(PG8_SA(0, 1), cA + hA, lda);
        if (wr == 1) PG8_BAR;
        PG8_WAIT_V(2); PG8_BAR;
        PG8_STAGEB(PG8_SB(1, 0), cB + kstep, ldb); PG8_STAGE(PG8_SA(1, 0), cA + kstep, lda); PG8_STAGEB(PG8_SB(1, 1), cB + hB + kstep, ldb);
        PG8_WAIT_V(6); PG8_BAR; }
    for (;;) {
        const bool has_next = P.next(ui + 1, nxt);
        const char* nA = cA; const char* nB = cB; int ldan = lda, ldbn = ldb, ntn = nt;
        if (has_next) P.desc(nxt, nA, nB, ldan, ldbn, ntn);
        nA = unip(nA); nB = unip(nB); ldan = uni(ldan); ldbn = uni(ldbn); ntn = uni(ntn);
        const size_t hAc = (size_t)HALF * lda * 2;
        for (int t = 0; t < nt; t += 2) {
            const bool last = (t == nt - 2);
            const char* a1 = cA + (size_t)(t + 1) * kstep;
            const char* a2 = last ? nA : cA + (size_t)(t + 2) * kstep; const char* b2 = last ? nB : cB + (size_t)(t + 2) * kstep;
            const int lda2 = last ? ldan : lda, ldb2 = last ? ldbn : ldb;
            const size_t hA2 = (size_t)HALF * lda2 * 2, hB2 = (size_t)HALF * ldb2 * 2;
            const char* a3 = a2 + kstep; const char* b3 = b2 + kstep;
            PG8_LDB(B0, 0, 0); PG8_LDB(B1, 0, 1); PG8_SCHED; PG8_LDA(At, 0, 0); PG8_STAGE(PG8_SA(1, 1), a1 + hAc, lda);
            PG8_WAIT_V(8); PG8_WAIT_L(0); PG8_BAR; PG8_MMA(0, 0, At, B0); PG8_MMA(0, 1, At, B1); PG8_BAR; PG8_SCHED;
            PG8_LDA(At, 0, 1); PG8_STAGEB(PG8_SB(0, 0), b2, ldb2); PG8_STAGEB(PG8_SB(0, 1), b2 + hB2, ldb2); PG8_STAGE(PG8_SA(0, 0), a2, lda2);
            PG8_WAIT_V(8); PG8_WAIT_L(0); PG8_BAR; PG8_MMA(1, 0, At, B0); PG8_MMA(1, 1, At, B1); PG8_BAR; PG8_SCHED;
            PG8_LDB(B0, 1, 0); PG8_LDB(B1, 1, 1); PG8_SCHED; PG8_LDA(At, 1, 0); PG8_STAGE(PG8_SA(0, 1), a2 + hA2, lda2);
            PG8_WAIT_V(8); PG8_WAIT_L(0); PG8_BAR; PG8_MMA(0, 0, At, B0); PG8_MMA(0, 1, At, B1); PG8_BAR; PG8_SCHED;
            PG8_LDA(At, 1, 1); PG8_STAGEB(PG8_SB(1, 0), b3, ldb2); PG8_STAGEB(PG8_SB(1, 1), b3 + hB2, ldb2); PG8_STAGE(PG8_SA(1, 0), a3, lda2);
            PG8_WAIT_V(8); PG8_WAIT_L(0); PG8_BAR; PG8_MMA(1, 0, At, B0); PG8_MMA(1, 1, At, B1); PG8_BAR; PG8_SCHED;
        }
        if (wr == 0) PG8_BAR;
        E(acc, cur, wr, wc, fr, fq);
        if (!has_next) break;
#pragma unroll
        for (int a = 0; a < 2; ++a)
#pragma unroll
            for (int b = 0; b < 2; ++b)
#pragma unroll
                for (int m = 0; m < 4; ++m)
#pragma unroll
                    for (int n = 0; n < 2; ++n) acc[a][b][m][n] = (f32x4){0.f, 0.f, 0.f, 0.f};
        cur = nxt; cA = nA; cB = nB; lda = ldan; ldb = ldbn; nt = ntn; ++ui;
        if (wr == 1) PG8_BAR;
    }
    PG8_WAIT_V(0);
    PG8_BAR;
#undef PG8_SA
#undef PG8_SB
#undef PG8_STAGE
#undef PG8_STAGEB
#undef PG8_STAGE_X
#undef PG8_LDA
#undef PG8_LDB
#undef PG8_MMA
#undef PG8_WAIT_V
#undef PG8_WAIT_L
#undef PG8_BAR
#undef PG8_SCHED
}

#define EPI_ROWS_BEGIN  _Pragma("unroll") for (int ai = 0; ai < 2; ++ai) _Pragma("unroll") for (int m = 0; m < 4; ++m) { const int row = u.pm * BM + ai * HALF + wr * 64 + m * 16 + fr;
#define EPI_COLS_BEGIN  _Pragma("unroll") for (int bj = 0; bj < 2; ++bj) _Pragma("unroll") for (int n = 0; n < 2; ++n) { const int col = bj * HALF + wc * 32 + 8 * fq + 4 * n; f32x4 v = acc[ai][bj][m][n];
#define EPI_END } }
#define EPI_COLS8_BEGIN  _Pragma("unroll") for (int bj = 0; bj < 2; ++bj) { const int col = bj * HALF + wc * 32 + 8 * fq; const f32x4 v0 = acc[ai][bj][m][0], v1 = acc[ai][bj][m][1];

struct EpiG1 {
    const float* rs; bf16_t* ZM; bf16_t* ZT;
    __device__ __forceinline__ void operator()(const f32x4 (&acc)[2][2][4][2], const Unit& u, int wr, int wc, int fr, int fq) const {
        const int pn = u.pn;
        if (pn >= 4 && pn < 6) {
            const int d0 = (pn - 4) * 256;
            EPI_ROWS_BEGIN
            EPI_COLS_BEGIN
                GAS bf16_t* d = (GAS bf16_t*)ZT + ((size_t)(row >> 6) * 512 + d0 + col) * 64 + (row & 63);
                const unsigned w0 = pk2(v[0], v[1]), w1 = pk2(v[2], v[3]);
                d[0] = (bf16_t)w0; d[64] = (bf16_t)(w0 >> 16); d[128] = (bf16_t)w1; d[192] = (bf16_t)(w1 >> 16);
            EPI_END
        } else if (pn >= 6 && pn < 8) {
            const int j0 = (pn - 6) * 256;
            EPI_ROWS_BEGIN
            EPI_COLS_BEGIN
                GAS bf16_t* d = (GAS bf16_t*)ZT + (size_t)MTOK * 512 + ((size_t)(row >> 9) * 512 + j0 + col) * 512 + (row & 511);
                const unsigned w0 = pk2(v[0], v[1]), w1 = pk2(v[2], v[3]);
                d[0] = (bf16_t)w0; d[512] = (bf16_t)(w0 >> 16); d[1024] = (bf16_t)w1; d[1536] = (bf16_t)(w1 >> 16);
            EPI_END
        } else {
            const int cm = (pn < 4 ? pn : pn - 4) * 256;
            EPI_ROWS_BEGIN
            EPI_COLS8_BEGIN
                u32x4 w; w.x = pk2(v0[0], v0[1]); w.y = pk2(v0[2], v0[3]); w.z = pk2(v1[0], v1[1]); w.w = pk2(v1[2], v1[3]);
                *(GAS u32x4*)((GAS bf16_t*)ZM + (size_t)row * ZMW + cm + col) = w;
            EPI_END
        }
    }
};
struct EpiDFT {
    bf16_t* Y;
    __device__ __forceinline__ void operator()(const f32x4 (&acc)[2][2][4][2], const Unit& u, int wr, int wc, int fr, int fq) const {
        int tok0, R, q;
        if (u.pm < 128) { tok0 = (u.pm >> 2) * 2048; R = 4; q = u.pm & 3; } else { const int t = u.pm - 128; tok0 = MP + (t >> 4) * 8192; R = 16; q = t & 15; }
        EPI_ROWS_BEGIN const int p = row - u.pm * BM;
        EPI_COLS_BEGIN
            const int k0 = u.pn * BM + col;
            GAS bf16_t* d = (GAS bf16_t*)Y + (size_t)(tok0 + R * k0 + q) * DM + 512 + p;
            const unsigned w0 = pk2(v[0], v[1]), w1 = pk2(v[2], v[3]);
            d[0] = (bf16_t)w0; d[(size_t)R * DM] = (bf16_t)(w0 >> 16); d[(size_t)2 * R * DM] = (bf16_t)w1; d[(size_t)3 * R * DM] = (bf16_t)(w1 >> 16);
        EPI_END
    }
};
struct EpiG2 {
    const float* rs; bf16_t* Y;
    __device__ __forceinline__ void operator()(const f32x4 (&acc)[2][2][4][2], const Unit& u, int wr, int wc, int fr, int fq) const {
        EPI_ROWS_BEGIN
        EPI_COLS8_BEGIN
            GAS u32x4* p = (GAS u32x4*)((GAS bf16_t*)Y + (size_t)row * DM + u.pn * BM + col);
            const u32x4 y = *p; u32x4 w;
            w.x = pk2(bflo(y.x) * siluf_(v0[0]), bfhi(y.x) * siluf_(v0[1])); w.y = pk2(bflo(y.y) * siluf_(v0[2]), bfhi(y.y) * siluf_(v0[3]));
            w.z = pk2(bflo(y.z) * siluf_(v1[0]), bfhi(y.z) * siluf_(v1[1])); w.w = pk2(bflo(y.w) * siluf_(v1[2]), bfhi(y.w) * siluf_(v1[3]));
            *p = w;
        EPI_END
    }
};
struct ProgG34 {
    StaticOrder S; const bf16_t* Y; const bf16_t* XB; const char* wsb; const bf16_t* WM; int layer;
    __device__ __forceinline__ bool next(int i, UnitX& u) const { Unit t; if (!S.next(i / 6, t)) return false; u.pm = t.pm; u.pn = t.pn; u.seg = i % 6; return true; }
    __device__ __forceinline__ void desc(const UnitX& u, const char*& A, const char*& B, int& lda, int& ldb, int& nt) const {
        const int b = u.seg >> 1; lda = DM;
        if (u.seg & 1) { A = (const char*)(XB + (size_t)u.pm * BM * DM); B = (const char*)(WM + (size_t)b * DM * DM + (size_t)u.pn * BM * DM); ldb = DM; nt = DM / BK; }
        else { const int kb = (b == 0) ? 512 : 256, ac = (b == 0) ? 0 : (b == 1 ? 512 : 768);
            const size_t woff = (size_t)((b == 0) ? 26 : 27 + b) * MiB + (size_t)layer * ((b == 0) ? MiB : MiB / 2);
            const bf16_t* w = (const bf16_t*)(wsb + woff);
            A = (const char*)(Y + (size_t)u.pm * BM * DM + ac); B = (const char*)(w + (size_t)u.pn * BM * kb); ldb = kb; nt = kb / BK; }
    }
};
struct EpiG34 {
    const float* rs; bf16_t* PT; bf16_t* MT; bf16_t* MG;
    __device__ __forceinline__ void operator()(const f32x4 (&acc)[2][2][4][2], const UnitX& u, int wr, int wc, int fr_, int fq_) const {
        int fr = fr_, fq = fq_; asm volatile("" : "+v"(fr), "+v"(fq));
        if ((u.seg & 1) == 0) {
            EPI_ROWS_BEGIN
            EPI_COLS8_BEGIN
                u32x4 w; w.x = pk2(v0[0], v0[1]); w.y = pk2(v0[2], v0[3]); w.z = pk2(v1[0], v1[1]); w.w = pk2(v1[2], v1[3]);
                *(GAS u32x4*)(PT + (size_t)(row - u.pm * BM) * 256 + col) = w;
            EPI_END
        } else {
            const int mode = u.seg >> 1;
            EPI_ROWS_BEGIN
            EPI_COLS8_BEGIN
                const size_t toff = (size_t)(row - u.pm * BM) * 256 + col;
                const u32x4 pv = *(const GAS u32x4*)(PT + toff);
                float r0 = bflo(pv.x) * sigmoidf_(v0[0]), r1 = bfhi(pv.x) * sigmoidf_(v0[1]), r2 = bflo(pv.y) * sigmoidf_(v0[2]), r3 = bfhi(pv.y) * sigmoidf_(v0[3]);
                float r4 = bflo(pv.z) * sigmoidf_(v1[0]), r5 = bfhi(pv.z) * sigmoidf_(v1[1]), r6 = bflo(pv.w) * sigmoidf_(v1[2]), r7 = bfhi(pv.w) * sigmoidf_(v1[3]);
                if (mode) { const u32x4 mv = *(const GAS u32x4*)(MT + toff); r0 += bflo(mv.x); r1 += bfhi(mv.x); r2 += bflo(mv.y); r3 += bfhi(mv.y); r4 += bflo(mv.z); r5 += bfhi(mv.z); r6 += bflo(mv.w); r7 += bfhi(mv.w); }
                u32x4 w; w.x = pk2(r0, r1); w.y = pk2(r2, r3); w.z = pk2(r4, r5); w.w = pk2(r6, r7);
                if (mode == 2) *(GAS u32x4*)(MG + (size_t)row * DM + u.pn * BM + col) = w; else *(GAS u32x4*)(MT + toff) = w;
            EPI_END
        }
    }
};
struct EpiG5 {
    bf16_t* O; float* ss;
    __device__ __forceinline__ void operator()(const f32x4 (&acc)[2][2][4][2], const Unit& u, int wr, int wc, int fr, int fq) const {
        EPI_ROWS_BEGIN float q = 0.f;
        EPI_COLS8_BEGIN
            u32x4 w; w.x = pk2(v0[0], v0[1]); w.y = pk2(v0[2], v0[3]); w.z = pk2(v1[0], v1[1]); w.w = pk2(v1[2], v1[3]);
            *(GAS u32x4*)((GAS bf16_t*)O + (size_t)row * DM + u.pn * BM + col) = w;
            q += ((v0[0] * v0[0] + v0[1] * v0[1]) + (v0[2] * v0[2] + v0[3] * v0[3])) + ((v1[0] * v1[0] + v1[1] * v1[1]) + (v1[2] * v1[2] + v1[3] * v1[3]));
        }
            q += __shfl_xor(q, 16); q += __shfl_xor(q, 32);
            if (fq == 0) atomicAdd(ss + row, q);
        }
    }
};
}

__device__ __forceinline__ void transpose_item(const float* W, int K, int pitch, int c0, int ncols, bf16_t* WT, int row_off, const float* g, float scale, LAS float* scr, int item, int lane) {
    const int nblk = ncols / 32, kb = item / nblk, nb = item % nblk, k0 = 64 * kb, n0 = 32 * nb;
#pragma unroll 8
    for (int i = 0; i < 32; ++i) { const int kk = 2 * i + (lane >> 5); float w = W[(size_t)(k0 + kk) * pitch + c0 + n0 + (lane & 31)] * scale; if (g) w *= g[k0 + kk]; scr[kk * 33 + (lane & 31)] = w; }
    LDS_WAIT(); asm volatile("" ::: "memory");
    const int c = lane & 7;
#pragma unroll
    for (int j = 0; j < 4; ++j) { const int n = (lane >> 3) + 8 * j; const LAS float* s = scr + (8 * c) * 33 + n;
        u32x4 o; o.x = pk2(s[0 * 33], s[1 * 33]); o.y = pk2(s[2 * 33], s[3 * 33]); o.z = pk2(s[4 * 33], s[5 * 33]); o.w = pk2(s[6 * 33], s[7 * 33]);
        *(u32x4*)(WT + (size_t)(row_off + n0 + n) * K + k0 + 8 * c) = o; }
    LDS_WAIT(); asm volatile("" ::: "memory");
}

struct Args { const float* in[14]; float* out; unsigned char* ws; int ph_lo, ph_hi; };

__device__ __forceinline__ void grid_row_info(int gr, int& seqbase, int& r, int& nrows) {
    if (gr < 1024) { seqbase = (gr >> 5) << 11; r = gr & 31; nrows = 32; } else { const int g2 = gr - 1024; seqbase = MP + ((g2 >> 7) << 13); r = g2 & 127; nrows = 128; }
}

constexpr int AT_KSLOT = 9216, AT_VSLOT = 8704, AT_VOFF = 73728, AT_BOFF = 143360;
__device__ __forceinline__ void attn_fill_issue(const GAS bf16_t* ZM, const GAS bf16_t* ZT, int tok0, int head, int tid, u32x4& kreg, u32x4& vreg) {
    kreg = *(const GAS u32x4*)(ZM + (size_t)(tok0 + (tid >> 3)) * ZMW + 512 + head * 64 + (tid & 7) * 8);
    vreg = *(const GAS u32x4*)(ZT + ((size_t)(tok0 >> 6) * 512 + head * 64) * 64 + tid * 8);
}
__device__ __forceinline__ void attn_fill_write(LAS unsigned char* lds, int slot, int tid, const u32x4 kreg, const u32x4 vreg) {
    *(LAS u32x4*)(lds + slot * AT_KSLOT + (tid >> 3) * 144 + (tid & 7) * 16) = kreg;
    LAS u32x2* vp = (LAS u32x2*)(lds + AT_VOFF + slot * AT_VSLOT + (tid >> 3) * 136 + (tid & 7) * 16);
    u32x2 a; a.x = vreg.x; a.y = vreg.y; u32x2 b; b.x = vreg.z; b.y = vreg.w;
    vp[0] = a; vp[1] = b;
}
__device__ __forceinline__ void attn_row_lds(LAS unsigned char* lds, int seqbase, int r, int rs, int head, int lane, int wave, const bf16x8 bq0, const bf16x8 bq1, GAS bf16_t* Y, const float (&bc)[64]) {
    const int g = wave & 3, dh = wave >> 2;
    const int qi = lane & 15, h4 = lane >> 4;
    const int cs = (g == 0) ? 0 : (g == 1) ? 8 : (g == 2) ? 24 : 32;
    const int qc = 16 * g + qi;
    const int qtok = seqbase + r * 64 + qc;
    int cst = qc - 8; cst = cst < 0 ? 0 : cst; cst = cst > 48 ? 48 : cst;
    f32x4 S[16];
    float mx = -3.0e38f;
#pragma unroll
    for (int t = 0; t < 16; ++t) {
        const int kr = t >> 1, hf = t & 1;
        const int slot = (rs + kr) & 7;
        const LAS unsigned char* kp = lds + slot * AT_KSLOT + (cs + 16 * hf + qi) * 144 + h4 * 16;
        const bf16x8 ak0 = *(const LAS bf16x8*)kp, ak1 = *(const LAS bf16x8*)(kp + 64);
        f32x4 s = {0.f, 0.f, 0.f, 0.f};
        s = __builtin_amdgcn_mfma_f32_16x16x32_bf16(ak0, bq0, s, 0, 0, 0);
        s = __builtin_amdgcn_mfma_f32_16x16x32_bf16(ak1, bq1, s, 0, 0, 0);
#pragma unroll
        for (int e = 0; e < 4; ++e) { const float val = s[e] + bc[t * 4 + e]; s[e] = val; mx = fmaxf(mx, val); }
        S[t] = s;
    }
    mx = fmaxf(mx, __shfl_xor(mx, 16)); mx = fmaxf(mx, __shfl_xor(mx, 32));
    float sum = 0.f;
    bf16x8 pf[8];
#pragma unroll
    for (int kr = 0; kr < 8; ++kr) {
        const f32x4 a = S[kr * 2], b = S[kr * 2 + 1];
        const float p0 = __expf(a[0] - mx), p1 = __expf(a[1] - mx), p2 = __expf(a[2] - mx), p3 = __expf(a[3] - mx);
        const float p4 = __expf(b[0] - mx), p5 = __expf(b[1] - mx), p6 = __expf(b[2] - mx), p7 = __expf(b[3] - mx);
        sum += ((p0 + p1) + (p2 + p3)) + ((p4 + p5) + (p6 + p7));
        u32x4 w; w.x = pk2(p0, p1); w.y = pk2(p2, p3); w.z = pk2(p4, p5); w.w = pk2(p6, p7);
        pf[kr] = __builtin_bit_cast(bf16x8, w);
    }
    sum += __shfl_xor(sum, 16); sum += __shfl_xor(sum, 32);
    const float inv = 1.0f / sum;
    GAS bf16_t* yp = Y + (size_t)qtok * DM + head * 64 + 4 * h4;
#pragma unroll
    for (int dti = 0; dti < 2; ++dti) {
        const int dt = 2 * dh + dti;
        f32x4 o = {0.f, 0.f, 0.f, 0.f};
#pragma unroll
        for (int kr = 0; kr < 8; ++kr) {
            const int slot = (rs + kr) & 7;
            const LAS unsigned char* vp = lds + AT_VOFF + slot * AT_VSLOT + (dt * 16 + qi) * 136 + (cs + 4 * h4) * 2;
            const u32x2 lo = *(const LAS u32x2*)vp, hi = *(const LAS u32x2*)(vp + 32);
            u32x4 w; w.x = lo.x; w.y = lo.y; w.z = hi.x; w.w = hi.y;
            o = __builtin_amdgcn_mfma_f32_16x16x32_bf16(__builtin_bit_cast(bf16x8, w), pf[kr], o, 0, 0, 0);
        }
        u32x2 w; w.x = pk2(o[0] * inv, o[1] * inv); w.y = pk2(o[2] * inv, o[3] * inv);
        *(GAS u32x2*)(yp + dt * 16) = w;
    }
}
__device__ __forceinline__ void attn_unit(LAS unsigned char* lds, int seqbase, int nrows, int ra, int rb, int head, int tid, int lane, int wave,
                                          const bf16_t* ZM_, const bf16_t* ZT_, bf16_t* Y_, const float* rpb) {
    const GAS bf16_t* ZM = (const GAS bf16_t*)ZM_; const GAS bf16_t* ZT = (const GAS bf16_t*)ZT_; GAS bf16_t* Y = (GAS bf16_t*)Y_;
    int rs = ra - 4; rs = rs < 0 ? 0 : rs; rs = rs > nrows - 8 ? nrows - 8 : rs;
    {   u32x4 kreg[8], vreg[8];
#pragma unroll
        for (int k = 0; k < 8; ++k) attn_fill_issue(ZM, ZT, seqbase + (rs + k) * 64, head, tid, kreg[k], vreg[k]);
        LAS float* bw = (LAS float*)(lds + AT_BOFF);
        if (tid < 465) bw[tid] = rpb[head * 465 + tid];
#pragma unroll
        for (int k = 0; k < 8; ++k) attn_fill_write(lds, (rs + k) & 7, tid, kreg[k], vreg[k]);
    }
    const GAS bf16_t* qbase = ZM + (size_t)(seqbase + 16 * (wave & 3) + (lane & 15)) * ZMW + head * 64 + 8 * (lane >> 4);
    bf16x8 q0 = *(const GAS bf16x8*)(qbase + (size_t)ra * 64 * ZMW), q1 = *(const GAS bf16x8*)(qbase + (size_t)ra * 64 * ZMW + 32);
    __syncthreads();
    float bc[64]; int cdelta = 1000;
#pragma unroll
    for (int i = 0; i < 64; ++i) bc[i] = 0.f;
#pragma unroll 1
    for (int r = ra; r < rb; ++r) {
        if (rs - r != cdelta) {
            cdelta = rs - r;
            const LAS float* bias = (const LAS float*)(lds + AT_BOFF);
            const int g_ = wave & 3, qi_ = lane & 15, h4_ = lane >> 4, cs_ = (g_ == 0) ? 0 : (g_ == 1) ? 8 : (g_ == 2) ? 24 : 32, qc_ = 16 * g_ + qi_;
            int cst_ = qc_ - 8; cst_ = cst_ < 0 ? 0 : cst_; cst_ = cst_ > 48 ? 48 : cst_;
#pragma unroll
            for (int t = 0; t < 16; ++t)
#pragma unroll
                for (int e = 0; e < 4; ++e) {
                    const int kc = cs_ + 16 * (t & 1) + 4 * h4_ + e; int dc = kc - qc_ + 15; dc = dc < 0 ? 0 : dc; dc = dc > 30 ? 30 : dc;
                    const float b = bias[(cdelta + (t >> 1) + 7) * 31 + dc];
                    bc[t * 4 + e] = ((kc >= cst_) && (kc < cst_ + 16)) ? b : -1.0e30f;
                }
        }
        const int rq = (r + 1 < rb) ? r + 1 : r;
        const bf16x8 nq0 = *(const GAS bf16x8*)(qbase + (size_t)rq * 64 * ZMW), nq1 = *(const GAS bf16x8*)(qbase + (size_t)rq * 64 * ZMW + 32);
        int rsn = r + 1 - 4; rsn = rsn < 0 ? 0 : rsn; rsn = rsn > nrows - 8 ? nrows - 8 : rsn;
        const bool adv = (r + 1 < rb) && (rsn != rs);
        u32x4 kreg = {0u, 0u, 0u, 0u}, vreg = {0u, 0u, 0u, 0u};
        if (adv) attn_fill_issue(ZM, ZT, seqbase + (rsn + 7) * 64, head, tid, kreg, vreg);
        attn_row_lds(lds, seqbase, r, rs, head, lane, wave, q0, q1, Y, bc);
        __syncthreads();
        if (adv) attn_fill_write(lds, (rsn + 7) & 7, tid, kreg, vreg);
        __syncthreads();
        rs = rsn; q0 = nq0; q1 = nq1;
    }
}

template <int R>
__device__ __forceinline__ void butterfly_unit(int tok0, int rowbase  , int p, int lp, const bf16_t* ZT, bf16_t* YQ) {
    constexpr int L = 512 * R;
    const bf16_t* zre = ZT + (size_t)MTOK * 512 + ((size_t)(tok0 >> 9) * 512 + p) * 512 + lp;
    const bf16_t* zim = zre + 256 * 512;
    float xr[R], xi[R];
#pragma unroll
    for (int s = 0; s < R; ++s) { xr[s] = bf2f(zre[(size_t)s * 512 * 512]); xi[s] = bf2f(zim[(size_t)s * 512 * 512]); }
    const float scale = rsqrtf(64.0f * (float)L);
#pragma unroll 1
    for (int q = 0; q < R; ++q) {
        float wr_, wi_; sincospif(-2.0f * (float)q / (float)R, &wi_, &wr_);
        float yr = xr[R - 1], yi = xi[R - 1];
#pragma unroll
        for (int s = R - 2; s >= 0; --s) { const float tr = yr * wr_ - yi * wi_ + xr[s], ti = yr * wi_ + yi * wr_ + xi[s]; yr = tr; yi = ti; }
        float tr_, ti_; sincospif(-2.0f * (float)(q * lp) / (float)L, &ti_, &tr_);
        const float orr = (yr * tr_ - yi * ti_) * scale, oi = (yr * ti_ + yi * tr_) * scale;
        bf16_t* d = YQ + (size_t)(rowbase + q * 256) * 1024 + lp;
        d[0] = (bf16_t)f2bf(orr); d[512] = (bf16_t)f2bf(oi);
    }
}

__global__ void __launch_bounds__(NWAVES * 64, 2) fwd_kernel(Args args) {
    extern __shared__ __attribute__((aligned(16))) unsigned char lds_raw[];
    LAS unsigned char* lds = (LAS unsigned char*)lds_raw;
    const int G = gridDim.x, bx = blockIdx.x;
    for (int ph = args.ph_lo; ph < args.ph_hi; ++ph) {
        if (ph > args.ph_lo) { cg::this_grid().sync(); }
        int tid = threadIdx.x; asm volatile("" : "+v"(tid));
        const int lane = tid & 63, wave = __builtin_amdgcn_readfirstlane(tid >> 6);
        const int gw = bx * NWAVES + wave, NGW = G * NWAVES;
        unsigned char* ws = args.ws; asm volatile("" : "+s"(ws));
        const float* x_prompt = args.in[0]; const float* x_sample = args.in[1];
        float* out = args.out;
        bf16_t* XB = (bf16_t*)(ws + WS_XB); bf16_t* OB = XB;
        bf16_t* ZM = (bf16_t*)(ws + WS_ZM); bf16_t* PB = ZM;
        bf16_t* ZT = (bf16_t*)(ws + WS_ZT); bf16_t* MG = ZT;
        bf16_t* YQ = (bf16_t*)(ws + WS_YQ);
        bf16_t* Y = (bf16_t*)(ws + WS_Y);
        bf16_t* TT = (bf16_t*)(ws + WS_T);
        float* RS = (float*)(ws + WS_RS); float* SS = (float*)(ws + WS_SS);
        const int layer = (ph == 0) ? 0 : (ph - 1) / 7;
        const int sub = (ph == 0) ? -1 : (ph - 1) % 7;
        const bf16_t* WIN = (const bf16_t*)(ws + WS_WIN) + (size_t)layer * NG1 * DM;
        const bf16_t* WG = (const bf16_t*)(ws + WS_WG) + (size_t)layer * DM * DM;
        const bf16_t* WM = (const bf16_t*)(ws + WS_WM) + (size_t)layer * 3072 * DM;
        const bf16_t* WA = (const bf16_t*)(ws + WS_WA) + (size_t)layer * DM * 512;
        const bf16_t* WB = (const bf16_t*)(ws + WS_WB) + (size_t)layer * DM * 256;
        const bf16_t* WC = (const bf16_t*)(ws + WS_WC) + (size_t)layer * DM * 256;
        const bf16_t* WO = (const bf16_t*)(ws + WS_WO) + (size_t)layer * DM * DM;

        if (PHON(0) && ph == 0) {
            LAS float* scr = (LAS float*)(lds + wave * 16384);
            for (int l = 0; l < 2; ++l) {
                const float* w_in = args.in[4] + (size_t)l * DM * DIN;
                const float* gpre = args.in[2] + l * DM;
                bf16_t* win = (bf16_t*)(ws + WS_WIN) + (size_t)l * NG1 * DM;
                bf16_t* wg = (bf16_t*)(ws + WS_WG) + (size_t)l * DM * DM;
                bf16_t* wm = (bf16_t*)(ws + WS_WM) + (size_t)l * 3072 * DM;
                for (int job = 0; job < 7; ++job) {
                    int c0, nc, ro; bf16_t* dst; float sc = 1.f;
                    switch (job) {
                        case 0: c0 = 0; nc = 512; dst = win; ro = 0; sc = 0.125f; break;
                        case 1: c0 = 512; nc = 1024; dst = win; ro = 512; break;
                        case 2: c0 = 2560; nc = 512; dst = win; ro = 2048; break;
                        case 3: c0 = 1536; nc = 512; dst = wg; ro = 0; break;
                        case 4: c0 = 2304; nc = 256; dst = wg; ro = 512; break;
                        case 5: c0 = 3072; nc = 256; dst = wg; ro = 768; break;
                        default: c0 = 3328; nc = 3072; dst = wm; ro = 0; break;
                    }
                    const int nitems = (DM / 64) * (nc / 32);
                    for (int it = gw; it < nitems; it += NGW) transpose_item(w_in, DM, DIN, c0, nc, dst, ro, gpre, sc, scr, it, lane);
                }
                {   const int ni = (512 / 64) * (DM / 32);
                    for (int it = gw; it < ni; it += NGW) transpose_item(args.in[10] + (size_t)l * 512 * DM, 512, DM, 0, DM, (bf16_t*)(ws + WS_WA) + (size_t)l * DM * 512, 0, nullptr, 1.f, scr, it, lane); }
                {   const int ni = (256 / 64) * (DM / 32);
                    for (int it = gw; it < ni; it += NGW) transpose_item(args.in[11] + (size_t)l * 256 * DM, 256, DM, 0, DM, (bf16_t*)(ws + WS_WB) + (size_t)l * DM * 256, 0, nullptr, 1.f, scr, it, lane);
                    for (int it = gw; it < ni; it += NGW) transpose_item(args.in[12] + (size_t)l * 256 * DM, 256, DM, 0, DM, (bf16_t*)(ws + WS_WC) + (size_t)l * DM * 256, 0, nullptr, 1.f, scr, it, lane); }
                {   const int ni = (DM / 64) * (DM / 32);
                    for (int it = gw; it < ni; it += NGW) transpose_item(args.in[13] + (size_t)l * DM * DM, DM, DM, 0, DM, (bf16_t*)(ws + WS_WO) + (size_t)l * DM * DM, 0, nullptr, 1.f, scr, it, lane); }
                LAS float* ctab = (LAS float*)(lds + 131072);
                if (l == 0) { if (tid < 64) { float sn, cs; sincospif((float)tid * (1.0f / 32.0f), &sn, &cs); ctab[tid] = cs; ctab[64 + tid] = sn; } __syncthreads(); }
                for (int idx = bx * 512 + tid; idx < DM * 256; idx += G * 512) {
                    const int k = idx >> 8, p = idx & 255, grp = p >> 6, mm = p & 63;
                    const f32x4* wrow = (const f32x4*)(w_in + (size_t)k * DIN + 2048 + grp * 64);
                    float are = 0.f, aim = 0.f;
#pragma unroll 4
                    for (int c4 = 0; c4 < 16; ++c4) { const f32x4 w = wrow[c4];
#pragma unroll
                        for (int e = 0; e < 4; ++e) { const int t = (mm * (4 * c4 + e)) & 63; are += w[e] * ctab[t]; aim -= w[e] * ctab[64 + t]; } }
                    const float gk = gpre[k];
                    win[(size_t)(1536 + p) * DM + k] = (bf16_t)f2bf(are * gk);
                    win[(size_t)(1536 + 256 + p) * DM + k] = (bf16_t)f2bf(aim * gk);
                }
            }
            for (int idx = bx * 512 + tid; idx < 512 * 512; idx += G * 512) {
                const int kp = idx >> 9, lp = idx & 511; float sn, cs; sincospif((float)((kp * lp) & 511) * (1.0f / 256.0f), &sn, &cs);
                TT[(size_t)kp * 1024 + lp] = (bf16_t)f2bf(cs); TT[(size_t)kp * 1024 + 512 + lp] = (bf16_t)f2bf(sn);
            }
        }
        if (PHON(1) && (ph == 0 || sub == 6)) {
            const int mode = (ph == 0) ? 0 : (layer == 0 ? 1 : 2);
            const float* gpost = args.in[3] + layer * DM;
            for (int m = gw; m < MTOK; m += NGW) {
                const float* xin = (mode == 2) ? (out + (size_t)m * DM) : ((m < MP) ? x_prompt + (size_t)m * DM : x_sample + (size_t)(m - MP) * DM);
                const f32x4* xr = (const f32x4*)xin + lane;
                f32x4 v[4];
#pragma unroll
                for (int j = 0; j < 4; ++j) v[j] = xr[64 * j];
                if (mode != 0) {
                    const float rq = rsqrtf(SS[m] * (1.0f / DM) + EPS);
                    const u32x2* orow = (const u32x2*)(OB + (size_t)m * DM) + lane;
#pragma unroll
                    for (int j = 0; j < 4; ++j) { const u32x2 ov = orow[64 * j]; const f32x4 gp = *((const f32x4*)gpost + lane + 64 * j);
                        v[j][0] += bflo(ov.x) * rq * gp[0]; v[j][1] += bfhi(ov.x) * rq * gp[1]; v[j][2] += bflo(ov.y) * rq * gp[2]; v[j][3] += bfhi(ov.y) * rq * gp[3]; }
                    f32x4* orow2 = (f32x4*)(out + (size_t)m * DM) + lane;
#pragma unroll
                    for (int j = 0; j < 4; ++j) orow2[64 * j] = v[j];
                }
                if (mode != 2) {
                    float s = 0.f;
#pragma unroll
                    for (int j = 0; j < 4; ++j) s += (v[j][0] * v[j][0] + v[j][1] * v[j][1]) + (v[j][2] * v[j][2] + v[j][3] * v[j][3]);
                    s = wave_sum(s);
                    const float rsv = rsqrtf(s * (1.0f / DM) + EPS);
                    u32x2* o8 = (u32x2*)(XB + (size_t)m * DM) + lane;
#pragma unroll
                    for (int j = 0; j < 4; ++j) { u32x2 w; w.x = pk2(v[j][0] * rsv, v[j][1] * rsv); w.y = pk2(v[j][2] * rsv, v[j][3] * rsv); o8[64 * j] = w; }
                    if (lane == 0) { SS[m] = 0.f; }
                }
            }
        } else if (PHON(2) && sub == 0) {
            pg8::Gemm g{XB, WIN, MTOK, NG1, DM, DM, DM}; pg8::StaticOrder S; S.init(MTOK, NG1, G, bx);
            pg8::EpiG1 E{RS, ZM, ZT};
            pg8::gemm_phase<pg8::EpiG1, pg8::StaticOrder, true>(lds, g, S, E);
        } else if (sub == 1) {
            if (PHON(3)) {
                const float* rpb = args.in[5] + (size_t)layer * 8 * 15 * 31;
                for (int un = bx; un < 512; un += G) {
                    if (un < 256) attn_unit(lds, (un >> 3) * 2048, 32, 0, 32, un & 7, tid, lane, wave, ZM, ZT, Y, rpb);
                    else { const int v = un - 256, st = v & 7; attn_unit(lds, MP + (v >> 6) * 8192, 128, st * 16, st * 16 + 16, (v >> 3) & 7, tid, lane, wave, ZM, ZT, Y, rpb); }
                }
            }
            if (PHON(4)) {
                LAS float* hbuf = (LAS float*)lds; LAS float* cbuf = (LAS float*)(lds + 65536);
                const float* dww = args.in[6] + (size_t)layer * 31 * 256; const float* dwb = args.in[7] + layer * 256;
                const float* lng = args.in[8] + layer * 256; const float* lnb = args.in[9] + layer * 256;
                const int c = tid & 255, half = tid >> 8;
                float w[31];
#pragma unroll
                for (int j = 0; j < 31; ++j) w[j] = dww[j * 256 + c];
                const float bc = dwb[c];
                const f32x4 lg = *((const f32x4*)lng + lane), lb = *((const f32x4*)lnb + lane);
                u32x4 pa[4], pb[4];
#define CONV_ISSUE(cu_) do { const int t0g_ = (cu_) * 32; \
                    int sbeg_, send_; if (t0g_ < MP) { sbeg_ = t0g_ & ~2047; send_ = sbeg_ + 2048; } else { sbeg_ = MP + ((t0g_ - MP) & ~8191); send_ = sbeg_ + 8192; } \
                    _Pragma("unroll") for (int k = 0; k < 4; ++k) { \
                        const int it = tid + k * 512, i = it >> 5, c8 = (it & 31) * 8; const int tok = t0g_ - 15 + i; \
                        pa[k] = (u32x4){0u, 0u, 0u, 0u}; pb[k] = (u32x4){0u, 0u, 0u, 0u}; \
                        if (it < 62 * 32 && tok >= sbeg_ && tok < send_) { pa[k] = *(const GAS u32x4*)((const GAS bf16_t*)ZM + (size_t)tok * ZMW + 1024 + c8); pb[k] = *(const GAS u32x4*)((const GAS bf16_t*)ZM + (size_t)tok * ZMW + 1280 + c8); } \
                    } } while (0)
                for (int cu = bx; cu < MTOK / 32; cu += G) {
                    const int t0g = cu * 32;
                    CONV_ISSUE(cu);
#pragma unroll
                    for (int k = 0; k < 4; ++k) {
                        const int it = tid + k * 512, i = it >> 5, c8 = (it & 31) * 8;
                        if (it < 62 * 32) {
                            const u32x4 a = pa[k], b = pb[k]; f32x4 h0, h1;
                            h0[0] = bflo(a.x) * sigmoidf_(bflo(b.x)); h0[1] = bfhi(a.x) * sigmoidf_(bfhi(b.x)); h0[2] = bflo(a.y) * sigmoidf_(bflo(b.y)); h0[3] = bfhi(a.y) * sigmoidf_(bfhi(b.y));
                            h1[0] = bflo(a.z) * sigmoidf_(bflo(b.z)); h1[1] = bfhi(a.z) * sigmoidf_(bfhi(b.z)); h1[2] = bflo(a.w) * sigmoidf_(bflo(b.w)); h1[3] = bfhi(a.w) * sigmoidf_(bfhi(b.w));
                            *(LAS f32x4*)(hbuf + i * 256 + c8) = h0; *(LAS f32x4*)(hbuf + i * 256 + c8 + 4) = h1;
                        }
                    }
                    __syncthreads();
                    {   float hv[46];
#pragma unroll
                        for (int i = 0; i < 46; ++i) hv[i] = hbuf[(half * 16 + i) * 256 + c];
#pragma unroll
                        for (int tt = 0; tt < 16; ++tt) {
                            float a = bc;
#pragma unroll
                            for (int j = 0; j < 31; ++j) a += w[j] * hv[tt + j];
                            cbuf[(half * 16 + tt) * 256 + c] = a;
                        }
                    }
                    __syncthreads();
#pragma unroll 1
                    for (int tt = 0; tt < 4; ++tt) {
                        const int t = wave * 4 + tt;
                        const f32x4 xv = *(const LAS f32x4*)(cbuf + t * 256 + 4 * lane);
                        const float mean = wave_sum((xv[0] + xv[1]) + (xv[2] + xv[3])) * (1.0f / 256.0f);
                        const f32x4 d = xv - mean;
                        const float var = wave_sum((d[0] * d[0] + d[1] * d[1]) + (d[2] * d[2] + d[3] * d[3])) * (1.0f / 256.0f);
                        const float rstd = rsqrtf(var + EPS);
                        const float y0 = siluf_(d[0] * rstd * lg[0] + lb[0]), y1 = siluf_(d[1] * rstd * lg[1] + lb[1]), y2 = siluf_(d[2] * rstd * lg[2] + lb[2]), y3 = siluf_(d[3] * rstd * lg[3] + lb[3]);
                        u32x2 wv; wv.x = pk2(y0, y1); wv.y = pk2(y2, y3);
                        *(GAS u32x2*)((GAS bf16_t*)Y + (size_t)(t0g + t) * DM + 768 + 4 * lane) = wv;
                    }
                }
            }
            if (PHON(5)) {
                for (int un = bx; un < 32 * 256; un += G) { const int seq = un >> 8, p = un & 255; butterfly_unit<4>(seq * 2048, seq * 1024 + p, p, tid, ZT, YQ); }
                for (int un = bx; un < 4 * 256; un += G) { const int seq = un >> 8, p = un & 255; butterfly_unit<16>(MP + seq * 8192, 32768 + seq * 4096 + p, p, tid, ZT, YQ); }
            }
        } else if (PHON(6) && sub == 2) {
            pg8::Gemm g{YQ, TT, NYQ, 512, 1024, 1024, 1024}; pg8::StaticOrder S; S.init(NYQ, 512, G, bx);
            pg8::EpiDFT E{Y};
            pg8::gemm_phase<pg8::EpiDFT, pg8::StaticOrder, true>(lds, g, S, E);
        } else if (PHON(7) && sub == 3) {
            pg8::Gemm g{XB, WG, MTOK, DM, DM, DM, DM}; pg8::StaticOrder S; S.init(MTOK, DM, G, bx);
            pg8::EpiG2 E{RS, Y};
            pg8::gemm_phase<pg8::EpiG2, pg8::StaticOrder, true>(lds, g, S, E);
        } else if (sub == 4) {
            pg8::ProgG34 PG; PG.S.init(MTOK, DM, G, bx); PG.Y = Y; PG.XB = XB; PG.wsb = (const char*)ws; PG.WM = WM; PG.layer = layer;
            pg8::EpiG34 EG{RS, PB + (size_t)bx * 65536, PB + (size_t)(256 + bx) * 65536, MG};
            pg8::gemm_multi<pg8::EpiG34, pg8::ProgG34>(lds, PG, EG);
        } else if (PHON(10) && sub == 5) {
            pg8::Gemm g{MG, WO, MTOK, DM, DM, DM, DM}; pg8::StaticOrder S; S.init(MTOK, DM, G, bx);
            pg8::EpiG5 E{OB, SS};
            pg8::gemm_phase<pg8::EpiG5, pg8::StaticOrder, true>(lds, g, S, E);
        }
    }
}

extern "C" void kernel_launch(void* const* d_in, const int* in_sizes, int n_in, void* d_out, int out_size, void* d_ws, size_t ws_size, hipStream_t stream) {
    static int grid = 0;
    if (grid == 0) {
        if (n_in != 14 || ws_size < WS_END) { fprintf(stderr, "kernel_launch: bad inputs (n_in %d, ws %zu < %zu)\n", n_in, ws_size, (size_t)WS_END); grid = -1; return; }
        int dev = 0, cus = 0, per_cu = 0;
        hipGetDevice(&dev); hipDeviceGetAttribute(&cus, hipDeviceAttributeMultiprocessorCount, dev);
        if (hipFuncSetAttribute((const void*)fwd_kernel, hipFuncAttributeMaxDynamicSharedMemorySize, LDS_BYTES) != hipSuccess) { fprintf(stderr, "hipFuncSetAttribute failed\n"); grid = -1; return; }
        hipOccupancyMaxActiveBlocksPerMultiprocessor(&per_cu, (const void*)fwd_kernel, NWAVES * 64, LDS_BYTES);
        (void)hipGetLastError();
        if (per_cu < 1) { fprintf(stderr, "occupancy query says 0 blocks per CU\n"); }
        grid = cus;
    }
    if (grid < 0) return;
    Args a{};
    for (int i = 0; i < 14; ++i) a.in[i] = (const float*)d_in[i];
    a.out = (float*)d_out; a.ws = (unsigned char*)d_ws;
#if MK_ONE_LAUNCH
    a.ph_lo = 0; a.ph_hi = 15;
    void* kargs[] = {&a};
    hipError_t e = hipLaunchCooperativeKernel((const void*)fwd_kernel, dim3(grid), dim3(NWAVES * 64), kargs, LDS_BYTES, stream);
    if (e != hipSuccess) fprintf(stderr, "cooperative launch failed: %s (grid %d)\n", hipGetErrorString(e), grid);
#else
    for (int ph = 0; ph < 15; ++ph) {
        a.ph_lo = ph; a.ph_hi = ph + 1;
        hipLaunchKernelGGL(fwd_kernel, dim3(grid), dim3(NWAVES * 64), LDS_BYTES, stream, a);
    }
#endif
}
```

```cpp
#include <hip/hip_runtime.h>
#include <hip/hip_cooperative_groups.h>
#include <cstdio>
#include <cstdint>
namespace cg = cooperative_groups;

#ifndef MK_ONE_LAUNCH
#define MK_ONE_LAUNCH 1
#endif

#ifndef PH_MASK
#define PH_MASK 0xFFFF
#endif
#define PHON(k) (((PH_MASK) >> (k)) & 1)
#define LAS __attribute__((address_space(3)))
typedef unsigned short bf16_t;
typedef short bf16x8 __attribute__((ext_vector_type(8)));
typedef short s16x4 __attribute__((ext_vector_type(4)));
typedef float f32x4 __attribute__((ext_vector_type(4)));
typedef unsigned u32x4 __attribute__((ext_vector_type(4)));
typedef unsigned u32x2 __attribute__((ext_vector_type(2)));

constexpr int DM = 1024;
constexpr int MP = 65536;
constexpr int MTOK = 98304;
constexpr int DIN = 6400;
constexpr int NG1 = 2560;
constexpr int ZMW = 1536;
constexpr int NYQ = 49152;
constexpr float EPS = 1e-6f;

constexpr size_t MiB = 1u << 20;
constexpr size_t WS_WIN = 0;
constexpr size_t WS_WG = 10 * MiB;
constexpr size_t WS_WM = 14 * MiB;
constexpr size_t WS_WA = 26 * MiB;
constexpr size_t WS_WB = 28 * MiB;
constexpr size_t WS_WC = 29 * MiB;
constexpr size_t WS_WO = 30 * MiB;
constexpr size_t WS_T = 34 * MiB;
constexpr size_t WS_RS = 35 * MiB;
constexpr size_t WS_SS = 35 * MiB + 512 * 1024;
constexpr size_t WS_XB = 36 * MiB;
constexpr size_t WS_ZM = 228 * MiB;
constexpr size_t WS_ZT = 516 * MiB;
constexpr size_t WS_YQ = 708 * MiB;
constexpr size_t WS_Y = 804 * MiB;
constexpr size_t WS_END = 996 * MiB;

constexpr int NWAVES = 8;
constexpr int LDS_BYTES = 147456;

__device__ __forceinline__ unsigned f2bf(float f) { unsigned u = __builtin_bit_cast(unsigned, f); return (u + 0x7fffu + ((u >> 16) & 1u)) >> 16; }
__device__ __forceinline__ unsigned pk2(float lo, float hi) { unsigned r; asm("v_cvt_pk_bf16_f32 %0, %1, %2" : "=v"(r) : "v"(lo), "v"(hi)); return r; }
__device__ __forceinline__ float bf2f(unsigned b) { return __builtin_bit_cast(float, b << 16); }
__device__ __forceinline__ float bflo(unsigned w) { return __builtin_bit_cast(float, w << 16); }
__device__ __forceinline__ float bfhi(unsigned w) { return __builtin_bit_cast(float, w & 0xffff0000u); }
__device__ __forceinline__ float sigmoidf_(float x) { return __builtin_amdgcn_rcpf(1.0f + __expf(-x)); }
__device__ __forceinline__ float siluf_(float x) { return x * __builtin_amdgcn_rcpf(1.0f + __expf(-x)); }
__device__ __forceinline__ float wave_sum(float v) {
#pragma unroll
    for (int o = 1; o < 64; o <<= 1) v += __shfl_xor(v, o);
    return v;
}
#define LDS_WAIT() asm volatile("s_waitcnt lgkmcnt(0)" ::: "memory")
#define GAS __attribute__((address_space(1)))

namespace pg8 {
constexpr int BM = 256, BK = 64, HALF = 128, HTB = HALF * BK * 2, STAGE_BYTES = 8 * HTB, NXCD = 8, WGM = 8;
__device__ __forceinline__ int lds_byte(int r, int c) { const int st = (r >> 4) * 2 + (c >> 5), rr = r & 15, cc = c & 31, ob = rr * 64 + cc * 2; return st * 1024 + (ob ^ (((ob >> 9) & 1) << 5)); }
__device__ __forceinline__ void stage_rc(int b, int& R, int& C) { const int st = b / 1024, sb = b % 1024, swz = sb ^ (((sb >> 9) & 1) << 5); R = (st >> 1) * 16 + swz / 64; C = (st & 1) * 32 + (swz % 64) / 2; }

__device__ __forceinline__ int perm32(int rho) { const int n = rho >> 4, i = rho & 15; return 8 * (i >> 2) + 4 * n + (i & 3); }
struct Unit { int pm, pn; };
struct Gemm { const bf16_t* A; const bf16_t* Bt; int M, N, K, lda, ldb; };

struct StaticOrder {
    int nM, nN, nwg, G, c;
    __device__ __forceinline__ void init(int M, int N, int G_, int c_) { nM = M / BM; nN = N / BM; nwg = nM * nN; G = G_; c = c_; }
    __device__ __forceinline__ bool next(int i, Unit& u) const {
        const long L = (long)i * G + c; if (L >= nwg) return false;
        int wgid = (int)L; { const int q = nwg / NXCD, r = nwg % NXCD, xcd = wgid % NXCD, off = wgid / NXCD; wgid = (xcd < r ? xcd * (q + 1) : r * (q + 1) + (xcd - r) * q) + off; }
        const int nig = WGM * nN, gid = wgid / nig, fm = gid * WGM, gsz = (nM - fm) < WGM ? (nM - fm) : WGM;
        u.pm = fm + ((wgid % nig) % gsz); u.pn = (wgid % nig) / gsz; return true;
    }
};

struct SingleUnit { Unit u; __device__ bool next(int i, Unit& o) const { if (i) return false; o = u; return true; } };
template <class Epi, class Sched, bool ALIGN_EPI>
__device__ __forceinline__ void gemm_phase(LAS unsigned char* lds, const Gemm g, const Sched& S, const Epi& E) {
    int tid = threadIdx.x; asm volatile("" : "+v"(tid));
    const int wid = __builtin_amdgcn_readfirstlane(tid >> 6), lane = tid & 63, wr = wid >> 2, wc = wid & 3, fr = lane & 15, fq = lane >> 4;
    const int K = g.K, nt = K / BK;
    unsigned voffA[2], voffB[2];
#pragma unroll
    for (int i = 0; i < 2; ++i) { int R, C; stage_rc(tid * 16 + i * 8192, R, C);
        const int Rb = (R & ~31) + perm32(R & 31);
        voffA[i] = (unsigned)(R * g.lda + C) * 2u; voffB[i] = (unsigned)(Rb * g.ldb + C) * 2u; }
    const size_t kstep = (size_t)(BK * 2);
    const size_t hstepA = (size_t)HALF * g.lda * 2, hstepB = (size_t)HALF * g.ldb * 2;
    const size_t tstepA = 2 * hstepA, tstepB = 2 * hstepB;
    const unsigned ldsw = (unsigned)wid * 1024u;
    const int aoff = lds_byte(wr * 64 + fr, fq * 8), boff = lds_byte(wc * 32 + fr, fq * 8);
#define PG8_SA(b, h) (((b) * 2 + (h)) * HTB)
#define PG8_SB(b, h) ((4 + (b) * 2 + (h)) * HTB)
#define PG8_STAGE(bufoff, gbase, voff) do { _Pragma("unroll") for (int _i = 0; _i < 2; ++_i) \
        __builtin_amdgcn_global_load_lds((const unsigned*)((const char*)(gbase) + (voff)[_i]), (LAS unsigned*)(lds + (bufoff) + ldsw + _i * 8192), 16, 0, 0); } while (0)
#define PG8_LDA(dst, b, h) do { _Pragma("unroll") for (int m = 0; m < 4; ++m) _Pragma("unroll") for (int k = 0; k < 2; ++k) dst[m][k] = *(const LAS bf16x8*)(lds + PG8_SA(b, h) + aoff + m * 2048 + k * 1024); } while (0)
#define PG8_LDB(dst, b, h) do { _Pragma("unroll") for (int n = 0; n < 2; ++n) _Pragma("unroll") for (int k = 0; k < 2; ++k) dst[n][k] = *(const LAS bf16x8*)(lds + PG8_SB(b, h) + boff + n * 2048 + k * 1024); } while (0)
#define PG8_MMA(ai, bj, At, Bt) do { __builtin_amdgcn_s_setprio(1); _Pragma("unroll") for (int m = 0; m < 4; ++m) _Pragma("unroll") for (int n = 0; n < 2; ++n) _Pragma("unroll") for (int k = 0; k < 2; ++k) \
        acc[ai][bj][m][n] = __builtin_amdgcn_mfma_f32_16x16x32_bf16(Bt[n][k], At[m][k], acc[ai][bj][m][n], 0, 0, 0); __builtin_amdgcn_s_setprio(0); } while (0)
#define PG8_WAIT_V(n) asm volatile("s_waitcnt vmcnt(" #n ")" ::: "memory")
#define PG8_WAIT_L(n) asm volatile("s_waitcnt lgkmcnt(" #n ")" ::: "memory")
#define PG8_BAR __builtin_amdgcn_s_barrier()
#define PG8_SCHED __builtin_amdgcn_sched_barrier(0)
    Unit cur, nxt; int ui = 0;
    if (!S.next(0, cur)) return;
    f32x4 acc[2][2][4][2];
#pragma unroll
    for (int a = 0; a < 2; ++a)
#pragma unroll
        for (int b = 0; b < 2; ++b)
#pragma unroll
            for (int m = 0; m < 4; ++m)
#pragma unroll
                for (int n = 0; n < 2; ++n) acc[a][b][m][n] = (f32x4){0.f, 0.f, 0.f, 0.f};
    bf16x8 At[4][2], B0[2][2], B1[2][2];
    const char* cA = (const char*)g.A + (size_t)cur.pm * tstepA; const char* cB = (const char*)g.Bt + (size_t)cur.pn * tstepB;
    PG8_STAGE(PG8_SB(0, 0), cB, voffB); PG8_STAGE(PG8_SB(0, 1), cB + hstepB, voffB); PG8_STAGE(PG8_SA(0, 0), cA, voffA); PG8_STAGE(PG8_SA(0, 1), cA + hstepA, voffA);
    if (wr == 1) PG8_BAR;
    PG8_WAIT_V(2); PG8_BAR;
    PG8_STAGE(PG8_SB(1, 0), cB + kstep, voffB); PG8_STAGE(PG8_SA(1, 0), cA + kstep, voffA); PG8_STAGE(PG8_SB(1, 1), cB + hstepB + kstep, voffB);
    PG8_WAIT_V(6); PG8_BAR;
    for (;;) {
        const bool has_next = S.next(ui + 1, nxt);
        const char* nA = has_next ? (const char*)g.A + (size_t)nxt.pm * tstepA : cA; const char* nB = has_next ? (const char*)g.Bt + (size_t)nxt.pn * tstepB : cB;
        for (int t = 0; t < nt; t += 2) {
            const bool last = (t == nt - 2);
            const char* a1 = cA + (size_t)(t + 1) * kstep;
            const char* a2 = last ? nA : cA + (size_t)(t + 2) * kstep; const char* b2 = last ? nB : cB + (size_t)(t + 2) * kstep;
            const char* a3 = a2 + kstep; const char* b3 = b2 + kstep;
            PG8_LDB(B0, 0, 0); PG8_LDB(B1, 0, 1); PG8_SCHED; PG8_LDA(At, 0, 0); PG8_STAGE(PG8_SA(1, 1), a1 + hstepA, voffA);
            PG8_WAIT_V(8); PG8_WAIT_L(0); PG8_BAR; PG8_MMA(0, 0, At, B0); PG8_MMA(0, 1, At, B1); PG8_BAR; PG8_SCHED;
            PG8_LDA(At, 0, 1); PG8_STAGE(PG8_SB(0, 0), b2, voffB); PG8_STAGE(PG8_SB(0, 1), b2 + hstepB, voffB); PG8_STAGE(PG8_SA(0, 0), a2, voffA);
            PG8_WAIT_V(8); PG8_WAIT_L(0); PG8_BAR; PG8_MMA(1, 0, At, B0); PG8_MMA(1, 1, At, B1); PG8_BAR; PG8_SCHED;
            PG8_LDB(B0, 1, 0); PG8_LDB(B1, 1, 1); PG8_SCHED; PG8_LDA(At, 1, 0); PG8_STAGE(PG8_SA(0, 1), a2 + hstepA, voffA);
            PG8_WAIT_V(8); PG8_WAIT_L(0); PG8_BAR; PG8_MMA(0, 0, At, B0); PG8_MMA(0, 1, At, B1); PG8_BAR; PG8_SCHED;
            PG8_LDA(At, 1, 1); PG8_STAGE(PG8_SB(1, 0), b3, voffB); PG8_STAGE(PG8_SB(1, 1), b3 + hstepB, voffB); PG8_STAGE(PG8_SA(1, 0), a3, voffA);
            PG8_WAIT_V(8); PG8_WAIT_L(0); PG8_BAR; PG8_MMA(1, 0, At, B0); PG8_MMA(1, 1, At, B1); PG8_BAR; PG8_SCHED;
        }
        if constexpr (ALIGN_EPI) { if (wr == 0) PG8_BAR; }
        E(acc, cur, wr, wc, fr, fq);
        if (!has_next) break;
#pragma unroll
        for (int a = 0; a < 2; ++a)
#pragma unroll
            for (int b = 0; b < 2; ++b)
#pragma unroll
                for (int m = 0; m < 4; ++m)
#pragma unroll
                    for (int n = 0; n < 2; ++n) acc[a][b][m][n] = (f32x4){0.f, 0.f, 0.f, 0.f};
        cur = nxt; cA = nA; cB = nB; ++ui;
        if constexpr (ALIGN_EPI) { if (wr == 1) PG8_BAR; }
    }
    PG8_WAIT_V(0);
    if constexpr (!ALIGN_EPI) { if (wr == 0) PG8_BAR; }
    PG8_BAR;
#undef PG8_SA
#undef PG8_SB
#undef PG8_STAGE
#undef PG8_LDA
#undef PG8_LDB
#undef PG8_MMA
#undef PG8_WAIT_V
#undef PG8_WAIT_L
#undef PG8_BAR
#undef PG8_SCHED
}

struct UnitX { int pm, pn, seg; };
__device__ __forceinline__ int uni(int v) { return __builtin_amdgcn_readfirstlane(v); }
__device__ __forceinline__ const char* unip(const char* p) { const unsigned long long v = (unsigned long long)p; const unsigned lo = (unsigned)__builtin_amdgcn_readfirstlane((int)(unsigned)v), hi = (unsigned)__builtin_amdgcn_readfirstlane((int)(unsigned)(v >> 32)); return (const char*)(((unsigned long long)hi << 32) | lo); }
template <class Epi, class Prog>
__device__ __forceinline__ void gemm_multi(LAS unsigned char* lds, const Prog& P, const Epi& E) {
    int tid = threadIdx.x; asm volatile("" : "+v"(tid));
    const int wid = __builtin_amdgcn_readfirstlane(tid >> 6), lane = tid & 63, wr = wid >> 2, wc = wid & 3, fr = lane & 15, fq = lane >> 4;
    unsigned Rr[2], RrB[2], Cc2[2];
#pragma unroll
    for (int i = 0; i < 2; ++i) { int R, C; stage_rc(tid * 16 + i * 8192, R, C); Rr[i] = (unsigned)R * 2u; RrB[i] = (unsigned)((R & ~31) + perm32(R & 31)) * 2u; Cc2[i] = (unsigned)C * 2u; }
    const size_t kstep = (size_t)(BK * 2);
    const unsigned ldsw = (unsigned)wid * 1024u;
    const int aoff = lds_byte(wr * 64 + fr, fq * 8), boff = lds_byte(wc * 32 + fr, fq * 8);
#define PG8_SA(b, h) (((b) * 2 + (h)) * HTB)
#define PG8_SB(b, h) ((4 + (b) * 2 + (h)) * HTB)
#define PG8_STAGE_X(RR, bufoff, gbase, ld) do { _Pragma("unroll") for (int _i = 0; _i < 2; ++_i) \
        __builtin_amdgcn_global_load_lds((const unsigned*)((const char*)(gbase) + (RR[_i] * (unsigned)(ld) + Cc2[_i])), (LAS unsigned*)(lds + (bufoff) + ldsw + _i * 8192), 16, 0, 0); } while (0)
#define PG8_STAGE(bufoff, gbase, ld) PG8_STAGE_X(Rr, bufoff, gbase, ld)
#define PG8_STAGEB(bufoff, gbase, ld) PG8_STAGE_X(RrB, bufoff, gbase, ld)
#define PG8_LDA(dst, b, h) do { _Pragma("unroll") for (int m = 0; m < 4; ++m) _Pragma("unroll") for (int k = 0; k < 2; ++k) dst[m][k] = *(const LAS bf16x8*)(lds + PG8_SA(b, h) + aoff + m * 2048 + k * 1024); } while (0)
#define PG8_LDB(dst, b, h) do { _Pragma("unroll") for (int n = 0; n < 2; ++n) _Pragma("unroll") for (int k = 0; k < 2; ++k) dst[n][k] = *(const LAS bf16x8*)(lds + PG8_SB(b, h) + boff + n * 2048 + k * 1024); } while (0)
#define PG8_MMA(ai, bj, At, Bt) do { __builtin_amdgcn_s_setprio(1); _Pragma("unroll") for (int m = 0; m < 4; ++m) _Pragma("unroll") for (int n = 0; n < 2; ++n) _Pragma("unroll") for (int k = 0; k < 2; ++k) \
        acc[ai][bj][m][n] = __builtin_amdgcn_mfma_f32_16x16x32_bf16(Bt[n][k], At[m][k], acc[ai][bj][m][n], 0, 0, 0); __builtin_amdgcn_s_setprio(0); } while (0)
#define PG8_WAIT_V(n) asm volatile("s_waitcnt vmcnt(" #n ")" ::: "memory")
#define PG8_WAIT_L(n) asm volatile("s_waitcnt lgkmcnt(" #n ")" ::: "memory")
#define PG8_BAR __builtin_amdgcn_s_barrier()
#define PG8_SCHED __builtin_amdgcn_sched_barrier(0)
    UnitX cur, nxt; int ui = 0;
    if (!P.next(0, cur)) return;
    f32x4 acc[2][2][4][2];
#pragma unroll
    for (int a = 0; a < 2; ++a)
#pragma unroll
        for (int b = 0; b < 2; ++b)
#pragma unroll
            for (int m = 0; m < 4; ++m)
#pragma unroll
                for (int n = 0; n < 2; ++n) acc[a][b][m][n] = (f32x4){0.f, 0.f, 0.f, 0.f};
    bf16x8 At[4][2], B0[2][2], B1[2][2];
    const char* cA; const char* cB; int lda, ldb, nt;
    P.desc(cur, cA, cB, lda, ldb, nt); cA = unip(cA); cB = unip(cB); lda = uni(lda); ldb = uni(ldb); nt = uni(nt);
    {   const size_t hA = (size_t)HALF * lda * 2, hB = (size_t)HALF * ldb * 2;
        PG8_STAGEB(PG8_SB(0, 0), cB, ldb); PG8_STAGEB(PG8_SB(0, 1), cB + hB, ldb); PG8_STAGE(PG8_SA(0, 0), cA, lda); PG8_STAGE(PG8_SA(0, 1), cA + hA, lda);
        if (wr == 1) PG8_BAR;
        PG8_WAIT_V(2); PG8_BAR;
        PG8_STAGEB(PG8_SB(1, 0), cB + kstep, ldb); PG8_STAGE(PG8_SA(1, 0), cA + kstep, lda); PG8_STAGEB(PG8_SB(1, 1), cB + hB + kstep, ldb);
        PG8_WAIT_V(6); PG8_BAR; }
    for (;;) {
        const bool has_next = P.next(ui + 1, nxt);
        const char* nA = cA; const char* nB = cB; int ldan = lda, ldbn = ldb, ntn = nt;
        if (has_next) P.desc(nxt, nA, nB, ldan, ldbn, ntn);
        nA = unip(nA); nB = unip(nB); ldan = uni(ldan); ldbn = uni(ldbn); ntn = uni(ntn);
        const size_t hAc = (size_t)HALF * lda * 2;
        for (int t = 0; t < nt; t += 2) {
            const bool last = (t == nt - 2);
            const char* a1 = cA + (size_t)(t + 1) * kstep;
            const char* a2 = last ? nA : cA + (size_t)(t + 2) * kstep; const char* b2 = last ? nB : cB + (size_t)(t + 2) * kstep;
            const int lda2 = last ? ldan : lda, ldb2 = last ? ldbn : ldb;
            const size_t hA2 = (size_t)HALF * lda2 * 2, hB2 = (size_t)HALF * ldb2 * 2;
            const char* a3 = a2 + kstep; const char* b3 = b2 + kstep;
            PG8_LDB(B0, 0, 0); PG8_LDB(B1, 0, 1); PG8_SCHED; PG8_LDA(At, 0, 0); PG8_STAGE(PG8_SA(1, 1), a1 + hAc, lda);
            PG8_WAIT_V(8); PG8_WAIT_L(0); PG8_BAR; PG8_MMA(0, 0, At, B0); PG8_MMA(0, 1, At, B1); PG8_BAR; PG8_SCHED;
            PG8_LDA(At, 0, 1); PG8_STAGEB(PG8_SB(0, 0), b2, ldb2); PG8_STAGEB(PG8_SB(0, 1), b2 + hB2, ldb2); PG8_STAGE(PG8_SA(0, 0), a2, lda2);
            PG8_WAIT_V(8); PG8_WAIT_L(0); PG8_BAR; PG8_MMA(1, 0, At, B0); PG8_MMA(1, 1, At, B1); PG8_BAR; PG8_SCHED;
            PG8_LDB(B0, 1, 0); PG8_LDB(B1, 1, 1); PG8_SCHED; PG8_LDA(At, 1, 0); PG8_STAGE(PG8_SA(0, 1), a2 + hA2, lda2);
            PG8_WAIT_V(8); PG8_WAIT_L(0); PG8_BAR; PG8_MMA(0, 0, At, B0); PG8_MMA(0, 1, At, B1); PG8_BAR; PG8_SCHED;
            PG8_LDA(At, 1, 1); PG8_STAGEB(PG8_SB(1, 0), b3, ldb2); PG8_STAGEB(PG8_SB(1, 1), b3 + hB2, ldb2); PG8_STAGE(PG8_SA(1, 0), a3, lda2);
            PG8_WAIT_V(8); PG8_WAIT_L(0); PG8_BAR; PG8_MMA(1, 0, At, B0); PG8_MMA(1, 1, At, B1); PG8_BAR; PG8_SCHED;
        }
        if (wr == 0) PG8_BAR;
        E(acc, cur, wr, wc, fr, fq);
        if (!has_next) break;
#pragma unroll
        for (int a = 0; a < 2; ++a)
#pragma unroll
            for (int b = 0; b < 2; ++b)
#pragma unroll
                for (int m = 0; m < 4; ++m)
#pragma unroll
                    for (int n = 0; n < 2; ++n) acc[a][b][m][n] = (f32x4){0.f, 0.f, 0.f, 0.f};
        cur = nxt; cA = nA; cB = nB; lda = ldan; ldb = ldbn; nt = ntn; ++ui;
        if (wr == 1) PG8_BAR;
    }
    PG8_WAIT_V(0);
    PG8_BAR;
#undef PG8_SA
#undef PG8_SB
#undef PG8_STAGE
#undef PG8_STAGEB
#undef PG8_STAGE_X
#undef PG8_LDA
#undef PG8_LDB
#undef PG8_MMA
#undef PG8_WAIT_V
#undef PG8_WAIT_L
#undef PG8_BAR
#undef PG8_SCHED
}

#define EPI_ROWS_BEGIN  _Pragma("unroll") for (int ai = 0; ai < 2; ++ai) _Pragma("unroll") for (int m = 0; m < 4; ++m) { const int row = u.pm * BM + ai * HALF + wr * 64 + m * 16 + fr;
#define EPI_COLS_BEGIN  _Pragma("unroll") for (int bj = 0; bj < 2; ++bj) _Pragma("unroll") for (int n = 0; n < 2; ++n) { const int col = bj * HALF + wc * 32 + 8 * fq + 4 * n; f32x4 v = acc[ai][bj][m][n];
#define EPI_END } }
#define EPI_COLS8_BEGIN  _Pragma("unroll") for (int bj = 0; bj < 2; ++bj) { const int col = bj * HALF + wc * 32 + 8 * fq; const f32x4 v0 = acc[ai][bj][m][0], v1 = acc[ai][bj][m][1];

struct EpiG1 {
    const float* rs; bf16_t* ZM; bf16_t* ZT;
    __device__ __forceinline__ void operator()(const f32x4 (&acc)[2][2][4][2], const Unit& u, int wr, int wc, int fr, int fq) const {
        const int pn = u.pn;
        if (pn >= 4 && pn < 6) {
            const int d0 = (pn - 4) * 256;
            EPI_ROWS_BEGIN
            EPI_COLS_BEGIN
                GAS bf16_t* d = (GAS bf16_t*)ZT + ((size_t)(row >> 6) * 512 + d0 + col) * 64 + (row & 63);
                const unsigned w0 = pk2(v[0], v[1]), w1 = pk2(v[2], v[3]);
                d[0] = (bf16_t)w0; d[64] = (bf16_t)(w0 >> 16); d[128] = (bf16_t)w1; d[192] = (bf16_t)(w1 >> 16);
            EPI_END
        } else if (pn >= 6 && pn < 8) {
            const int j0 = (pn - 6) * 256;
            EPI_ROWS_BEGIN
            EPI_COLS_BEGIN
                GAS bf16_t* d = (GAS bf16_t*)ZT + (size_t)MTOK * 512 + ((size_t)(row >> 9) * 512 + j0 + col) * 512 + (row & 511);
                const unsigned w0 = pk2(v[0], v[1]), w1 = pk2(v[2], v[3]);
                d[0] = (bf16_t)w0; d[512] = (bf16_t)(w0 >> 16); d[1024] = (bf16_t)w1; d[1536] = (bf16_t)(w1 >> 16);
            EPI_END
        } else {
            const int cm = (pn < 4 ? pn : pn - 4) * 256;
            EPI_ROWS_BEGIN
            EPI_COLS8_BEGIN
                u32x4 w; w.x = pk2(v0[0], v0[1]); w.y = pk2(v0[2], v0[3]); w.z = pk2(v1[0], v1[1]); w.w = pk2(v1[2], v1[3]);
                *(GAS u32x4*)((GAS bf16_t*)ZM + (size_t)row * ZMW + cm + col) = w;
            EPI_END
        }
    }
};
struct EpiDFT {
    bf16_t* Y;
    __device__ __forceinline__ void operator()(const f32x4 (&acc)[2][2][4][2], const Unit& u, int wr, int wc, int fr, int fq) const {
        int tok0, R, q;
        if (u.pm < 128) { tok0 = (u.pm >> 2) * 2048; R = 4; q = u.pm & 3; } else { const int t = u.pm - 128; tok0 = MP + (t >> 4) * 8192; R = 16; q = t & 15; }
        EPI_ROWS_BEGIN const int p = row - u.pm * BM;
        EPI_COLS_BEGIN
            const int k0 = u.pn * BM + col;
            GAS bf16_t* d = (GAS bf16_t*)Y + (size_t)(tok0 + R * k0 + q) * DM + 512 + p;
            const unsigned w0 = pk2(v[0], v[1]), w1 = pk2(v[2], v[3]);
            d[0] = (bf16_t)w0; d[(size_t)R * DM] = (bf16_t)(w0 >> 16); d[(size_t)2 * R * DM] = (bf16_t)w1; d[(size_t)3 * R * DM] = (bf16_t)(w1 >> 16);
        EPI_END
    }
};
struct EpiG2 {
    const float* rs; bf16_t* Y;
    __device__ __forceinline__ void operator()(const f32x4 (&acc)[2][2][4][2], const Unit& u, int wr, int wc, int fr, int fq) const {
        EPI_ROWS_BEGIN
        EPI_COLS8_BEGIN
            GAS u32x4* p = (GAS u32x4*)((GAS bf16_t*)Y + (size_t)row * DM + u.pn * BM + col);
            const u32x4 y = *p; u32x4 w;
            w.x = pk2(bflo(y.x) * siluf_(v0[0]), bfhi(y.x) * siluf_(v0[1])); w.y = pk2(bflo(y.y) * siluf_(v0[2]), bfhi(y.y) * siluf_(v0[3]));
            w.z = pk2(bflo(y.z) * siluf_(v1[0]), bfhi(y.z) * siluf_(v1[1])); w.w = pk2(bflo(y.w) * siluf_(v1[2]), bfhi(y.w) * siluf_(v1[3]));
            *p = w;
        EPI_END
    }
};
struct ProgG34 {
    StaticOrder S; const bf16_t* Y; const bf16_t* XB; const char* wsb; const bf16_t* WM; int layer;
    __device__ __forceinline__ bool next(int i, UnitX& u) const { Unit t; if (!S.next(i / 6, t)) return false; u.pm = t.pm; u.pn = t.pn; u.seg = i % 6; return true; }
    __device__ __forceinline__ void desc(const UnitX& u, const char*& A, const char*& B, int& lda, int& ldb, int& nt) const {
        const int b = u.seg >> 1; lda = DM;
        if (u.seg & 1) { A = (const char*)(XB + (size_t)u.pm * BM * DM); B = (const char*)(WM + (size_t)b * DM * DM + (size_t)u.pn * BM * DM); ldb = DM; nt = DM / BK; }
        else { const int kb = (b == 0) ? 512 : 256, ac = (b == 0) ? 0 : (b == 1 ? 512 : 768);
            const size_t woff = (size_t)((b == 0) ? 26 : 27 + b) * MiB + (size_t)layer * ((b == 0) ? MiB : MiB / 2);
            const bf16_t* w = (const bf16_t*)(wsb + woff);
            A = (const char*)(Y + (size_t)u.pm * BM * DM + ac); B = (const char*)(w + (size_t)u.pn * BM * kb); ldb = kb; nt = kb / BK; }
    }
};
struct EpiG34 {
    const float* rs; bf16_t* PT; bf16_t* MT; bf16_t* MG;
    __device__ __forceinline__ void operator()(const f32x4 (&acc)[2][2][4][2], const UnitX& u, int wr, int wc, int fr_, int fq_) const {
        int fr = fr_, fq = fq_; asm volatile("" : "+v"(fr), "+v"(fq));
        if ((u.seg & 1) == 0) {
            EPI_ROWS_BEGIN
            EPI_COLS8_BEGIN
                u32x4 w; w.x = pk2(v0[0], v0[1]); w.y = pk2(v0[2], v0[3]); w.z = pk2(v1[0], v1[1]); w.w = pk2(v1[2], v1[3]);
                *(GAS u32x4*)(PT + (size_t)(row - u.pm * BM) * 256 + col) = w;
            EPI_END
        } else {
            const int mode = u.seg >> 1;
            GAS bf16_t* dst = (mode == 2) ? (GAS bf16_t*)MG + (size_t)u.pm * BM * DM + u.pn * BM : (GAS bf16_t*)MT;
            const int dld = (mode == 2) ? DM : 256;
            const int rl0 = wr * 64 + fr, c0 = wc * 32 + 8 * fq;
#pragma unroll
            for (int ai = 0; ai < 2; ++ai) {
                u32x4 pv[4][2], mv[4][2];
#pragma unroll
                for (int m = 0; m < 4; ++m)
#pragma unroll
                    for (int bj = 0; bj < 2; ++bj) pv[m][bj] = *(const GAS u32x4*)(PT + (size_t)(ai * HALF + rl0 + m * 16) * 256 + bj * HALF + c0);
                if (mode != 0) {
#pragma unroll
                    for (int m = 0; m < 4; ++m)
#pragma unroll
                        for (int bj = 0; bj < 2; ++bj) mv[m][bj] = *(const GAS u32x4*)(MT + (size_t)(ai * HALF + rl0 + m * 16) * 256 + bj * HALF + c0);
                } else {
#pragma unroll
                    for (int m = 0; m < 4; ++m)
#pragma unroll
                        for (int bj = 0; bj < 2; ++bj) mv[m][bj] = (u32x4){0u, 0u, 0u, 0u};
                }
                __builtin_amdgcn_sched_barrier(0);
#pragma unroll
                for (int m = 0; m < 4; ++m)
#pragma unroll
                    for (int bj = 0; bj < 2; ++bj) {
                        const f32x4 v0 = acc[ai][bj][m][0], v1 = acc[ai][bj][m][1]; const u32x4 p = pv[m][bj], q = mv[m][bj];
                        const float r0 = bflo(q.x) + bflo(p.x) * sigmoidf_(v0[0]), r1 = bfhi(q.x) + bfhi(p.x) * sigmoidf_(v0[1]), r2 = bflo(q.y) + bflo(p.y) * sigmoidf_(v0[2]), r3 = bfhi(q.y) + bfhi(p.y) * sigmoidf_(v0[3]);
                        const float r4 = bflo(q.z) + bflo(p.z) * sigmoidf_(v1[0]), r5 = bfhi(q.z) + bfhi(p.z) * sigmoidf_(v1[1]), r6 = bflo(q.w) + bflo(p.w) * sigmoidf_(v1[2]), r7 = bfhi(q.w) + bfhi(p.w) * sigmoidf_(v1[3]);
                        u32x4 w; w.x = pk2(r0, r1); w.y = pk2(r2, r3); w.z = pk2(r4, r5); w.w = pk2(r6, r7);
                        *(GAS u32x4*)(dst + (size_t)(ai * HALF + rl0 + m * 16) * dld + bj * HALF + c0) = w;
                    }
                __builtin_amdgcn_sched_barrier(0);
            }
        }
    }
};
struct EpiG5 {
    bf16_t* O; float* ss;
    __device__ __forceinline__ void operator()(const f32x4 (&acc)[2][2][4][2], const Unit& u, int wr, int wc, int fr, int fq) const {
        EPI_ROWS_BEGIN float q = 0.f;
        EPI_COLS8_BEGIN
            u32x4 w; w.x = pk2(v0[0], v0[1]); w.y = pk2(v0[2], v0[3]); w.z = pk2(v1[0], v1[1]); w.w = pk2(v1[2], v1[3]);
            *(GAS u32x4*)((GAS bf16_t*)O + (size_t)row * DM + u.pn * BM + col) = w;
            q += ((v0[0] * v0[0] + v0[1] * v0[1]) + (v0[2] * v0[2] + v0[3] * v0[3])) + ((v1[0] * v1[0] + v1[1] * v1[1]) + (v1[2] * v1[2] + v1[3] * v1[3]));
        }
            q += __shfl_xor(q, 16); q += __shfl_xor(q, 32);
            if (fq == 0) atomicAdd(ss + row, q);
        }
    }
};
}

__device__ __forceinline__ void transpose_item(const float* W, int K, int pitch, int c0, int ncols, bf16_t* WT, int row_off, const float* g, float scale, LAS float* scr, int item, int lane) {
    const int nblk = ncols / 32, kb = item / nblk, nb = item % nblk, k0 = 64 * kb, n0 = 32 * nb;
#pragma unroll 8
    for (int i = 0; i < 32; ++i) { const int kk = 2 * i + (lane >> 5); float w = W[(size_t)(k0 + kk) * pitch + c0 + n0 + (lane & 31)] * scale; if (g) w *= g[k0 + kk]; scr[kk * 33 + (lane & 31)] = w; }
    LDS_WAIT(); asm volatile("" ::: "memory");
    const int c = lane & 7;
#pragma unroll
    for (int j = 0; j < 4; ++j) { const int n = (lane >> 3) + 8 * j; const LAS float* s = scr + (8 * c) * 33 + n;
        u32x4 o; o.x = pk2(s[0 * 33], s[1 * 33]); o.y = pk2(s[2 * 33], s[3 * 33]); o.z = pk2(s[4 * 33], s[5 * 33]); o.w = pk2(s[6 * 33], s[7 * 33]);
        *(u32x4*)(WT + (size_t)(row_off + n0 + n) * K + k0 + 8 * c) = o; }
    LDS_WAIT(); asm volatile("" ::: "memory");
}

struct Args { const float* in[14]; float* out; unsigned char* ws; int ph_lo, ph_hi; };

__device__ __forceinline__ void grid_row_info(int gr, int& seqbase, int& r, int& nrows) {
    if (gr < 1024) { seqbase = (gr >> 5) << 11; r = gr & 31; nrows = 32; } else { const int g2 = gr - 1024; seqbase = MP + ((g2 >> 7) << 13); r = g2 & 127; nrows = 128; }
}

constexpr int AT_KSLOT = 9216, AT_VSLOT = 8704, AT_VOFF = 73728, AT_BOFF = 143360;
__device__ __forceinline__ void attn_fill_issue(const GAS bf16_t* ZM, const GAS bf16_t* ZT, int tok0, int head, int tid, u32x4& kreg, u32x4& vreg) {
    kreg = *(const GAS u32x4*)(ZM + (size_t)(tok0 + (tid >> 3)) * ZMW + 512 + head * 64 + (tid & 7) * 8);
    vreg = *(const GAS u32x4*)(ZT + ((size_t)(tok0 >> 6) * 512 + head * 64) * 64 + tid * 8);
}
__device__ __forceinline__ void attn_fill_write(LAS unsigned char* lds, int slot, int tid, const u32x4 kreg, const u32x4 vreg) {
    *(LAS u32x4*)(lds + slot * AT_KSLOT + (tid >> 3) * 144 + (tid & 7) * 16) = kreg;
    LAS u32x2* vp = (LAS u32x2*)(lds + AT_VOFF + slot * AT_VSLOT + (tid >> 3) * 136 + (tid & 7) * 16);
    u32x2 a; a.x = vreg.x; a.y = vreg.y; u32x2 b; b.x = vreg.z; b.y = vreg.w;
    vp[0] = a; vp[1] = b;
}
__device__ __forceinline__ void attn_row_lds(LAS unsigned char* lds, int seqbase, int r, int rs, int head, int lane, int wave, const bf16x8 bq0, const bf16x8 bq1, GAS bf16_t* Y, const unsigned (&bcp)[32]) {
    const int g = wave & 3, dh = wave >> 2;
    const int qi = lane & 15, h4 = lane >> 4;
    const int cs = (g == 0) ? 0 : (g == 1) ? 8 : (g == 2) ? 24 : 32;
    const int qc = 16 * g + qi;
    const int qtok = seqbase + r * 64 + qc;
    f32x4 S[16];
    float mx = -3.0e38f;
#pragma unroll
    for (int hb = 0; hb < 2; ++hb) {
        bf16x8 ak[8][2];
#pragma unroll
        for (int tt = 0; tt < 8; ++tt) {
            const int t = hb * 8 + tt, kr = t >> 1, hf = t & 1;
            const int slot = (rs + kr) & 7;
            const LAS unsigned char* kp = lds + slot * AT_KSLOT + (cs + 16 * hf + qi) * 144 + h4 * 16;
            ak[tt][0] = *(const LAS bf16x8*)kp; ak[tt][1] = *(const LAS bf16x8*)(kp + 64);
        }
        __builtin_amdgcn_sched_barrier(0);
#pragma unroll
        for (int tt = 0; tt < 8; ++tt) {
            const int t = hb * 8 + tt;
            f32x4 s = {0.f, 0.f, 0.f, 0.f};
            s = __builtin_amdgcn_mfma_f32_16x16x32_bf16(ak[tt][0], bq0, s, 0, 0, 0);
            s = __builtin_amdgcn_mfma_f32_16x16x32_bf16(ak[tt][1], bq1, s, 0, 0, 0);
            s[0] += bflo(bcp[2 * t]); s[1] += bfhi(bcp[2 * t]); s[2] += bflo(bcp[2 * t + 1]); s[3] += bfhi(bcp[2 * t + 1]);
            mx = fmaxf(mx, fmaxf(fmaxf(s[0], s[1]), fmaxf(s[2], s[3])));
            S[t] = s;
        }
        __builtin_amdgcn_sched_barrier(0);
    }
    u32x2 vf[2][8][2];
#pragma unroll
    for (int dti = 0; dti < 2; ++dti)
#pragma unroll
        for (int kr = 0; kr < 8; ++kr) {
            const int slot = (rs + kr) & 7;
            const LAS unsigned char* vp = lds + AT_VOFF + slot * AT_VSLOT + ((2 * dh + dti) * 16 + qi) * 136 + (cs + 4 * h4) * 2;
            vf[dti][kr][0] = *(const LAS u32x2*)vp; vf[dti][kr][1] = *(const LAS u32x2*)(vp + 32);
        }
    __builtin_amdgcn_sched_barrier(0);
    mx = fmaxf(mx, __shfl_xor(mx, 16)); mx = fmaxf(mx, __shfl_xor(mx, 32));
    float sum = 0.f;
    bf16x8 pf[8];
#pragma unroll
    for (int kr = 0; kr < 8; ++kr) {
        const f32x4 a = S[kr * 2], b = S[kr * 2 + 1];
        const float p0 = __expf(a[0] - mx), p1 = __expf(a[1] - mx), p2 = __expf(a[2] - mx), p3 = __expf(a[3] - mx);
        const float p4 = __expf(b[0] - mx), p5 = __expf(b[1] - mx), p6 = __expf(b[2] - mx), p7 = __expf(b[3] - mx);
        sum += ((p0 + p1) + (p2 + p3)) + ((p4 + p5) + (p6 + p7));
        u32x4 w; w.x = pk2(p0, p1); w.y = pk2(p2, p3); w.z = pk2(p4, p5); w.w = pk2(p6, p7);
        pf[kr] = __builtin_bit_cast(bf16x8, w);
    }
    sum += __shfl_xor(sum, 16); sum += __shfl_xor(sum, 32);
    const float inv = __builtin_amdgcn_rcpf(sum);
    GAS bf16_t* yp = Y + (size_t)qtok * DM + head * 64 + 4 * h4;
#pragma unroll
    for (int dti = 0; dti < 2; ++dti) {
        const int dt = 2 * dh + dti;
        f32x4 o = {0.f, 0.f, 0.f, 0.f};
#pragma unroll
        for (int kr = 0; kr < 8; ++kr) {
            u32x4 w; w.x = vf[dti][kr][0].x; w.y = vf[dti][kr][0].y; w.z = vf[dti][kr][1].x; w.w = vf[dti][kr][1].y;
            o = __builtin_amdgcn_mfma_f32_16x16x32_bf16(__builtin_bit_cast(bf16x8, w), pf[kr], o, 0, 0, 0);
        }
        u32x2 w; w.x = pk2(o[0] * inv, o[1] * inv); w.y = pk2(o[2] * inv, o[3] * inv);
        *(GAS u32x2*)(yp + dt * 16) = w;
    }
}
__device__ __forceinline__ void attn_unit(LAS unsigned char* lds, int seqbase, int nrows, int ra, int rb, int head, int tid, int lane, int wave,
                                          const bf16_t* ZM_, const bf16_t* ZT_, bf16_t* Y_, const float* rpb) {
    const GAS bf16_t* ZM = (const GAS bf16_t*)ZM_; const GAS bf16_t* ZT = (const GAS bf16_t*)ZT_; GAS bf16_t* Y = (GAS bf16_t*)Y_;
    int rs = ra - 4; rs = rs < 0 ? 0 : rs; rs = rs > nrows - 8 ? nrows - 8 : rs;
    {   u32x4 kreg[8], vreg[8];
#pragma unroll
        for (int k = 0; k < 8; ++k) attn_fill_issue(ZM, ZT, seqbase + (rs + k) * 64, head, tid, kreg[k], vreg[k]);
        LAS float* bw = (LAS float*)(lds + AT_BOFF);
        if (tid < 465) bw[tid] = rpb[head * 465 + tid];
#pragma unroll
        for (int k = 0; k < 8; ++k) attn_fill_write(lds, (rs + k) & 7, tid, kreg[k], vreg[k]);
    }
    const GAS bf16_t* qbase = ZM + (size_t)(seqbase + 16 * (wave & 3) + (lane & 15)) * ZMW + head * 64 + 8 * (lane >> 4);
    bf16x8 q0 = *(const GAS bf16x8*)(qbase + (size_t)ra * 64 * ZMW), q1 = *(const GAS bf16x8*)(qbase + (size_t)ra * 64 * ZMW + 32);
    __syncthreads();
    unsigned bcp[32]; int cdelta = 1000;
#pragma unroll
    for (int i = 0; i < 32; ++i) bcp[i] = 0u;
#pragma unroll 1
    for (int r = ra; r < rb; ++r) {
        if (rs - r != cdelta) {
            cdelta = rs - r;
            const LAS float* bias = (const LAS float*)(lds + AT_BOFF);
            const int g_ = wave & 3, qi_ = lane & 15, h4_ = lane >> 4, cs_ = (g_ == 0) ? 0 : (g_ == 1) ? 8 : (g_ == 2) ? 24 : 32, qc_ = 16 * g_ + qi_;
            int cst_ = qc_ - 8; cst_ = cst_ < 0 ? 0 : cst_; cst_ = cst_ > 48 ? 48 : cst_;
#pragma unroll
            for (int t = 0; t < 16; ++t) {
                float bv[4];
#pragma unroll
                for (int e = 0; e < 4; ++e) {
                    const int kc = cs_ + 16 * (t & 1) + 4 * h4_ + e; int dc = kc - qc_ + 15; dc = dc < 0 ? 0 : dc; dc = dc > 30 ? 30 : dc;
                    const float b = bias[(cdelta + (t >> 1) + 7) * 31 + dc];
                    bv[e] = ((kc >= cst_) && (kc < cst_ + 16)) ? b : -1.0e30f;
                }
                bcp[2 * t] = pk2(bv[0], bv[1]); bcp[2 * t + 1] = pk2(bv[2], bv[3]);
            }
        }
        const int rq = (r + 1 < rb) ? r + 1 : r;
        const bf16x8 nq0 = *(const GAS bf16x8*)(qbase + (size_t)rq * 64 * ZMW), nq1 = *(const GAS bf16x8*)(qbase + (size_t)rq * 64 * ZMW + 32);
        int rsn = r + 1 - 4; rsn = rsn < 0 ? 0 : rsn; rsn = rsn > nrows - 8 ? nrows - 8 : rsn;
        const bool adv = (r + 1 < rb) && (rsn != rs);
        u32x4 kreg = {0u, 0u, 0u, 0u}, vreg = {0u, 0u, 0u, 0u};
        if (adv) attn_fill_issue(ZM, ZT, seqbase + (rsn + 7) * 64, head, tid, kreg, vreg);
        attn_row_lds(lds, seqbase, r, rs, head, lane, wave, q0, q1, Y, bcp);
        LDS_WAIT(); __builtin_amdgcn_s_barrier(); asm volatile("" ::: "memory");
        if (adv) attn_fill_write(lds, (rsn + 7) & 7, tid, kreg, vreg);
        LDS_WAIT(); __builtin_amdgcn_s_barrier(); asm volatile("" ::: "memory");
        rs = rsn; q0 = nq0; q1 = nq1;
    }
}

#define DFT4(r0, i0, r1, i1, r2, i2, r3, i3) do { \
    const float ar_ = r0 + r2, ai_ = i0 + i2, br_ = r0 - r2, bi_ = i0 - i2, cr_ = r1 + r3, ci_ = i1 + i3, dr_ = r1 - r3, di_ = i1 - i3; \
    r0 = ar_ + cr_; i0 = ai_ + ci_; r1 = br_ + di_; i1 = bi_ - dr_; r2 = ar_ - cr_; i2 = ai_ - ci_; r3 = br_ - di_; i3 = bi_ + dr_; } while (0)
template <int R, int NU>
__device__ __forceinline__ void butterfly_unit(int tok0, int rowbase  , int p0, int lp, const bf16_t* ZT_, bf16_t* YQ_, const float (&twr)[R], const float (&twi)[R]) {
    const GAS bf16_t* zre = (const GAS bf16_t*)ZT_ + (size_t)MTOK * 512 + ((size_t)(tok0 >> 9) * 512 + p0) * 512 + lp;
    const GAS bf16_t* zim = zre + 256 * 512;
    float xr[NU][R], xi[NU][R];
#pragma unroll
    for (int u = 0; u < NU; ++u)
#pragma unroll
        for (int s = 0; s < R; ++s) { xr[u][s] = bf2f(zre[(size_t)s * 512 * 512 + u * 512]); xi[u][s] = bf2f(zim[(size_t)s * 512 * 512 + u * 512]); }
#pragma unroll
    for (int u = 0; u < NU; ++u) {
        if constexpr (R == 4) {
            DFT4(xr[u][0], xi[u][0], xr[u][1], xi[u][1], xr[u][2], xi[u][2], xr[u][3], xi[u][3]);
        } else {
#pragma unroll
            for (int b = 0; b < 4; ++b) DFT4(xr[u][b], xi[u][b], xr[u][4 + b], xi[u][4 + b], xr[u][8 + b], xi[u][8 + b], xr[u][12 + b], xi[u][12 + b]);
            constexpr float WR[10] = {1.f, 0.9238795325f, 0.7071067812f, 0.3826834324f, 0.f, 0.f, -0.7071067812f, 0.f, 0.f, -0.9238795325f};
            constexpr float WI[10] = {0.f, -0.3826834324f, -0.7071067812f, -0.9238795325f, -1.f, 0.f, -0.7071067812f, 0.f, 0.f, 0.3826834324f};
#pragma unroll
            for (int c = 1; c < 4; ++c)
#pragma unroll
                for (int b = 1; b < 4; ++b) { const float wr_ = WR[c * b], wi_ = WI[c * b]; const float tr = xr[u][4 * c + b] * wr_ - xi[u][4 * c + b] * wi_, ti = xr[u][4 * c + b] * wi_ + xi[u][4 * c + b] * wr_; xr[u][4 * c + b] = tr; xi[u][4 * c + b] = ti; }
#pragma unroll
            for (int c = 0; c < 4; ++c) DFT4(xr[u][4 * c], xi[u][4 * c], xr[u][4 * c + 1], xi[u][4 * c + 1], xr[u][4 * c + 2], xi[u][4 * c + 2], xr[u][4 * c + 3], xi[u][4 * c + 3]);
        }
        GAS bf16_t* d0 = (GAS bf16_t*)YQ_ + (size_t)(rowbase + u) * 1024 + lp;
#pragma unroll
        for (int q = 0; q < R; ++q) {
            const int sl = (R == 16) ? 4 * (q & 3) + (q >> 2) : q;
            const float orr = xr[u][sl] * twr[q] - xi[u][sl] * twi[q], oi = xr[u][sl] * twi[q] + xi[u][sl] * twr[q];
            GAS bf16_t* d = d0 + (size_t)q * 256 * 1024;
            d[0] = (bf16_t)f2bf(orr); d[512] = (bf16_t)f2bf(oi);
        }
    }
}

__global__ void __launch_bounds__(NWAVES * 64, 2) fwd_kernel(Args args) {
    extern __shared__ __attribute__((aligned(16))) unsigned char lds_raw[];
    LAS unsigned char* lds = (LAS unsigned char*)lds_raw;
    const int G = gridDim.x, bx = blockIdx.x;
    for (int ph = args.ph_lo; ph < args.ph_hi; ++ph) {
        if (ph > args.ph_lo) { cg::this_grid().sync(); }
        int tid = threadIdx.x; asm volatile("" : "+v"(tid));
        const int lane = tid & 63, wave = __builtin_amdgcn_readfirstlane(tid >> 6);
        const int gw = bx * NWAVES + wave, NGW = G * NWAVES;
        unsigned char* ws = args.ws; asm volatile("" : "+s"(ws));
        const float* x_prompt = args.in[0]; const float* x_sample = args.in[1];
        float* out = args.out;
        bf16_t* XB = (bf16_t*)(ws + WS_XB); bf16_t* OB = XB;
        bf16_t* ZM = (bf16_t*)(ws + WS_ZM); bf16_t* PB = ZM;
        bf16_t* ZT = (bf16_t*)(ws + WS_ZT); bf16_t* MG = ZT;
        bf16_t* YQ = (bf16_t*)(ws + WS_YQ);
        bf16_t* Y = (bf16_t*)(ws + WS_Y);
        bf16_t* TT = (bf16_t*)(ws + WS_T);
        float* RS = (float*)(ws + WS_RS); float* SS = (float*)(ws + WS_SS);
        const int layer = (ph == 0) ? 0 : (ph - 1) / 7;
        const int sub = (ph == 0) ? -1 : (ph - 1) % 7;
        const bf16_t* WIN = (const bf16_t*)(ws + WS_WIN) + (size_t)layer * NG1 * DM;
        const bf16_t* WG = (const bf16_t*)(ws + WS_WG) + (size_t)layer * DM * DM;
        const bf16_t* WM = (const bf16_t*)(ws + WS_WM) + (size_t)layer * 3072 * DM;
        const bf16_t* WA = (const bf16_t*)(ws + WS_WA) + (size_t)layer * DM * 512;
        const bf16_t* WB = (const bf16_t*)(ws + WS_WB) + (size_t)layer * DM * 256;
        const bf16_t* WC = (const bf16_t*)(ws + WS_WC) + (size_t)layer * DM * 256;
        const bf16_t* WO = (const bf16_t*)(ws + WS_WO) + (size_t)layer * DM * DM;

        if (PHON(0) && ph == 0) {
            LAS float* scr = (LAS float*)(lds + wave * 16384);
            for (int l = 0; l < 2; ++l) {
                const float* w_in = args.in[4] + (size_t)l * DM * DIN;
                const float* gpre = args.in[2] + l * DM;
                bf16_t* win = (bf16_t*)(ws + WS_WIN) + (size_t)l * NG1 * DM;
                bf16_t* wg = (bf16_t*)(ws + WS_WG) + (size_t)l * DM * DM;
                bf16_t* wm = (bf16_t*)(ws + WS_WM) + (size_t)l * 3072 * DM;
                for (int job = 0; job < 7; ++job) {
                    int c0, nc, ro; bf16_t* dst; float sc = 1.f;
                    switch (job) {
                        case 0: c0 = 0; nc = 512; dst = win; ro = 0; sc = 0.125f; break;
                        case 1: c0 = 512; nc = 1024; dst = win; ro = 512; break;
                        case 2: c0 = 2560; nc = 512; dst = win; ro = 2048; break;
                        case 3: c0 = 1536; nc = 512; dst = wg; ro = 0; break;
                        case 4: c0 = 2304; nc = 256; dst = wg; ro = 512; break;
                        case 5: c0 = 3072; nc = 256; dst = wg; ro = 768; break;
                        default: c0 = 3328; nc = 3072; dst = wm; ro = 0; break;
                    }
                    const int nitems = (DM / 64) * (nc / 32);
                    for (int it = gw; it < nitems; it += NGW) transpose_item(w_in, DM, DIN, c0, nc, dst, ro, gpre, sc, scr, it, lane);
                }
                {   const int ni = (512 / 64) * (DM / 32);
                    for (int it = gw; it < ni; it += NGW) transpose_item(args.in[10] + (size_t)l * 512 * DM, 512, DM, 0, DM, (bf16_t*)(ws + WS_WA) + (size_t)l * DM * 512, 0, nullptr, 1.f, scr, it, lane); }
                {   const int ni = (256 / 64) * (DM / 32);
                    for (int it = gw; it < ni; it += NGW) transpose_item(args.in[11] + (size_t)l * 256 * DM, 256, DM, 0, DM, (bf16_t*)(ws + WS_WB) + (size_t)l * DM * 256, 0, nullptr, 1.f, scr, it, lane);
                    for (int it = gw; it < ni; it += NGW) transpose_item(args.in[12] + (size_t)l * 256 * DM, 256, DM, 0, DM, (bf16_t*)(ws + WS_WC) + (size_t)l * DM * 256, 0, nullptr, 1.f, scr, it, lane); }
                {   const int ni = (DM / 64) * (DM / 32);
                    for (int it = gw; it < ni; it += NGW) transpose_item(args.in[13] + (size_t)l * DM * DM, DM, DM, 0, DM, (bf16_t*)(ws + WS_WO) + (size_t)l * DM * DM, 0, nullptr, 1.f, scr, it, lane); }
                LAS float* ctab = (LAS float*)(lds + 131072);
                if (l == 0) { if (tid < 64) { float sn, cs; sincospif((float)tid * (1.0f / 32.0f), &sn, &cs); ctab[tid] = cs; ctab[64 + tid] = sn; } __syncthreads(); }
                for (int idx = bx * 512 + tid; idx < DM * 256; idx += G * 512) {
                    const int k = idx >> 8, p = idx & 255, grp = p >> 6, mm = p & 63;
                    const f32x4* wrow = (const f32x4*)(w_in + (size_t)k * DIN + 2048 + grp * 64);
                    float are = 0.f, aim = 0.f;
#pragma unroll 4
                    for (int c4 = 0; c4 < 16; ++c4) { const f32x4 w = wrow[c4];
#pragma unroll
                        for (int e = 0; e < 4; ++e) { const int t = (mm * (4 * c4 + e)) & 63; are += w[e] * ctab[t]; aim -= w[e] * ctab[64 + t]; } }
                    const float gk = gpre[k];
                    win[(size_t)(1536 + p) * DM + k] = (bf16_t)f2bf(are * gk);
                    win[(size_t)(1536 + 256 + p) * DM + k] = (bf16_t)f2bf(aim * gk);
                }
            }
            for (int idx = bx * 512 + tid; idx < 512 * 512; idx += G * 512) {
                const int kp = idx >> 9, lp = idx & 511; float sn, cs; sincospif((float)((kp * lp) & 511) * (1.0f / 256.0f), &sn, &cs);
                TT[(size_t)kp * 1024 + lp] = (bf16_t)f2bf(cs); TT[(size_t)kp * 1024 + 512 + lp] = (bf16_t)f2bf(sn);
            }
        }
        if (PHON(1) && (ph == 0 || sub == 6)) {
            const int mode = (ph == 0) ? 0 : (layer == 0 ? 1 : 2);
            const float* gpost = args.in[3] + layer * DM;
            for (int m = gw; m < MTOK; m += NGW) {
                const float* xin = (mode == 2) ? (out + (size_t)m * DM) : ((m < MP) ? x_prompt + (size_t)m * DM : x_sample + (size_t)(m - MP) * DM);
                const f32x4* xr = (const f32x4*)xin + lane;
                f32x4 v[4];
#pragma unroll
                for (int j = 0; j < 4; ++j) v[j] = xr[64 * j];
                if (mode != 0) {
                    const float rq = rsqrtf(SS[m] * (1.0f / DM) + EPS);
                    const u32x2* orow = (const u32x2*)(OB + (size_t)m * DM) + lane;
#pragma unroll
                    for (int j = 0; j < 4; ++j) { const u32x2 ov = orow[64 * j]; const f32x4 gp = *((const f32x4*)gpost + lane + 64 * j);
                        v[j][0] += bflo(ov.x) * rq * gp[0]; v[j][1] += bfhi(ov.x) * rq * gp[1]; v[j][2] += bflo(ov.y) * rq * gp[2]; v[j][3] += bfhi(ov.y) * rq * gp[3]; }
                    f32x4* orow2 = (f32x4*)(out + (size_t)m * DM) + lane;
#pragma unroll
                    for (int j = 0; j < 4; ++j) orow2[64 * j] = v[j];
                }
                if (mode != 2) {
                    float s = 0.f;
#pragma unroll
                    for (int j = 0; j < 4; ++j) s += (v[j][0] * v[j][0] + v[j][1] * v[j][1]) + (v[j][2] * v[j][2] + v[j][3] * v[j][3]);
                    s = wave_sum(s);
                    const float rsv = rsqrtf(s * (1.0f / DM) + EPS);
                    u32x2* o8 = (u32x2*)(XB + (size_t)m * DM) + lane;
#pragma unroll
                    for (int j = 0; j < 4; ++j) { u32x2 w; w.x = pk2(v[j][0] * rsv, v[j][1] * rsv); w.y = pk2(v[j][2] * rsv, v[j][3] * rsv); o8[64 * j] = w; }
                    if (lane == 0) { SS[m] = 0.f; }
                }
            }
        } else if (PHON(2) && sub == 0) {
            pg8::Gemm g{XB, WIN, MTOK, NG1, DM, DM, DM}; pg8::StaticOrder S; S.init(MTOK, NG1, G, bx);
            pg8::EpiG1 E{RS, ZM, ZT};
            pg8::gemm_phase<pg8::EpiG1, pg8::StaticOrder, true>(lds, g, S, E);
        } else if (sub == 1) {
            if (PHON(3)) {
                const float* rpb = args.in[5] + (size_t)layer * 8 * 15 * 31;
                for (int un = bx; un < 512; un += G) {
                    if (un < 256) attn_unit(lds, (un >> 3) * 2048, 32, 0, 32, un & 7, tid, lane, wave, ZM, ZT, Y, rpb);
                    else { const int v = un - 256, st = v & 7; attn_unit(lds, MP + (v >> 6) * 8192, 128, st * 16, st * 16 + 16, (v >> 3) & 7, tid, lane, wave, ZM, ZT, Y, rpb); }
                }
            }
            if (PHON(4)) {
                LAS float* hbuf = (LAS float*)lds; LAS float* cbuf = (LAS float*)(lds + 65536);
                const float* dww = args.in[6] + (size_t)layer * 31 * 256; const float* dwb = args.in[7] + layer * 256;
                const float* lng = args.in[8] + layer * 256; const float* lnb = args.in[9] + layer * 256;
                const int c = tid & 255, half = tid >> 8;
                float w[31];
#pragma unroll
                for (int j = 0; j < 31; ++j) w[j] = dww[j * 256 + c];
                const float bc = dwb[c];
                const f32x4 lg = *((const f32x4*)lng + lane), lb = *((const f32x4*)lnb + lane);
                u32x4 pa[4], pb[4];
#define CONV_ISSUE(cu_) do { const int t0g_ = (cu_) * 32; \
                    int sbeg_, send_; if (t0g_ < MP) { sbeg_ = t0g_ & ~2047; send_ = sbeg_ + 2048; } else { sbeg_ = MP + ((t0g_ - MP) & ~8191); send_ = sbeg_ + 8192; } \
                    _Pragma("unroll") for (int k = 0; k < 4; ++k) { \
                        const int it = tid + k * 512, i = it >> 5, c8 = (it & 31) * 8; const int tok = t0g_ - 15 + i; \
                        int tokc = tok < sbeg_ ? sbeg_ : tok; tokc = tokc > send_ - 1 ? send_ - 1 : tokc;     \
                        const u32x4 la_ = *(const GAS u32x4*)((const GAS bf16_t*)ZM + (size_t)tokc * ZMW + 1024 + c8), lb_ = *(const GAS u32x4*)((const GAS bf16_t*)ZM + (size_t)tokc * ZMW + 1280 + c8); \
                        const unsigned keep_ = (tok >= sbeg_ && tok < send_) ? 0xffffffffu : 0u; \
                        pa[k].x = la_.x & keep_; pa[k].y = la_.y & keep_; pa[k].z = la_.z & keep_; pa[k].w = la_.w & keep_; pb[k] = lb_; \
                    } } while (0)
                for (int cu = bx; cu < MTOK / 32; cu += G) {
                    const int t0g = cu * 32;
                    CONV_ISSUE(cu);
#pragma unroll
                    for (int k = 0; k < 4; ++k) {
                        const int it = tid + k * 512, i = it >> 5, c8 = (it & 31) * 8;
                        if (it < 62 * 32) {
                            const u32x4 a = pa[k], b = pb[k]; f32x4 h0, h1;
                            h0[0] = bflo(a.x) * sigmoidf_(bflo(b.x)); h0[1] = bfhi(a.x) * sigmoidf_(bfhi(b.x)); h0[2] = bflo(a.y) * sigmoidf_(bflo(b.y)); h0[3] = bfhi(a.y) * sigmoidf_(bfhi(b.y));
                            h1[0] = bflo(a.z) * sigmoidf_(bflo(b.z)); h1[1] = bfhi(a.z) * sigmoidf_(bfhi(b.z)); h1[2] = bflo(a.w) * sigmoidf_(bflo(b.w)); h1[3] = bfhi(a.w) * sigmoidf_(bfhi(b.w));
                            *(LAS f32x4*)(hbuf + i * 256 + c8) = h0; *(LAS f32x4*)(hbuf + i * 256 + c8 + 4) = h1;
                        }
                    }
                    __syncthreads();
                    {   float hv[46];
#pragma unroll
                        for (int i = 0; i < 46; ++i) hv[i] = hbuf[(half * 16 + i) * 256 + c];
#pragma unroll
                        for (int tt = 0; tt < 16; ++tt) {
                            float a = bc;
#pragma unroll
                            for (int j = 0; j < 31; ++j) a += w[j] * hv[tt + j];
                            cbuf[(half * 16 + tt) * 256 + c] = a;
                        }
                    }
                    __syncthreads();
#pragma unroll
                    for (int tt = 0; tt < 4; ++tt) {
                        const int t = wave * 4 + tt;
                        const f32x4 xv = *(const LAS f32x4*)(cbuf + t * 256 + 4 * lane);
                        const float mean = wave_sum((xv[0] + xv[1]) + (xv[2] + xv[3])) * (1.0f / 256.0f);
                        const f32x4 d = xv - mean;
                        const float var = wave_sum((d[0] * d[0] + d[1] * d[1]) + (d[2] * d[2] + d[3] * d[3])) * (1.0f / 256.0f);
                        const float rstd = rsqrtf(var + EPS);
                        const float y0 = siluf_(d[0] * rstd * lg[0] + lb[0]), y1 = siluf_(d[1] * rstd * lg[1] + lb[1]), y2 = siluf_(d[2] * rstd * lg[2] + lb[2]), y3 = siluf_(d[3] * rstd * lg[3] + lb[3]);
                        u32x2 wv; wv.x = pk2(y0, y1); wv.y = pk2(y2, y3);
                        *(GAS u32x2*)((GAS bf16_t*)Y + (size_t)(t0g + t) * DM + 768 + 4 * lane) = wv;
                    }
                }
            }
            if (PHON(5)) {
                float t4r[4], t4i[4], t16r[16], t16i[16];
                {   const float s4 = rsqrtf(64.0f * 2048.0f), s16 = rsqrtf(64.0f * 8192.0f);
#pragma unroll
                    for (int q = 0; q < 4; ++q) { float sn, cs; sincospif(-2.0f * (float)(q * tid) / 2048.0f, &sn, &cs); t4r[q] = cs * s4; t4i[q] = sn * s4; }
#pragma unroll
                    for (int q = 0; q < 16; ++q) { float sn, cs; sincospif(-2.0f * (float)(q * tid) / 8192.0f, &sn, &cs); t16r[q] = cs * s16; t16i[q] = sn * s16; } }
                for (int un = bx; un < 32 * 64; un += G) { const int seq = un >> 6, p = (un & 63) * 4; butterfly_unit<4, 4>(seq * 2048, seq * 1024 + p, p, tid, ZT, YQ, t4r, t4i); }
                for (int un = bx; un < 4 * 128; un += G) { const int seq = un >> 7, p = (un & 127) * 2; butterfly_unit<16, 2>(MP + seq * 8192, 32768 + seq * 4096 + p, p, tid, ZT, YQ, t16r, t16i); }
            }
        } else if (PHON(6) && sub == 2) {
            pg8::Gemm g{YQ, TT, NYQ, 512, 1024, 1024, 1024}; pg8::StaticOrder S; S.init(NYQ, 512, G, bx);
            pg8::EpiDFT E{Y};
            pg8::gemm_phase<pg8::EpiDFT, pg8::StaticOrder, true>(lds, g, S, E);
        } else if (PHON(7) && sub == 3) {
            pg8::Gemm g{XB, WG, MTOK, DM, DM, DM, DM}; pg8::StaticOrder S; S.init(MTOK, DM, G, bx);
            pg8::EpiG2 E{RS, Y};
            pg8::gemm_phase<pg8::EpiG2, pg8::StaticOrder, true>(lds, g, S, E);
        } else if (sub == 4) {
            pg8::ProgG34 PG; PG.S.init(MTOK, DM, G, bx); PG.Y = Y; PG.XB = XB; PG.wsb = (const char*)ws; PG.WM = WM; PG.layer = layer;
            pg8::EpiG34 EG{RS, PB + (size_t)bx * 65536, PB + (size_t)(256 + bx) * 65536, MG};
            pg8::gemm_multi<pg8::EpiG34, pg8::ProgG34>(lds, PG, EG);
        } else if (PHON(10) && sub == 5) {
            pg8::Gemm g{MG, WO, MTOK, DM, DM, DM, DM}; pg8::StaticOrder S; S.init(MTOK, DM, G, bx);
            pg8::EpiG5 E{OB, SS};
            pg8::gemm_phase<pg8::EpiG5, pg8::StaticOrder, true>(lds, g, S, E);
        }
    }
}

extern "C" void kernel_launch(void* const* d_in, const int* in_sizes, int n_in, void* d_out, int out_size, void* d_ws, size_t ws_size, hipStream_t stream) {
    static int grid = 0;
    if (grid == 0) {
        if (n_in != 14 || ws_size < WS_END) { fprintf(stderr, "kernel_launch: bad inputs (n_in %d, ws %zu < %zu)\n", n_in, ws_size, (size_t)WS_END); grid = -1; return; }
        int dev = 0, cus = 0, per_cu = 0;
        hipGetDevice(&dev); hipDeviceGetAttribute(&cus, hipDeviceAttributeMultiprocessorCount, dev);
        if (hipFuncSetAttribute((const void*)fwd_kernel, hipFuncAttributeMaxDynamicSharedMemorySize, LDS_BYTES) != hipSuccess) { fprintf(stderr, "hipFuncSetAttribute failed\n"); grid = -1; return; }
        hipOccupancyMaxActiveBlocksPerMultiprocessor(&per_cu, (const void*)fwd_kernel, NWAVES * 64, LDS_BYTES);
        (void)hipGetLastError();
        if (per_cu < 1) { fprintf(stderr, "occupancy query says 0 blocks per CU\n"); }
        grid = cus;
    }
    if (grid < 0) return;
    Args a{};
    for (int i = 0; i < 14; ++i) a.in[i] = (const float*)d_in[i];
    a.out = (float*)d_out; a.ws = (unsigned char*)d_ws;
#if MK_ONE_LAUNCH
    a.ph_lo = 0; a.ph_hi = 15;
    void* kargs[] = {&a};
    hipError_t e = hipLaunchCooperativeKernel((const void*)fwd_kernel, dim3(grid), dim3(NWAVES * 64), kargs, LDS_BYTES, stream);
    if (e != hipSuccess) fprintf(stderr, "cooperative launch failed: %s (grid %d)\n", hipGetErrorString(e), grid);
#else
    for (int ph = 0; ph < 15; ++ph) {
        a.ph_lo = ph; a.ph_hi = ph + 1;
        hipLaunchKernelGGL(fwd_kernel, dim3(grid), dim3(NWAVES * 64), LDS_BYTES, stream, a);
    }
#endif
}
```

```cpp
#include <hip/hip_runtime.h>
#include <hip/hip_cooperative_groups.h>
#include <cstdio>
#include <cstdint>
namespace cg = cooperative_groups;

#ifndef MK_ONE_LAUNCH
#define MK_ONE_LAUNCH 1
#endif

#ifndef PH_MASK
#define PH_MASK 0xFFFF
#endif
#define PHON(k) (((PH_MASK) >> (k)) & 1)
#define LAS __attribute__((address_space(3)))
typedef unsigned short bf16_t;
typedef short bf16x8 __attribute__((ext_vector_type(8)));
typedef short s16x4 __attribute__((ext_vector_type(4)));
typedef float f32x4 __attribute__((ext_vector_type(4)));
typedef unsigned u32x4 __attribute__((ext_vector_type(4)));
typedef unsigned u32x2 __attribute__((ext_vector_type(2)));

constexpr int DM = 1024;
constexpr int MP = 65536;
constexpr int MTOK = 98304;
constexpr int DIN = 6400;
constexpr int NG1 = 2560;
constexpr int ZMW = 1536;
constexpr int NYQ = 49152;
constexpr float EPS = 1e-6f;

constexpr size_t MiB = 1u << 20;
constexpr size_t WS_WIN = 0;
constexpr size_t WS_WG = 10 * MiB;
constexpr size_t WS_WM = 14 * MiB;
constexpr size_t WS_WA = 26 * MiB;
constexpr size_t WS_WB = 28 * MiB;
constexpr size_t WS_WC = 29 * MiB;
constexpr size_t WS_WO = 30 * MiB;
constexpr size_t WS_T = 34 * MiB;
constexpr size_t WS_RS = 35 * MiB;
constexpr size_t WS_SS = 35 * MiB + 512 * 1024;
constexpr size_t WS_XB = 36 * MiB;
constexpr size_t WS_ZM = 228 * MiB;
constexpr size_t WS_ZT = 516 * MiB;
constexpr size_t WS_YQ = 708 * MiB;
constexpr size_t WS_Y = 804 * MiB;
constexpr size_t WS_END = 996 * MiB;

constexpr int NWAVES = 8;
constexpr int LDS_BYTES = 147456;

__device__ __forceinline__ unsigned f2bf(float f) { unsigned u = __builtin_bit_cast(unsigned, f); return (u + 0x7fffu + ((u >> 16) & 1u)) >> 16; }
__device__ __forceinline__ unsigned pk2(float lo, float hi) { unsigned r; asm("v_cvt_pk_bf16_f32 %0, %1, %2" : "=v"(r) : "v"(lo), "v"(hi)); return r; }
__device__ __forceinline__ float bf2f(unsigned b) { return __builtin_bit_cast(float, b << 16); }
__device__ __forceinline__ float bflo(unsigned w) { return __builtin_bit_cast(float, w << 16); }
__device__ __forceinline__ float bfhi(unsigned w) { return __builtin_bit_cast(float, w & 0xffff0000u); }
__device__ __forceinline__ float sigmoidf_(float x) { return __builtin_amdgcn_rcpf(1.0f + __expf(-x)); }
__device__ __forceinline__ float siluf_(float x) { return x * __builtin_amdgcn_rcpf(1.0f + __expf(-x)); }
__device__ __forceinline__ float wave_sum(float v) {
#pragma unroll
    for (int o = 1; o < 64; o <<= 1) v += __shfl_xor(v, o);
    return v;
}
#define LDS_WAIT() asm volatile("s_waitcnt lgkmcnt(0)" ::: "memory")
#define GAS __attribute__((address_space(1)))

namespace pg8 {
constexpr int BM = 256, BK = 64, HALF = 128, HTB = HALF * BK * 2, STAGE_BYTES = 8 * HTB, NXCD = 8, WGM = 8;
__device__ __forceinline__ int lds_byte(int r, int c) { const int st = (r >> 4) * 2 + (c >> 5), rr = r & 15, cc = c & 31, ob = rr * 64 + cc * 2; return st * 1024 + (ob ^ (((ob >> 9) & 1) << 5)); }
__device__ __forceinline__ void stage_rc(int b, int& R, int& C) { const int st = b / 1024, sb = b % 1024, swz = sb ^ (((sb >> 9) & 1) << 5); R = (st >> 1) * 16 + swz / 64; C = (st & 1) * 32 + (swz % 64) / 2; }

__device__ __forceinline__ int perm32(int rho) { const int n = rho >> 4, i = rho & 15; return 8 * (i >> 2) + 4 * n + (i & 3); }
struct Unit { int pm, pn; };
struct Gemm { const bf16_t* A; const bf16_t* Bt; int M, N, K, lda, ldb; };

struct StaticOrder {
    int nM, nN, nwg, G, c;
    __device__ __forceinline__ void init(int M, int N, int G_, int c_) { nM = M / BM; nN = N / BM; nwg = nM * nN; G = G_; c = c_; }
    __device__ __forceinline__ bool next(int i, Unit& u) const {
        const long L = (long)i * G + c; if (L >= nwg) return false;
        int wgid = (int)L; { const int q = nwg / NXCD, r = nwg % NXCD, xcd = wgid % NXCD, off = wgid / NXCD; wgid = (xcd < r ? xcd * (q + 1) : r * (q + 1) + (xcd - r) * q) + off; }
        const int nig = WGM * nN, gid = wgid / nig, fm = gid * WGM, gsz = (nM - fm) < WGM ? (nM - fm) : WGM;
        u.pm = fm + ((wgid % nig) % gsz); u.pn = (wgid % nig) / gsz; return true;
    }
};

struct SingleUnit { Unit u; __device__ bool next(int i, Unit& o) const { if (i) return false; o = u; return true; } };
template <class Epi, class Sched, bool ALIGN_EPI>
__device__ __forceinline__ void gemm_phase(LAS unsigned char* lds, const Gemm g, const Sched& S, const Epi& E) {
    int tid = threadIdx.x; asm volatile("" : "+v"(tid));
    const int wid = __builtin_amdgcn_readfirstlane(tid >> 6), lane = tid & 63, wr = wid >> 2, wc = wid & 3, fr = lane & 15, fq = lane >> 4;
    const int K = g.K, nt = K / BK;
    unsigned voffA[2], voffB[2];
#pragma unroll
    for (int i = 0; i < 2; ++i) { int R, C; stage_rc(tid * 16 + i * 8192, R, C);
        const int Rb = (R & ~31) + perm32(R & 31);
        voffA[i] = (unsigned)(R * g.lda + C) * 2u; voffB[i] = (unsigned)(Rb * g.ldb + C) * 2u; }
    const size_t kstep = (size_t)(BK * 2);
    const size_t hstepA = (size_t)HALF * g.lda * 2, hstepB = (size_t)HALF * g.ldb * 2;
    const size_t tstepA = 2 * hstepA, tstepB = 2 * hstepB;
    const unsigned ldsw = (unsigned)wid * 1024u;
    const int aoff = lds_byte(wr * 64 + fr, fq * 8), boff = lds_byte(wc * 32 + fr, fq * 8);
#define PG8_SA(b, h) (((b) * 2 + (h)) * HTB)
#define PG8_SB(b, h) ((4 + (b) * 2 + (h)) * HTB)
#define PG8_STAGE(bufoff, gbase, voff) do { _Pragma("unroll") for (int _i = 0; _i < 2; ++_i) \
        __builtin_amdgcn_global_load_lds((const unsigned*)((const char*)(gbase) + (voff)[_i]), (LAS unsigned*)(lds + (bufoff) + ldsw + _i * 8192), 16, 0, 0); } while (0)
#define PG8_LDA(dst, b, h) do { _Pragma("unroll") for (int m = 0; m < 4; ++m) _Pragma("unroll") for (int k = 0; k < 2; ++k) dst[m][k] = *(const LAS bf16x8*)(lds + PG8_SA(b, h) + aoff + m * 2048 + k * 1024); } while (0)
#define PG8_LDB(dst, b, h) do { _Pragma("unroll") for (int n = 0; n < 2; ++n) _Pragma("unroll") for (int k = 0; k < 2; ++k) dst[n][k] = *(const LAS bf16x8*)(lds + PG8_SB(b, h) + boff + n * 2048 + k * 1024); } while (0)
#define PG8_MMA(ai, bj, At, Bt) do { __builtin_amdgcn_s_setprio(1); _Pragma("unroll") for (int m = 0; m < 4; ++m) _Pragma("unroll") for (int n = 0; n < 2; ++n) _Pragma("unroll") for (int k = 0; k < 2; ++k) \
        acc[ai][bj][m][n] = __builtin_amdgcn_mfma_f32_16x16x32_bf16(Bt[n][k], At[m][k], acc[ai][bj][m][n], 0, 0, 0); __builtin_amdgcn_s_setprio(0); } while (0)
#define PG8_WAIT_V(n) asm volatile("s_waitcnt vmcnt(" #n ")" ::: "memory")
#define PG8_WAIT_L(n) asm volatile("s_waitcnt lgkmcnt(" #n ")" ::: "memory")
#define PG8_BAR __builtin_amdgcn_s_barrier()
#define PG8_SCHED __builtin_amdgcn_sched_barrier(0)
    Unit cur, nxt; int ui = 0;
    if (!S.next(0, cur)) return;
    f32x4 acc[2][2][4][2];
#pragma unroll
    for (int a = 0; a < 2; ++a)
#pragma unroll
        for (int b = 0; b < 2; ++b)
#pragma unroll
            for (int m = 0; m < 4; ++m)
#pragma unroll
                for (int n = 0; n < 2; ++n) acc[a][b][m][n] = (f32x4){0.f, 0.f, 0.f, 0.f};
    bf16x8 At[4][2], B0[2][2], B1[2][2];
    const char* cA = (const char*)g.A + (size_t)cur.pm * tstepA; const char* cB = (const char*)g.Bt + (size_t)cur.pn * tstepB;
    PG8_STAGE(PG8_SB(0, 0), cB, voffB); PG8_STAGE(PG8_SB(0, 1), cB + hstepB, voffB); PG8_STAGE(PG8_SA(0, 0), cA, voffA); PG8_STAGE(PG8_SA(0, 1), cA + hstepA, voffA);
    if (wr == 1) PG8_BAR;
    PG8_WAIT_V(2); PG8_BAR;
    PG8_STAGE(PG8_SB(1, 0), cB + kstep, voffB); PG8_STAGE(PG8_SA(1, 0), cA + kstep, voffA); PG8_STAGE(PG8_SB(1, 1), cB + hstepB + kstep, voffB);
    PG8_WAIT_V(6); PG8_BAR;
    for (;;) {
        const bool has_next = S.next(ui + 1, nxt);
        const char* nA = has_next ? (const char*)g.A + (size_t)nxt.pm * tstepA : cA; const char* nB = has_next ? (const char*)g.Bt + (size_t)nxt.pn * tstepB : cB;
        for (int t = 0; t < nt; t += 2) {
            const bool last = (t == nt - 2);
            const char* a1 = cA + (size_t)(t + 1) * kstep;
            const char* a2 = last ? nA : cA + (size_t)(t + 2) * kstep; const char* b2 = last ? nB : cB + (size_t)(t + 2) * kstep;
            const char* a3 = a2 + kstep; const char* b3 = b2 + kstep;
            PG8_LDB(B0, 0, 0); PG8_LDB(B1, 0, 1); PG8_SCHED; PG8_LDA(At, 0, 0); PG8_STAGE(PG8_SA(1, 1), a1 + hstepA, voffA);
            PG8_WAIT_V(8); PG8_WAIT_L(0); PG8_BAR; PG8_MMA(0, 0, At, B0); PG8_MMA(0, 1, At, B1); PG8_BAR; PG8_SCHED;
            PG8_LDA(At, 0, 1); PG8_STAGE(PG8_SB(0, 0), b2, voffB); PG8_STAGE(PG8_SB(0, 1), b2 + hstepB, voffB); PG8_STAGE(PG8_SA(0, 0), a2, voffA);
            PG8_WAIT_V(8); PG8_WAIT_L(0); PG8_BAR; PG8_MMA(1, 0, At, B0); PG8_MMA(1, 1, At, B1); PG8_BAR; PG8_SCHED;
            PG8_LDB(B0, 1, 0); PG8_LDB(B1, 1, 1); PG8_SCHED; PG8_LDA(At, 1, 0); PG8_STAGE(PG8_SA(0, 1), a2 + hstepA, voffA);
            PG8_WAIT_V(8); PG8_WAIT_L(0); PG8_BAR; PG8_MMA(0, 0, At, B0); PG8_MMA(0, 1, At, B1); PG8_BAR; PG8_SCHED;
            PG8_LDA(At, 1, 1); PG8_STAGE(PG8_SB(1, 0), b3, voffB); PG8_STAGE(PG8_SB(1, 1), b3 + hstepB, voffB); PG8_STAGE(PG8_SA(1, 0), a3, voffA);
            PG8_WAIT_V(8); PG8_WAIT_L(0); PG8_BAR; PG8_MMA(1, 0, At, B0); PG8_MMA(1, 1, At, B1); PG8_BAR; PG8_SCHED;
        }
        if constexpr (ALIGN_EPI) { if (wr == 0) PG8_BAR; }
        E(acc, cur, wr, wc, fr, fq);
        if (!has_next) break;
#pragma unroll
        for (int a = 0; a < 2; ++a)
#pragma unroll
            for (int b = 0; b < 2; ++b)
#pragma unroll
                for (int m = 0; m < 4; ++m)
#pragma unroll
                    for (int n = 0; n < 2; ++n) acc[a][b][m][n] = (f32x4){0.f, 0.f, 0.f, 0.f};
        cur = nxt; cA = nA; cB = nB; ++ui;
        if constexpr (ALIGN_EPI) { if (wr == 1) PG8_BAR; }
    }
    PG8_WAIT_V(0);
    if constexpr (!ALIGN_EPI) { if (wr == 0) PG8_BAR; }
    PG8_BAR;
#undef PG8_SA
#undef PG8_SB
#undef PG8_STAGE
#undef PG8_LDA
#undef PG8_LDB
#undef PG8_MMA
#undef PG8_WAIT_V
#undef PG8_WAIT_L
#undef PG8_BAR
#undef PG8_SCHED
}

struct UnitX { int pm, pn, seg; };
__device__ __forceinline__ int uni(int v) { return __builtin_amdgcn_readfirstlane(v); }
__device__ __forceinline__ const char* unip(const char* p) { const unsigned long long v = (unsigned long long)p; const unsigned lo = (unsigned)__builtin_amdgcn_readfirstlane((int)(unsigned)v), hi = (unsigned)__builtin_amdgcn_readfirstlane((int)(unsigned)(v >> 32)); return (const char*)(((unsigned long long)hi << 32) | lo); }
template <class Epi, class Prog>
__device__ __forceinline__ void gemm_multi(LAS unsigned char* lds, const Prog& P, const Epi& E) {
    int tid = threadIdx.x; asm volatile("" : "+v"(tid));
    const int wid = __builtin_amdgcn_readfirstlane(tid >> 6), lane = tid & 63, wr = wid >> 2, wc = wid & 3, fr = lane & 15, fq = lane >> 4;
    unsigned Rr[2], RrB[2], Cc2[2];
#pragma unroll
    for (int i = 0; i < 2; ++i) { int R, C; stage_rc(tid * 16 + i * 8192, R, C); Rr[i] = (unsigned)R * 2u; RrB[i] = (unsigned)((R & ~31) + perm32(R & 31)) * 2u; Cc2[i] = (unsigned)C * 2u; }
    const size_t kstep = (size_t)(BK * 2);
    const unsigned ldsw = (unsigned)wid * 1024u;
    const int aoff = lds_byte(wr * 64 + fr, fq * 8), boff = lds_byte(wc * 32 + fr, fq * 8);
#define PG8_SA(b, h) (((b) * 2 + (h)) * HTB)
#define PG8_SB(b, h) ((4 + (b) * 2 + (h)) * HTB)
#define PG8_STAGE_X(RR, bufoff, gbase, ld) do { _Pragma("unroll") for (int _i = 0; _i < 2; ++_i) \
        __builtin_amdgcn_global_load_lds((const unsigned*)((const char*)(gbase) + (RR[_i] * (unsigned)(ld) + Cc2[_i])), (LAS unsigned*)(lds + (bufoff) + ldsw + _i * 8192), 16, 0, 0); } while (0)
#define PG8_STAGE(bufoff, gbase, ld) PG8_STAGE_X(Rr, bufoff, gbase, ld)
#define PG8_STAGEB(bufoff, gbase, ld) PG8_STAGE_X(RrB, bufoff, gbase, ld)
#define PG8_LDA(dst, b, h) do { _Pragma("unroll") for (int m = 0; m < 4; ++m) _Pragma("unroll") for (int k = 0; k < 2; ++k) dst[m][k] = *(const LAS bf16x8*)(lds + PG8_SA(b, h) + aoff + m * 2048 + k * 1024); } while (0)
#define PG8_LDB(dst, b, h) do { _Pragma("unroll") for (int n = 0; n < 2; ++n) _Pragma("unroll") for (int k = 0; k < 2; ++k) dst[n][k] = *(const LAS bf16x8*)(lds + PG8_SB(b, h) + boff + n * 2048 + k * 1024); } while (0)
#define PG8_MMA(ai, bj, At, Bt) do { __builtin_amdgcn_s_setprio(1); _Pragma("unroll") for (int m = 0; m < 4; ++m) _Pragma("unroll") for (int n = 0; n < 2; ++n) _Pragma("unroll") for (int k = 0; k < 2; ++k) \
        acc[ai][bj][m][n] = __builtin_amdgcn_mfma_f32_16x16x32_bf16(Bt[n][k], At[m][k], acc[ai][bj][m][n], 0, 0, 0); __builtin_amdgcn_s_setprio(0); } while (0)
#define PG8_WAIT_V(n) asm volatile("s_waitcnt vmcnt(" #n ")" ::: "memory")
#define PG8_WAIT_L(n) asm volatile("s_waitcnt lgkmcnt(" #n ")" ::: "memory")
#define PG8_BAR __builtin_amdgcn_s_barrier()
#define PG8_SCHED __builtin_amdgcn_sched_barrier(0)
    UnitX cur, nxt; int ui = 0;
    if (!P.next(0, cur)) return;
    f32x4 acc[2][2][4][2];
#pragma unroll
    for (int a = 0; a < 2; ++a)
#pragma unroll
        for (int b = 0; b < 2; ++b)
#pragma unroll
            for (int m = 0; m < 4; ++m)
#pragma unroll
                for (int n = 0; n < 2; ++n) acc[a][b][m][n] = (f32x4){0.f, 0.f, 0.f, 0.f};
    bf16x8 At[4][2], B0[2][2], B1[2][2];
    const char* cA; const char* cB; int lda, ldb, nt;
    P.desc(cur, cA, cB, lda, ldb, nt); cA = unip(cA); cB = unip(cB); lda = uni(lda); ldb = uni(ldb); nt = uni(nt);
    {   const size_t hA = (size_t)HALF * lda * 2, hB = (size_t)HALF * ldb * 2;
        PG8_STAGEB(PG8_SB(0, 0), cB, ldb); PG8_STAGEB(PG8_SB(0, 1), cB + hB, ldb); PG8_STAGE(PG8_SA(0, 0), cA, lda); PG8_STAGE(PG8_SA(0, 1), cA + hA, lda);
        if (wr == 1) PG8_BAR;
        PG8_WAIT_V(2); PG8_BAR;
        PG8_STAGEB(PG8_SB(1, 0), cB + kstep, ldb); PG8_STAGE(PG8_SA(1, 0), cA + kstep, lda); PG8_STAGEB(PG8_SB(1, 1), cB + hB + kstep, ldb);
        PG8_WAIT_V(6); PG8_BAR; }
    for (;;) {
        const bool has_next = P.next(ui + 1, nxt);
        const char* nA = cA; const char* nB = cB; int ldan = lda, ldbn = ldb, ntn = nt;
        if (has_next) P.desc(nxt, nA, nB, ldan, ldbn, ntn);
        nA = unip(nA); nB = unip(nB); ldan = uni(ldan); ldbn = uni(ldbn); ntn = uni(ntn);
        const size_t hAc = (size_t)HALF * lda * 2;
        for (int t = 0; t < nt; t += 2) {
            const bool last = (t == nt - 2);
            const char* a1 = cA + (size_t)(t + 1) * kstep;
            const char* a2 = last ? nA : cA + (size_t)(t + 2) * kstep; const char* b2 = last ? nB : cB + (size_t)(t + 2) * kstep;
            const int lda2 = last ? ldan : lda, ldb2 = last ? ldbn : ldb;
            const size_t hA2 = (size_t)HALF * lda2 * 2, hB2 = (size_t)HALF * ldb2 * 2;
            const char* a3 = a2 + kstep; const char* b3 = b2 + kstep;
            PG8_LDB(B0, 0, 0); PG8_LDB(B1, 0, 1); PG8_SCHED; PG8_LDA(At, 0, 0); PG8_STAGE(PG8_SA(1, 1), a1 + hAc, lda);
            PG8_WAIT_V(8); PG8_WAIT_L(0); PG8_BAR; PG8_MMA(0, 0, At, B0); PG8_MMA(0, 1, At, B1); PG8_BAR; PG8_SCHED;
            PG8_LDA(At, 0, 1); PG8_STAGEB(PG8_SB(0, 0), b2, ldb2); PG8_STAGEB(PG8_SB(0, 1), b2 + hB2, ldb2); PG8_STAGE(PG8_SA(0, 0), a2, lda2);
            PG8_WAIT_V(8); PG8_WAIT_L(0); PG8_BAR; PG8_MMA(1, 0, At, B0); PG8_MMA(1, 1, At, B1); PG8_BAR; PG8_SCHED;
            PG8_LDB(B0, 1, 0); PG8_LDB(B1, 1, 1); PG8_SCHED; PG8_LDA(At, 1, 0); PG8_STAGE(PG8_SA(0, 1), a2 + hA2, lda2);
            PG8_WAIT_V(8); PG8_WAIT_L(0); PG8_BAR; PG8_MMA(0, 0, At, B0); PG8_MMA(0, 1, At, B1); PG8_BAR; PG8_SCHED;
            PG8_LDA(At, 1, 1); PG8_STAGEB(PG8_SB(1, 0), b3, ldb2); PG8_STAGEB(PG8_SB(1, 1), b3 + hB2, ldb2); PG8_STAGE(PG8_SA(1, 0), a3, lda2);
            PG8_WAIT_V(8); PG8_WAIT_L(0); PG8_BAR; PG8_MMA(1, 0, At, B0); PG8_MMA(1, 1, At, B1); PG8_BAR; PG8_SCHED;
        }
        if (wr == 0) PG8_BAR;
        E(acc, cur, wr, wc, fr, fq);
        if (!has_next) break;
#pragma unroll
        for (int a = 0; a < 2; ++a)
#pragma unroll
            for (int b = 0; b < 2; ++b)
#pragma unroll
                for (int m = 0; m < 4; ++m)
#pragma unroll
                    for (int n = 0; n < 2; ++n) acc[a][b][m][n] = (f32x4){0.f, 0.f, 0.f, 0.f};
        cur = nxt; cA = nA; cB = nB; lda = ldan; ldb = ldbn; nt = ntn; ++ui;
        if (wr == 1) PG8_BAR;
    }
    PG8_WAIT_V(0);
    PG8_BAR;
#undef PG8_SA
#undef PG8_SB
#undef PG8_STAGE
#undef PG8_STAGEB
#undef PG8_STAGE_X
#undef PG8_LDA
#undef PG8_LDB
#undef PG8_MMA
#undef PG8_WAIT_V
#undef PG8_WAIT_L
#undef PG8_BAR
#undef PG8_SCHED
}

#define EPI_ROWS_BEGIN  _Pragma("unroll") for (int ai = 0; ai < 2; ++ai) _Pragma("unroll") for (int m = 0; m < 4; ++m) { const int row = u.pm * BM + ai * HALF + wr * 64 + m * 16 + fr;
#define EPI_COLS_BEGIN  _Pragma("unroll") for (int bj = 0; bj < 2; ++bj) _Pragma("unroll") for (int n = 0; n < 2; ++n) { const int col = bj * HALF + wc * 32 + 8 * fq + 4 * n; f32x4 v = acc[ai][bj][m][n];
#define EPI_END } }
#define EPI_COLS8_BEGIN  _Pragma("unroll") for (int bj = 0; bj < 2; ++bj) { const int col = bj * HALF + wc * 32 + 8 * fq; const f32x4 v0 = acc[ai][bj][m][0], v1 = acc[ai][bj][m][1];

struct EpiG1 {
    const float* rs; bf16_t* ZM; bf16_t* ZT;
    __device__ __forceinline__ void operator()(const f32x4 (&acc)[2][2][4][2], const Unit& u, int wr, int wc, int fr, int fq) const {
        const int pn = u.pn;
        if (pn >= 4 && pn < 6) {
            const int d0 = (pn - 4) * 256;
            EPI_ROWS_BEGIN
            EPI_COLS_BEGIN
                GAS bf16_t* d = (GAS bf16_t*)ZT + ((size_t)(row >> 6) * 512 + d0 + col) * 64 + (row & 63);
                const unsigned w0 = pk2(v[0], v[1]), w1 = pk2(v[2], v[3]);
                d[0] = (bf16_t)w0; d[64] = (bf16_t)(w0 >> 16); d[128] = (bf16_t)w1; d[192] = (bf16_t)(w1 >> 16);
            EPI_END
        } else if (pn >= 6 && pn < 8) {
            const int j0 = (pn - 6) * 256;
            EPI_ROWS_BEGIN
            EPI_COLS_BEGIN
                GAS bf16_t* d = (GAS bf16_t*)ZT + (size_t)MTOK * 512 + ((size_t)(row >> 9) * 512 + j0 + col) * 512 + (row & 511);
                const unsigned w0 = pk2(v[0], v[1]), w1 = pk2(v[2], v[3]);
                d[0] = (bf16_t)w0; d[512] = (bf16_t)(w0 >> 16); d[1024] = (bf16_t)w1; d[1536] = (bf16_t)(w1 >> 16);
            EPI_END
        } else {
            const int cm = (pn < 4 ? pn : pn - 4) * 256;
            EPI_ROWS_BEGIN
            EPI_COLS8_BEGIN
                u32x4 w; w.x = pk2(v0[0], v0[1]); w.y = pk2(v0[2], v0[3]); w.z = pk2(v1[0], v1[1]); w.w = pk2(v1[2], v1[3]);
                *(GAS u32x4*)((GAS bf16_t*)ZM + (size_t)row * ZMW + cm + col) = w;
            EPI_END
        }
    }
};
struct EpiDFT {
    bf16_t* Y;
    __device__ __forceinline__ void operator()(const f32x4 (&acc)[2][2][4][2], const Unit& u, int wr, int wc, int fr, int fq) const {
        int tok0, R, q;
        if (u.pm < 128) { tok0 = (u.pm >> 2) * 2048; R = 4; q = u.pm & 3; } else { const int t = u.pm - 128; tok0 = MP + (t >> 4) * 8192; R = 16; q = t & 15; }
        EPI_ROWS_BEGIN const int p = row - u.pm * BM;
        EPI_COLS_BEGIN
            const int k0 = u.pn * BM + col;
            GAS bf16_t* d = (GAS bf16_t*)Y + (size_t)(tok0 + R * k0 + q) * DM + 512 + p;
            const unsigned w0 = pk2(v[0], v[1]), w1 = pk2(v[2], v[3]);
            d[0] = (bf16_t)w0; d[(size_t)R * DM] = (bf16_t)(w0 >> 16); d[(size_t)2 * R * DM] = (bf16_t)w1; d[(size_t)3 * R * DM] = (bf16_t)(w1 >> 16);
        EPI_END
    }
};
struct EpiG2 {
    const float* rs; bf16_t* Y;
    __device__ __forceinline__ void operator()(const f32x4 (&acc)[2][2][4][2], const Unit& u, int wr, int wc, int fr, int fq) const {
        EPI_ROWS_BEGIN
        EPI_COLS8_BEGIN
            GAS u32x4* p = (GAS u32x4*)((GAS bf16_t*)Y + (size_t)row * DM + u.pn * BM + col);
            const u32x4 y = *p; u32x4 w;
            w.x = pk2(bflo(y.x) * siluf_(v0[0]), bfhi(y.x) * siluf_(v0[1])); w.y = pk2(bflo(y.y) * siluf_(v0[2]), bfhi(y.y) * siluf_(v0[3]));
            w.z = pk2(bflo(y.z) * siluf_(v1[0]), bfhi(y.z) * siluf_(v1[1])); w.w = pk2(bflo(y.w) * siluf_(v1[2]), bfhi(y.w) * siluf_(v1[3]));
            *p = w;
        EPI_END
    }
};
struct ProgG34 {
    StaticOrder S; const bf16_t* Y; const bf16_t* XB; const char* wsb; const bf16_t* WM; int layer;
    __device__ __forceinline__ bool next(int i, UnitX& u) const { Unit t; if (!S.next(i / 6, t)) return false; u.pm = t.pm; u.pn = t.pn; u.seg = i % 6; return true; }
    __device__ __forceinline__ void desc(const UnitX& u, const char*& A, const char*& B, int& lda, int& ldb, int& nt) const {
        const int b = u.seg >> 1; lda = DM;
        if (u.seg & 1) { A = (const char*)(XB + (size_t)u.pm * BM * DM); B = (const char*)(WM + (size_t)b * DM * DM + (size_t)u.pn * BM * DM); ldb = DM; nt = DM / BK; }
        else { const int kb = (b == 0) ? 512 : 256, ac = (b == 0) ? 0 : (b == 1 ? 512 : 768);
            const size_t woff = (size_t)((b == 0) ? 26 : 27 + b) * MiB + (size_t)layer * ((b == 0) ? MiB : MiB / 2);
            const bf16_t* w = (const bf16_t*)(wsb + woff);
            A = (const char*)(Y + (size_t)u.pm * BM * DM + ac); B = (const char*)(w + (size_t)u.pn * BM * kb); ldb = kb; nt = kb / BK; }
    }
};
struct EpiG34 {
    const float* rs; bf16_t* PT; bf16_t* MT; bf16_t* MG;
    __device__ __forceinline__ void operator()(const f32x4 (&acc)[2][2][4][2], const UnitX& u, int wr, int wc, int fr_, int fq_) const {
        int fr = fr_, fq = fq_; asm volatile("" : "+v"(fr), "+v"(fq));
        if ((u.seg & 1) == 0) {
            EPI_ROWS_BEGIN
            EPI_COLS8_BEGIN
                u32x4 w; w.x = pk2(v0[0], v0[1]); w.y = pk2(v0[2], v0[3]); w.z = pk2(v1[0], v1[1]); w.w = pk2(v1[2], v1[3]);
                *(GAS u32x4*)(PT + (size_t)(row - u.pm * BM) * 256 + col) = w;
            EPI_END
        } else {
            const int mode = u.seg >> 1;
            GAS bf16_t* dst = (mode == 2) ? (GAS bf16_t*)MG + (size_t)u.pm * BM * DM + u.pn * BM : (GAS bf16_t*)MT;
            const int dld = (mode == 2) ? DM : 256;
            const int rl0 = wr * 64 + fr, c0 = wc * 32 + 8 * fq;
#pragma unroll
            for (int ai = 0; ai < 2; ++ai) {
                u32x4 pv[4][2], mv[4][2];
#pragma unroll
                for (int m = 0; m < 4; ++m)
#pragma unroll
                    for (int bj = 0; bj < 2; ++bj) pv[m][bj] = *(const GAS u32x4*)(PT + (size_t)(ai * HALF + rl0 + m * 16) * 256 + bj * HALF + c0);
                if (mode != 0) {
#pragma unroll
                    for (int m = 0; m < 4; ++m)
#pragma unroll
                        for (int bj = 0; bj < 2; ++bj) mv[m][bj] = *(const GAS u32x4*)(MT + (size_t)(ai * HALF + rl0 + m * 16) * 256 + bj * HALF + c0);
                } else {
#pragma unroll
                    for (int m = 0; m < 4; ++m)
#pragma unroll
                        for (int bj = 0; bj < 2; ++bj) mv[m][bj] = (u32x4){0u, 0u, 0u, 0u};
                }
                __builtin_amdgcn_sched_barrier(0);
#pragma unroll
                for (int m = 0; m < 4; ++m)
#pragma unroll
                    for (int bj = 0; bj < 2; ++bj) {
                        const f32x4 v0 = acc[ai][bj][m][0], v1 = acc[ai][bj][m][1]; const u32x4 p = pv[m][bj], q = mv[m][bj];
                        const float r0 = bflo(q.x) + bflo(p.x) * sigmoidf_(v0[0]), r1 = bfhi(q.x) + bfhi(p.x) * sigmoidf_(v0[1]), r2 = bflo(q.y) + bflo(p.y) * sigmoidf_(v0[2]), r3 = bfhi(q.y) + bfhi(p.y) * sigmoidf_(v0[3]);
                        const float r4 = bflo(q.z) + bflo(p.z) * sigmoidf_(v1[0]), r5 = bfhi(q.z) + bfhi(p.z) * sigmoidf_(v1[1]), r6 = bflo(q.w) + bflo(p.w) * sigmoidf_(v1[2]), r7 = bfhi(q.w) + bfhi(p.w) * sigmoidf_(v1[3]);
                        u32x4 w; w.x = pk2(r0, r1); w.y = pk2(r2, r3); w.z = pk2(r4, r5); w.w = pk2(r6, r7);
                        *(GAS u32x4*)(dst + (size_t)(ai * HALF + rl0 + m * 16) * dld + bj * HALF + c0) = w;
                    }
                __builtin_amdgcn_sched_barrier(0);
            }
        }
    }
};
struct EpiG5 {
    bf16_t* O; float* ss;
    __device__ __forceinline__ void operator()(const f32x4 (&acc)[2][2][4][2], const Unit& u, int wr, int wc, int fr, int fq) const {
        EPI_ROWS_BEGIN float q = 0.f;
        EPI_COLS8_BEGIN
            u32x4 w; w.x = pk2(v0[0], v0[1]); w.y = pk2(v0[2], v0[3]); w.z = pk2(v1[0], v1[1]); w.w = pk2(v1[2], v1[3]);
            *(GAS u32x4*)((GAS bf16_t*)O + (size_t)row * DM + u.pn * BM + col) = w;
            q += ((v0[0] * v0[0] + v0[1] * v0[1]) + (v0[2] * v0[2] + v0[3] * v0[3])) + ((v1[0] * v1[0] + v1[1] * v1[1]) + (v1[2] * v1[2] + v1[3] * v1[3]));
        }
            q += __shfl_xor(q, 16); q += __shfl_xor(q, 32);
            if (fq == 0) atomicAdd(ss + row, q);
        }
    }
};
}

__device__ __forceinline__ void transpose_item(const float* W, int K, int pitch, int c0, int ncols, bf16_t* WT, int row_off, const float* g, float scale, LAS float* scr, int item, int lane) {
    const int nblk = ncols / 32, kb = item / nblk, nb = item % nblk, k0 = 64 * kb, n0 = 32 * nb;
#pragma unroll 8
    for (int i = 0; i < 32; ++i) { const int kk = 2 * i + (lane >> 5); float w = W[(size_t)(k0 + kk) * pitch + c0 + n0 + (lane & 31)] * scale; if (g) w *= g[k0 + kk]; scr[kk * 33 + (lane & 31)] = w; }
    LDS_WAIT(); asm volatile("" ::: "memory");
    const int c = lane & 7;
#pragma unroll
    for (int j = 0; j < 4; ++j) { const int n = (lane >> 3) + 8 * j; const LAS float* s = scr + (8 * c) * 33 + n;
        u32x4 o; o.x = pk2(s[0 * 33], s[1 * 33]); o.y = pk2(s[2 * 33], s[3 * 33]); o.z = pk2(s[4 * 33], s[5 * 33]); o.w = pk2(s[6 * 33], s[7 * 33]);
        *(u32x4*)(WT + (size_t)(row_off + n0 + n) * K + k0 + 8 * c) = o; }
    LDS_WAIT(); asm volatile("" ::: "memory");
}

struct Args { const float* in[14]; float* out; unsigned char* ws; int ph_lo, ph_hi; };

__device__ __forceinline__ void grid_row_info(int gr, int& seqbase, int& r, int& nrows) {
    if (gr < 1024) { seqbase = (gr >> 5) << 11; r = gr & 31; nrows = 32; } else { const int g2 = gr - 1024; seqbase = MP + ((g2 >> 7) << 13); r = g2 & 127; nrows = 128; }
}

constexpr int AT_KSLOT = 9216, AT_VSLOT = 8704, AT_VOFF = 73728, AT_BOFF = 143360;
__device__ __forceinline__ void attn_fill_issue(const GAS bf16_t* ZM, const GAS bf16_t* ZT, int tok0, int head, int tid, u32x4& kreg, u32x4& vreg) {
    kreg = *(const GAS u32x4*)(ZM + (size_t)(tok0 + (tid >> 3)) * ZMW + 512 + head * 64 + (tid & 7) * 8);
    vreg = *(const GAS u32x4*)(ZT + ((size_t)(tok0 >> 6) * 512 + head * 64) * 64 + tid * 8);
}
__device__ __forceinline__ void attn_fill_write(LAS unsigned char* lds, int slot, int tid, const u32x4 kreg, const u32x4 vreg) {
    *(LAS u32x4*)(lds + slot * AT_KSLOT + (tid >> 3) * 144 + (tid & 7) * 16) = kreg;
    LAS u32x2* vp = (LAS u32x2*)(lds + AT_VOFF + slot * AT_VSLOT + (tid >> 3) * 136 + (tid & 7) * 16);
    u32x2 a; a.x = vreg.x; a.y = vreg.y; u32x2 b; b.x = vreg.z; b.y = vreg.w;
    vp[0] = a; vp[1] = b;
}
__device__ __forceinline__ void attn_row_lds(LAS unsigned char* lds, int seqbase, int r, int rs, int head, int lane, int wave, const bf16x8 bq0, const bf16x8 bq1, GAS bf16_t* Y, const unsigned (&bcp)[32]) {
    const int g = wave & 3, dh = wave >> 2;
    const int qi = lane & 15, h4 = lane >> 4;
    const int cs = (g == 0) ? 0 : (g == 1) ? 8 : (g == 2) ? 24 : 32;
    const int qc = 16 * g + qi;
    const int qtok = seqbase + r * 64 + qc;
    f32x4 S[16];
    float mx = -3.0e38f;
#pragma unroll
    for (int hb = 0; hb < 2; ++hb) {
        bf16x8 ak[8][2];
#pragma unroll
        for (int tt = 0; tt < 8; ++tt) {
            const int t = hb * 8 + tt, kr = t >> 1, hf = t & 1;
            const int slot = (rs + kr) & 7;
            const LAS unsigned char* kp = lds + slot * AT_KSLOT + (cs + 16 * hf + qi) * 144 + h4 * 16;
            ak[tt][0] = *(const LAS bf16x8*)kp; ak[tt][1] = *(const LAS bf16x8*)(kp + 64);
        }
        __builtin_amdgcn_sched_barrier(0);
#pragma unroll
        for (int tt = 0; tt < 8; ++tt) {
            const int t = hb * 8 + tt;
            f32x4 s = {0.f, 0.f, 0.f, 0.f};
            s = __builtin_amdgcn_mfma_f32_16x16x32_bf16(ak[tt][0], bq0, s, 0, 0, 0);
            s = __builtin_amdgcn_mfma_f32_16x16x32_bf16(ak[tt][1], bq1, s, 0, 0, 0);
            s[0] += bflo(bcp[2 * t]); s[1] += bfhi(bcp[2 * t]); s[2] += bflo(bcp[2 * t + 1]); s[3] += bfhi(bcp[2 * t + 1]);
            mx = fmaxf(mx, fmaxf(fmaxf(s[0], s[1]), fmaxf(s[2], s[3])));
            S[t] = s;
        }
        __builtin_amdgcn_sched_barrier(0);
    }
    u32x2 vf[2][8][2];
#pragma unroll
    for (int dti = 0; dti < 2; ++dti)
#pragma unroll
        for (int kr = 0; kr < 8; ++kr) {
            const int slot = (rs + kr) & 7;
            const LAS unsigned char* vp = lds + AT_VOFF + slot * AT_VSLOT + ((2 * dh + dti) * 16 + qi) * 136 + (cs + 4 * h4) * 2;
            vf[dti][kr][0] = *(const LAS u32x2*)vp; vf[dti][kr][1] = *(const LAS u32x2*)(vp + 32);
        }
    __builtin_amdgcn_sched_barrier(0);
    mx = fmaxf(mx, __shfl_xor(mx, 16)); mx = fmaxf(mx, __shfl_xor(mx, 32));
    float sum = 0.f;
    bf16x8 pf[8];
#pragma unroll
    for (int kr = 0; kr < 8; ++kr) {
        const f32x4 a = S[kr * 2], b = S[kr * 2 + 1];
        const float p0 = __expf(a[0] - mx), p1 = __expf(a[1] - mx), p2 = __expf(a[2] - mx), p3 = __expf(a[3] - mx);
        const float p4 = __expf(b[0] - mx), p5 = __expf(b[1] - mx), p6 = __expf(b[2] - mx), p7 = __expf(b[3] - mx);
        sum += ((p0 + p1) + (p2 + p3)) + ((p4 + p5) + (p6 + p7));
        u32x4 w; w.x = pk2(p0, p1); w.y = pk2(p2, p3); w.z = pk2(p4, p5); w.w = pk2(p6, p7);
        pf[kr] = __builtin_bit_cast(bf16x8, w);
    }
    sum += __shfl_xor(sum, 16); sum += __shfl_xor(sum, 32);
    const float inv = __builtin_amdgcn_rcpf(sum);
    GAS bf16_t* yp = Y + (size_t)qtok * DM + head * 64 + 4 * h4;
#pragma unroll
    for (int dti = 0; dti < 2; ++dti) {
        const int dt = 2 * dh + dti;
        f32x4 o = {0.f, 0.f, 0.f, 0.f};
#pragma unroll
        for (int kr = 0; kr < 8; ++kr) {
            u32x4 w; w.x = vf[dti][kr][0].x; w.y = vf[dti][kr][0].y; w.z = vf[dti][kr][1].x; w.w = vf[dti][kr][1].y;
            o = __builtin_amdgcn_mfma_f32_16x16x32_bf16(__builtin_bit_cast(bf16x8, w), pf[kr], o, 0, 0, 0);
        }
        u32x2 w; w.x = pk2(o[0] * inv, o[1] * inv); w.y = pk2(o[2] * inv, o[3] * inv);
        *(GAS u32x2*)(yp + dt * 16) = w;
    }
}
__device__ __forceinline__ void attn_unit(LAS unsigned char* lds, int seqbase, int nrows, int ra, int rb, int head, int tid, int lane, int wave,
                                          const bf16_t* ZM_, const bf16_t* ZT_, bf16_t* Y_, const float* rpb) {
    const GAS bf16_t* ZM = (const GAS bf16_t*)ZM_; const GAS bf16_t* ZT = (const GAS bf16_t*)ZT_; GAS bf16_t* Y = (GAS bf16_t*)Y_;
    int rs = ra - 4; rs = rs < 0 ? 0 : rs; rs = rs > nrows - 8 ? nrows - 8 : rs;
    {   u32x4 kreg[8], vreg[8];
#pragma unroll
        for (int k = 0; k < 8; ++k) attn_fill_issue(ZM, ZT, seqbase + (rs + k) * 64, head, tid, kreg[k], vreg[k]);
        LAS float* bw = (LAS float*)(lds + AT_BOFF);
        if (tid < 465) bw[tid] = rpb[head * 465 + tid];
#pragma unroll
        for (int k = 0; k < 8; ++k) attn_fill_write(lds, (rs + k) & 7, tid, kreg[k], vreg[k]);
    }
    const GAS bf16_t* qbase = ZM + (size_t)(seqbase + 16 * (wave & 3) + (lane & 15)) * ZMW + head * 64 + 8 * (lane >> 4);
    bf16x8 q0 = *(const GAS bf16x8*)(qbase + (size_t)ra * 64 * ZMW), q1 = *(const GAS bf16x8*)(qbase + (size_t)ra * 64 * ZMW + 32);
    __syncthreads();
    unsigned bcp[32]; int cdelta = 1000;
#pragma unroll
    for (int i = 0; i < 32; ++i) bcp[i] = 0u;
#pragma unroll 1
    for (int r = ra; r < rb; ++r) {
        if (rs - r != cdelta) {
            cdelta = rs - r;
            const LAS float* bias = (const LAS float*)(lds + AT_BOFF);
            const int g_ = wave & 3, qi_ = lane & 15, h4_ = lane >> 4, cs_ = (g_ == 0) ? 0 : (g_ == 1) ? 8 : (g_ == 2) ? 24 : 32, qc_ = 16 * g_ + qi_;
            int cst_ = qc_ - 8; cst_ = cst_ < 0 ? 0 : cst_; cst_ = cst_ > 48 ? 48 : cst_;
#pragma unroll
            for (int t = 0; t < 16; ++t) {
                float bv[4];
#pragma unroll
                for (int e = 0; e < 4; ++e) {
                    const int kc = cs_ + 16 * (t & 1) + 4 * h4_ + e; int dc = kc - qc_ + 15; dc = dc < 0 ? 0 : dc; dc = dc > 30 ? 30 : dc;
                    const float b = bias[(cdelta + (t >> 1) + 7) * 31 + dc];
                    bv[e] = ((kc >= cst_) && (kc < cst_ + 16)) ? b : -1.0e30f;
                }
                bcp[2 * t] = pk2(bv[0], bv[1]); bcp[2 * t + 1] = pk2(bv[2], bv[3]);
            }
        }
        const int rq = (r + 1 < rb) ? r + 1 : r;
        const bf16x8 nq0 = *(const GAS bf16x8*)(qbase + (size_t)rq * 64 * ZMW), nq1 = *(const GAS bf16x8*)(qbase + (size_t)rq * 64 * ZMW + 32);
        int rsn = r + 1 - 4; rsn = rsn < 0 ? 0 : rsn; rsn = rsn > nrows - 8 ? nrows - 8 : rsn;
        const bool adv = (r + 1 < rb) && (rsn != rs);
        u32x4 kreg = {0u, 0u, 0u, 0u}, vreg = {0u, 0u, 0u, 0u};
        if (adv) attn_fill_issue(ZM, ZT, seqbase + (rsn + 7) * 64, head, tid, kreg, vreg);
        attn_row_lds(lds, seqbase, r, rs, head, lane, wave, q0, q1, Y, bcp);
        LDS_WAIT(); __builtin_amdgcn_s_barrier(); asm volatile("" ::: "memory");
        if (adv) attn_fill_write(lds, (rsn + 7) & 7, tid, kreg, vreg);
        LDS_WAIT(); __builtin_amdgcn_s_barrier(); asm volatile("" ::: "memory");
        rs = rsn; q0 = nq0; q1 = nq1;
    }
}

#define DFT4(r0, i0, r1, i1, r2, i2, r3, i3) do { \
    const float ar_ = r0 + r2, ai_ = i0 + i2, br_ = r0 - r2, bi_ = i0 - i2, cr_ = r1 + r3, ci_ = i1 + i3, dr_ = r1 - r3, di_ = i1 - i3; \
    r0 = ar_ + cr_; i0 = ai_ + ci_; r1 = br_ + di_; i1 = bi_ - dr_; r2 = ar_ - cr_; i2 = ai_ - ci_; r3 = br_ - di_; i3 = bi_ + dr_; } while (0)
template <int R, int NU>
__device__ __forceinline__ void butterfly_unit(int tok0, int rowbase  , int p0, int lp, const bf16_t* ZT_, bf16_t* YQ_, const float (&twr)[R], const float (&twi)[R]) {
    const GAS bf16_t* zre = (const GAS bf16_t*)ZT_ + (size_t)MTOK * 512 + ((size_t)(tok0 >> 9) * 512 + p0) * 512 + lp;
    const GAS bf16_t* zim = zre + 256 * 512;
    float xr[NU][R], xi[NU][R];
#pragma unroll
    for (int u = 0; u < NU; ++u)
#pragma unroll
        for (int s = 0; s < R; ++s) { xr[u][s] = bf2f(zre[(size_t)s * 512 * 512 + u * 512]); xi[u][s] = bf2f(zim[(size_t)s * 512 * 512 + u * 512]); }
#pragma unroll
    for (int u = 0; u < NU; ++u) {
        if constexpr (R == 4) {
            DFT4(xr[u][0], xi[u][0], xr[u][1], xi[u][1], xr[u][2], xi[u][2], xr[u][3], xi[u][3]);
        } else {
#pragma unroll
            for (int b = 0; b < 4; ++b) DFT4(xr[u][b], xi[u][b], xr[u][4 + b], xi[u][4 + b], xr[u][8 + b], xi[u][8 + b], xr[u][12 + b], xi[u][12 + b]);
            constexpr float WR[10] = {1.f, 0.9238795325f, 0.7071067812f, 0.3826834324f, 0.f, 0.f, -0.7071067812f, 0.f, 0.f, -0.9238795325f};
            constexpr float WI[10] = {0.f, -0.3826834324f, -0.7071067812f, -0.9238795325f, -1.f, 0.f, -0.7071067812f, 0.f, 0.f, 0.3826834324f};
#pragma unroll
            for (int c = 1; c < 4; ++c)
#pragma unroll
                for (int b = 1; b < 4; ++b) { const float wr_ = WR[c * b], wi_ = WI[c * b]; const float tr = xr[u][4 * c + b] * wr_ - xi[u][4 * c + b] * wi_, ti = xr[u][4 * c + b] * wi_ + xi[u][4 * c + b] * wr_; xr[u][4 * c + b] = tr; xi[u][4 * c + b] = ti; }
#pragma unroll
            for (int c = 0; c < 4; ++c) DFT4(xr[u][4 * c], xi[u][4 * c], xr[u][4 * c + 1], xi[u][4 * c + 1], xr[u][4 * c + 2], xi[u][4 * c + 2], xr[u][4 * c + 3], xi[u][4 * c + 3]);
        }
        GAS bf16_t* d0 = (GAS bf16_t*)YQ_ + (size_t)(rowbase + u) * 1024 + lp;
#pragma unroll
        for (int q = 0; q < R; ++q) {
            const int sl = (R == 16) ? 4 * (q & 3) + (q >> 2) : q;
            const float orr = xr[u][sl] * twr[q] - xi[u][sl] * twi[q], oi = xr[u][sl] * twi[q] + xi[u][sl] * twr[q];
            GAS bf16_t* d = d0 + (size_t)q * 256 * 1024;
            d[0] = (bf16_t)f2bf(orr); d[512] = (bf16_t)f2bf(oi);
        }
    }
}

template <int MODE>
__device__ __forceinline__ void row_pass(int gw, int NGW, int lane, const float* x_prompt, const float* x_sample, float* out, bf16_t* XB, const bf16_t* O, float* RS, float* SS, const float* gpost) {
    for (int m = gw; m < MTOK; m += NGW) {
        f32x4 v[4];
        GAS u32x2* xbrow = (GAS u32x2*)((GAS bf16_t*)XB + (size_t)m * DM) + lane;
        if constexpr (MODE == 2) {
            u32x2 xv[4];
#pragma unroll
            for (int j = 0; j < 4; ++j) xv[j] = xbrow[64 * j];
            const float irs = RS[m];
#pragma unroll
            for (int j = 0; j < 4; ++j) { v[j][0] = bflo(xv[j].x) * irs; v[j][1] = bfhi(xv[j].x) * irs; v[j][2] = bflo(xv[j].y) * irs; v[j][3] = bfhi(xv[j].y) * irs; }
        } else {
            const GAS f32x4* xr = (const GAS f32x4*)((m < MP) ? x_prompt + (size_t)m * DM : x_sample + (size_t)(m - MP) * DM) + lane;
#pragma unroll
            for (int j = 0; j < 4; ++j) v[j] = xr[64 * j];
        }
        if constexpr (MODE != 0) {
            const float rq = rsqrtf(SS[m] * (1.0f / DM) + EPS);
            const GAS u32x2* orow = (const GAS u32x2*)((const GAS bf16_t*)O + (size_t)m * DM) + lane;
#pragma unroll
            for (int j = 0; j < 4; ++j) { const u32x2 ov = orow[64 * j]; const f32x4 gp = *((const GAS f32x4*)gpost + lane + 64 * j);
                v[j][0] += bflo(ov.x) * rq * gp[0]; v[j][1] += bfhi(ov.x) * rq * gp[1]; v[j][2] += bflo(ov.y) * rq * gp[2]; v[j][3] += bfhi(ov.y) * rq * gp[3]; }
            if constexpr (MODE == 2) {
                GAS f32x4* orow2 = (GAS f32x4*)(out + (size_t)m * DM) + lane;
#pragma unroll
                for (int j = 0; j < 4; ++j) orow2[64 * j] = v[j];
            }
        }
        if constexpr (MODE != 2) {
            float s = 0.f;
#pragma unroll
            for (int j = 0; j < 4; ++j) s += (v[j][0] * v[j][0] + v[j][1] * v[j][1]) + (v[j][2] * v[j][2] + v[j][3] * v[j][3]);
            s = wave_sum(s);
            const float ms = s * (1.0f / DM) + EPS;
            const float rsv = rsqrtf(ms);
#pragma unroll
            for (int j = 0; j < 4; ++j) { u32x2 w; w.x = pk2(v[j][0] * rsv, v[j][1] * rsv); w.y = pk2(v[j][2] * rsv, v[j][3] * rsv); xbrow[64 * j] = w; }
            if (lane == 0) { RS[m] = sqrtf(ms); SS[m] = 0.f; }
        }
    }
}

__global__ void __launch_bounds__(NWAVES * 64, 2) fwd_kernel(Args args) {
    extern __shared__ __attribute__((aligned(16))) unsigned char lds_raw[];
    LAS unsigned char* lds = (LAS unsigned char*)lds_raw;
    const int G = gridDim.x, bx = blockIdx.x;
    for (int ph = args.ph_lo; ph < args.ph_hi; ++ph) {
        if (ph > args.ph_lo) { cg::this_grid().sync(); }
        int tid = threadIdx.x; asm volatile("" : "+v"(tid));
        const int lane = tid & 63, wave = __builtin_amdgcn_readfirstlane(tid >> 6);
        const int gw = bx * NWAVES + wave, NGW = G * NWAVES;
        unsigned char* ws = args.ws; asm volatile("" : "+s"(ws));
        const float* x_prompt = args.in[0]; const float* x_sample = args.in[1];
        float* out = args.out;
        bf16_t* XB = (bf16_t*)(ws + WS_XB); bf16_t* OB = XB;
        bf16_t* ZM = (bf16_t*)(ws + WS_ZM); bf16_t* PB = ZM;
        bf16_t* ZT = (bf16_t*)(ws + WS_ZT); bf16_t* MG = ZT;
        bf16_t* YQ = (bf16_t*)(ws + WS_YQ);
        bf16_t* Y = (bf16_t*)(ws + WS_Y);
        bf16_t* TT = (bf16_t*)(ws + WS_T);
        float* RS = (float*)(ws + WS_RS); float* SS = (float*)(ws + WS_SS);
        const int layer = (ph == 0) ? 0 : (ph - 1) / 7;
        const int sub = (ph == 0) ? -1 : (ph - 1) % 7;
        const bf16_t* WIN = (const bf16_t*)(ws + WS_WIN) + (size_t)layer * NG1 * DM;
        const bf16_t* WG = (const bf16_t*)(ws + WS_WG) + (size_t)layer * DM * DM;
        const bf16_t* WM = (const bf16_t*)(ws + WS_WM) + (size_t)layer * 3072 * DM;
        const bf16_t* WA = (const bf16_t*)(ws + WS_WA) + (size_t)layer * DM * 512;
        const bf16_t* WB = (const bf16_t*)(ws + WS_WB) + (size_t)layer * DM * 256;
        const bf16_t* WC = (const bf16_t*)(ws + WS_WC) + (size_t)layer * DM * 256;
        const bf16_t* WO = (const bf16_t*)(ws + WS_WO) + (size_t)layer * DM * DM;

        if (PHON(0) && ph == 0) {
            LAS float* scr = (LAS float*)(lds + wave * 16384);
            for (int l = 0; l < 2; ++l) {
                const float* w_in = args.in[4] + (size_t)l * DM * DIN;
                const float* gpre = args.in[2] + l * DM;
                bf16_t* win = (bf16_t*)(ws + WS_WIN) + (size_t)l * NG1 * DM;
                bf16_t* wg = (bf16_t*)(ws + WS_WG) + (size_t)l * DM * DM;
                bf16_t* wm = (bf16_t*)(ws + WS_WM) + (size_t)l * 3072 * DM;
                for (int job = 0; job < 7; ++job) {
                    int c0, nc, ro; bf16_t* dst; float sc = 1.f;
                    switch (job) {
                        case 0: c0 = 0; nc = 512; dst = win; ro = 0; sc = 0.125f; break;
                        case 1: c0 = 512; nc = 1024; dst = win; ro = 512; break;
                        case 2: c0 = 2560; nc = 512; dst = win; ro = 2048; break;
                        case 3: c0 = 1536; nc = 512; dst = wg; ro = 0; break;
                        case 4: c0 = 2304; nc = 256; dst = wg; ro = 512; break;
                        case 5: c0 = 3072; nc = 256; dst = wg; ro = 768; break;
                        default: c0 = 3328; nc = 3072; dst = wm; ro = 0; break;
                    }
                    const int nitems = (DM / 64) * (nc / 32);
                    for (int it = gw; it < nitems; it += NGW) transpose_item(w_in, DM, DIN, c0, nc, dst, ro, gpre, sc, scr, it, lane);
                }
                {   const int ni = (512 / 64) * (DM / 32);
                    for (int it = gw; it < ni; it += NGW) transpose_item(args.in[10] + (size_t)l * 512 * DM, 512, DM, 0, DM, (bf16_t*)(ws + WS_WA) + (size_t)l * DM * 512, 0, nullptr, 1.f, scr, it, lane); }
                {   const int ni = (256 / 64) * (DM / 32);
                    for (int it = gw; it < ni; it += NGW) transpose_item(args.in[11] + (size_t)l * 256 * DM, 256, DM, 0, DM, (bf16_t*)(ws + WS_WB) + (size_t)l * DM * 256, 0, nullptr, 1.f, scr, it, lane);
                    for (int it = gw; it < ni; it += NGW) transpose_item(args.in[12] + (size_t)l * 256 * DM, 256, DM, 0, DM, (bf16_t*)(ws + WS_WC) + (size_t)l * DM * 256, 0, nullptr, 1.f, scr, it, lane); }
                {   const int ni = (DM / 64) * (DM / 32);
                    for (int it = gw; it < ni; it += NGW) transpose_item(args.in[13] + (size_t)l * DM * DM, DM, DM, 0, DM, (bf16_t*)(ws + WS_WO) + (size_t)l * DM * DM, 0, nullptr, 1.f, scr, it, lane); }
                LAS float* ctab = (LAS float*)(lds + 131072);
                if (l == 0) { if (tid < 64) { float sn, cs; sincospif((float)tid * (1.0f / 32.0f), &sn, &cs); ctab[tid] = cs; ctab[64 + tid] = sn; } __syncthreads(); }
                for (int idx = bx * 512 + tid; idx < DM * 256; idx += G * 512) {
                    const int k = idx >> 8, p = idx & 255, grp = p >> 6, mm = p & 63;
                    const f32x4* wrow = (const f32x4*)(w_in + (size_t)k * DIN + 2048 + grp * 64);
                    float are = 0.f, aim = 0.f;
#pragma unroll 4
                    for (int c4 = 0; c4 < 16; ++c4) { const f32x4 w = wrow[c4];
#pragma unroll
                        for (int e = 0; e < 4; ++e) { const int t = (mm * (4 * c4 + e)) & 63; are += w[e] * ctab[t]; aim -= w[e] * ctab[64 + t]; } }
                    const float gk = gpre[k];
                    win[(size_t)(1536 + p) * DM + k] = (bf16_t)f2bf(are * gk);
                    win[(size_t)(1536 + 256 + p) * DM + k] = (bf16_t)f2bf(aim * gk);
                }
            }
            for (int idx = bx * 512 + tid; idx < 512 * 512; idx += G * 512) {
                const int kp = idx >> 9, lp = idx & 511; float sn, cs; sincospif((float)((kp * lp) & 511) * (1.0f / 256.0f), &sn, &cs);
                TT[(size_t)kp * 1024 + lp] = (bf16_t)f2bf(cs); TT[(size_t)kp * 1024 + 512 + lp] = (bf16_t)f2bf(sn);
            }
        }
        if (PHON(1) && (ph == 0 || sub == 6)) {
            const float* gpost = args.in[3] + layer * DM;
            if (ph == 0) row_pass<0>(gw, NGW, lane, x_prompt, x_sample, out, XB, Y, RS, SS, gpost);
            else if (layer == 0) row_pass<1>(gw, NGW, lane, x_prompt, x_sample, out, XB, Y, RS, SS, gpost);
            else row_pass<2>(gw, NGW, lane, x_prompt, x_sample, out, XB, Y, RS, SS, gpost);
        } else if (PHON(2) && sub == 0) {
            pg8::Gemm g{XB, WIN, MTOK, NG1, DM, DM, DM}; pg8::StaticOrder S; S.init(MTOK, NG1, G, bx);
            pg8::EpiG1 E{RS, ZM, ZT};
            pg8::gemm_phase<pg8::EpiG1, pg8::StaticOrder, true>(lds, g, S, E);
        } else if (sub == 1) {
            if (PHON(3)) {
                const float* rpb = args.in[5] + (size_t)layer * 8 * 15 * 31;
                for (int un = bx; un < 512; un += G) {
                    if (un < 256) attn_unit(lds, (un >> 3) * 2048, 32, 0, 32, un & 7, tid, lane, wave, ZM, ZT, Y, rpb);
                    else { const int v = un - 256, st = v & 7; attn_unit(lds, MP + (v >> 6) * 8192, 128, st * 16, st * 16 + 16, (v >> 3) & 7, tid, lane, wave, ZM, ZT, Y, rpb); }
                }
            }
            if (PHON(4)) {
                LAS float* hbuf = (LAS float*)lds; LAS float* cbuf = (LAS float*)(lds + 65536);
                const float* dww = args.in[6] + (size_t)layer * 31 * 256; const float* dwb = args.in[7] + layer * 256;
                const float* lng = args.in[8] + layer * 256; const float* lnb = args.in[9] + layer * 256;
                const int c = tid & 255, half = tid >> 8;
                float w[31];
#pragma unroll
                for (int j = 0; j < 31; ++j) w[j] = dww[j * 256 + c];
                const float bc = dwb[c];
                const f32x4 lg = *((const f32x4*)lng + lane), lb = *((const f32x4*)lnb + lane);
                u32x4 pa[4], pb[4];
#define CONV_ISSUE(cu_) do { const int t0g_ = (cu_) * 32; \
                    int sbeg_, send_; if (t0g_ < MP) { sbeg_ = t0g_ & ~2047; send_ = sbeg_ + 2048; } else { sbeg_ = MP + ((t0g_ - MP) & ~8191); send_ = sbeg_ + 8192; } \
                    _Pragma("unroll") for (int k = 0; k < 4; ++k) { \
                        const int it = tid + k * 512, i = it >> 5, c8 = (it & 31) * 8; const int tok = t0g_ - 15 + i; \
                        int tokc = tok < sbeg_ ? sbeg_ : tok; tokc = tokc > send_ - 1 ? send_ - 1 : tokc;     \
                        const u32x4 la_ = *(const GAS u32x4*)((const GAS bf16_t*)ZM + (size_t)tokc * ZMW + 1024 + c8), lb_ = *(const GAS u32x4*)((const GAS bf16_t*)ZM + (size_t)tokc * ZMW + 1280 + c8); \
                        const unsigned keep_ = (tok >= sbeg_ && tok < send_) ? 0xffffffffu : 0u; \
                        pa[k].x = la_.x & keep_; pa[k].y = la_.y & keep_; pa[k].z = la_.z & keep_; pa[k].w = la_.w & keep_; pb[k] = lb_; \
                    } } while (0)
                for (int cu = bx; cu < MTOK / 32; cu += G) {
                    const int t0g = cu * 32;
                    CONV_ISSUE(cu);
#pragma unroll
                    for (int k = 0; k < 4; ++k) {
                        const int it = tid + k * 512, i = it >> 5, c8 = (it & 31) * 8;
                        if (it < 62 * 32) {
                            const u32x4 a = pa[k], b = pb[k]; f32x4 h0, h1;
                            h0[0] = bflo(a.x) * sigmoidf_(bflo(b.x)); h0[1] = bfhi(a.x) * sigmoidf_(bfhi(b.x)); h0[2] = bflo(a.y) * sigmoidf_(bflo(b.y)); h0[3] = bfhi(a.y) * sigmoidf_(bfhi(b.y));
                            h1[0] = bflo(a.z) * sigmoidf_(bflo(b.z)); h1[1] = bfhi(a.z) * sigmoidf_(bfhi(b.z)); h1[2] = bflo(a.w) * sigmoidf_(bflo(b.w)); h1[3] = bfhi(a.w) * sigmoidf_(bfhi(b.w));
                            *(LAS f32x4*)(hbuf + i * 256 + c8) = h0; *(LAS f32x4*)(hbuf + i * 256 + c8 + 4) = h1;
                        }
                    }
                    __syncthreads();
                    {   float hv[46];
#pragma unroll
                        for (int i = 0; i < 46; ++i) hv[i] = hbuf[(half * 16 + i) * 256 + c];
#pragma unroll
                        for (int tt = 0; tt < 16; ++tt) {
                            float a = bc;
#pragma unroll
                            for (int j = 0; j < 31; ++j) a += w[j] * hv[tt + j];
                            cbuf[(half * 16 + tt) * 256 + c] = a;
                        }
                    }
                    __syncthreads();
#pragma unroll
                    for (int tt = 0; tt < 4; ++tt) {
                        const int t = wave * 4 + tt;
                        const f32x4 xv = *(const LAS f32x4*)(cbuf + t * 256 + 4 * lane);
                        const float mean = wave_sum((xv[0] + xv[1]) + (xv[2] + xv[3])) * (1.0f / 256.0f);
                        const f32x4 d = xv - mean;
                        const float var = wave_sum((d[0] * d[0] + d[1] * d[1]) + (d[2] * d[2] + d[3] * d[3])) * (1.0f / 256.0f);
                        const float rstd = rsqrtf(var + EPS);
                        const float y0 = siluf_(d[0] * rstd * lg[0] + lb[0]), y1 = siluf_(d[1] * rstd * lg[1] + lb[1]), y2 = siluf_(d[2] * rstd * lg[2] + lb[2]), y3 = siluf_(d[3] * rstd * lg[3] + lb[3]);
                        u32x2 wv; wv.x = pk2(y0, y1); wv.y = pk2(y2, y3);
                        *(GAS u32x2*)((GAS bf16_t*)Y + (size_t)(t0g + t) * DM + 768 + 4 * lane) = wv;
                    }
                }
            }
            if (PHON(5)) {
                float t4r[4], t4i[4], t16r[16], t16i[16];
                {   const float s4 = rsqrtf(64.0f * 2048.0f), s16 = rsqrtf(64.0f * 8192.0f);
#pragma unroll
                    for (int q = 0; q < 4; ++q) { float sn, cs; sincospif(-2.0f * (float)(q * tid) / 2048.0f, &sn, &cs); t4r[q] = cs * s4; t4i[q] = sn * s4; }
#pragma unroll
                    for (int q = 0; q < 16; ++q) { float sn, cs; sincospif(-2.0f * (float)(q * tid) / 8192.0f, &sn, &cs); t16r[q] = cs * s16; t16i[q] = sn * s16; } }
                for (int un = bx; un < 32 * 64; un += G) { const int seq = un >> 6, p = (un & 63) * 4; butterfly_unit<4, 4>(seq * 2048, seq * 1024 + p, p, tid, ZT, YQ, t4r, t4i); }
                for (int un = bx; un < 4 * 128; un += G) { const int seq = un >> 7, p = (un & 127) * 2; butterfly_unit<16, 2>(MP + seq * 8192, 32768 + seq * 4096 + p, p, tid, ZT, YQ, t16r, t16i); }
            }
        } else if (PHON(6) && sub == 2) {
            pg8::Gemm g{YQ, TT, NYQ, 512, 1024, 1024, 1024}; pg8::StaticOrder S; S.init(NYQ, 512, G, bx);
            pg8::EpiDFT E{Y};
            pg8::gemm_phase<pg8::EpiDFT, pg8::StaticOrder, true>(lds, g, S, E);
        } else if (PHON(7) && sub == 3) {
            pg8::Gemm g{XB, WG, MTOK, DM, DM, DM, DM}; pg8::StaticOrder S; S.init(MTOK, DM, G, bx);
            pg8::EpiG2 E{RS, Y};
            pg8::gemm_phase<pg8::EpiG2, pg8::StaticOrder, true>(lds, g, S, E);
        } else if (sub == 4) {
            pg8::ProgG34 PG; PG.S.init(MTOK, DM, G, bx); PG.Y = Y; PG.XB = XB; PG.wsb = (const char*)ws; PG.WM = WM; PG.layer = layer;
            pg8::EpiG34 EG{RS, PB + (size_t)bx * 65536, PB + (size_t)(256 + bx) * 65536, MG};
            pg8::gemm_multi<pg8::EpiG34, pg8::ProgG34>(lds, PG, EG);
        } else if (PHON(10) && sub == 5) {
            pg8::Gemm g{MG, WO, MTOK, DM, DM, DM, DM}; pg8::StaticOrder S; S.init(MTOK, DM, G, bx);
            pg8::EpiG5 E{Y, SS};
            pg8::gemm_phase<pg8::EpiG5, pg8::StaticOrder, true>(lds, g, S, E);
        }
    }
}

extern "C" void kernel_launch(void* const* d_in, const int* in_sizes, int n_in, void* d_out, int out_size, void* d_ws, size_t ws_size, hipStream_t stream) {
    static int grid = 0;
    if (grid == 0) {
        if (n_in != 14 || ws_size < WS_END) { fprintf(stderr, "kernel_launch: bad inputs (n_in %d, ws %zu < %zu)\n", n_in, ws_size, (size_t)WS_END); grid = -1; return; }
        int dev = 0, cus = 0, per_cu = 0;
        hipGetDevice(&dev); hipDeviceGetAttribute(&cus, hipDeviceAttributeMultiprocessorCount, dev);
        if (hipFuncSetAttribute((const void*)fwd_kernel, hipFuncAttributeMaxDynamicSharedMemorySize, LDS_BYTES) != hipSuccess) { fprintf(stderr, "hipFuncSetAttribute failed\n"); grid = -1; return; }
        hipOccupancyMaxActiveBlocksPerMultiprocessor(&per_cu, (const void*)fwd_kernel, NWAVES * 64, LDS_BYTES);
        (void)hipGetLastError();
        if (per_cu < 1) { fprintf(stderr, "occupancy query says 0 blocks per CU\n"); }
        grid = cus;
    }
    if (grid < 0) return;
    Args a{};
    for (int i = 0; i < 14; ++i) a.in[i] = (const float*)d_in[i];
    a.out = (float*)d_out; a.ws = (unsigned char*)d_ws;
#if MK_ONE_LAUNCH
    a.ph_lo = 0; a.ph_hi = 15;
    void* kargs[] = {&a};
    hipError_t e = hipLaunchCooperativeKernel((const void*)fwd_kernel, dim3(grid), dim3(NWAVES * 64), kargs, LDS_BYTES, stream);
    if (e != hipSuccess) fprintf(stderr, "cooperative launch failed: %s (grid %d)\n", hipGetErrorString(e), grid);
#else
    for (int ph = 0; ph < 15; ++ph) {
        a.ph_lo = ph; a.ph_hi = ph + 1;
        hipLaunchKernelGGL(fwd_kernel, dim3(grid), dim3(NWAVES * 64), LDS_BYTES, stream, a);
    }
#endif
}
```

```cpp
#include <hip/hip_runtime.h>
#include <hip/hip_cooperative_groups.h>
#include <cstdio>
#include <cstdint>
namespace cg = cooperative_groups;

#ifndef MK_ONE_LAUNCH
#define MK_ONE_LAUNCH 1
#endif

#ifndef PH_MASK
#define PH_MASK 0xFFFF
#endif
#define PHON(k) (((PH_MASK) >> (k)) & 1)
#define LAS __attribute__((address_space(3)))
typedef unsigned short bf16_t;
typedef short bf16x8 __attribute__((ext_vector_type(8)));
typedef short s16x4 __attribute__((ext_vector_type(4)));
typedef float f32x4 __attribute__((ext_vector_type(4)));
typedef unsigned u32x4 __attribute__((ext_vector_type(4)));
typedef unsigned u32x2 __attribute__((ext_vector_type(2)));

constexpr int DM = 1024;
constexpr int MP = 65536;
constexpr int MTOK = 98304;
constexpr int DIN = 6400;
constexpr int NG1 = 2560;
constexpr int ZMW = 1536;
constexpr int NYQ = 49152;
constexpr float EPS = 1e-6f;

constexpr size_t MiB = 1u << 20;
constexpr size_t WS_WIN = 0;
constexpr size_t WS_WG = 10 * MiB;
constexpr size_t WS_WM = 14 * MiB;
constexpr size_t WS_WA = 26 * MiB;
constexpr size_t WS_WB = 28 * MiB;
constexpr size_t WS_WC = 29 * MiB;
constexpr size_t WS_WO = 30 * MiB;
constexpr size_t WS_T = 34 * MiB;
constexpr size_t WS_RS = 35 * MiB;
constexpr size_t WS_SS = 35 * MiB + 512 * 1024;
constexpr size_t WS_XB = 36 * MiB;
constexpr size_t WS_ZM = 228 * MiB;
constexpr size_t WS_ZT = 516 * MiB;
constexpr size_t WS_YQ = 708 * MiB;
constexpr size_t WS_Y = 804 * MiB;
constexpr size_t WS_END = 996 * MiB;

constexpr int NWAVES = 8;
constexpr int LDS_BYTES = 147456;

__device__ __forceinline__ unsigned f2bf(float f) { unsigned u = __builtin_bit_cast(unsigned, f); return (u + 0x7fffu + ((u >> 16) & 1u)) >> 16; }
__device__ __forceinline__ unsigned pk2(float lo, float hi) { unsigned r; asm("v_cvt_pk_bf16_f32 %0, %1, %2" : "=v"(r) : "v"(lo), "v"(hi)); return r; }
__device__ __forceinline__ float bf2f(unsigned b) { return __builtin_bit_cast(float, b << 16); }
__device__ __forceinline__ float bflo(unsigned w) { return __builtin_bit_cast(float, w << 16); }
__device__ __forceinline__ float bfhi(unsigned w) { return __builtin_bit_cast(float, w & 0xffff0000u); }
__device__ __forceinline__ float sigmoidf_(float x) { return __builtin_amdgcn_rcpf(1.0f + __expf(-x)); }
__device__ __forceinline__ float siluf_(float x) { return x * __builtin_amdgcn_rcpf(1.0f + __expf(-x)); }
__device__ __forceinline__ float wave_sum(float v) {
#pragma unroll
    for (int o = 1; o < 64; o <<= 1) v += __shfl_xor(v, o);
    return v;
}
#define LDS_WAIT() asm volatile("s_waitcnt lgkmcnt(0)" ::: "memory")
#define GAS __attribute__((address_space(1)))

namespace pg8 {
constexpr int BM = 256, BK = 64, HALF = 128, HTB = HALF * BK * 2, STAGE_BYTES = 8 * HTB, NXCD = 8, WGM = 8;
__device__ __forceinline__ int lds_byte(int r, int c) { const int st = (r >> 4) * 2 + (c >> 5), rr = r & 15, cc = c & 31, ob = rr * 64 + cc * 2; return st * 1024 + (ob ^ (((ob >> 9) & 1) << 5)); }
__device__ __forceinline__ void stage_rc(int b, int& R, int& C) { const int st = b / 1024, sb = b % 1024, swz = sb ^ (((sb >> 9) & 1) << 5); R = (st >> 1) * 16 + swz / 64; C = (st & 1) * 32 + (swz % 64) / 2; }

__device__ __forceinline__ int perm32(int rho) { const int n = rho >> 4, i = rho & 15; return 8 * (i >> 2) + 4 * n + (i & 3); }
struct Unit { int pm, pn; };
struct Gemm { const bf16_t* A; const bf16_t* Bt; int M, N, K, lda, ldb; };

struct StaticOrder {
    int nM, nN, nwg, G, c;
    __device__ __forceinline__ void init(int M, int N, int G_, int c_) { nM = M / BM; nN = N / BM; nwg = nM * nN; G = G_; c = c_; }
    __device__ __forceinline__ bool next(int i, Unit& u) const {
        const long L = (long)i * G + c; if (L >= nwg) return false;
        int wgid = (int)L; { const int q = nwg / NXCD, r = nwg % NXCD, xcd = wgid % NXCD, off = wgid / NXCD; wgid = (xcd < r ? xcd * (q + 1) : r * (q + 1) + (xcd - r) * q) + off; }
        const int nig = WGM * nN, gid = wgid / nig, fm = gid * WGM, gsz = (nM - fm) < WGM ? (nM - fm) : WGM;
        u.pm = fm + ((wgid % nig) % gsz); u.pn = (wgid % nig) / gsz; return true;
    }
};

struct SingleUnit { Unit u; __device__ bool next(int i, Unit& o) const { if (i) return false; o = u; return true; } };
template <class Epi, class Sched, bool ALIGN_EPI>
__device__ __forceinline__ void gemm_phase(LAS unsigned char* lds, const Gemm g, const Sched& S, const Epi& E) {
    int tid = threadIdx.x; asm volatile("" : "+v"(tid));
    const int wid = __builtin_amdgcn_readfirstlane(tid >> 6), lane = tid & 63, wr = wid >> 2, wc = wid & 3, fr = lane & 15, fq = lane >> 4;
    const int K = g.K, nt = K / BK;
    unsigned voffA[2], voffB[2];
#pragma unroll
    for (int i = 0; i < 2; ++i) { int R, C; stage_rc(tid * 16 + i * 8192, R, C);
        const int Rb = (R & ~31) + perm32(R & 31);
        voffA[i] = (unsigned)(R * g.lda + C) * 2u; voffB[i] = (unsigned)(Rb * g.ldb + C) * 2u; }
    const size_t kstep = (size_t)(BK * 2);
    const size_t hstepA = (size_t)HALF * g.lda * 2, hstepB = (size_t)HALF * g.ldb * 2;
    const size_t tstepA = 2 * hstepA, tstepB = 2 * hstepB;
    const unsigned ldsw = (unsigned)wid * 1024u;
    const int aoff = lds_byte(wr * 64 + fr, fq * 8), boff = lds_byte(wc * 32 + fr, fq * 8);
#define PG8_SA(b, h) (((b) * 2 + (h)) * HTB)
#define PG8_SB(b, h) ((4 + (b) * 2 + (h)) * HTB)
#define PG8_STAGE(bufoff, gbase, voff) do { _Pragma("unroll") for (int _i = 0; _i < 2; ++_i) \
        __builtin_amdgcn_global_load_lds((const unsigned*)((const char*)(gbase) + (voff)[_i]), (LAS unsigned*)(lds + (bufoff) + ldsw + _i * 8192), 16, 0, 0); } while (0)
#define PG8_LDA(dst, b, h) do { _Pragma("unroll") for (int m = 0; m < 4; ++m) _Pragma("unroll") for (int k = 0; k < 2; ++k) dst[m][k] = *(const LAS bf16x8*)(lds + PG8_SA(b, h) + aoff + m * 2048 + k * 1024); } while (0)
#define PG8_LDB(dst, b, h) do { _Pragma("unroll") for (int n = 0; n < 2; ++n) _Pragma("unroll") for (int k = 0; k < 2; ++k) dst[n][k] = *(const LAS bf16x8*)(lds + PG8_SB(b, h) + boff + n * 2048 + k * 1024); } while (0)
#define PG8_MMA(ai, bj, At, Bt) do { __builtin_amdgcn_s_setprio(1); _Pragma("unroll") for (int m = 0; m < 4; ++m) _Pragma("unroll") for (int n = 0; n < 2; ++n) _Pragma("unroll") for (int k = 0; k < 2; ++k) \
        acc[ai][bj][m][n] = __builtin_amdgcn_mfma_f32_16x16x32_bf16(Bt[n][k], At[m][k], acc[ai][bj][m][n], 0, 0, 0); __builtin_amdgcn_s_setprio(0); } while (0)
#define PG8_WAIT_V(n) asm volatile("s_waitcnt vmcnt(" #n ")" ::: "memory")
#define PG8_WAIT_L(n) asm volatile("s_waitcnt lgkmcnt(" #n ")" ::: "memory")
#define PG8_BAR __builtin_amdgcn_s_barrier()
#define PG8_SCHED __builtin_amdgcn_sched_barrier(0)
    Unit cur, nxt; int ui = 0;
    if (!S.next(0, cur)) return;
    f32x4 acc[2][2][4][2];
#pragma unroll
    for (int a = 0; a < 2; ++a)
#pragma unroll
        for (int b = 0; b < 2; ++b)
#pragma unroll
            for (int m = 0; m < 4; ++m)
#pragma unroll
                for (int n = 0; n < 2; ++n) acc[a][b][m][n] = (f32x4){0.f, 0.f, 0.f, 0.f};
    bf16x8 At[4][2], B0[2][2], B1[2][2];
    const char* cA = (const char*)g.A + (size_t)cur.pm * tstepA; const char* cB = (const char*)g.Bt + (size_t)cur.pn * tstepB;
    PG8_STAGE(PG8_SB(0, 0), cB, voffB); PG8_STAGE(PG8_SB(0, 1), cB + hstepB, voffB); PG8_STAGE(PG8_SA(0, 0), cA, voffA); PG8_STAGE(PG8_SA(0, 1), cA + hstepA, voffA);
    if (wr == 1) PG8_BAR;
    PG8_WAIT_V(2); PG8_BAR;
    PG8_STAGE(PG8_SB(1, 0), cB + kstep, voffB); PG8_STAGE(PG8_SA(1, 0), cA + kstep, voffA); PG8_STAGE(PG8_SB(1, 1), cB + hstepB + kstep, voffB);
    PG8_WAIT_V(6); PG8_BAR;
    for (;;) {
        const bool has_next = S.next(ui + 1, nxt);
        const char* nA = has_next ? (const char*)g.A + (size_t)nxt.pm * tstepA : cA; const char* nB = has_next ? (const char*)g.Bt + (size_t)nxt.pn * tstepB : cB;
        for (int t = 0; t < nt; t += 2) {
            const bool last = (t == nt - 2);
            const char* a1 = cA + (size_t)(t + 1) * kstep;
            const char* a2 = last ? nA : cA + (size_t)(t + 2) * kstep; const char* b2 = last ? nB : cB + (size_t)(t + 2) * kstep;
            const char* a3 = a2 + kstep; const char* b3 = b2 + kstep;
            PG8_LDB(B0, 0, 0); PG8_LDB(B1, 0, 1); PG8_SCHED; PG8_LDA(At, 0, 0); PG8_STAGE(PG8_SA(1, 1), a1 + hstepA, voffA);
            PG8_WAIT_V(8); PG8_WAIT_L(0); PG8_BAR; PG8_MMA(0, 0, At, B0); PG8_MMA(0, 1, At, B1); PG8_BAR; PG8_SCHED;
            PG8_LDA(At, 0, 1); PG8_STAGE(PG8_SB(0, 0), b2, voffB); PG8_STAGE(PG8_SB(0, 1), b2 + hstepB, voffB); PG8_STAGE(PG8_SA(0, 0), a2, voffA);
            PG8_WAIT_V(8); PG8_WAIT_L(0); PG8_BAR; PG8_MMA(1, 0, At, B0); PG8_MMA(1, 1, At, B1); PG8_BAR; PG8_SCHED;
            PG8_LDB(B0, 1, 0); PG8_LDB(B1, 1, 1); PG8_SCHED; PG8_LDA(At, 1, 0); PG8_STAGE(PG8_SA(0, 1), a2 + hstepA, voffA);
            PG8_WAIT_V(8); PG8_WAIT_L(0); PG8_BAR; PG8_MMA(0, 0, At, B0); PG8_MMA(0, 1, At, B1); PG8_BAR; PG8_SCHED;
            PG8_LDA(At, 1, 1); PG8_STAGE(PG8_SB(1, 0), b3, voffB); PG8_STAGE(PG8_SB(1, 1), b3 + hstepB, voffB); PG8_STAGE(PG8_SA(1, 0), a3, voffA);
            PG8_WAIT_V(8); PG8_WAIT_L(0); PG8_BAR; PG8_MMA(1, 0, At, B0); PG8_MMA(1, 1, At, B1); PG8_BAR; PG8_SCHED;
        }
        if constexpr (ALIGN_EPI) { if (wr == 0) PG8_BAR; }
        E(acc, cur, wr, wc, fr, fq);
        if (!has_next) break;
#pragma unroll
        for (int a = 0; a < 2; ++a)
#pragma unroll
            for (int b = 0; b < 2; ++b)
#pragma unroll
                for (int m = 0; m < 4; ++m)
#pragma unroll
                    for (int n = 0; n < 2; ++n) acc[a][b][m][n] = (f32x4){0.f, 0.f, 0.f, 0.f};
        cur = nxt; cA = nA; cB = nB; ++ui;
        if constexpr (ALIGN_EPI) { if (wr == 1) PG8_BAR; }
    }
    PG8_WAIT_V(0);
    if constexpr (!ALIGN_EPI) { if (wr == 0) PG8_BAR; }
    PG8_BAR;
#undef PG8_SA
#undef PG8_SB
#undef PG8_STAGE
#undef PG8_LDA
#undef PG8_LDB
#undef PG8_MMA
#undef PG8_WAIT_V
#undef PG8_WAIT_L
#undef PG8_BAR
#undef PG8_SCHED
}

struct UnitX { int pm, pn, seg; };
__device__ __forceinline__ int uni(int v) { return __builtin_amdgcn_readfirstlane(v); }
__device__ __forceinline__ const char* unip(const char* p) { const unsigned long long v = (unsigned long long)p; const unsigned lo = (unsigned)__builtin_amdgcn_readfirstlane((int)(unsigned)v), hi = (unsigned)__builtin_amdgcn_readfirstlane((int)(unsigned)(v >> 32)); return (const char*)(((unsigned long long)hi << 32) | lo); }
template <class Epi, class Prog>
__device__ __forceinline__ void gemm_multi(LAS unsigned char* lds, const Prog& P, const Epi& E) {
    int tid = threadIdx.x; asm volatile("" : "+v"(tid));
    const int wid = __builtin_amdgcn_readfirstlane(tid >> 6), lane = tid & 63, wr = wid >> 2, wc = wid & 3, fr = lane & 15, fq = lane >> 4;
    unsigned Rr[2], RrB[2], Cc2[2];
#pragma unroll
    for (int i = 0; i < 2; ++i) { int R, C; stage_rc(tid * 16 + i * 8192, R, C); Rr[i] = (unsigned)R * 2u; RrB[i] = (unsigned)((R & ~31) + perm32(R & 31)) * 2u; Cc2[i] = (unsigned)C * 2u; }
    const size_t kstep = (size_t)(BK * 2);
    const unsigned ldsw = (unsigned)wid * 1024u;
    const int aoff = lds_byte(wr * 64 + fr, fq * 8), boff = lds_byte(wc * 32 + fr, fq * 8);
#define PG8_SA(b, h) (((b) * 2 + (h)) * HTB)
#define PG8_SB(b, h) ((4 + (b) * 2 + (h)) * HTB)
#define PG8_STAGE_X(RR, bufoff, gbase, ld) do { _Pragma("unroll") for (int _i = 0; _i < 2; ++_i) \
        __builtin_amdgcn_global_load_lds((const unsigned*)((const char*)(gbase) + (RR[_i] * (unsigned)(ld) + Cc2[_i])), (LAS unsigned*)(lds + (bufoff) + ldsw + _i * 8192), 16, 0, 0); } while (0)
#define PG8_STAGE(bufoff, gbase, ld) PG8_STAGE_X(Rr, bufoff, gbase, ld)
#define PG8_STAGEB(bufoff, gbase, ld) PG8_STAGE_X(RrB, bufoff, gbase, ld)
#define PG8_LDA(dst, b, h) do { _Pragma("unroll") for (int m = 0; m < 4; ++m) _Pragma("unroll") for (int k = 0; k < 2; ++k) dst[m][k] = *(const LAS bf16x8*)(lds + PG8_SA(b, h) + aoff + m * 2048 + k * 1024); } while (0)
#define PG8_LDB(dst, b, h) do { _Pragma("unroll") for (int n = 0; n < 2; ++n) _Pragma("unroll") for (int k = 0; k < 2; ++k) dst[n][k] = *(const LAS bf16x8*)(lds + PG8_SB(b, h) + boff + n * 2048 + k * 1024); } while (0)
#define PG8_MMA(ai, bj, At, Bt) do { __builtin_amdgcn_s_setprio(1); _Pragma("unroll") for (int m = 0; m < 4; ++m) _Pragma("unroll") for (int n = 0; n < 2; ++n) _Pragma("unroll") for (int k = 0; k < 2; ++k) \
        acc[ai][bj][m][n] = __builtin_amdgcn_mfma_f32_16x16x32_bf16(Bt[n][k], At[m][k], acc[ai][bj][m][n], 0, 0, 0); __builtin_amdgcn_s_setprio(0); } while (0)
#define PG8_WAIT_V(n) asm volatile("s_waitcnt vmcnt(" #n ")" ::: "memory")
#define PG8_WAIT_L(n) asm volatile("s_waitcnt lgkmcnt(" #n ")" ::: "memory")
#define PG8_BAR __builtin_amdgcn_s_barrier()
#define PG8_SCHED __builtin_amdgcn_sched_barrier(0)
    UnitX cur, nxt; int ui = 0;
    if (!P.next(0, cur)) return;
    f32x4 acc[2][2][4][2];
#pragma unroll
    for (int a = 0; a < 2; ++a)
#pragma unroll
        for (int b = 0; b < 2; ++b)
#pragma unroll
            for (int m = 0; m < 4; ++m)
#pragma unroll
                for (int n = 0; n < 2; ++n) acc[a][b][m][n] = (f32x4){0.f, 0.f, 0.f, 0.f};
    bf16x8 At[4][2], B0[2][2], B1[2][2];
    const char* cA; const char* cB; int lda, ldb, nt;
    P.desc(cur, cA, cB, lda, ldb, nt); cA = unip(cA); cB = unip(cB); lda = uni(lda); ldb = uni(ldb); nt = uni(nt);
    {   const size_t hA = (size_t)HALF * lda * 2, hB = (size_t)HALF * ldb * 2;
        PG8_STAGEB(PG8_SB(0, 0), cB, ldb); PG8_STAGEB(PG8_SB(0, 1), cB + hB, ldb); PG8_STAGE(PG8_SA(0, 0), cA, lda); PG8_STAGE(PG8_SA(0, 1), cA + hA, lda);
        if (wr == 1) PG8_BAR;
        PG8_WAIT_V(2); PG8_BAR;
        PG8_STAGEB(PG8_SB(1, 0), cB + kstep, ldb); PG8_STAGE(PG8_SA(1, 0), cA + kstep, lda); PG8_STAGEB(PG8_SB(1, 1), cB + hB + kstep, ldb);
        PG8_WAIT_V(6); PG8_BAR; }
    for (;;) {
        const bool has_next = P.next(ui + 1, nxt);
        const char* nA = cA; const char* nB = cB; int ldan = lda, ldbn = ldb, ntn = nt;
        if (has_next) P.desc(nxt, nA, nB, ldan, ldbn, ntn);
        nA = unip(nA); nB = unip(nB); ldan = uni(ldan); ldbn = uni(ldbn); ntn = uni(ntn);
        const size_t hAc = (size_t)HALF * lda * 2;
        for (int t = 0; t < nt; t += 2) {
            const bool last = (t == nt - 2);
            const char* a1 = cA + (size_t)(t + 1) * kstep;
            const char* a2 = last ? nA : cA + (size_t)(t + 2) * kstep; const char* b2 = last ? nB : cB + (size_t)(t + 2) * kstep;
            const int lda2 = last ? ldan : lda, ldb2 = last ? ldbn : ldb;
            const size_t hA2 = (size_t)HALF * lda2 * 2, hB2 = (size_t)HALF * ldb2 * 2;
            const char* a3 = a2 + kstep; const char* b3 = b2 + kstep;
            PG8_LDB(B0, 0, 0); PG8_LDB(B1, 0, 1); PG8_SCHED; PG8_LDA(At, 0, 0); PG8_STAGE(PG8_SA(1, 1), a1 + hAc, lda);
            PG8_WAIT_V(8); PG8_WAIT_L(0); PG8_BAR; PG8_MMA(0, 0, At, B0); PG8_MMA(0, 1, At, B1); PG8_BAR; PG8_SCHED;
            PG8_LDA(At, 0, 1); PG8_STAGEB(PG8_SB(0, 0), b2, ldb2); PG8_STAGEB(PG8_SB(0, 1), b2 + hB2, ldb2); PG8_STAGE(PG8_SA(0, 0), a2, lda2);
            PG8_WAIT_V(8); PG8_WAIT_L(0); PG8_BAR; PG8_MMA(1, 0, At, B0); PG8_MMA(1, 1, At, B1); PG8_BAR; PG8_SCHED;
            PG8_LDB(B0, 1, 0); PG8_LDB(B1, 1, 1); PG8_SCHED; PG8_LDA(At, 1, 0); PG8_STAGE(PG8_SA(0, 1), a2 + hA2, lda2);
            PG8_WAIT_V(8); PG8_WAIT_L(0); PG8_BAR; PG8_MMA(0, 0, At, B0); PG8_MMA(0, 1, At, B1); PG8_BAR; PG8_SCHED;
            PG8_LDA(At, 1, 1); PG8_STAGEB(PG8_SB(1, 0), b3, ldb2); PG8_STAGEB(PG8_SB(1, 1), b3 + hB2, ldb2); PG8_STAGE(PG8_SA(1, 0), a3, lda2);
            PG8_WAIT_V(8); PG8_WAIT_L(0); PG8_BAR; PG8_MMA(1, 0, At, B0); PG8_MMA(1, 1, At, B1); PG8_BAR; PG8_SCHED;
        }
        if (wr == 0) PG8_BAR;
        E(acc, cur, wr, wc, fr, fq);
        if (!has_next) break;
#pragma unroll
        for (int a = 0; a < 2; ++a)
#pragma unroll
            for (int b = 0; b < 2; ++b)
#pragma unroll
                for (int m = 0; m < 4; ++m)
#pragma unroll
                    for (int n = 0; n < 2; ++n) acc[a][b][m][n] = (f32x4){0.f, 0.f, 0.f, 0.f};
        cur = nxt; cA = nA; cB = nB; lda = ldan; ldb = ldbn; nt = ntn; ++ui;
        if (wr == 1) PG8_BAR;
    }
    PG8_WAIT_V(0);
    PG8_BAR;
#undef PG8_SA
#undef PG8_SB
#undef PG8_STAGE
#undef PG8_STAGEB
#undef PG8_STAGE_X
#undef PG8_LDA
#undef PG8_LDB
#undef PG8_MMA
#undef PG8_WAIT_V
#undef PG8_WAIT_L
#undef PG8_BAR
#undef PG8_SCHED
}

#define EPI_ROWS_BEGIN  _Pragma("unroll") for (int ai = 0; ai < 2; ++ai) _Pragma("unroll") for (int m = 0; m < 4; ++m) { const int row = u.pm * BM + ai * HALF + wr * 64 + m * 16 + fr;
#define EPI_COLS_BEGIN  _Pragma("unroll") for (int bj = 0; bj < 2; ++bj) _Pragma("unroll") for (int n = 0; n < 2; ++n) { const int col = bj * HALF + wc * 32 + 8 * fq + 4 * n; f32x4 v = acc[ai][bj][m][n];
#define EPI_END } }
#define EPI_COLS8_BEGIN  _Pragma("unroll") for (int bj = 0; bj < 2; ++bj) { const int col = bj * HALF + wc * 32 + 8 * fq; const f32x4 v0 = acc[ai][bj][m][0], v1 = acc[ai][bj][m][1];

struct EpiG1 {
    const float* rs; bf16_t* ZM; bf16_t* ZT;
    __device__ __forceinline__ void operator()(const f32x4 (&acc)[2][2][4][2], const Unit& u, int wr, int wc, int fr, int fq) const {
        const int pn = u.pn;
        if (pn >= 4 && pn < 6) {
            const int d0 = (pn - 4) * 256;
            EPI_ROWS_BEGIN
            EPI_COLS_BEGIN
                GAS bf16_t* d = (GAS bf16_t*)ZT + ((size_t)(row >> 6) * 512 + d0 + col) * 64 + (row & 63);
                const unsigned w0 = pk2(v[0], v[1]), w1 = pk2(v[2], v[3]);
                d[0] = (bf16_t)w0; d[64] = (bf16_t)(w0 >> 16); d[128] = (bf16_t)w1; d[192] = (bf16_t)(w1 >> 16);
            EPI_END
        } else if (pn >= 6 && pn < 8) {
            const int j0 = (pn - 6) * 256;
            EPI_ROWS_BEGIN
            EPI_COLS_BEGIN
                GAS bf16_t* d = (GAS bf16_t*)ZT + (size_t)MTOK * 512 + ((size_t)(row >> 9) * 512 + j0 + col) * 512 + (row & 511);
                const unsigned w0 = pk2(v[0], v[1]), w1 = pk2(v[2], v[3]);
                d[0] = (bf16_t)w0; d[512] = (bf16_t)(w0 >> 16); d[1024] = (bf16_t)w1; d[1536] = (bf16_t)(w1 >> 16);
            EPI_END
        } else {
            const int cm = (pn < 4 ? pn : pn - 4) * 256;
            EPI_ROWS_BEGIN
            EPI_COLS8_BEGIN
                u32x4 w; w.x = pk2(v0[0], v0[1]); w.y = pk2(v0[2], v0[3]); w.z = pk2(v1[0], v1[1]); w.w = pk2(v1[2], v1[3]);
                *(GAS u32x4*)((GAS bf16_t*)ZM + (size_t)row * ZMW + cm + col) = w;
            EPI_END
        }
    }
};
struct EpiDFT {
    bf16_t* Y;
    __device__ __forceinline__ void operator()(const f32x4 (&acc)[2][2][4][2], const Unit& u, int wr, int wc, int fr, int fq) const {
        int tok0, R, q;
        if (u.pm < 128) { tok0 = (u.pm >> 2) * 2048; R = 4; q = u.pm & 3; } else { const int t = u.pm - 128; tok0 = MP + (t >> 4) * 8192; R = 16; q = t & 15; }
        EPI_ROWS_BEGIN const int p = row - u.pm * BM;
        EPI_COLS_BEGIN
            const int k0 = u.pn * BM + col;
            GAS bf16_t* d = (GAS bf16_t*)Y + (size_t)(tok0 + R * k0 + q) * DM + 512 + p;
            const unsigned w0 = pk2(v[0], v[1]), w1 = pk2(v[2], v[3]);
            d[0] = (bf16_t)w0; d[(size_t)R * DM] = (bf16_t)(w0 >> 16); d[(size_t)2 * R * DM] = (bf16_t)w1; d[(size_t)3 * R * DM] = (bf16_t)(w1 >> 16);
        EPI_END
    }
};
struct EpiG2 {
    const float* rs; bf16_t* Y;
    __device__ __forceinline__ void operator()(const f32x4 (&acc)[2][2][4][2], const Unit& u, int wr, int wc, int fr, int fq) const {
        EPI_ROWS_BEGIN
        EPI_COLS8_BEGIN
            GAS u32x4* p = (GAS u32x4*)((GAS bf16_t*)Y + (size_t)row * DM + u.pn * BM + col);
            const u32x4 y = *p; u32x4 w;
            w.x = pk2(bflo(y.x) * siluf_(v0[0]), bfhi(y.x) * siluf_(v0[1])); w.y = pk2(bflo(y.y) * siluf_(v0[2]), bfhi(y.y) * siluf_(v0[3]));
            w.z = pk2(bflo(y.z) * siluf_(v1[0]), bfhi(y.z) * siluf_(v1[1])); w.w = pk2(bflo(y.w) * siluf_(v1[2]), bfhi(y.w) * siluf_(v1[3]));
            *p = w;
        EPI_END
    }
};
struct ProgG34 {
    StaticOrder S; const bf16_t* Y; const bf16_t* XB; const char* wsb; const bf16_t* WM; int layer;
    __device__ __forceinline__ bool next(int i, UnitX& u) const { Unit t; if (!S.next(i / 6, t)) return false; u.pm = t.pm; u.pn = t.pn; u.seg = i % 6; return true; }
    __device__ __forceinline__ void desc(const UnitX& u, const char*& A, const char*& B, int& lda, int& ldb, int& nt) const {
        const int b = u.seg >> 1; lda = DM;
        if (u.seg & 1) { A = (const char*)(XB + (size_t)u.pm * BM * DM); B = (const char*)(WM + (size_t)b * DM * DM + (size_t)u.pn * BM * DM); ldb = DM; nt = DM / BK; }
        else { const int kb = (b == 0) ? 512 : 256, ac = (b == 0) ? 0 : (b == 1 ? 512 : 768);
            const size_t woff = (size_t)((b == 0) ? 26 : 27 + b) * MiB + (size_t)layer * ((b == 0) ? MiB : MiB / 2);
            const bf16_t* w = (const bf16_t*)(wsb + woff);
            A = (const char*)(Y + (size_t)u.pm * BM * DM + ac); B = (const char*)(w + (size_t)u.pn * BM * kb); ldb = kb; nt = kb / BK; }
    }
};
struct EpiG34 {
    const float* rs; bf16_t* PT; bf16_t* MT; bf16_t* MG;
    __device__ __forceinline__ void operator()(const f32x4 (&acc)[2][2][4][2], const UnitX& u, int wr, int wc, int fr_, int fq_) const {
        int fr = fr_, fq = fq_; asm volatile("" : "+v"(fr), "+v"(fq));
        if ((u.seg & 1) == 0) {
            EPI_ROWS_BEGIN
            EPI_COLS8_BEGIN
                u32x4 w; w.x = pk2(v0[0], v0[1]); w.y = pk2(v0[2], v0[3]); w.z = pk2(v1[0], v1[1]); w.w = pk2(v1[2], v1[3]);
                *(GAS u32x4*)(PT + (size_t)(row - u.pm * BM) * 256 + col) = w;
            EPI_END
        } else {
            const int mode = u.seg >> 1;
            GAS bf16_t* dst = (mode == 2) ? (GAS bf16_t*)MG + (size_t)u.pm * BM * DM + u.pn * BM : (GAS bf16_t*)MT;
            const int dld = (mode == 2) ? DM : 256;
            const int rl0 = wr * 64 + fr, c0 = wc * 32 + 8 * fq;
#pragma unroll
            for (int ai = 0; ai < 2; ++ai) {
                u32x4 pv[4][2], mv[4][2];
#pragma unroll
                for (int m = 0; m < 4; ++m)
#pragma unroll
                    for (int bj = 0; bj < 2; ++bj) pv[m][bj] = *(const GAS u32x4*)(PT + (size_t)(ai * HALF + rl0 + m * 16) * 256 + bj * HALF + c0);
                if (mode != 0) {
#pragma unroll
                    for (int m = 0; m < 4; ++m)
#pragma unroll
                        for (int bj = 0; bj < 2; ++bj) mv[m][bj] = *(const GAS u32x4*)(MT + (size_t)(ai * HALF + rl0 + m * 16) * 256 + bj * HALF + c0);
                } else {
#pragma unroll
                    for (int m = 0; m < 4; ++m)
#pragma unroll
                        for (int bj = 0; bj < 2; ++bj) mv[m][bj] = (u32x4){0u, 0u, 0u, 0u};
                }
                __builtin_amdgcn_sched_barrier(0);
#pragma unroll
                for (int m = 0; m < 4; ++m)
#pragma unroll
                    for (int bj = 0; bj < 2; ++bj) {
                        const f32x4 v0 = acc[ai][bj][m][0], v1 = acc[ai][bj][m][1]; const u32x4 p = pv[m][bj], q = mv[m][bj];
                        const float r0 = bflo(q.x) + bflo(p.x) * sigmoidf_(v0[0]), r1 = bfhi(q.x) + bfhi(p.x) * sigmoidf_(v0[1]), r2 = bflo(q.y) + bflo(p.y) * sigmoidf_(v0[2]), r3 = bfhi(q.y) + bfhi(p.y) * sigmoidf_(v0[3]);
                        const float r4 = bflo(q.z) + bflo(p.z) * sigmoidf_(v1[0]), r5 = bfhi(q.z) + bfhi(p.z) * sigmoidf_(v1[1]), r6 = bflo(q.w) + bflo(p.w) * sigmoidf_(v1[2]), r7 = bfhi(q.w) + bfhi(p.w) * sigmoidf_(v1[3]);
                        u32x4 w; w.x = pk2(r0, r1); w.y = pk2(r2, r3); w.z = pk2(r4, r5); w.w = pk2(r6, r7);
                        *(GAS u32x4*)(dst + (size_t)(ai * HALF + rl0 + m * 16) * dld + bj * HALF + c0) = w;
                    }
                __builtin_amdgcn_sched_barrier(0);
            }
        }
    }
};
struct EpiG5 {
    bf16_t* O; float* ss;
    __device__ __forceinline__ void operator()(const f32x4 (&acc)[2][2][4][2], const Unit& u, int wr, int wc, int fr, int fq) const {
        EPI_ROWS_BEGIN float q = 0.f;
        EPI_COLS8_BEGIN
            u32x4 w; w.x = pk2(v0[0], v0[1]); w.y = pk2(v0[2], v0[3]); w.z = pk2(v1[0], v1[1]); w.w = pk2(v1[2], v1[3]);
            *(GAS u32x4*)((GAS bf16_t*)O + (size_t)row * DM + u.pn * BM + col) = w;
            q += ((v0[0] * v0[0] + v0[1] * v0[1]) + (v0[2] * v0[2] + v0[3] * v0[3])) + ((v1[0] * v1[0] + v1[1] * v1[1]) + (v1[2] * v1[2] + v1[3] * v1[3]));
        }
            q += __shfl_xor(q, 16); q += __shfl_xor(q, 32);
            if (fq == 0) atomicAdd(ss + row, q);
        }
    }
};
}

__device__ __forceinline__ void transpose_item(const float* W, int K, int pitch, int c0, int ncols, bf16_t* WT, int row_off, const float* g, float scale, LAS float* scr, int item, int lane) {
    const int nblk = ncols / 32, kb = item / nblk, nb = item % nblk, k0 = 64 * kb, n0 = 32 * nb;
#pragma unroll 8
    for (int i = 0; i < 32; ++i) { const int kk = 2 * i + (lane >> 5); float w = W[(size_t)(k0 + kk) * pitch + c0 + n0 + (lane & 31)] * scale; if (g) w *= g[k0 + kk]; scr[kk * 33 + (lane & 31)] = w; }
    LDS_WAIT(); asm volatile("" ::: "memory");
    const int c = lane & 7;
#pragma unroll
    for (int j = 0; j < 4; ++j) { const int n = (lane >> 3) + 8 * j; const LAS float* s = scr + (8 * c) * 33 + n;
        u32x4 o; o.x = pk2(s[0 * 33], s[1 * 33]); o.y = pk2(s[2 * 33], s[3 * 33]); o.z = pk2(s[4 * 33], s[5 * 33]); o.w = pk2(s[6 * 33], s[7 * 33]);
        *(u32x4*)(WT + (size_t)(row_off + n0 + n) * K + k0 + 8 * c) = o; }
    LDS_WAIT(); asm volatile("" ::: "memory");
}

struct Args { const float* in[14]; float* out; unsigned char* ws; int ph_lo, ph_hi; };

__device__ __forceinline__ void grid_row_info(int gr, int& seqbase, int& r, int& nrows) {
    if (gr < 1024) { seqbase = (gr >> 5) << 11; r = gr & 31; nrows = 32; } else { const int g2 = gr - 1024; seqbase = MP + ((g2 >> 7) << 13); r = g2 & 127; nrows = 128; }
}

constexpr int AT_KSLOT = 9216, AT_VSLOT = 8704, AT_VOFF = 73728, AT_BOFF = 143360;
__device__ __forceinline__ void attn_fill_issue(const GAS bf16_t* ZM, const GAS bf16_t* ZT, int tok0, int head, int tid, u32x4& kreg, u32x4& vreg) {
    kreg = *(const GAS u32x4*)(ZM + (size_t)(tok0 + (tid >> 3)) * ZMW + 512 + head * 64 + (tid & 7) * 8);
    vreg = *(const GAS u32x4*)(ZT + ((size_t)(tok0 >> 6) * 512 + head * 64) * 64 + tid * 8);
}
__device__ __forceinline__ void attn_fill_write(LAS unsigned char* lds, int slot, int tid, const u32x4 kreg, const u32x4 vreg) {
    *(LAS u32x4*)(lds + slot * AT_KSLOT + (tid >> 3) * 144 + (tid & 7) * 16) = kreg;
    LAS u32x2* vp = (LAS u32x2*)(lds + AT_VOFF + slot * AT_VSLOT + (tid >> 3) * 136 + (tid & 7) * 16);
    u32x2 a; a.x = vreg.x; a.y = vreg.y; u32x2 b; b.x = vreg.z; b.y = vreg.w;
    vp[0] = a; vp[1] = b;
}
__device__ __forceinline__ void attn_row_lds(LAS unsigned char* lds, int seqbase, int r, int rs, int head, int lane, int wave, const bf16x8 bq0, const bf16x8 bq1, GAS bf16_t* Y, const unsigned (&bcp)[32]) {
    const int g = wave & 3, dh = wave >> 2;
    const int qi = lane & 15, h4 = lane >> 4;
    const int cs = (g == 0) ? 0 : (g == 1) ? 8 : (g == 2) ? 24 : 32;
    const int qc = 16 * g + qi;
    const int qtok = seqbase + r * 64 + qc;
    f32x4 S[16];
    float mx = -3.0e38f;
#pragma unroll
    for (int hb = 0; hb < 2; ++hb) {
        bf16x8 ak[8][2];
#pragma unroll
        for (int tt = 0; tt < 8; ++tt) {
            const int t = hb * 8 + tt, kr = t >> 1, hf = t & 1;
            const int slot = (rs + kr) & 7;
            const LAS unsigned char* kp = lds + slot * AT_KSLOT + (cs + 16 * hf + qi) * 144 + h4 * 16;
            ak[tt][0] = *(const LAS bf16x8*)kp; ak[tt][1] = *(const LAS bf16x8*)(kp + 64);
        }
        __builtin_amdgcn_sched_barrier(0);
#pragma unroll
        for (int tt = 0; tt < 8; ++tt) {
            const int t = hb * 8 + tt;
            f32x4 s = {0.f, 0.f, 0.f, 0.f};
            s = __builtin_amdgcn_mfma_f32_16x16x32_bf16(ak[tt][0], bq0, s, 0, 0, 0);
            s = __builtin_amdgcn_mfma_f32_16x16x32_bf16(ak[tt][1], bq1, s, 0, 0, 0);
            s[0] += bflo(bcp[2 * t]); s[1] += bfhi(bcp[2 * t]); s[2] += bflo(bcp[2 * t + 1]); s[3] += bfhi(bcp[2 * t + 1]);
            mx = fmaxf(mx, fmaxf(fmaxf(s[0], s[1]), fmaxf(s[2], s[3])));
            S[t] = s;
        }
        __builtin_amdgcn_sched_barrier(0);
    }
    u32x2 vf[2][8][2];
#pragma unroll
    for (int dti = 0; dti < 2; ++dti)
#pragma unroll
        for (int kr = 0; kr < 8; ++kr) {
            const int slot = (rs + kr) & 7;
            const LAS unsigned char* vp = lds + AT_VOFF + slot * AT_VSLOT + ((2 * dh + dti) * 16 + qi) * 136 + (cs + 4 * h4) * 2;
            vf[dti][kr][0] = *(const LAS u32x2*)vp; vf[dti][kr][1] = *(const LAS u32x2*)(vp + 32);
        }
    __builtin_amdgcn_sched_barrier(0);
    mx = fmaxf(mx, __shfl_xor(mx, 16)); mx = fmaxf(mx, __shfl_xor(mx, 32));
    float sum = 0.f;
    bf16x8 pf[8];
#pragma unroll
    for (int kr = 0; kr < 8; ++kr) {
        const f32x4 a = S[kr * 2], b = S[kr * 2 + 1];
        const float p0 = __expf(a[0] - mx), p1 = __expf(a[1] - mx), p2 = __expf(a[2] - mx), p3 = __expf(a[3] - mx);
        const float p4 = __expf(b[0] - mx), p5 = __expf(b[1] - mx), p6 = __expf(b[2] - mx), p7 = __expf(b[3] - mx);
        sum += ((p0 + p1) + (p2 + p3)) + ((p4 + p5) + (p6 + p7));
        u32x4 w; w.x = pk2(p0, p1); w.y = pk2(p2, p3); w.z = pk2(p4, p5); w.w = pk2(p6, p7);
        pf[kr] = __builtin_bit_cast(bf16x8, w);
    }
    sum += __shfl_xor(sum, 16); sum += __shfl_xor(sum, 32);
    const float inv = __builtin_amdgcn_rcpf(sum);
    GAS bf16_t* yp = Y + (size_t)qtok * DM + head * 64 + 4 * h4;
#pragma unroll
    for (int dti = 0; dti < 2; ++dti) {
        const int dt = 2 * dh + dti;
        f32x4 o = {0.f, 0.f, 0.f, 0.f};
#pragma unroll
        for (int kr = 0; kr < 8; ++kr) {
            u32x4 w; w.x = vf[dti][kr][0].x; w.y = vf[dti][kr][0].y; w.z = vf[dti][kr][1].x; w.w = vf[dti][kr][1].y;
            o = __builtin_amdgcn_mfma_f32_16x16x32_bf16(__builtin_bit_cast(bf16x8, w), pf[kr], o, 0, 0, 0);
        }
        u32x2 w; w.x = pk2(o[0] * inv, o[1] * inv); w.y = pk2(o[2] * inv, o[3] * inv);
        *(GAS u32x2*)(yp + dt * 16) = w;
    }
}
__device__ __forceinline__ void attn_unit(LAS unsigned char* lds, int seqbase, int nrows, int ra, int rb, int head, int tid, int lane, int wave,
                                          const bf16_t* ZM_, const bf16_t* ZT_, bf16_t* Y_, const float* rpb) {
    const GAS bf16_t* ZM = (const GAS bf16_t*)ZM_; const GAS bf16_t* ZT = (const GAS bf16_t*)ZT_; GAS bf16_t* Y = (GAS bf16_t*)Y_;
    int rs = ra - 4; rs = rs < 0 ? 0 : rs; rs = rs > nrows - 8 ? nrows - 8 : rs;
    {   u32x4 kreg[8], vreg[8];
#pragma unroll
        for (int k = 0; k < 8; ++k) attn_fill_issue(ZM, ZT, seqbase + (rs + k) * 64, head, tid, kreg[k], vreg[k]);
        LAS float* bw = (LAS float*)(lds + AT_BOFF);
        if (tid < 465) bw[tid] = rpb[head * 465 + tid];
#pragma unroll
        for (int k = 0; k < 8; ++k) attn_fill_write(lds, (rs + k) & 7, tid, kreg[k], vreg[k]);
    }
    const GAS bf16_t* qbase = ZM + (size_t)(seqbase + 16 * (wave & 3) + (lane & 15)) * ZMW + head * 64 + 8 * (lane >> 4);
    bf16x8 q0 = *(const GAS bf16x8*)(qbase + (size_t)ra * 64 * ZMW), q1 = *(const GAS bf16x8*)(qbase + (size_t)ra * 64 * ZMW + 32);
    __syncthreads();
    unsigned bcp[32]; int cdelta = 1000;
#pragma unroll
    for (int i = 0; i < 32; ++i) bcp[i] = 0u;
#pragma unroll 1
    for (int r = ra; r < rb; ++r) {
        if (rs - r != cdelta) {
            cdelta = rs - r;
            const LAS float* bias = (const LAS float*)(lds + AT_BOFF);
            const int g_ = wave & 3, qi_ = lane & 15, h4_ = lane >> 4, cs_ = (g_ == 0) ? 0 : (g_ == 1) ? 8 : (g_ == 2) ? 24 : 32, qc_ = 16 * g_ + qi_;
            int cst_ = qc_ - 8; cst_ = cst_ < 0 ? 0 : cst_; cst_ = cst_ > 48 ? 48 : cst_;
#pragma unroll
            for (int t = 0; t < 16; ++t) {
                float bv[4];
#pragma unroll
                for (int e = 0; e < 4; ++e) {
                    const int kc = cs_ + 16 * (t & 1) + 4 * h4_ + e; int dc = kc - qc_ + 15; dc = dc < 0 ? 0 : dc; dc = dc > 30 ? 30 : dc;
                    const float b = bias[(cdelta + (t >> 1) + 7) * 31 + dc];
                    bv[e] = ((kc >= cst_) && (kc < cst_ + 16)) ? b : -1.0e30f;
                }
                bcp[2 * t] = pk2(bv[0], bv[1]); bcp[2 * t + 1] = pk2(bv[2], bv[3]);
            }
        }
        const int rq = (r + 1 < rb) ? r + 1 : r;
        const bf16x8 nq0 = *(const GAS bf16x8*)(qbase + (size_t)rq * 64 * ZMW), nq1 = *(const GAS bf16x8*)(qbase + (size_t)rq * 64 * ZMW + 32);
        int rsn = r + 1 - 4; rsn = rsn < 0 ? 0 : rsn; rsn = rsn > nrows - 8 ? nrows - 8 : rsn;
        const bool adv = (r + 1 < rb) && (rsn != rs);
        u32x4 kreg = {0u, 0u, 0u, 0u}, vreg = {0u, 0u, 0u, 0u};
        if (adv) attn_fill_issue(ZM, ZT, seqbase + (rsn + 7) * 64, head, tid, kreg, vreg);
        attn_row_lds(lds, seqbase, r, rs, head, lane, wave, q0, q1, Y, bcp);
        LDS_WAIT(); __builtin_amdgcn_s_barrier(); asm volatile("" ::: "memory");
        if (adv) attn_fill_write(lds, (rsn + 7) & 7, tid, kreg, vreg);
        LDS_WAIT(); __builtin_amdgcn_s_barrier(); asm volatile("" ::: "memory");
        rs = rsn; q0 = nq0; q1 = nq1;
    }
}

#define DFT4(r0, i0, r1, i1, r2, i2, r3, i3) do { \
    const float ar_ = r0 + r2, ai_ = i0 + i2, br_ = r0 - r2, bi_ = i0 - i2, cr_ = r1 + r3, ci_ = i1 + i3, dr_ = r1 - r3, di_ = i1 - i3; \
    r0 = ar_ + cr_; i0 = ai_ + ci_; r1 = br_ + di_; i1 = bi_ - dr_; r2 = ar_ - cr_; i2 = ai_ - ci_; r3 = br_ - di_; i3 = bi_ + dr_; } while (0)
template <int R, int NU>
__device__ __forceinline__ void butterfly_unit(int tok0, int rowbase  , int p0, int t, const bf16_t* ZT_, bf16_t* YQ_, const float (&twr)[2][R], const float (&twi)[2][R]) {
    const GAS unsigned* zre = (const GAS unsigned*)((const GAS bf16_t*)ZT_ + (size_t)MTOK * 512 + ((size_t)(tok0 >> 9) * 512 + p0) * 512) + t;
    const GAS unsigned* zim = zre + 256 * 256;
    float xr[NU][2][R], xi[NU][2][R];
#pragma unroll
    for (int u = 0; u < NU; ++u)
#pragma unroll
        for (int s = 0; s < R; ++s) {
            const unsigned wr_ = zre[(size_t)s * 512 * 256 + u * 256], wi_ = zim[(size_t)s * 512 * 256 + u * 256];
            xr[u][0][s] = bflo(wr_); xr[u][1][s] = bfhi(wr_); xi[u][0][s] = bflo(wi_); xi[u][1][s] = bfhi(wi_);
        }
#pragma unroll
    for (int u = 0; u < NU; ++u) {
#pragma unroll
        for (int h = 0; h < 2; ++h) {
            if constexpr (R == 4) {
                DFT4(xr[u][h][0], xi[u][h][0], xr[u][h][1], xi[u][h][1], xr[u][h][2], xi[u][h][2], xr[u][h][3], xi[u][h][3]);
            } else {
#pragma unroll
                for (int b = 0; b < 4; ++b) DFT4(xr[u][h][b], xi[u][h][b], xr[u][h][4 + b], xi[u][h][4 + b], xr[u][h][8 + b], xi[u][h][8 + b], xr[u][h][12 + b], xi[u][h][12 + b]);
                constexpr float WR[10] = {1.f, 0.9238795325f, 0.7071067812f, 0.3826834324f, 0.f, 0.f, -0.7071067812f, 0.f, 0.f, -0.9238795325f};
                constexpr float WI[10] = {0.f, -0.3826834324f, -0.7071067812f, -0.9238795325f, -1.f, 0.f, -0.7071067812f, 0.f, 0.f, 0.3826834324f};
#pragma unroll
                for (int c = 1; c < 4; ++c)
#pragma unroll
                    for (int b = 1; b < 4; ++b) { const float w0 = WR[c * b], w1 = WI[c * b]; const float tr = xr[u][h][4 * c + b] * w0 - xi[u][h][4 * c + b] * w1, ti = xr[u][h][4 * c + b] * w1 + xi[u][h][4 * c + b] * w0; xr[u][h][4 * c + b] = tr; xi[u][h][4 * c + b] = ti; }
#pragma unroll
                for (int c = 0; c < 4; ++c) DFT4(xr[u][h][4 * c], xi[u][h][4 * c], xr[u][h][4 * c + 1], xi[u][h][4 * c + 1], xr[u][h][4 * c + 2], xi[u][h][4 * c + 2], xr[u][h][4 * c + 3], xi[u][h][4 * c + 3]);
            }
        }
        GAS unsigned* d0 = (GAS unsigned*)((GAS bf16_t*)YQ_ + (size_t)(rowbase + u) * 1024) + t;
#pragma unroll
        for (int q = 0; q < R; ++q) {
            const int sl = (R == 16) ? 4 * (q & 3) + (q >> 2) : q;
            const float r0 = xr[u][0][sl] * twr[0][q] - xi[u][0][sl] * twi[0][q], i0 = xr[u][0][sl] * twi[0][q] + xi[u][0][sl] * twr[0][q];
            const float r1 = xr[u][1][sl] * twr[1][q] - xi[u][1][sl] * twi[1][q], i1 = xr[u][1][sl] * twi[1][q] + xi[u][1][sl] * twr[1][q];
            GAS unsigned* d = d0 + (size_t)q * 256 * 512;
            d[0] = pk2(r0, r1); d[256] = pk2(i0, i1);
        }
    }
}

template <int MODE>
__device__ __forceinline__ void row_pass(int gw, int NGW, int lane, const float* x_prompt, const float* x_sample, float* out, bf16_t* XB, const bf16_t* O, float* RS, float* SS, const float* gpost) {
    for (int m = gw; m < MTOK; m += NGW) {
        f32x4 v[4];
        GAS u32x2* xbrow = (GAS u32x2*)((GAS bf16_t*)XB + (size_t)m * DM) + lane;
        if constexpr (MODE == 2) {
            u32x2 xv[4];
#pragma unroll
            for (int j = 0; j < 4; ++j) xv[j] = xbrow[64 * j];
            const float irs = RS[m];
#pragma unroll
            for (int j = 0; j < 4; ++j) { v[j][0] = bflo(xv[j].x) * irs; v[j][1] = bfhi(xv[j].x) * irs; v[j][2] = bflo(xv[j].y) * irs; v[j][3] = bfhi(xv[j].y) * irs; }
        } else {
            const GAS f32x4* xr = (const GAS f32x4*)((m < MP) ? x_prompt + (size_t)m * DM : x_sample + (size_t)(m - MP) * DM) + lane;
#pragma unroll
            for (int j = 0; j < 4; ++j) v[j] = xr[64 * j];
        }
        if constexpr (MODE != 0) {
            const float rq = rsqrtf(SS[m] * (1.0f / DM) + EPS);
            const GAS u32x2* orow = (const GAS u32x2*)((const GAS bf16_t*)O + (size_t)m * DM) + lane;
#pragma unroll
            for (int j = 0; j < 4; ++j) { const u32x2 ov = orow[64 * j]; const f32x4 gp = *((const GAS f32x4*)gpost + lane + 64 * j);
                v[j][0] += bflo(ov.x) * rq * gp[0]; v[j][1] += bfhi(ov.x) * rq * gp[1]; v[j][2] += bflo(ov.y) * rq * gp[2]; v[j][3] += bfhi(ov.y) * rq * gp[3]; }
            if constexpr (MODE == 2) {
                GAS f32x4* orow2 = (GAS f32x4*)(out + (size_t)m * DM) + lane;
#pragma unroll
                for (int j = 0; j < 4; ++j) orow2[64 * j] = v[j];
            }
        }
        if constexpr (MODE != 2) {
            float s = 0.f;
#pragma unroll
            for (int j = 0; j < 4; ++j) s += (v[j][0] * v[j][0] + v[j][1] * v[j][1]) + (v[j][2] * v[j][2] + v[j][3] * v[j][3]);
            s = wave_sum(s);
            const float ms = s * (1.0f / DM) + EPS;
            const float rsv = rsqrtf(ms);
#pragma unroll
            for (int j = 0; j < 4; ++j) { u32x2 w; w.x = pk2(v[j][0] * rsv, v[j][1] * rsv); w.y = pk2(v[j][2] * rsv, v[j][3] * rsv); xbrow[64 * j] = w; }
            if (lane == 0) { RS[m] = sqrtf(ms); SS[m] = 0.f; }
        }
    }
}

__global__ void __launch_bounds__(NWAVES * 64, 2) fwd_kernel(Args args) {
    extern __shared__ __attribute__((aligned(16))) unsigned char lds_raw[];
    LAS unsigned char* lds = (LAS unsigned char*)lds_raw;
    const int G = gridDim.x, bx = blockIdx.x;
    for (int ph = args.ph_lo; ph < args.ph_hi; ++ph) {
        if (ph > args.ph_lo) { cg::this_grid().sync(); }
        int tid = threadIdx.x; asm volatile("" : "+v"(tid));
        const int lane = tid & 63, wave = __builtin_amdgcn_readfirstlane(tid >> 6);
        const int gw = bx * NWAVES + wave, NGW = G * NWAVES;
        unsigned char* ws = args.ws; asm volatile("" : "+s"(ws));
        const float* x_prompt = args.in[0]; const float* x_sample = args.in[1];
        float* out = args.out;
        bf16_t* XB = (bf16_t*)(ws + WS_XB); bf16_t* OB = XB;
        bf16_t* ZM = (bf16_t*)(ws + WS_ZM); bf16_t* PB = ZM;
        bf16_t* ZT = (bf16_t*)(ws + WS_ZT); bf16_t* MG = ZT;
        bf16_t* YQ = (bf16_t*)(ws + WS_YQ);
        bf16_t* Y = (bf16_t*)(ws + WS_Y);
        bf16_t* TT = (bf16_t*)(ws + WS_T);
        float* RS = (float*)(ws + WS_RS); float* SS = (float*)(ws + WS_SS);
        const int layer = (ph == 0) ? 0 : (ph - 1) / 7;
        const int sub = (ph == 0) ? -1 : (ph - 1) % 7;
        const bf16_t* WIN = (const bf16_t*)(ws + WS_WIN) + (size_t)layer * NG1 * DM;
        const bf16_t* WG = (const bf16_t*)(ws + WS_WG) + (size_t)layer * DM * DM;
        const bf16_t* WM = (const bf16_t*)(ws + WS_WM) + (size_t)layer * 3072 * DM;
        const bf16_t* WA = (const bf16_t*)(ws + WS_WA) + (size_t)layer * DM * 512;
        const bf16_t* WB = (const bf16_t*)(ws + WS_WB) + (size_t)layer * DM * 256;
        const bf16_t* WC = (const bf16_t*)(ws + WS_WC) + (size_t)layer * DM * 256;
        const bf16_t* WO = (const bf16_t*)(ws + WS_WO) + (size_t)layer * DM * DM;

        if (PHON(0) && ph == 0) {
            LAS float* scr = (LAS float*)(lds + wave * 16384);
            for (int l = 0; l < 2; ++l) {
                const float* w_in = args.in[4] + (size_t)l * DM * DIN;
                const float* gpre = args.in[2] + l * DM;
                bf16_t* win = (bf16_t*)(ws + WS_WIN) + (size_t)l * NG1 * DM;
                bf16_t* wg = (bf16_t*)(ws + WS_WG) + (size_t)l * DM * DM;
                bf16_t* wm = (bf16_t*)(ws + WS_WM) + (size_t)l * 3072 * DM;
                for (int job = 0; job < 7; ++job) {
                    int c0, nc, ro; bf16_t* dst; float sc = 1.f;
                    switch (job) {
                        case 0: c0 = 0; nc = 512; dst = win; ro = 0; sc = 0.125f; break;
                        case 1: c0 = 512; nc = 1024; dst = win; ro = 512; break;
                        case 2: c0 = 2560; nc = 512; dst = win; ro = 2048; break;
                        case 3: c0 = 1536; nc = 512; dst = wg; ro = 0; break;
                        case 4: c0 = 2304; nc = 256; dst = wg; ro = 512; break;
                        case 5: c0 = 3072; nc = 256; dst = wg; ro = 768; break;
                        default: c0 = 3328; nc = 3072; dst = wm; ro = 0; break;
                    }
                    const int nitems = (DM / 64) * (nc / 32);
                    for (int it = gw; it < nitems; it += NGW) transpose_item(w_in, DM, DIN, c0, nc, dst, ro, gpre, sc, scr, it, lane);
                }
                {   const int ni = (512 / 64) * (DM / 32);
                    for (int it = gw; it < ni; it += NGW) transpose_item(args.in[10] + (size_t)l * 512 * DM, 512, DM, 0, DM, (bf16_t*)(ws + WS_WA) + (size_t)l * DM * 512, 0, nullptr, 1.f, scr, it, lane); }
                {   const int ni = (256 / 64) * (DM / 32);
                    for (int it = gw; it < ni; it += NGW) transpose_item(args.in[11] + (size_t)l * 256 * DM, 256, DM, 0, DM, (bf16_t*)(ws + WS_WB) + (size_t)l * DM * 256, 0, nullptr, 1.f, scr, it, lane);
                    for (int it = gw; it < ni; it += NGW) transpose_item(args.in[12] + (size_t)l * 256 * DM, 256, DM, 0, DM, (bf16_t*)(ws + WS_WC) + (size_t)l * DM * 256, 0, nullptr, 1.f, scr, it, lane); }
                {   const int ni = (DM / 64) * (DM / 32);
                    for (int it = gw; it < ni; it += NGW) transpose_item(args.in[13] + (size_t)l * DM * DM, DM, DM, 0, DM, (bf16_t*)(ws + WS_WO) + (size_t)l * DM * DM, 0, nullptr, 1.f, scr, it, lane); }
                LAS float* ctab = (LAS float*)(lds + 131072);
                if (l == 0) { if (tid < 64) { float sn, cs; sincospif((float)tid * (1.0f / 32.0f), &sn, &cs); ctab[tid] = cs; ctab[64 + tid] = sn; } __syncthreads(); }
                for (int idx = bx * 512 + tid; idx < DM * 256; idx += G * 512) {
                    const int k = idx >> 8, p = idx & 255, grp = p >> 6, mm = p & 63;
                    const f32x4* wrow = (const f32x4*)(w_in + (size_t)k * DIN + 2048 + grp * 64);
                    float are = 0.f, aim = 0.f;
#pragma unroll 4
                    for (int c4 = 0; c4 < 16; ++c4) { const f32x4 w = wrow[c4];
#pragma unroll
                        for (int e = 0; e < 4; ++e) { const int t = (mm * (4 * c4 + e)) & 63; are += w[e] * ctab[t]; aim -= w[e] * ctab[64 + t]; } }
                    const float gk = gpre[k];
                    win[(size_t)(1536 + p) * DM + k] = (bf16_t)f2bf(are * gk);
                    win[(size_t)(1536 + 256 + p) * DM + k] = (bf16_t)f2bf(aim * gk);
                }
            }
            for (int idx = bx * 512 + tid; idx < 512 * 512; idx += G * 512) {
                const int kp = idx >> 9, lp = idx & 511; float sn, cs; sincospif((float)((kp * lp) & 511) * (1.0f / 256.0f), &sn, &cs);
                TT[(size_t)kp * 1024 + lp] = (bf16_t)f2bf(cs); TT[(size_t)kp * 1024 + 512 + lp] = (bf16_t)f2bf(sn);
            }
        }
        if (PHON(1) && (ph == 0 || sub == 6)) {
            const float* gpost = args.in[3] + layer * DM;
            if (ph == 0) row_pass<0>(gw, NGW, lane, x_prompt, x_sample, out, XB, Y, RS, SS, gpost);
            else if (layer == 0) row_pass<1>(gw, NGW, lane, x_prompt, x_sample, out, XB, Y, RS, SS, gpost);
            else row_pass<2>(gw, NGW, lane, x_prompt, x_sample, out, XB, Y, RS, SS, gpost);
        } else if (PHON(2) && sub == 0) {
            pg8::Gemm g{XB, WIN, MTOK, NG1, DM, DM, DM}; pg8::StaticOrder S; S.init(MTOK, NG1, G, bx);
            pg8::EpiG1 E{RS, ZM, ZT};
            pg8::gemm_phase<pg8::EpiG1, pg8::StaticOrder, true>(lds, g, S, E);
        } else if (sub == 1) {
            if (PHON(3)) {
                const float* rpb = args.in[5] + (size_t)layer * 8 * 15 * 31;
                for (int un = bx; un < 512; un += G) {
                    if (un < 256) attn_unit(lds, (un >> 3) * 2048, 32, 0, 32, un & 7, tid, lane, wave, ZM, ZT, Y, rpb);
                    else { const int v = un - 256, st = v & 7; attn_unit(lds, MP + (v >> 6) * 8192, 128, st * 16, st * 16 + 16, (v >> 3) & 7, tid, lane, wave, ZM, ZT, Y, rpb); }
                }
            }
            if (PHON(4)) {
                LAS float* hbuf = (LAS float*)lds; LAS float* cbuf = (LAS float*)(lds + 65536);
                const float* dww = args.in[6] + (size_t)layer * 31 * 256; const float* dwb = args.in[7] + layer * 256;
                const float* lng = args.in[8] + layer * 256; const float* lnb = args.in[9] + layer * 256;
                const int c = tid & 255, half = tid >> 8;
                float w[31];
#pragma unroll
                for (int j = 0; j < 31; ++j) w[j] = dww[j * 256 + c];
                const float bc = dwb[c];
                const f32x4 lg = *((const f32x4*)lng + lane), lb = *((const f32x4*)lnb + lane);
                u32x4 pa[4], pb[4];
#define CONV_ISSUE(cu_) do { const int t0g_ = (cu_) * 32; \
                    int sbeg_, send_; if (t0g_ < MP) { sbeg_ = t0g_ & ~2047; send_ = sbeg_ + 2048; } else { sbeg_ = MP + ((t0g_ - MP) & ~8191); send_ = sbeg_ + 8192; } \
                    _Pragma("unroll") for (int k = 0; k < 4; ++k) { \
                        const int it = tid + k * 512, i = it >> 5, c8 = (it & 31) * 8; const int tok = t0g_ - 15 + i; \
                        int tokc = tok < sbeg_ ? sbeg_ : tok; tokc = tokc > send_ - 1 ? send_ - 1 : tokc;     \
                        const u32x4 la_ = *(const GAS u32x4*)((const GAS bf16_t*)ZM + (size_t)tokc * ZMW + 1024 + c8), lb_ = *(const GAS u32x4*)((const GAS bf16_t*)ZM + (size_t)tokc * ZMW + 1280 + c8); \
                        const unsigned keep_ = (tok >= sbeg_ && tok < send_) ? 0xffffffffu : 0u; \
                        pa[k].x = la_.x & keep_; pa[k].y = la_.y & keep_; pa[k].z = la_.z & keep_; pa[k].w = la_.w & keep_; pb[k] = lb_; \
                    } } while (0)
                for (int cu = bx; cu < MTOK / 32; cu += G) {
                    const int t0g = cu * 32;
                    CONV_ISSUE(cu);
#pragma unroll
                    for (int k = 0; k < 4; ++k) {
                        const int it = tid + k * 512, i = it >> 5, c8 = (it & 31) * 8;
                        if (it < 62 * 32) {
                            const u32x4 a = pa[k], b = pb[k]; f32x4 h0, h1;
                            h0[0] = bflo(a.x) * sigmoidf_(bflo(b.x)); h0[1] = bfhi(a.x) * sigmoidf_(bfhi(b.x)); h0[2] = bflo(a.y) * sigmoidf_(bflo(b.y)); h0[3] = bfhi(a.y) * sigmoidf_(bfhi(b.y));
                            h1[0] = bflo(a.z) * sigmoidf_(bflo(b.z)); h1[1] = bfhi(a.z) * sigmoidf_(bfhi(b.z)); h1[2] = bflo(a.w) * sigmoidf_(bflo(b.w)); h1[3] = bfhi(a.w) * sigmoidf_(bfhi(b.w));
                            *(LAS f32x4*)(hbuf + i * 256 + c8) = h0; *(LAS f32x4*)(hbuf + i * 256 + c8 + 4) = h1;
                        }
                    }
                    __syncthreads();
                    {   float hv[46];
#pragma unroll
                        for (int i = 0; i < 46; ++i) hv[i] = hbuf[(half * 16 + i) * 256 + c];
#pragma unroll
                        for (int tt = 0; tt < 16; ++tt) {
                            float a = bc;
#pragma unroll
                            for (int j = 0; j < 31; ++j) a += w[j] * hv[tt + j];
                            cbuf[(half * 16 + tt) * 256 + c] = a;
                        }
                    }
                    __syncthreads();
#pragma unroll
                    for (int tt = 0; tt < 4; ++tt) {
                        const int t = wave * 4 + tt;
                        const f32x4 xv = *(const LAS f32x4*)(cbuf + t * 256 + 4 * lane);
                        const float mean = wave_sum((xv[0] + xv[1]) + (xv[2] + xv[3])) * (1.0f / 256.0f);
                        const f32x4 d = xv - mean;
                        const float var = wave_sum((d[0] * d[0] + d[1] * d[1]) + (d[2] * d[2] + d[3] * d[3])) * (1.0f / 256.0f);
                        const float rstd = rsqrtf(var + EPS);
                        const float y0 = siluf_(d[0] * rstd * lg[0] + lb[0]), y1 = siluf_(d[1] * rstd * lg[1] + lb[1]), y2 = siluf_(d[2] * rstd * lg[2] + lb[2]), y3 = siluf_(d[3] * rstd * lg[3] + lb[3]);
                        u32x2 wv; wv.x = pk2(y0, y1); wv.y = pk2(y2, y3);
                        *(GAS u32x2*)((GAS bf16_t*)Y + (size_t)(t0g + t) * DM + 768 + 4 * lane) = wv;
                    }
                }
            }
            if (PHON(5)) {
                float t4r[2][4], t4i[2][4], t16r[2][16], t16i[2][16];
                const int bt = tid & 255, bh = tid >> 8;
                {   const float s4 = rsqrtf(64.0f * 2048.0f), s16 = rsqrtf(64.0f * 8192.0f);
#pragma unroll
                    for (int h = 0; h < 2; ++h) {
#pragma unroll
                        for (int q = 0; q < 4; ++q) { float sn, cs; sincospif(-2.0f * (float)(q * (2 * bt + h)) / 2048.0f, &sn, &cs); t4r[h][q] = cs * s4; t4i[h][q] = sn * s4; }
#pragma unroll
                        for (int q = 0; q < 16; ++q) { float sn, cs; sincospif(-2.0f * (float)(q * (2 * bt + h)) / 8192.0f, &sn, &cs); t16r[h][q] = cs * s16; t16i[h][q] = sn * s16; } } }
                for (int un = bx; un < 32 * 32; un += G) { const int seq = un >> 5, p = (un & 31) * 8 + bh * 4; butterfly_unit<4, 4>(seq * 2048, seq * 1024 + p, p, bt, ZT, YQ, t4r, t4i); }
                for (int un = bx; un < 4 * 128; un += G) { const int seq = un >> 7, p = (un & 127) * 2 + bh; butterfly_unit<16, 1>(MP + seq * 8192, 32768 + seq * 4096 + p, p, bt, ZT, YQ, t16r, t16i); }
            }
        } else if (PHON(6) && sub == 2) {
            pg8::Gemm g{YQ, TT, NYQ, 512, 1024, 1024, 1024}; pg8::StaticOrder S; S.init(NYQ, 512, G, bx);
            pg8::EpiDFT E{Y};
            pg8::gemm_phase<pg8::EpiDFT, pg8::StaticOrder, true>(lds, g, S, E);
        } else if (PHON(7) && sub == 3) {
            pg8::Gemm g{XB, WG, MTOK, DM, DM, DM, DM}; pg8::StaticOrder S; S.init(MTOK, DM, G, bx);
            pg8::EpiG2 E{RS, Y};
            pg8::gemm_phase<pg8::EpiG2, pg8::StaticOrder, true>(lds, g, S, E);
        } else if (sub == 4) {
            pg8::ProgG34 PG; PG.S.init(MTOK, DM, G, bx); PG.Y = Y; PG.XB = XB; PG.wsb = (const char*)ws; PG.WM = WM; PG.layer = layer;
            pg8::EpiG34 EG{RS, PB + (size_t)bx * 65536, PB + (size_t)(256 + bx) * 65536, MG};
            pg8::gemm_multi<pg8::EpiG34, pg8::ProgG34>(lds, PG, EG);
        } else if (PHON(10) && sub == 5) {
            pg8::Gemm g{MG, WO, MTOK, DM, DM, DM, DM}; pg8::StaticOrder S; S.init(MTOK, DM, G, bx);
            pg8::EpiG5 E{Y, SS};
            pg8::gemm_phase<pg8::EpiG5, pg8::StaticOrder, true>(lds, g, S, E);
        }
    }
}

extern "C" void kernel_launch(void* const* d_in, const int* in_sizes, int n_in, void* d_out, int out_size, void* d_ws, size_t ws_size, hipStream_t stream) {
    static int grid = 0;
    if (grid == 0) {
        if (n_in != 14 || ws_size < WS_END) { fprintf(stderr, "kernel_launch: bad inputs (n_in %d, ws %zu < %zu)\n", n_in, ws_size, (size_t)WS_END); grid = -1; return; }
        int dev = 0, cus = 0, per_cu = 0;
        hipGetDevice(&dev); hipDeviceGetAttribute(&cus, hipDeviceAttributeMultiprocessorCount, dev);
        if (hipFuncSetAttribute((const void*)fwd_kernel, hipFuncAttributeMaxDynamicSharedMemorySize, LDS_BYTES) != hipSuccess) { fprintf(stderr, "hipFuncSetAttribute failed\n"); grid = -1; return; }
        hipOccupancyMaxActiveBlocksPerMultiprocessor(&per_cu, (const void*)fwd_kernel, NWAVES * 64, LDS_BYTES);
        (void)hipGetLastError();
        if (per_cu < 1) { fprintf(stderr, "occupancy query says 0 blocks per CU\n"); }
        grid = cus;
    }
    if (grid < 0) return;
    Args a{};
    for (int i = 0; i < 14; ++i) a.in[i] = (const float*)d_in[i];
    a.out = (float*)d_out; a.ws = (unsigned char*)d_ws;
#if MK_ONE_LAUNCH
    a.ph_lo = 0; a.ph_hi = 15;
    void* kargs[] = {&a};
    hipError_t e = hipLaunchCooperativeKernel((const void*)fwd_kernel, dim3(grid), dim3(NWAVES * 64), kargs, LDS_BYTES, stream);
    if (e != hipSuccess) fprintf(stderr, "cooperative launch failed: %s (grid %d)\n", hipGetErrorString(e), grid);
#else
    for (int ph = 0; ph < 15; ++ph) {
        a.ph_lo = ph; a.ph_hi = ph + 1;
        hipLaunchKernelGGL(fwd_kernel, dim3(grid), dim3(NWAVES * 64), LDS_BYTES, stream, a);
    }
#endif
}
```

```cpp
#include <hip/hip_runtime.h>
#include <hip/hip_cooperative_groups.h>
#include <cstdio>
#include <cstdint>
namespace cg = cooperative_groups;

#ifndef MK_ONE_LAUNCH
#define MK_ONE_LAUNCH 1
#endif

#ifndef PH_MASK
#define PH_MASK 0xFFFF
#endif
#define PHON(k) (((PH_MASK) >> (k)) & 1)
#define LAS __attribute__((address_space(3)))
typedef unsigned short bf16_t;
typedef short bf16x8 __attribute__((ext_vector_type(8)));
typedef short s16x4 __attribute__((ext_vector_type(4)));
typedef float f32x4 __attribute__((ext_vector_type(4)));
typedef unsigned u32x4 __attribute__((ext_vector_type(4)));
typedef unsigned u32x2 __attribute__((ext_vector_type(2)));

constexpr int DM = 1024;
constexpr int MP = 65536;
constexpr int MTOK = 98304;
constexpr int DIN = 6400;
constexpr int NG1 = 2560;
constexpr int ZMW = 1536;
constexpr int NYQ = 49152;
constexpr float EPS = 1e-6f;

constexpr size_t MiB = 1u << 20;
constexpr size_t WS_WIN = 0;
constexpr size_t WS_WG = 10 * MiB;
constexpr size_t WS_WM = 14 * MiB;
constexpr size_t WS_WA = 26 * MiB;
constexpr size_t WS_WB = 28 * MiB;
constexpr size_t WS_WC = 29 * MiB;
constexpr size_t WS_WO = 30 * MiB;
constexpr size_t WS_T = 34 * MiB;
constexpr size_t WS_RS = 35 * MiB;
constexpr size_t WS_SS = 35 * MiB + 512 * 1024;
constexpr size_t WS_XB = 36 * MiB;
constexpr size_t WS_ZM = 228 * MiB;
constexpr size_t WS_ZT = 516 * MiB;
constexpr size_t WS_YQ = 708 * MiB;
constexpr size_t WS_Y = 804 * MiB;
constexpr size_t WS_END = 996 * MiB;

constexpr int NWAVES = 8;
constexpr int LDS_BYTES = 163840;

__device__ __forceinline__ unsigned f2bf(float f) { unsigned u = __builtin_bit_cast(unsigned, f); return (u + 0x7fffu + ((u >> 16) & 1u)) >> 16; }
__device__ __forceinline__ unsigned pk2(float lo, float hi) { unsigned r; asm("v_cvt_pk_bf16_f32 %0, %1, %2" : "=v"(r) : "v"(lo), "v"(hi)); return r; }
__device__ __forceinline__ float bf2f(unsigned b) { return __builtin_bit_cast(float, b << 16); }
__device__ __forceinline__ float bflo(unsigned w) { return __builtin_bit_cast(float, w << 16); }
__device__ __forceinline__ float bfhi(unsigned w) { return __builtin_bit_cast(float, w & 0xffff0000u); }
__device__ __forceinline__ float sigmoidf_(float x) { return __builtin_amdgcn_rcpf(1.0f + __expf(-x)); }
__device__ __forceinline__ float siluf_(float x) { return x * __builtin_amdgcn_rcpf(1.0f + __expf(-x)); }
__device__ __forceinline__ float wave_sum(float v) {
#pragma unroll
    for (int o = 1; o < 64; o <<= 1) v += __shfl_xor(v, o);
    return v;
}
#define LDS_WAIT() asm volatile("s_waitcnt lgkmcnt(0)" ::: "memory")
#define GAS __attribute__((address_space(1)))

namespace pg8 {
constexpr int BM = 256, BK = 64, HALF = 128, HTB = HALF * BK * 2, STAGE_BYTES = 8 * HTB, NXCD = 8, WGM = 8;
__device__ __forceinline__ int lds_byte(int r, int c) { const int st = (r >> 4) * 2 + (c >> 5), rr = r & 15, cc = c & 31, ob = rr * 64 + cc * 2; return st * 1024 + (ob ^ (((ob >> 9) & 1) << 5)); }
__device__ __forceinline__ void stage_rc(int b, int& R, int& C) { const int st = b / 1024, sb = b % 1024, swz = sb ^ (((sb >> 9) & 1) << 5); R = (st >> 1) * 16 + swz / 64; C = (st & 1) * 32 + (swz % 64) / 2; }

__device__ __forceinline__ int perm32(int rho) { const int n = rho >> 4, i = rho & 15; return 8 * (i >> 2) + 4 * n + (i & 3); }
struct Unit { int pm, pn; };
struct Gemm { const bf16_t* A; const bf16_t* Bt; int M, N, K, lda, ldb; };

struct StaticOrder {
    int nM, nN, nwg, G, c;
    __device__ __forceinline__ void init(int M, int N, int G_, int c_) { nM = M / BM; nN = N / BM; nwg = nM * nN; G = G_; c = c_; }
    __device__ __forceinline__ bool next(int i, Unit& u) const {
        const long L = (long)i * G + c; if (L >= nwg) return false;
        int wgid = (int)L; { const int q = nwg / NXCD, r = nwg % NXCD, xcd = wgid % NXCD, off = wgid / NXCD; wgid = (xcd < r ? xcd * (q + 1) : r * (q + 1) + (xcd - r) * q) + off; }
        const int nig = WGM * nN, gid = wgid / nig, fm = gid * WGM, gsz = (nM - fm) < WGM ? (nM - fm) : WGM;
        u.pm = fm + ((wgid % nig) % gsz); u.pn = (wgid % nig) / gsz; return true;
    }
};

struct SingleUnit { Unit u; __device__ bool next(int i, Unit& o) const { if (i) return false; o = u; return true; } };
template <class Epi, class Sched, bool ALIGN_EPI>
__device__ __forceinline__ void gemm_phase(LAS unsigned char* lds, const Gemm g, const Sched& S, const Epi& E) {
    int tid = threadIdx.x; asm volatile("" : "+v"(tid));
    const int wid = __builtin_amdgcn_readfirstlane(tid >> 6), lane = tid & 63, wr = wid >> 2, wc = wid & 3, fr = lane & 15, fq = lane >> 4;
    const int K = g.K, nt = K / BK;
    unsigned voffA[2], voffB[2];
#pragma unroll
    for (int i = 0; i < 2; ++i) { int R, C; stage_rc(tid * 16 + i * 8192, R, C);
        const int Rb = (R & ~31) + perm32(R & 31);
        voffA[i] = (unsigned)(R * g.lda + C) * 2u; voffB[i] = (unsigned)(Rb * g.ldb + C) * 2u; }
    const size_t kstep = (size_t)(BK * 2);
    const size_t hstepA = (size_t)HALF * g.lda * 2, hstepB = (size_t)HALF * g.ldb * 2;
    const size_t tstepA = 2 * hstepA, tstepB = 2 * hstepB;
    const unsigned ldsw = (unsigned)wid * 1024u;
    const int aoff = lds_byte(wr * 64 + fr, fq * 8), boff = lds_byte(wc * 32 + fr, fq * 8);
#define PG8_SA(b, h) (((b) * 2 + (h)) * HTB)
#define PG8_SB(b, h) ((4 + (b) * 2 + (h)) * HTB)
#define PG8_STAGE(bufoff, gbase, voff) do { _Pragma("unroll") for (int _i = 0; _i < 2; ++_i) \
        __builtin_amdgcn_global_load_lds((const unsigned*)((const char*)(gbase) + (voff)[_i]), (LAS unsigned*)(lds + (bufoff) + ldsw + _i * 8192), 16, 0, 0); } while (0)
#define PG8_LDA(dst, b, h) do { _Pragma("unroll") for (int m = 0; m < 4; ++m) _Pragma("unroll") for (int k = 0; k < 2; ++k) dst[m][k] = *(const LAS bf16x8*)(lds + PG8_SA(b, h) + aoff + m * 2048 + k * 1024); } while (0)
#define PG8_LDB(dst, b, h) do { _Pragma("unroll") for (int n = 0; n < 2; ++n) _Pragma("unroll") for (int k = 0; k < 2; ++k) dst[n][k] = *(const LAS bf16x8*)(lds + PG8_SB(b, h) + boff + n * 2048 + k * 1024); } while (0)
#define PG8_MMA(ai, bj, At, Bt) do { __builtin_amdgcn_s_setprio(1); _Pragma("unroll") for (int m = 0; m < 4; ++m) _Pragma("unroll") for (int n = 0; n < 2; ++n) _Pragma("unroll") for (int k = 0; k < 2; ++k) \
        acc[ai][bj][m][n] = __builtin_amdgcn_mfma_f32_16x16x32_bf16(Bt[n][k], At[m][k], acc[ai][bj][m][n], 0, 0, 0); __builtin_amdgcn_s_setprio(0); } while (0)
#define PG8_WAIT_V(n) asm volatile("s_waitcnt vmcnt(" #n ")" ::: "memory")
#define PG8_WAIT_L(n) asm volatile("s_waitcnt lgkmcnt(" #n ")" ::: "memory")
#define PG8_BAR __builtin_amdgcn_s_barrier()
#define PG8_SCHED __builtin_amdgcn_sched_barrier(0)
    Unit cur, nxt; int ui = 0;
    if (!S.next(0, cur)) return;
    f32x4 acc[2][2][4][2];
#pragma unroll
    for (int a = 0; a < 2; ++a)
#pragma unroll
        for (int b = 0; b < 2; ++b)
#pragma unroll
            for (int m = 0; m < 4; ++m)
#pragma unroll
                for (int n = 0; n < 2; ++n) acc[a][b][m][n] = (f32x4){0.f, 0.f, 0.f, 0.f};
    bf16x8 At[4][2], B0[2][2], B1[2][2];
    const char* cA = (const char*)g.A + (size_t)cur.pm * tstepA; const char* cB = (const char*)g.Bt + (size_t)cur.pn * tstepB;
    PG8_STAGE(PG8_SB(0, 0), cB, voffB); PG8_STAGE(PG8_SB(0, 1), cB + hstepB, voffB); PG8_STAGE(PG8_SA(0, 0), cA, voffA); PG8_STAGE(PG8_SA(0, 1), cA + hstepA, voffA);
    if (wr == 1) PG8_BAR;
    PG8_WAIT_V(2); PG8_BAR;
    PG8_STAGE(PG8_SB(1, 0), cB + kstep, voffB); PG8_STAGE(PG8_SA(1, 0), cA + kstep, voffA); PG8_STAGE(PG8_SB(1, 1), cB + hstepB + kstep, voffB);
    PG8_WAIT_V(6); PG8_BAR;
    for (;;) {
        const bool has_next = S.next(ui + 1, nxt);
        const char* nA = has_next ? (const char*)g.A + (size_t)nxt.pm * tstepA : cA; const char* nB = has_next ? (const char*)g.Bt + (size_t)nxt.pn * tstepB : cB;
        for (int t = 0; t < nt; t += 2) {
            const bool last = (t == nt - 2);
            const char* a1 = cA + (size_t)(t + 1) * kstep;
            const char* a2 = last ? nA : cA + (size_t)(t + 2) * kstep; const char* b2 = last ? nB : cB + (size_t)(t + 2) * kstep;
            const char* a3 = a2 + kstep; const char* b3 = b2 + kstep;
            PG8_LDB(B0, 0, 0); PG8_LDB(B1, 0, 1); PG8_SCHED; PG8_LDA(At, 0, 0); PG8_STAGE(PG8_SA(1, 1), a1 + hstepA, voffA);
            PG8_WAIT_V(8); PG8_WAIT_L(0); PG8_BAR; PG8_MMA(0, 0, At, B0); PG8_MMA(0, 1, At, B1); PG8_BAR; PG8_SCHED;
            PG8_LDA(At, 0, 1); PG8_STAGE(PG8_SB(0, 0), b2, voffB); PG8_STAGE(PG8_SB(0, 1), b2 + hstepB, voffB); PG8_STAGE(PG8_SA(0, 0), a2, voffA);
            PG8_WAIT_V(8); PG8_WAIT_L(0); PG8_BAR; PG8_MMA(1, 0, At, B0); PG8_MMA(1, 1, At, B1); PG8_BAR; PG8_SCHED;
            PG8_LDB(B0, 1, 0); PG8_LDB(B1, 1, 1); PG8_SCHED; PG8_LDA(At, 1, 0); PG8_STAGE(PG8_SA(0, 1), a2 + hstepA, voffA);
            PG8_WAIT_V(8); PG8_WAIT_L(0); PG8_BAR; PG8_MMA(0, 0, At, B0); PG8_MMA(0, 1, At, B1); PG8_BAR; PG8_SCHED;
            PG8_LDA(At, 1, 1); PG8_STAGE(PG8_SB(1, 0), b3, voffB); PG8_STAGE(PG8_SB(1, 1), b3 + hstepB, voffB); PG8_STAGE(PG8_SA(1, 0), a3, voffA);
            PG8_WAIT_V(8); PG8_WAIT_L(0); PG8_BAR; PG8_MMA(1, 0, At, B0); PG8_MMA(1, 1, At, B1); PG8_BAR; PG8_SCHED;
        }
        if constexpr (ALIGN_EPI) { if (wr == 0) PG8_BAR; }
        E(acc, cur, wr, wc, fr, fq);
        if (!has_next) break;
#pragma unroll
        for (int a = 0; a < 2; ++a)
#pragma unroll
            for (int b = 0; b < 2; ++b)
#pragma unroll
                for (int m = 0; m < 4; ++m)
#pragma unroll
                    for (int n = 0; n < 2; ++n) acc[a][b][m][n] = (f32x4){0.f, 0.f, 0.f, 0.f};
        cur = nxt; cA = nA; cB = nB; ++ui;
        if constexpr (ALIGN_EPI) { if (wr == 1) PG8_BAR; }
    }
    PG8_WAIT_V(0);
    if constexpr (!ALIGN_EPI) { if (wr == 0) PG8_BAR; }
    PG8_BAR;
#undef PG8_SA
#undef PG8_SB
#undef PG8_STAGE
#undef PG8_LDA
#undef PG8_LDB
#undef PG8_MMA
#undef PG8_WAIT_V
#undef PG8_WAIT_L
#undef PG8_BAR
#undef PG8_SCHED
}

struct UnitX { int pm, pn, seg; };
__device__ __forceinline__ int uni(int v) { return __builtin_amdgcn_readfirstlane(v); }
__device__ __forceinline__ const char* unip(const char* p) { const unsigned long long v = (unsigned long long)p; const unsigned lo = (unsigned)__builtin_amdgcn_readfirstlane((int)(unsigned)v), hi = (unsigned)__builtin_amdgcn_readfirstlane((int)(unsigned)(v >> 32)); return (const char*)(((unsigned long long)hi << 32) | lo); }
template <class Epi, class Prog>
__device__ __forceinline__ void gemm_multi(LAS unsigned char* lds, const Prog& P, const Epi& E) {
    int tid = threadIdx.x; asm volatile("" : "+v"(tid));
    const int wid = __builtin_amdgcn_readfirstlane(tid >> 6), lane = tid & 63, wr = wid >> 2, wc = wid & 3, fr = lane & 15, fq = lane >> 4;
    unsigned Rr[2], RrB[2], Cc2[2];
#pragma unroll
    for (int i = 0; i < 2; ++i) { int R, C; stage_rc(tid * 16 + i * 8192, R, C); Rr[i] = (unsigned)R * 2u; RrB[i] = (unsigned)((R & ~31) + perm32(R & 31)) * 2u; Cc2[i] = (unsigned)C * 2u; }
    const size_t kstep = (size_t)(BK * 2);
    const unsigned ldsw = (unsigned)wid * 1024u;
    const int aoff = lds_byte(wr * 64 + fr, fq * 8), boff = lds_byte(wc * 32 + fr, fq * 8);
#define PG8_SA(b, h) (((b) * 2 + (h)) * HTB)
#define PG8_SB(b, h) ((4 + (b) * 2 + (h)) * HTB)
#define PG8_STAGE_X(RR, bufoff, gbase, ld) do { _Pragma("unroll") for (int _i = 0; _i < 2; ++_i) \
        __builtin_amdgcn_global_load_lds((const unsigned*)((const char*)(gbase) + (RR[_i] * (unsigned)(ld) + Cc2[_i])), (LAS unsigned*)(lds + (bufoff) + ldsw + _i * 8192), 16, 0, 0); } while (0)
#define PG8_STAGE(bufoff, gbase, ld) PG8_STAGE_X(Rr, bufoff, gbase, ld)
#define PG8_STAGEB(bufoff, gbase, ld) PG8_STAGE_X(RrB, bufoff, gbase, ld)
#define PG8_LDA(dst, b, h) do { _Pragma("unroll") for (int m = 0; m < 4; ++m) _Pragma("unroll") for (int k = 0; k < 2; ++k) dst[m][k] = *(const LAS bf16x8*)(lds + PG8_SA(b, h) + aoff + m * 2048 + k * 1024); } while (0)
#define PG8_LDB(dst, b, h) do { _Pragma("unroll") for (int n = 0; n < 2; ++n) _Pragma("unroll") for (int k = 0; k < 2; ++k) dst[n][k] = *(const LAS bf16x8*)(lds + PG8_SB(b, h) + boff + n * 2048 + k * 1024); } while (0)
#define PG8_MMA(ai, bj, At, Bt) do { __builtin_amdgcn_s_setprio(1); _Pragma("unroll") for (int m = 0; m < 4; ++m) _Pragma("unroll") for (int n = 0; n < 2; ++n) _Pragma("unroll") for (int k = 0; k < 2; ++k) \
        acc[ai][bj][m][n] = __builtin_amdgcn_mfma_f32_16x16x32_bf16(Bt[n][k], At[m][k], acc[ai][bj][m][n], 0, 0, 0); __builtin_amdgcn_s_setprio(0); } while (0)
#define PG8_WAIT_V(n) asm volatile("s_waitcnt vmcnt(" #n ")" ::: "memory")
#define PG8_WAIT_L(n) asm volatile("s_waitcnt lgkmcnt(" #n ")" ::: "memory")
#define PG8_BAR __builtin_amdgcn_s_barrier()
#define PG8_SCHED __builtin_amdgcn_sched_barrier(0)
    UnitX cur, nxt; int ui = 0;
    if (!P.next(0, cur)) return;
    f32x4 acc[2][2][4][2];
#pragma unroll
    for (int a = 0; a < 2; ++a)
#pragma unroll
        for (int b = 0; b < 2; ++b)
#pragma unroll
            for (int m = 0; m < 4; ++m)
#pragma unroll
                for (int n = 0; n < 2; ++n) acc[a][b][m][n] = (f32x4){0.f, 0.f, 0.f, 0.f};
    bf16x8 At[4][2], B0[2][2], B1[2][2];
    const char* cA; const char* cB; int lda, ldb, nt;
    P.desc(cur, cA, cB, lda, ldb, nt); cA = unip(cA); cB = unip(cB); lda = uni(lda); ldb = uni(ldb); nt = uni(nt);
    {   const size_t hA = (size_t)HALF * lda * 2, hB = (size_t)HALF * ldb * 2;
        PG8_STAGEB(PG8_SB(0, 0), cB, ldb); PG8_STAGEB(PG8_SB(0, 1), cB + hB, ldb); PG8_STAGE(PG8_SA(0, 0), cA, lda); PG8_STAGE(PG8_SA(0, 1), cA + hA, lda);
        if (wr == 1) PG8_BAR;
        PG8_WAIT_V(2); PG8_BAR;
        PG8_STAGEB(PG8_SB(1, 0), cB + kstep, ldb); PG8_STAGE(PG8_SA(1, 0), cA + kstep, lda); PG8_STAGEB(PG8_SB(1, 1), cB + hB + kstep, ldb);
        PG8_WAIT_V(6); PG8_BAR; }
    for (;;) {
        const bool has_next = P.next(ui + 1, nxt);
        const char* nA = cA; const char* nB = cB; int ldan = lda, ldbn = ldb, ntn = nt;
        if (has_next) P.desc(nxt, nA, nB, ldan, ldbn, ntn);
        nA = unip(nA); nB = unip(nB); ldan = uni(ldan); ldbn = uni(ldbn); ntn = uni(ntn);
        const size_t hAc = (size_t)HALF * lda * 2;
        for (int t = 0; t < nt; t += 2) {
            const bool last = (t == nt - 2);
            const char* a1 = cA + (size_t)(t + 1) * kstep;
            const char* a2 = last ? nA : cA + (size_t)(t + 2) * kstep; const char* b2 = last ? nB : cB + (size_t)(t + 2) * kstep;
            const int lda2 = last ? ldan : lda, ldb2 = last ? ldbn : ldb;
            const size_t hA2 = (size_t)HALF * lda2 * 2, hB2 = (size_t)HALF * ldb2 * 2;
            const char* a3 = a2 + kstep; const char* b3 = b2 + kstep;
            PG8_LDB(B0, 0, 0); PG8_LDB(B1, 0, 1); PG8_SCHED; PG8_LDA(At, 0, 0); PG8_STAGE(PG8_SA(1, 1), a1 + hAc, lda);
            PG8_WAIT_V(8); PG8_WAIT_L(0); PG8_BAR; PG8_MMA(0, 0, At, B0); PG8_MMA(0, 1, At, B1); PG8_BAR; PG8_SCHED;
            PG8_LDA(At, 0, 1); PG8_STAGEB(PG8_SB(0, 0), b2, ldb2); PG8_STAGEB(PG8_SB(0, 1), b2 + hB2, ldb2); PG8_STAGE(PG8_SA(0, 0), a2, lda2);
            PG8_WAIT_V(8); PG8_WAIT_L(0); PG8_BAR; PG8_MMA(1, 0, At, B0); PG8_MMA(1, 1, At, B1); PG8_BAR; PG8_SCHED;
            PG8_LDB(B0, 1, 0); PG8_LDB(B1, 1, 1); PG8_SCHED; PG8_LDA(At, 1, 0); PG8_STAGE(PG8_SA(0, 1), a2 + hA2, lda2);
            PG8_WAIT_V(8); PG8_WAIT_L(0); PG8_BAR; PG8_MMA(0, 0, At, B0); PG8_MMA(0, 1, At, B1); PG8_BAR; PG8_SCHED;
            PG8_LDA(At, 1, 1); PG8_STAGEB(PG8_SB(1, 0), b3, ldb2); PG8_STAGEB(PG8_SB(1, 1), b3 + hB2, ldb2); PG8_STAGE(PG8_SA(1, 0), a3, lda2);
            PG8_WAIT_V(8); PG8_WAIT_L(0); PG8_BAR; PG8_MMA(1, 0, At, B0); PG8_MMA(1, 1, At, B1); PG8_BAR; PG8_SCHED;
        }
        if (wr == 0) PG8_BAR;
        E(acc, cur, wr, wc, fr, fq);
        if (!has_next) break;
#pragma unroll
        for (int a = 0; a < 2; ++a)
#pragma unroll
            for (int b = 0; b < 2; ++b)
#pragma unroll
                for (int m = 0; m < 4; ++m)
#pragma unroll
                    for (int n = 0; n < 2; ++n) acc[a][b][m][n] = (f32x4){0.f, 0.f, 0.f, 0.f};
        cur = nxt; cA = nA; cB = nB; lda = ldan; ldb = ldbn; nt = ntn; ++ui;
        if (wr == 1) PG8_BAR;
    }
    PG8_WAIT_V(0);
    PG8_BAR;
#undef PG8_SA
#undef PG8_SB
#undef PG8_STAGE
#undef PG8_STAGEB
#undef PG8_STAGE_X
#undef PG8_LDA
#undef PG8_LDB
#undef PG8_MMA
#undef PG8_WAIT_V
#undef PG8_WAIT_L
#undef PG8_BAR
#undef PG8_SCHED
}

#define EPI_ROWS_BEGIN  _Pragma("unroll") for (int ai = 0; ai < 2; ++ai) _Pragma("unroll") for (int m = 0; m < 4; ++m) { const int row = u.pm * BM + ai * HALF + wr * 64 + m * 16 + fr;
#define EPI_COLS_BEGIN  _Pragma("unroll") for (int bj = 0; bj < 2; ++bj) _Pragma("unroll") for (int n = 0; n < 2; ++n) { const int col = bj * HALF + wc * 32 + 8 * fq + 4 * n; f32x4 v = acc[ai][bj][m][n];
#define EPI_END } }
#define EPI_COLS8_BEGIN  _Pragma("unroll") for (int bj = 0; bj < 2; ++bj) { const int col = bj * HALF + wc * 32 + 8 * fq; const f32x4 v0 = acc[ai][bj][m][0], v1 = acc[ai][bj][m][1];

struct EpiG1 {
    const float* rs; bf16_t* ZM; bf16_t* ZT;
    __device__ __forceinline__ void operator()(const f32x4 (&acc)[2][2][4][2], const Unit& u, int wr, int wc, int fr, int fq) const {
        const int pn = u.pn;
        if (pn >= 4 && pn < 6) {
            const int d0 = (pn - 4) * 256;
            EPI_ROWS_BEGIN
            EPI_COLS_BEGIN
                GAS bf16_t* d = (GAS bf16_t*)ZT + ((size_t)(row >> 6) * 512 + d0 + col) * 64 + (row & 63);
                const unsigned w0 = pk2(v[0], v[1]), w1 = pk2(v[2], v[3]);
                d[0] = (bf16_t)w0; d[64] = (bf16_t)(w0 >> 16); d[128] = (bf16_t)w1; d[192] = (bf16_t)(w1 >> 16);
            EPI_END
        } else if (pn >= 6 && pn < 8) {
            const int j0 = (pn - 6) * 256;
            EPI_ROWS_BEGIN
            EPI_COLS_BEGIN
                GAS bf16_t* d = (GAS bf16_t*)ZT + (size_t)MTOK * 512 + ((size_t)(row >> 9) * 512 + j0 + col) * 512 + (row & 511);
                const unsigned w0 = pk2(v[0], v[1]), w1 = pk2(v[2], v[3]);
                d[0] = (bf16_t)w0; d[512] = (bf16_t)(w0 >> 16); d[1024] = (bf16_t)w1; d[1536] = (bf16_t)(w1 >> 16);
            EPI_END
        } else {
            const int cm = (pn < 4 ? pn : pn - 4) * 256;
            EPI_ROWS_BEGIN
            EPI_COLS8_BEGIN
                u32x4 w; w.x = pk2(v0[0], v0[1]); w.y = pk2(v0[2], v0[3]); w.z = pk2(v1[0], v1[1]); w.w = pk2(v1[2], v1[3]);
                *(GAS u32x4*)((GAS bf16_t*)ZM + (size_t)row * ZMW + cm + col) = w;
            EPI_END
        }
    }
};
struct EpiDFT {
    bf16_t* Y;
    __device__ __forceinline__ void operator()(const f32x4 (&acc)[2][2][4][2], const Unit& u, int wr, int wc, int fr, int fq) const {
        int tok0, R, q;
        if (u.pm < 128) { tok0 = (u.pm >> 2) * 2048; R = 4; q = u.pm & 3; } else { const int t = u.pm - 128; tok0 = MP + (t >> 4) * 8192; R = 16; q = t & 15; }
        EPI_ROWS_BEGIN const int p = row - u.pm * BM;
        EPI_COLS_BEGIN
            const int k0 = u.pn * BM + col;
            GAS bf16_t* d = (GAS bf16_t*)Y + (size_t)(tok0 + R * k0 + q) * DM + 512 + p;
            const unsigned w0 = pk2(v[0], v[1]), w1 = pk2(v[2], v[3]);
            d[0] = (bf16_t)w0; d[(size_t)R * DM] = (bf16_t)(w0 >> 16); d[(size_t)2 * R * DM] = (bf16_t)w1; d[(size_t)3 * R * DM] = (bf16_t)(w1 >> 16);
        EPI_END
    }
};
struct EpiG2 {
    const float* rs; bf16_t* Y;
    __device__ __forceinline__ void operator()(const f32x4 (&acc)[2][2][4][2], const Unit& u, int wr, int wc, int fr, int fq) const {
        EPI_ROWS_BEGIN
        EPI_COLS8_BEGIN
            GAS u32x4* p = (GAS u32x4*)((GAS bf16_t*)Y + (size_t)row * DM + u.pn * BM + col);
            const u32x4 y = *p; u32x4 w;
            w.x = pk2(bflo(y.x) * siluf_(v0[0]), bfhi(y.x) * siluf_(v0[1])); w.y = pk2(bflo(y.y) * siluf_(v0[2]), bfhi(y.y) * siluf_(v0[3]));
            w.z = pk2(bflo(y.z) * siluf_(v1[0]), bfhi(y.z) * siluf_(v1[1])); w.w = pk2(bflo(y.w) * siluf_(v1[2]), bfhi(y.w) * siluf_(v1[3]));
            *p = w;
        EPI_END
    }
};
struct ProgG34 {
    StaticOrder S; const bf16_t* Y; const bf16_t* XB; const char* wsb; const bf16_t* WM; int layer;
    __device__ __forceinline__ bool next(int i, UnitX& u) const { Unit t; if (!S.next(i / 6, t)) return false; u.pm = t.pm; u.pn = t.pn; u.seg = i % 6; return true; }
    __device__ __forceinline__ void desc(const UnitX& u, const char*& A, const char*& B, int& lda, int& ldb, int& nt) const {
        const int b = u.seg >> 1; lda = DM;
        if (u.seg & 1) { A = (const char*)(XB + (size_t)u.pm * BM * DM); B = (const char*)(WM + (size_t)b * DM * DM + (size_t)u.pn * BM * DM); ldb = DM; nt = DM / BK; }
        else { const int kb = (b == 0) ? 512 : 256, ac = (b == 0) ? 0 : (b == 1 ? 512 : 768);
            const size_t woff = (size_t)((b == 0) ? 26 : 27 + b) * MiB + (size_t)layer * ((b == 0) ? MiB : MiB / 2);
            const bf16_t* w = (const bf16_t*)(wsb + woff);
            A = (const char*)(Y + (size_t)u.pm * BM * DM + ac); B = (const char*)(w + (size_t)u.pn * BM * kb); ldb = kb; nt = kb / BK; }
    }
};
struct EpiG34 {
    const float* rs; bf16_t* PT; bf16_t* MT; bf16_t* MG;
    __device__ __forceinline__ void operator()(const f32x4 (&acc)[2][2][4][2], const UnitX& u, int wr, int wc, int fr_, int fq_) const {
        int fr = fr_, fq = fq_; asm volatile("" : "+v"(fr), "+v"(fq));
        if ((u.seg & 1) == 0) {
            EPI_ROWS_BEGIN
            EPI_COLS8_BEGIN
                u32x4 w; w.x = pk2(v0[0], v0[1]); w.y = pk2(v0[2], v0[3]); w.z = pk2(v1[0], v1[1]); w.w = pk2(v1[2], v1[3]);
                *(GAS u32x4*)(PT + (size_t)(row - u.pm * BM) * 256 + col) = w;
            EPI_END
        } else {
            const int mode = u.seg >> 1;
            GAS bf16_t* dst = (mode == 2) ? (GAS bf16_t*)MG + (size_t)u.pm * BM * DM + u.pn * BM : (GAS bf16_t*)MT;
            const int dld = (mode == 2) ? DM : 256;
            const int rl0 = wr * 64 + fr, c0 = wc * 32 + 8 * fq;
#pragma unroll
            for (int ai = 0; ai < 2; ++ai) {
                u32x4 pv[4][2], mv[4][2];
#pragma unroll
                for (int m = 0; m < 4; ++m)
#pragma unroll
                    for (int bj = 0; bj < 2; ++bj) pv[m][bj] = *(const GAS u32x4*)(PT + (size_t)(ai * HALF + rl0 + m * 16) * 256 + bj * HALF + c0);
                if (mode != 0) {
#pragma unroll
                    for (int m = 0; m < 4; ++m)
#pragma unroll
                        for (int bj = 0; bj < 2; ++bj) mv[m][bj] = *(const GAS u32x4*)(MT + (size_t)(ai * HALF + rl0 + m * 16) * 256 + bj * HALF + c0);
                } else {
#pragma unroll
                    for (int m = 0; m < 4; ++m)
#pragma unroll
                        for (int bj = 0; bj < 2; ++bj) mv[m][bj] = (u32x4){0u, 0u, 0u, 0u};
                }
                __builtin_amdgcn_sched_barrier(0);
#pragma unroll
                for (int m = 0; m < 4; ++m)
#pragma unroll
                    for (int bj = 0; bj < 2; ++bj) {
                        const f32x4 v0 = acc[ai][bj][m][0], v1 = acc[ai][bj][m][1]; const u32x4 p = pv[m][bj], q = mv[m][bj];
                        const float r0 = bflo(q.x) + bflo(p.x) * sigmoidf_(v0[0]), r1 = bfhi(q.x) + bfhi(p.x) * sigmoidf_(v0[1]), r2 = bflo(q.y) + bflo(p.y) * sigmoidf_(v0[2]), r3 = bfhi(q.y) + bfhi(p.y) * sigmoidf_(v0[3]);
                        const float r4 = bflo(q.z) + bflo(p.z) * sigmoidf_(v1[0]), r5 = bfhi(q.z) + bfhi(p.z) * sigmoidf_(v1[1]), r6 = bflo(q.w) + bflo(p.w) * sigmoidf_(v1[2]), r7 = bfhi(q.w) + bfhi(p.w) * sigmoidf_(v1[3]);
                        u32x4 w; w.x = pk2(r0, r1); w.y = pk2(r2, r3); w.z = pk2(r4, r5); w.w = pk2(r6, r7);
                        *(GAS u32x4*)(dst + (size_t)(ai * HALF + rl0 + m * 16) * dld + bj * HALF + c0) = w;
                    }
                __builtin_amdgcn_sched_barrier(0);
            }
        }
    }
};
struct EpiG5 {
    bf16_t* O; float* ss;
    __device__ __forceinline__ void operator()(const f32x4 (&acc)[2][2][4][2], const Unit& u, int wr, int wc, int fr, int fq) const {
        EPI_ROWS_BEGIN float q = 0.f;
        EPI_COLS8_BEGIN
            u32x4 w; w.x = pk2(v0[0], v0[1]); w.y = pk2(v0[2], v0[3]); w.z = pk2(v1[0], v1[1]); w.w = pk2(v1[2], v1[3]);
            *(GAS u32x4*)((GAS bf16_t*)O + (size_t)row * DM + u.pn * BM + col) = w;
            q += ((v0[0] * v0[0] + v0[1] * v0[1]) + (v0[2] * v0[2] + v0[3] * v0[3])) + ((v1[0] * v1[0] + v1[1] * v1[1]) + (v1[2] * v1[2] + v1[3] * v1[3]));
        }
            q += __shfl_xor(q, 16); q += __shfl_xor(q, 32);
            if (fq == 0) atomicAdd(ss + row, q);
        }
    }
};
}

__device__ __forceinline__ void transpose_item(const float* W, int K, int pitch, int c0, int ncols, bf16_t* WT, int row_off, const float* g, float scale, LAS float* scr, int item, int lane) {
    const int nblk = ncols / 32, kb = item / nblk, nb = item % nblk, k0 = 64 * kb, n0 = 32 * nb;
#pragma unroll 8
    for (int i = 0; i < 32; ++i) { const int kk = 2 * i + (lane >> 5); float w = W[(size_t)(k0 + kk) * pitch + c0 + n0 + (lane & 31)] * scale; if (g) w *= g[k0 + kk]; scr[kk * 33 + (lane & 31)] = w; }
    LDS_WAIT(); asm volatile("" ::: "memory");
    const int c = lane & 7;
#pragma unroll
    for (int j = 0; j < 4; ++j) { const int n = (lane >> 3) + 8 * j; const LAS float* s = scr + (8 * c) * 33 + n;
        u32x4 o; o.x = pk2(s[0 * 33], s[1 * 33]); o.y = pk2(s[2 * 33], s[3 * 33]); o.z = pk2(s[4 * 33], s[5 * 33]); o.w = pk2(s[6 * 33], s[7 * 33]);
        *(u32x4*)(WT + (size_t)(row_off + n0 + n) * K + k0 + 8 * c) = o; }
    LDS_WAIT(); asm volatile("" ::: "memory");
}

struct Args { const float* in[14]; float* out; unsigned char* ws; int ph_lo, ph_hi; };

__device__ __forceinline__ void grid_row_info(int gr, int& seqbase, int& r, int& nrows) {
    if (gr < 1024) { seqbase = (gr >> 5) << 11; r = gr & 31; nrows = 32; } else { const int g2 = gr - 1024; seqbase = MP + ((g2 >> 7) << 13); r = g2 & 127; nrows = 128; }
}

constexpr int AT_NSLOT = 9, AT_KSLOT = 9216, AT_VSLOT = 8704, AT_VOFF = AT_NSLOT * AT_KSLOT, AT_BOFF = AT_VOFF + AT_NSLOT * AT_VSLOT;
static_assert(AT_BOFF + 465 * 4 <= LDS_BYTES, "attention LDS map");
__device__ __forceinline__ void attn_fill_issue(const GAS bf16_t* ZM, const GAS bf16_t* ZT, int tok0, int head, int tid, u32x4& kreg, u32x4& vreg) {
    kreg = *(const GAS u32x4*)(ZM + (size_t)(tok0 + (tid >> 3)) * ZMW + 512 + head * 64 + (tid & 7) * 8);
    vreg = *(const GAS u32x4*)(ZT + ((size_t)(tok0 >> 6) * 512 + head * 64) * 64 + tid * 8);
}
__device__ __forceinline__ void attn_fill_write(LAS unsigned char* lds, int slot, int tid, const u32x4 kreg, const u32x4 vreg) {
    *(LAS u32x4*)(lds + slot * AT_KSLOT + (tid >> 3) * 144 + (tid & 7) * 16) = kreg;
    LAS u32x2* vp = (LAS u32x2*)(lds + AT_VOFF + slot * AT_VSLOT + (tid >> 3) * 136 + (tid & 7) * 16);
    u32x2 a; a.x = vreg.x; a.y = vreg.y; u32x2 b; b.x = vreg.z; b.y = vreg.w;
    vp[0] = a; vp[1] = b;
}
__device__ __forceinline__ void attn_row_lds(LAS unsigned char* lds, int seqbase, int r, int rs, int head, int lane, int wave, const bf16x8 bq0, const bf16x8 bq1, GAS bf16_t* Y, const unsigned (&bcp)[32]) {
    const int g = wave & 3;
    const int qi = lane & 15, h4 = lane >> 4;
    const int cs = (g == 0) ? 0 : (g == 1) ? 8 : (g == 2) ? 24 : 32;
    const int qc = 16 * g + qi;
    const int qtok = seqbase + r * 64 + qc;
    const int sb = rs % AT_NSLOT;
    f32x4 S[16];
    float mx = -3.0e38f;
#pragma unroll
    for (int hb = 0; hb < 2; ++hb) {
        bf16x8 ak[8][2];
#pragma unroll
        for (int tt = 0; tt < 8; ++tt) {
            const int t = hb * 8 + tt, kr = t >> 1, hf = t & 1;
            int slot = sb + kr; slot = slot >= AT_NSLOT ? slot - AT_NSLOT : slot;
            const LAS unsigned char* kp = lds + slot * AT_KSLOT + (cs + 16 * hf + qi) * 144 + h4 * 16;
            ak[tt][0] = *(const LAS bf16x8*)kp; ak[tt][1] = *(const LAS bf16x8*)(kp + 64);
        }
        __builtin_amdgcn_sched_barrier(0);
#pragma unroll
        for (int tt = 0; tt < 8; ++tt) {
            const int t = hb * 8 + tt;
            f32x4 s = {0.f, 0.f, 0.f, 0.f};
            s = __builtin_amdgcn_mfma_f32_16x16x32_bf16(ak[tt][0], bq0, s, 0, 0, 0);
            s = __builtin_amdgcn_mfma_f32_16x16x32_bf16(ak[tt][1], bq1, s, 0, 0, 0);
            s[0] += bflo(bcp[2 * t]); s[1] += bfhi(bcp[2 * t]); s[2] += bflo(bcp[2 * t + 1]); s[3] += bfhi(bcp[2 * t + 1]);
            mx = fmaxf(mx, fmaxf(fmaxf(s[0], s[1]), fmaxf(s[2], s[3])));
            S[t] = s;
        }
        __builtin_amdgcn_sched_barrier(0);
    }
    mx = fmaxf(mx, __shfl_xor(mx, 16)); mx = fmaxf(mx, __shfl_xor(mx, 32));
    float sum = 0.f;
    bf16x8 pf[8];
#pragma unroll
    for (int kr = 0; kr < 8; ++kr) {
        const f32x4 a = S[kr * 2], b = S[kr * 2 + 1];
        const float p0 = __expf(a[0] - mx), p1 = __expf(a[1] - mx), p2 = __expf(a[2] - mx), p3 = __expf(a[3] - mx);
        const float p4 = __expf(b[0] - mx), p5 = __expf(b[1] - mx), p6 = __expf(b[2] - mx), p7 = __expf(b[3] - mx);
        sum += ((p0 + p1) + (p2 + p3)) + ((p4 + p5) + (p6 + p7));
        u32x4 w; w.x = pk2(p0, p1); w.y = pk2(p2, p3); w.z = pk2(p4, p5); w.w = pk2(p6, p7);
        pf[kr] = __builtin_bit_cast(bf16x8, w);
    }
    sum += __shfl_xor(sum, 16); sum += __shfl_xor(sum, 32);
    const float inv = __builtin_amdgcn_rcpf(sum);
    GAS bf16_t* yp = Y + (size_t)qtok * DM + head * 64 + 4 * h4;
#pragma unroll
    for (int dp = 0; dp < 2; ++dp) {
        u32x2 vf[2][8][2];
#pragma unroll
        for (int dti = 0; dti < 2; ++dti)
#pragma unroll
            for (int kr = 0; kr < 8; ++kr) {
                int slot = sb + kr; slot = slot >= AT_NSLOT ? slot - AT_NSLOT : slot;
                const LAS unsigned char* vp = lds + AT_VOFF + slot * AT_VSLOT + ((2 * dp + dti) * 16 + qi) * 136 + (cs + 4 * h4) * 2;
                vf[dti][kr][0] = *(const LAS u32x2*)vp; vf[dti][kr][1] = *(const LAS u32x2*)(vp + 32);
            }
        __builtin_amdgcn_sched_barrier(0);
#pragma unroll
        for (int dti = 0; dti < 2; ++dti) {
            f32x4 o = {0.f, 0.f, 0.f, 0.f};
#pragma unroll
            for (int kr = 0; kr < 8; ++kr) {
                u32x4 w; w.x = vf[dti][kr][0].x; w.y = vf[dti][kr][0].y; w.z = vf[dti][kr][1].x; w.w = vf[dti][kr][1].y;
                o = __builtin_amdgcn_mfma_f32_16x16x32_bf16(__builtin_bit_cast(bf16x8, w), pf[kr], o, 0, 0, 0);
            }
            u32x2 w; w.x = pk2(o[0] * inv, o[1] * inv); w.y = pk2(o[2] * inv, o[3] * inv);
            *(GAS u32x2*)(yp + (2 * dp + dti) * 16) = w;
        }
        __builtin_amdgcn_sched_barrier(0);
    }
}
#define ATT_RS(r_) ((r_) - 4 < 0 ? 0 : ((r_) - 4 > nrows - 8 ? nrows - 8 : (r_) - 4))
__device__ __forceinline__ void attn_unit(LAS unsigned char* lds, int seqbase, int nrows, int ra, int rb, int head, int tid, int lane, int wave,
                                          const bf16_t* ZM_, const bf16_t* ZT_, bf16_t* Y_, const float* rpb) {
    const GAS bf16_t* ZM = (const GAS bf16_t*)ZM_; const GAS bf16_t* ZT = (const GAS bf16_t*)ZT_; GAS bf16_t* Y = (GAS bf16_t*)Y_;
    const int rsel = wave >> 2;
    const int lo = ATT_RS(ra);
    int top = lo + 8;
    {   u32x4 kreg[9], vreg[9];
#pragma unroll
        for (int k = 0; k < 9; ++k) { int row = lo + k; row = row > nrows - 1 ? nrows - 1 : row; attn_fill_issue(ZM, ZT, seqbase + row * 64, head, tid, kreg[k], vreg[k]); }
        LAS float* bw = (LAS float*)(lds + AT_BOFF);
        if (tid < 465) bw[tid] = rpb[head * 465 + tid];
#pragma unroll
        for (int k = 0; k < 9; ++k) attn_fill_write(lds, (lo + k) % AT_NSLOT, tid, kreg[k], vreg[k]);
    }
    const GAS bf16_t* qbase = ZM + (size_t)(seqbase + 16 * (wave & 3) + (lane & 15)) * ZMW + head * 64 + 8 * (lane >> 4);
    bf16x8 q0 = *(const GAS bf16x8*)(qbase + (size_t)(ra + rsel) * 64 * ZMW), q1 = *(const GAS bf16x8*)(qbase + (size_t)(ra + rsel) * 64 * ZMW + 32);
    __syncthreads();
    unsigned bcp[32]; int cdelta = 1000;
#pragma unroll
    for (int i = 0; i < 32; ++i) bcp[i] = 0u;
#pragma unroll 1
    for (int r = ra; r < rb; r += 2) {
        const int rr = r + rsel, rs = ATT_RS(rr);
        if (rs - rr != cdelta) {
            cdelta = rs - rr;
            const LAS float* bias = (const LAS float*)(lds + AT_BOFF);
            const int g_ = wave & 3, qi_ = lane & 15, h4_ = lane >> 4, cs_ = (g_ == 0) ? 0 : (g_ == 1) ? 8 : (g_ == 2) ? 24 : 32, qc_ = 16 * g_ + qi_;
            int cst_ = qc_ - 8; cst_ = cst_ < 0 ? 0 : cst_; cst_ = cst_ > 48 ? 48 : cst_;
#pragma unroll
            for (int t = 0; t < 16; ++t) {
                float bv[4];
#pragma unroll
                for (int e = 0; e < 4; ++e) {
                    const int kc = cs_ + 16 * (t & 1) + 4 * h4_ + e; int dc = kc - qc_ + 15; dc = dc < 0 ? 0 : dc; dc = dc > 30 ? 30 : dc;
                    const float b = bias[(cdelta + (t >> 1) + 7) * 31 + dc];
                    bv[e] = ((kc >= cst_) && (kc < cst_ + 16)) ? b : -1.0e30f;
                }
                bcp[2 * t] = pk2(bv[0], bv[1]); bcp[2 * t + 1] = pk2(bv[2], bv[3]);
            }
        }
        const int rqn = (r + 2 < rb) ? rr + 2 : rr;
        const bf16x8 nq0 = *(const GAS bf16x8*)(qbase + (size_t)rqn * 64 * ZMW), nq1 = *(const GAS bf16x8*)(qbase + (size_t)rqn * 64 * ZMW + 32);
        int ntop = (r + 2 < rb) ? ATT_RS(r + 3) + 7 : top; ntop = ntop < top ? top : ntop;
        const int nnew = ntop - top;
        u32x4 kreg0 = {0u, 0u, 0u, 0u}, vreg0 = {0u, 0u, 0u, 0u}, kreg1 = {0u, 0u, 0u, 0u}, vreg1 = {0u, 0u, 0u, 0u};
        if (nnew >= 1) attn_fill_issue(ZM, ZT, seqbase + (top + 1) * 64, head, tid, kreg0, vreg0);
        if (nnew >= 2) attn_fill_issue(ZM, ZT, seqbase + (top + 2) * 64, head, tid, kreg1, vreg1);
        attn_row_lds(lds, seqbase, rr, rs, head, lane, wave, q0, q1, Y, bcp);
        LDS_WAIT(); __builtin_amdgcn_s_barrier(); asm volatile("" ::: "memory");
        if (nnew >= 1) attn_fill_write(lds, (top + 1) % AT_NSLOT, tid, kreg0, vreg0);
        if (nnew >= 2) attn_fill_write(lds, (top + 2) % AT_NSLOT, tid, kreg1, vreg1);
        LDS_WAIT(); __builtin_amdgcn_s_barrier(); asm volatile("" ::: "memory");
        top = ntop; q0 = nq0; q1 = nq1;
    }
}

#define DFT4(r0, i0, r1, i1, r2, i2, r3, i3) do { \
    const float ar_ = r0 + r2, ai_ = i0 + i2, br_ = r0 - r2, bi_ = i0 - i2, cr_ = r1 + r3, ci_ = i1 + i3, dr_ = r1 - r3, di_ = i1 - i3; \
    r0 = ar_ + cr_; i0 = ai_ + ci_; r1 = br_ + di_; i1 = bi_ - dr_; r2 = ar_ - cr_; i2 = ai_ - ci_; r3 = br_ - di_; i3 = bi_ + dr_; } while (0)
template <int R, int NU>
__device__ __forceinline__ void butterfly_unit(int tok0, int rowbase  , int p0, int t, const bf16_t* ZT_, bf16_t* YQ_, const float (&twr)[2][R], const float (&twi)[2][R]) {
    const GAS unsigned* zre = (const GAS unsigned*)((const GAS bf16_t*)ZT_ + (size_t)MTOK * 512 + ((size_t)(tok0 >> 9) * 512 + p0) * 512) + t;
    const GAS unsigned* zim = zre + 256 * 256;
    float xr[NU][2][R], xi[NU][2][R];
#pragma unroll
    for (int u = 0; u < NU; ++u)
#pragma unroll
        for (int s = 0; s < R; ++s) {
            const unsigned wr_ = zre[(size_t)s * 512 * 256 + u * 256], wi_ = zim[(size_t)s * 512 * 256 + u * 256];
            xr[u][0][s] = bflo(wr_); xr[u][1][s] = bfhi(wr_); xi[u][0][s] = bflo(wi_); xi[u][1][s] = bfhi(wi_);
        }
#pragma unroll
    for (int u = 0; u < NU; ++u) {
#pragma unroll
        for (int h = 0; h < 2; ++h) {
            if constexpr (R == 4) {
                DFT4(xr[u][h][0], xi[u][h][0], xr[u][h][1], xi[u][h][1], xr[u][h][2], xi[u][h][2], xr[u][h][3], xi[u][h][3]);
            } else {
#pragma unroll
                for (int b = 0; b < 4; ++b) DFT4(xr[u][h][b], xi[u][h][b], xr[u][h][4 + b], xi[u][h][4 + b], xr[u][h][8 + b], xi[u][h][8 + b], xr[u][h][12 + b], xi[u][h][12 + b]);
                constexpr float WR[10] = {1.f, 0.9238795325f, 0.7071067812f, 0.3826834324f, 0.f, 0.f, -0.7071067812f, 0.f, 0.f, -0.9238795325f};
                constexpr float WI[10] = {0.f, -0.3826834324f, -0.7071067812f, -0.9238795325f, -1.f, 0.f, -0.7071067812f, 0.f, 0.f, 0.3826834324f};
#pragma unroll
                for (int c = 1; c < 4; ++c)
#pragma unroll
                    for (int b = 1; b < 4; ++b) { const float w0 = WR[c * b], w1 = WI[c * b]; const float tr = xr[u][h][4 * c + b] * w0 - xi[u][h][4 * c + b] * w1, ti = xr[u][h][4 * c + b] * w1 + xi[u][h][4 * c + b] * w0; xr[u][h][4 * c + b] = tr; xi[u][h][4 * c + b] = ti; }
#pragma unroll
                for (int c = 0; c < 4; ++c) DFT4(xr[u][h][4 * c], xi[u][h][4 * c], xr[u][h][4 * c + 1], xi[u][h][4 * c + 1], xr[u][h][4 * c + 2], xi[u][h][4 * c + 2], xr[u][h][4 * c + 3], xi[u][h][4 * c + 3]);
            }
        }
        GAS unsigned* d0 = (GAS unsigned*)((GAS bf16_t*)YQ_ + (size_t)(rowbase + u) * 1024) + t;
#pragma unroll
        for (int q = 0; q < R; ++q) {
            const int sl = (R == 16) ? 4 * (q & 3) + (q >> 2) : q;
            const float r0 = xr[u][0][sl] * twr[0][q] - xi[u][0][sl] * twi[0][q], i0 = xr[u][0][sl] * twi[0][q] + xi[u][0][sl] * twr[0][q];
            const float r1 = xr[u][1][sl] * twr[1][q] - xi[u][1][sl] * twi[1][q], i1 = xr[u][1][sl] * twi[1][q] + xi[u][1][sl] * twr[1][q];
            GAS unsigned* d = d0 + (size_t)q * 256 * 512;
            d[0] = pk2(r0, r1); d[256] = pk2(i0, i1);
        }
    }
}

template <int MODE>
__device__ __forceinline__ void row_pass(int gw, int NGW, int lane, const float* x_prompt, const float* x_sample, float* out, bf16_t* XB, const bf16_t* O, float* RS, float* SS, const float* gpost) {
    for (int m = gw; m < MTOK; m += NGW) {
        f32x4 v[4];
        GAS u32x2* xbrow = (GAS u32x2*)((GAS bf16_t*)XB + (size_t)m * DM) + lane;
        if constexpr (MODE == 2) {
            u32x2 xv[4];
#pragma unroll
            for (int j = 0; j < 4; ++j) xv[j] = xbrow[64 * j];
            const float irs = RS[m];
#pragma unroll
            for (int j = 0; j < 4; ++j) { v[j][0] = bflo(xv[j].x) * irs; v[j][1] = bfhi(xv[j].x) * irs; v[j][2] = bflo(xv[j].y) * irs; v[j][3] = bfhi(xv[j].y) * irs; }
        } else {
            const GAS f32x4* xr = (const GAS f32x4*)((m < MP) ? x_prompt + (size_t)m * DM : x_sample + (size_t)(m - MP) * DM) + lane;
#pragma unroll
            for (int j = 0; j < 4; ++j) v[j] = xr[64 * j];
        }
        if constexpr (MODE != 0) {
            const float rq = rsqrtf(SS[m] * (1.0f / DM) + EPS);
            const GAS u32x2* orow = (const GAS u32x2*)((const GAS bf16_t*)O + (size_t)m * DM) + lane;
#pragma unroll
            for (int j = 0; j < 4; ++j) { const u32x2 ov = orow[64 * j]; const f32x4 gp = *((const GAS f32x4*)gpost + lane + 64 * j);
                v[j][0] += bflo(ov.x) * rq * gp[0]; v[j][1] += bfhi(ov.x) * rq * gp[1]; v[j][2] += bflo(ov.y) * rq * gp[2]; v[j][3] += bfhi(ov.y) * rq * gp[3]; }
            if constexpr (MODE == 2) {
                GAS f32x4* orow2 = (GAS f32x4*)(out + (size_t)m * DM) + lane;
#pragma unroll
                for (int j = 0; j < 4; ++j) orow2[64 * j] = v[j];
            }
        }
        if constexpr (MODE != 2) {
            float s = 0.f;
#pragma unroll
            for (int j = 0; j < 4; ++j) s += (v[j][0] * v[j][0] + v[j][1] * v[j][1]) + (v[j][2] * v[j][2] + v[j][3] * v[j][3]);
            s = wave_sum(s);
            const float ms = s * (1.0f / DM) + EPS;
            const float rsv = rsqrtf(ms);
#pragma unroll
            for (int j = 0; j < 4; ++j) { u32x2 w; w.x = pk2(v[j][0] * rsv, v[j][1] * rsv); w.y = pk2(v[j][2] * rsv, v[j][3] * rsv); xbrow[64 * j] = w; }
            if (lane == 0) { RS[m] = sqrtf(ms); SS[m] = 0.f; }
        }
    }
}

__global__ void __launch_bounds__(NWAVES * 64, 2) fwd_kernel(Args args) {
    extern __shared__ __attribute__((aligned(16))) unsigned char lds_raw[];
    LAS unsigned char* lds = (LAS unsigned char*)lds_raw;
    const int G = gridDim.x, bx = blockIdx.x;
    for (int ph = args.ph_lo; ph < args.ph_hi; ++ph) {
        if (ph > args.ph_lo) { cg::this_grid().sync(); }
        int tid = threadIdx.x; asm volatile("" : "+v"(tid));
        const int lane = tid & 63, wave = __builtin_amdgcn_readfirstlane(tid >> 6);
        const int gw = bx * NWAVES + wave, NGW = G * NWAVES;
        unsigned char* ws = args.ws; asm volatile("" : "+s"(ws));
        const float* x_prompt = args.in[0]; const float* x_sample = args.in[1];
        float* out = args.out;
        bf16_t* XB = (bf16_t*)(ws + WS_XB); bf16_t* OB = XB;
        bf16_t* ZM = (bf16_t*)(ws + WS_ZM); bf16_t* PB = ZM;
        bf16_t* ZT = (bf16_t*)(ws + WS_ZT); bf16_t* MG = ZT;
        bf16_t* YQ = (bf16_t*)(ws + WS_YQ);
        bf16_t* Y = (bf16_t*)(ws + WS_Y);
        bf16_t* TT = (bf16_t*)(ws + WS_T);
        float* RS = (float*)(ws + WS_RS); float* SS = (float*)(ws + WS_SS);
        const int layer = (ph == 0) ? 0 : (ph - 1) / 7;
        const int sub = (ph == 0) ? -1 : (ph - 1) % 7;
        const bf16_t* WIN = (const bf16_t*)(ws + WS_WIN) + (size_t)layer * NG1 * DM;
        const bf16_t* WG = (const bf16_t*)(ws + WS_WG) + (size_t)layer * DM * DM;
        const bf16_t* WM = (const bf16_t*)(ws + WS_WM) + (size_t)layer * 3072 * DM;
        const bf16_t* WA = (const bf16_t*)(ws + WS_WA) + (size_t)layer * DM * 512;
        const bf16_t* WB = (const bf16_t*)(ws + WS_WB) + (size_t)layer * DM * 256;
        const bf16_t* WC = (const bf16_t*)(ws + WS_WC) + (size_t)layer * DM * 256;
        const bf16_t* WO = (const bf16_t*)(ws + WS_WO) + (size_t)layer * DM * DM;

        if (PHON(0) && ph == 0) {
            LAS float* scr = (LAS float*)(lds + wave * 16384);
            for (int l = 0; l < 2; ++l) {
                const float* w_in = args.in[4] + (size_t)l * DM * DIN;
                const float* gpre = args.in[2] + l * DM;
                bf16_t* win = (bf16_t*)(ws + WS_WIN) + (size_t)l * NG1 * DM;
                bf16_t* wg = (bf16_t*)(ws + WS_WG) + (size_t)l * DM * DM;
                bf16_t* wm = (bf16_t*)(ws + WS_WM) + (size_t)l * 3072 * DM;
                for (int job = 0; job < 7; ++job) {
                    int c0, nc, ro; bf16_t* dst; float sc = 1.f;
                    switch (job) {
                        case 0: c0 = 0; nc = 512; dst = win; ro = 0; sc = 0.125f; break;
                        case 1: c0 = 512; nc = 1024; dst = win; ro = 512; break;
                        case 2: c0 = 2560; nc = 512; dst = win; ro = 2048; break;
                        case 3: c0 = 1536; nc = 512; dst = wg; ro = 0; break;
                        case 4: c0 = 2304; nc = 256; dst = wg; ro = 512; break;
                        case 5: c0 = 3072; nc = 256; dst = wg; ro = 768; break;
                        default: c0 = 3328; nc = 3072; dst = wm; ro = 0; break;
                    }
                    const int nitems = (DM / 64) * (nc / 32);
                    for (int it = gw; it < nitems; it += NGW) transpose_item(w_in, DM, DIN, c0, nc, dst, ro, gpre, sc, scr, it, lane);
                }
                {   const int ni = (512 / 64) * (DM / 32);
                    for (int it = gw; it < ni; it += NGW) transpose_item(args.in[10] + (size_t)l * 512 * DM, 512, DM, 0, DM, (bf16_t*)(ws + WS_WA) + (size_t)l * DM * 512, 0, nullptr, 1.f, scr, it, lane); }
                {   const int ni = (256 / 64) * (DM / 32);
                    for (int it = gw; it < ni; it += NGW) transpose_item(args.in[11] + (size_t)l * 256 * DM, 256, DM, 0, DM, (bf16_t*)(ws + WS_WB) + (size_t)l * DM * 256, 0, nullptr, 1.f, scr, it, lane);
                    for (int it = gw; it < ni; it += NGW) transpose_item(args.in[12] + (size_t)l * 256 * DM, 256, DM, 0, DM, (bf16_t*)(ws + WS_WC) + (size_t)l * DM * 256, 0, nullptr, 1.f, scr, it, lane); }
                {   const int ni = (DM / 64) * (DM / 32);
                    for (int it = gw; it < ni; it += NGW) transpose_item(args.in[13] + (size_t)l * DM * DM, DM, DM, 0, DM, (bf16_t*)(ws + WS_WO) + (size_t)l * DM * DM, 0, nullptr, 1.f, scr, it, lane); }
                LAS float* ctab = (LAS float*)(lds + 131072);
                if (l == 0) { if (tid < 64) { float sn, cs; sincospif((float)tid * (1.0f / 32.0f), &sn, &cs); ctab[tid] = cs; ctab[64 + tid] = sn; } __syncthreads(); }
                for (int idx = bx * 512 + tid; idx < DM * 256; idx += G * 512) {
                    const int k = idx >> 8, p = idx & 255, grp = p >> 6, mm = p & 63;
                    const f32x4* wrow = (const f32x4*)(w_in + (size_t)k * DIN + 2048 + grp * 64);
                    float are = 0.f, aim = 0.f;
#pragma unroll 4
                    for (int c4 = 0; c4 < 16; ++c4) { const f32x4 w = wrow[c4];
#pragma unroll
                        for (int e = 0; e < 4; ++e) { const int t = (mm * (4 * c4 + e)) & 63; are += w[e] * ctab[t]; aim -= w[e] * ctab[64 + t]; } }
                    const float gk = gpre[k];
                    win[(size_t)(1536 + p) * DM + k] = (bf16_t)f2bf(are * gk);
                    win[(size_t)(1536 + 256 + p) * DM + k] = (bf16_t)f2bf(aim * gk);
                }
            }
            for (int idx = bx * 512 + tid; idx < 512 * 512; idx += G * 512) {
                const int kp = idx >> 9, lp = idx & 511; float sn, cs; sincospif((float)((kp * lp) & 511) * (1.0f / 256.0f), &sn, &cs);
                TT[(size_t)kp * 1024 + lp] = (bf16_t)f2bf(cs); TT[(size_t)kp * 1024 + 512 + lp] = (bf16_t)f2bf(sn);
            }
        }
        if (PHON(1) && (ph == 0 || sub == 6)) {
            const float* gpost = args.in[3] + layer * DM;
            if (ph == 0) row_pass<0>(gw, NGW, lane, x_prompt, x_sample, out, XB, Y, RS, SS, gpost);
            else if (layer == 0) row_pass<1>(gw, NGW, lane, x_prompt, x_sample, out, XB, Y, RS, SS, gpost);
            else row_pass<2>(gw, NGW, lane, x_prompt, x_sample, out, XB, Y, RS, SS, gpost);
        } else if (PHON(2) && sub == 0) {
            pg8::Gemm g{XB, WIN, MTOK, NG1, DM, DM, DM}; pg8::StaticOrder S; S.init(MTOK, NG1, G, bx);
            pg8::EpiG1 E{RS, ZM, ZT};
            pg8::gemm_phase<pg8::EpiG1, pg8::StaticOrder, true>(lds, g, S, E);
        } else if (sub == 1) {
            if (PHON(3)) {
                const float* rpb = args.in[5] + (size_t)layer * 8 * 15 * 31;
                for (int un = bx; un < 512; un += G) {
                    if (un < 256) attn_unit(lds, (un >> 3) * 2048, 32, 0, 32, un & 7, tid, lane, wave, ZM, ZT, Y, rpb);
                    else { const int v = un - 256, st = v & 7; attn_unit(lds, MP + (v >> 6) * 8192, 128, st * 16, st * 16 + 16, (v >> 3) & 7, tid, lane, wave, ZM, ZT, Y, rpb); }
                }
            }
            if (PHON(4)) {
                LAS float* hbuf = (LAS float*)lds; LAS float* cbuf = (LAS float*)(lds + 65536);
                const float* dww = args.in[6] + (size_t)layer * 31 * 256; const float* dwb = args.in[7] + layer * 256;
                const float* lng = args.in[8] + layer * 256; const float* lnb = args.in[9] + layer * 256;
                const int c = tid & 255, half = tid >> 8;
                float w[31];
#pragma unroll
                for (int j = 0; j < 31; ++j) w[j] = dww[j * 256 + c];
                const float bc = dwb[c];
                const f32x4 lg = *((const f32x4*)lng + lane), lb = *((const f32x4*)lnb + lane);
                u32x4 pa[4], pb[4];
#define CONV_ISSUE(cu_) do { const int t0g_ = (cu_) * 32; \
                    int sbeg_, send_; if (t0g_ < MP) { sbeg_ = t0g_ & ~2047; send_ = sbeg_ + 2048; } else { sbeg_ = MP + ((t0g_ - MP) & ~8191); send_ = sbeg_ + 8192; } \
                    _Pragma("unroll") for (int k = 0; k < 4; ++k) { \
                        const int it = tid + k * 512, i = it >> 5, c8 = (it & 31) * 8; const int tok = t0g_ - 15 + i; \
                        int tokc = tok < sbeg_ ? sbeg_ : tok; tokc = tokc > send_ - 1 ? send_ - 1 : tokc;     \
                        const u32x4 la_ = *(const GAS u32x4*)((const GAS bf16_t*)ZM + (size_t)tokc * ZMW + 1024 + c8), lb_ = *(const GAS u32x4*)((const GAS bf16_t*)ZM + (size_t)tokc * ZMW + 1280 + c8); \
                        const unsigned keep_ = (tok >= sbeg_ && tok < send_) ? 0xffffffffu : 0u; \
                        pa[k].x = la_.x & keep_; pa[k].y = la_.y & keep_; pa[k].z = la_.z & keep_; pa[k].w = la_.w & keep_; pb[k] = lb_; \
                    } } while (0)
                for (int cu = bx; cu < MTOK / 32; cu += G) {
                    const int t0g = cu * 32;
                    CONV_ISSUE(cu);
#pragma unroll
                    for (int k = 0; k < 4; ++k) {
                        const int it = tid + k * 512, i = it >> 5, c8 = (it & 31) * 8;
                        if (it < 62 * 32) {
                            const u32x4 a = pa[k], b = pb[k]; f32x4 h0, h1;
                            h0[0] = bflo(a.x) * sigmoidf_(bflo(b.x)); h0[1] = bfhi(a.x) * sigmoidf_(bfhi(b.x)); h0[2] = bflo(a.y) * sigmoidf_(bflo(b.y)); h0[3] = bfhi(a.y) * sigmoidf_(bfhi(b.y));
                            h1[0] = bflo(a.z) * sigmoidf_(bflo(b.z)); h1[1] = bfhi(a.z) * sigmoidf_(bfhi(b.z)); h1[2] = bflo(a.w) * sigmoidf_(bflo(b.w)); h1[3] = bfhi(a.w) * sigmoidf_(bfhi(b.w));
                            *(LAS f32x4*)(hbuf + i * 256 + c8) = h0; *(LAS f32x4*)(hbuf + i * 256 + c8 + 4) = h1;
                        }
                    }
                    __syncthreads();
                    {   float hv[46];
#pragma unroll
                        for (int i = 0; i < 46; ++i) hv[i] = hbuf[(half * 16 + i) * 256 + c];
#pragma unroll
                        for (int tt = 0; tt < 16; ++tt) {
                            float a = bc;
#pragma unroll
                            for (int j = 0; j < 31; ++j) a += w[j] * hv[tt + j];
                            cbuf[(half * 16 + tt) * 256 + c] = a;
                        }
                    }
                    __syncthreads();
#pragma unroll
                    for (int tt = 0; tt < 4; ++tt) {
                        const int t = wave * 4 + tt;
                        const f32x4 xv = *(const LAS f32x4*)(cbuf + t * 256 + 4 * lane);
                        const float mean = wave_sum((xv[0] + xv[1]) + (xv[2] + xv[3])) * (1.0f / 256.0f);
                        const f32x4 d = xv - mean;
                        const float var = wave_sum((d[0] * d[0] + d[1] * d[1]) + (d[2] * d[2] + d[3] * d[3])) * (1.0f / 256.0f);
                        const float rstd = rsqrtf(var + EPS);
                        const float y0 = siluf_(d[0] * rstd * lg[0] + lb[0]), y1 = siluf_(d[1] * rstd * lg[1] + lb[1]), y2 = siluf_(d[2] * rstd * lg[2] + lb[2]), y3 = siluf_(d[3] * rstd * lg[3] + lb[3]);
                        u32x2 wv; wv.x = pk2(y0, y1); wv.y = pk2(y2, y3);
                        *(GAS u32x2*)((GAS bf16_t*)Y + (size_t)(t0g + t) * DM + 768 + 4 * lane) = wv;
                    }
                }
            }
            if (PHON(5)) {
                float t4r[2][4], t4i[2][4], t16r[2][16], t16i[2][16];
                const int bt = tid & 255, bh = tid >> 8;
                {   const float s4 = rsqrtf(64.0f * 2048.0f), s16 = rsqrtf(64.0f * 8192.0f);
#pragma unroll
                    for (int h = 0; h < 2; ++h) {
#pragma unroll
                        for (int q = 0; q < 4; ++q) { float sn, cs; sincospif(-2.0f * (float)(q * (2 * bt + h)) / 2048.0f, &sn, &cs); t4r[h][q] = cs * s4; t4i[h][q] = sn * s4; }
#pragma unroll
                        for (int q = 0; q < 16; ++q) { float sn, cs; sincospif(-2.0f * (float)(q * (2 * bt + h)) / 8192.0f, &sn, &cs); t16r[h][q] = cs * s16; t16i[h][q] = sn * s16; } } }
                for (int un = bx; un < 32 * 32; un += G) { const int seq = un >> 5, p = (un & 31) * 8 + bh * 4; butterfly_unit<4, 4>(seq * 2048, seq * 1024 + p, p, bt, ZT, YQ, t4r, t4i); }
                for (int un = bx; un < 4 * 128; un += G) { const int seq = un >> 7, p = (un & 127) * 2 + bh; butterfly_unit<16, 1>(MP + seq * 8192, 32768 + seq * 4096 + p, p, bt, ZT, YQ, t16r, t16i); }
            }
        } else if (PHON(6) && sub == 2) {
            pg8::Gemm g{YQ, TT, NYQ, 512, 1024, 1024, 1024}; pg8::StaticOrder S; S.init(NYQ, 512, G, bx);
            pg8::EpiDFT E{Y};
            pg8::gemm_phase<pg8::EpiDFT, pg8::StaticOrder, true>(lds, g, S, E);
        } else if (PHON(7) && sub == 3) {
            pg8::Gemm g{XB, WG, MTOK, DM, DM, DM, DM}; pg8::StaticOrder S; S.init(MTOK, DM, G, bx);
            pg8::EpiG2 E{RS, Y};
            pg8::gemm_phase<pg8::EpiG2, pg8::StaticOrder, true>(lds, g, S, E);
        } else if (sub == 4) {
            pg8::ProgG34 PG; PG.S.init(MTOK, DM, G, bx); PG.Y = Y; PG.XB = XB; PG.wsb = (const char*)ws; PG.WM = WM; PG.layer = layer;
            pg8::EpiG34 EG{RS, PB + (size_t)bx * 65536, PB + (size_t)(256 + bx) * 65536, MG};
            pg8::gemm_multi<pg8::EpiG34, pg8::ProgG34>(lds, PG, EG);
        } else if (PHON(10) && sub == 5) {
            pg8::Gemm g{MG, WO, MTOK, DM, DM, DM, DM}; pg8::StaticOrder S; S.init(MTOK, DM, G, bx);
            pg8::EpiG5 E{Y, SS};
            pg8::gemm_phase<pg8::EpiG5, pg8::StaticOrder, true>(lds, g, S, E);
        }
    }
}

extern "C" void kernel_launch(void* const* d_in, const int* in_sizes, int n_in, void* d_out, int out_size, void* d_ws, size_t ws_size, hipStream_t stream) {
    static int grid = 0;
    if (grid == 0) {
        if (n_in != 14 || ws_size < WS_END) { fprintf(stderr, "kernel_launch: bad inputs (n_in %d, ws %zu < %zu)\n", n_in, ws_size, (size_t)WS_END); grid = -1; return; }
        int dev = 0, cus = 0, per_cu = 0;
        hipGetDevice(&dev); hipDeviceGetAttribute(&cus, hipDeviceAttributeMultiprocessorCount, dev);
        if (hipFuncSetAttribute((const void*)fwd_kernel, hipFuncAttributeMaxDynamicSharedMemorySize, LDS_BYTES) != hipSuccess) { fprintf(stderr, "hipFuncSetAttribute failed\n"); grid = -1; return; }
        hipOccupancyMaxActiveBlocksPerMultiprocessor(&per_cu, (const void*)fwd_kernel, NWAVES * 64, LDS_BYTES);
        (void)hipGetLastError();
        if (per_cu < 1) { fprintf(stderr, "occupancy query says 0 blocks per CU\n"); }
        grid = cus;
    }
    if (grid < 0) return;
    Args a{};
    for (int i = 0; i < 14; ++i) a.in[i] = (const float*)d_in[i];
    a.out = (float*)d_out; a.ws = (unsigned char*)d_ws;
#if MK_ONE_LAUNCH
    a.ph_lo = 0; a.ph_hi = 15;
    void* kargs[] = {&a};
    hipError_t e = hipLaunchCooperativeKernel((const void*)fwd_kernel, dim3(grid), dim3(NWAVES * 64), kargs, LDS_BYTES, stream);
    if (e != hipSuccess) fprintf(stderr, "cooperative launch failed: %s (grid %d)\n", hipGetErrorString(e), grid);
#else
    for (int ph = 0; ph < 15; ++ph) {
        a.ph_lo = ph; a.ph_hi = ph + 1;
        hipLaunchKernelGGL(fwd_kernel, dim3(grid), dim3(NWAVES * 64), LDS_BYTES, stream, a);
    }
#endif
}
```

```cpp
#include <hip/hip_runtime.h>
#include <hip/hip_cooperative_groups.h>
#include <cstdio>
#include <cstdint>
namespace cg = cooperative_groups;

#ifndef MK_ONE_LAUNCH
#define MK_ONE_LAUNCH 1
#endif

#ifndef PH_MASK
#define PH_MASK 0xFFFF
#endif
#define PHON(k) (((PH_MASK) >> (k)) & 1)
#define LAS __attribute__((address_space(3)))
typedef unsigned short bf16_t;
typedef short bf16x8 __attribute__((ext_vector_type(8)));
typedef short s16x4 __attribute__((ext_vector_type(4)));
typedef float f32x4 __attribute__((ext_vector_type(4)));
typedef unsigned u32x4 __attribute__((ext_vector_type(4)));
typedef unsigned u32x2 __attribute__((ext_vector_type(2)));

constexpr int DM = 1024;
constexpr int MP = 65536;
constexpr int MTOK = 98304;
constexpr int DIN = 6400;
constexpr int NG1 = 2560;
constexpr int ZMW = 1536;
constexpr int NYQ = 49152;
constexpr float EPS = 1e-6f;

constexpr size_t MiB = 1u << 20;
constexpr size_t WS_WIN = 0;
constexpr size_t WS_WG = 10 * MiB;
constexpr size_t WS_WM = 14 * MiB;
constexpr size_t WS_WA = 26 * MiB;
constexpr size_t WS_WB = 28 * MiB;
constexpr size_t WS_WC = 29 * MiB;
constexpr size_t WS_WO = 30 * MiB;
constexpr size_t WS_T = 34 * MiB;
constexpr size_t WS_RS = 35 * MiB;
constexpr size_t WS_SS = 35 * MiB + 512 * 1024;
constexpr size_t WS_XB = 36 * MiB;
constexpr size_t WS_ZM = 228 * MiB;
constexpr size_t WS_ZT = 516 * MiB;
constexpr size_t WS_YQ = 708 * MiB;
constexpr size_t WS_Y = 804 * MiB;
constexpr size_t WS_END = 996 * MiB;

constexpr int NWAVES = 8;
constexpr int LDS_BYTES = 163840;

__device__ __forceinline__ unsigned f2bf(float f) { unsigned u = __builtin_bit_cast(unsigned, f); return (u + 0x7fffu + ((u >> 16) & 1u)) >> 16; }
__device__ __forceinline__ unsigned pk2(float lo, float hi) { unsigned r; asm("v_cvt_pk_bf16_f32 %0, %1, %2" : "=v"(r) : "v"(lo), "v"(hi)); return r; }
__device__ __forceinline__ float bf2f(unsigned b) { return __builtin_bit_cast(float, b << 16); }
__device__ __forceinline__ float bflo(unsigned w) { return __builtin_bit_cast(float, w << 16); }
__device__ __forceinline__ float bfhi(unsigned w) { return __builtin_bit_cast(float, w & 0xffff0000u); }
__device__ __forceinline__ float sigmoidf_(float x) { return __builtin_amdgcn_rcpf(1.0f + __expf(-x)); }
__device__ __forceinline__ float siluf_(float x) { return x * __builtin_amdgcn_rcpf(1.0f + __expf(-x)); }
__device__ __forceinline__ float wave_sum(float v) {
#pragma unroll
    for (int o = 1; o < 64; o <<= 1) v += __shfl_xor(v, o);
    return v;
}
#define LDS_WAIT() asm volatile("s_waitcnt lgkmcnt(0)" ::: "memory")
#define GAS __attribute__((address_space(1)))

namespace pg8 {
constexpr int BM = 256, BK = 64, HALF = 128, HTB = HALF * BK * 2, STAGE_BYTES = 8 * HTB, NXCD = 8, WGM = 8;
__device__ __forceinline__ int lds_byte(int r, int c) { const int st = (r >> 4) * 2 + (c >> 5), rr = r & 15, cc = c & 31, ob = rr * 64 + cc * 2; return st * 1024 + (ob ^ (((ob >> 9) & 1) << 5)); }
__device__ __forceinline__ void stage_rc(int b, int& R, int& C) { const int st = b / 1024, sb = b % 1024, swz = sb ^ (((sb >> 9) & 1) << 5); R = (st >> 1) * 16 + swz / 64; C = (st & 1) * 32 + (swz % 64) / 2; }

__device__ __forceinline__ int perm32(int rho) { const int n = rho >> 4, i = rho & 15; return 8 * (i >> 2) + 4 * n + (i & 3); }
struct Unit { int pm, pn; };
struct Gemm { const bf16_t* A; const bf16_t* Bt; int M, N, K, lda, ldb; };

struct StaticOrder {
    int nM, nN, nwg, G, c;
    __device__ __forceinline__ void init(int M, int N, int G_, int c_) { nM = M / BM; nN = N / BM; nwg = nM * nN; G = G_; c = c_; }
    __device__ __forceinline__ bool next(int i, Unit& u) const {
        const long L = (long)i * G + c; if (L >= nwg) return false;
        int wgid = (int)L; { const int q = nwg / NXCD, r = nwg % NXCD, xcd = wgid % NXCD, off = wgid / NXCD; wgid = (xcd < r ? xcd * (q + 1) : r * (q + 1) + (xcd - r) * q) + off; }
        const int nig = WGM * nN, gid = wgid / nig, fm = gid * WGM, gsz = (nM - fm) < WGM ? (nM - fm) : WGM;
        u.pm = fm + ((wgid % nig) % gsz); u.pn = (wgid % nig) / gsz; return true;
    }
};

struct SingleUnit { Unit u; __device__ bool next(int i, Unit& o) const { if (i) return false; o = u; return true; } };
template <class Epi, class Sched, bool ALIGN_EPI>
__device__ __forceinline__ void gemm_phase(LAS unsigned char* lds, const Gemm g, const Sched& S, const Epi& E) {
    int tid = threadIdx.x; asm volatile("" : "+v"(tid));
    const int wid = __builtin_amdgcn_readfirstlane(tid >> 6), lane = tid & 63, wr = wid >> 2, wc = wid & 3, fr = lane & 15, fq = lane >> 4;
    const int K = g.K, nt = K / BK;
    unsigned voffA[2], voffB[2];
#pragma unroll
    for (int i = 0; i < 2; ++i) { int R, C; stage_rc(tid * 16 + i * 8192, R, C);
        const int Rb = (R & ~31) + perm32(R & 31);
        voffA[i] = (unsigned)(R * g.lda + C) * 2u; voffB[i] = (unsigned)(Rb * g.ldb + C) * 2u; }
    const size_t kstep = (size_t)(BK * 2);
    const size_t hstepA = (size_t)HALF * g.lda * 2, hstepB = (size_t)HALF * g.ldb * 2;
    const size_t tstepA = 2 * hstepA, tstepB = 2 * hstepB;
    const unsigned ldsw = (unsigned)wid * 1024u;
    const int aoff = lds_byte(wr * 64 + fr, fq * 8), boff = lds_byte(wc * 32 + fr, fq * 8);
#define PG8_SA(b, h) (((b) * 2 + (h)) * HTB)
#define PG8_SB(b, h) ((4 + (b) * 2 + (h)) * HTB)
#define PG8_STAGE(bufoff, gbase, voff) do { _Pragma("unroll") for (int _i = 0; _i < 2; ++_i) \
        __builtin_amdgcn_global_load_lds((const unsigned*)((const char*)(gbase) + (voff)[_i]), (LAS unsigned*)(lds + (bufoff) + ldsw + _i * 8192), 16, 0, 0); } while (0)
#define PG8_LDA(dst, b, h) do { _Pragma("unroll") for (int m = 0; m < 4; ++m) _Pragma("unroll") for (int k = 0; k < 2; ++k) dst[m][k] = *(const LAS bf16x8*)(lds + PG8_SA(b, h) + aoff + m * 2048 + k * 1024); } while (0)
#define PG8_LDB(dst, b, h) do { _Pragma("unroll") for (int n = 0; n < 2; ++n) _Pragma("unroll") for (int k = 0; k < 2; ++k) dst[n][k] = *(const LAS bf16x8*)(lds + PG8_SB(b, h) + boff + n * 2048 + k * 1024); } while (0)
#define PG8_MMA(ai, bj, At, Bt) do { __builtin_amdgcn_s_setprio(1); _Pragma("unroll") for (int m = 0; m < 4; ++m) _Pragma("unroll") for (int n = 0; n < 2; ++n) _Pragma("unroll") for (int k = 0; k < 2; ++k) \
        acc[ai][bj][m][n] = __builtin_amdgcn_mfma_f32_16x16x32_bf16(Bt[n][k], At[m][k], acc[ai][bj][m][n], 0, 0, 0); __builtin_amdgcn_s_setprio(0); } while (0)
#define PG8_WAIT_V(n) asm volatile("s_waitcnt vmcnt(" #n ")" ::: "memory")
#define PG8_WAIT_L(n) asm volatile("s_waitcnt lgkmcnt(" #n ")" ::: "memory")
#define PG8_BAR __builtin_amdgcn_s_barrier()
#define PG8_SCHED __builtin_amdgcn_sched_barrier(0)
    Unit cur, nxt; int ui = 0;
    if (!S.next(0, cur)) return;
    f32x4 acc[2][2][4][2];
#pragma unroll
    for (int a = 0; a < 2; ++a)
#pragma unroll
        for (int b = 0; b < 2; ++b)
#pragma unroll
            for (int m = 0; m < 4; ++m)
#pragma unroll
                for (int n = 0; n < 2; ++n) acc[a][b][m][n] = (f32x4){0.f, 0.f, 0.f, 0.f};
    bf16x8 At[4][2], B0[2][2], B1[2][2];
    const char* cA = (const char*)g.A + (size_t)cur.pm * tstepA; const char* cB = (const char*)g.Bt + (size_t)cur.pn * tstepB;
    PG8_STAGE(PG8_SB(0, 0), cB, voffB); PG8_STAGE(PG8_SB(0, 1), cB + hstepB, voffB); PG8_STAGE(PG8_SA(0, 0), cA, voffA); PG8_STAGE(PG8_SA(0, 1), cA + hstepA, voffA);
    if (wr == 1) PG8_BAR;
    PG8_WAIT_V(2); PG8_BAR;
    PG8_STAGE(PG8_SB(1, 0), cB + kstep, voffB); PG8_STAGE(PG8_SA(1, 0), cA + kstep, voffA); PG8_STAGE(PG8_SB(1, 1), cB + hstepB + kstep, voffB);
    PG8_WAIT_V(6); PG8_BAR;
    for (;;) {
        const bool has_next = S.next(ui + 1, nxt);
        const char* nA = has_next ? (const char*)g.A + (size_t)nxt.pm * tstepA : cA; const char* nB = has_next ? (const char*)g.Bt + (size_t)nxt.pn * tstepB : cB;
        for (int t = 0; t < nt; t += 2) {
            const bool last = (t == nt - 2);
            const char* a1 = cA + (size_t)(t + 1) * kstep;
            const char* a2 = last ? nA : cA + (size_t)(t + 2) * kstep; const char* b2 = last ? nB : cB + (size_t)(t + 2) * kstep;
            const char* a3 = a2 + kstep; const char* b3 = b2 + kstep;
            PG8_LDB(B0, 0, 0); PG8_LDB(B1, 0, 1); PG8_SCHED; PG8_LDA(At, 0, 0); PG8_STAGE(PG8_SA(1, 1), a1 + hstepA, voffA);
            PG8_WAIT_V(8); PG8_WAIT_L(0); PG8_BAR; PG8_MMA(0, 0, At, B0); PG8_MMA(0, 1, At, B1); PG8_BAR; PG8_SCHED;
            PG8_LDA(At, 0, 1); PG8_STAGE(PG8_SB(0, 0), b2, voffB); PG8_STAGE(PG8_SB(0, 1), b2 + hstepB, voffB); PG8_STAGE(PG8_SA(0, 0), a2, voffA);
            PG8_WAIT_V(8); PG8_WAIT_L(0); PG8_BAR; PG8_MMA(1, 0, At, B0); PG8_MMA(1, 1, At, B1); PG8_BAR; PG8_SCHED;
            PG8_LDB(B0, 1, 0); PG8_LDB(B1, 1, 1); PG8_SCHED; PG8_LDA(At, 1, 0); PG8_STAGE(PG8_SA(0, 1), a2 + hstepA, voffA);
            PG8_WAIT_V(8); PG8_WAIT_L(0); PG8_BAR; PG8_MMA(0, 0, At, B0); PG8_MMA(0, 1, At, B1); PG8_BAR; PG8_SCHED;
            PG8_LDA(At, 1, 1); PG8_STAGE(PG8_SB(1, 0), b3, voffB); PG8_STAGE(PG8_SB(1, 1), b3 + hstepB, voffB); PG8_STAGE(PG8_SA(1, 0), a3, voffA);
            PG8_WAIT_V(8); PG8_WAIT_L(0); PG8_BAR; PG8_MMA(1, 0, At, B0); PG8_MMA(1, 1, At, B1); PG8_BAR; PG8_SCHED;
        }
        if constexpr (ALIGN_EPI) { if (wr == 0) PG8_BAR; }
        E(acc, cur, wr, wc, fr, fq);
        if (!has_next) break;
#pragma unroll
        for (int a = 0; a < 2; ++a)
#pragma unroll
            for (int b = 0; b < 2; ++b)
#pragma unroll
                for (int m = 0; m < 4; ++m)
#pragma unroll
                    for (int n = 0; n < 2; ++n) acc[a][b][m][n] = (f32x4){0.f, 0.f, 0.f, 0.f};
        cur = nxt; cA = nA; cB = nB; ++ui;
        if constexpr (ALIGN_EPI) { if (wr == 1) PG8_BAR; }
    }
    PG8_WAIT_V(0);
    if constexpr (!ALIGN_EPI) { if (wr == 0) PG8_BAR; }
    PG8_BAR;
#undef PG8_SA
#undef PG8_SB
#undef PG8_STAGE
#undef PG8_LDA
#undef PG8_LDB
#undef PG8_MMA
#undef PG8_WAIT_V
#undef PG8_WAIT_L
#undef PG8_BAR
#undef PG8_SCHED
}

struct UnitX { int pm, pn, seg; };
__device__ __forceinline__ int uni(int v) { return __builtin_amdgcn_readfirstlane(v); }
__device__ __forceinline__ const char* unip(const char* p) { const unsigned long long v = (unsigned long long)p; const unsigned lo = (unsigned)__builtin_amdgcn_readfirstlane((int)(unsigned)v), hi = (unsigned)__builtin_amdgcn_readfirstlane((int)(unsigned)(v >> 32)); return (const char*)(((unsigned long long)hi << 32) | lo); }
template <class Epi, class Prog>
__device__ __forceinline__ void gemm_multi(LAS unsigned char* lds, const Prog& P, const Epi& E) {
    int tid = threadIdx.x; asm volatile("" : "+v"(tid));
    const int wid = __builtin_amdgcn_readfirstlane(tid >> 6), lane = tid & 63, wr = wid >> 2, wc = wid & 3, fr = lane & 15, fq = lane >> 4;
    unsigned Rr[2], RrB[2], Cc2[2];
#pragma unroll
    for (int i = 0; i < 2; ++i) { int R, C; stage_rc(tid * 16 + i * 8192, R, C); Rr[i] = (unsigned)R * 2u; RrB[i] = (unsigned)((R & ~31) + perm32(R & 31)) * 2u; Cc2[i] = (unsigned)C * 2u; }
    const size_t kstep = (size_t)(BK * 2);
    const unsigned ldsw = (unsigned)wid * 1024u;
    const int aoff = lds_byte(wr * 64 + fr, fq * 8), boff = lds_byte(wc * 32 + fr, fq * 8);
#define PG8_SA(b, h) (((b) * 2 + (h)) * HTB)
#define PG8_SB(b, h) ((4 + (b) * 2 + (h)) * HTB)
#define PG8_STAGE_X(RR, bufoff, gbase, ld) do { _Pragma("unroll") for (int _i = 0; _i < 2; ++_i) \
        __builtin_amdgcn_global_load_lds((const unsigned*)((const char*)(gbase) + (RR[_i] * (unsigned)(ld) + Cc2[_i])), (LAS unsigned*)(lds + (bufoff) + ldsw + _i * 8192), 16, 0, 0); } while (0)
#define PG8_STAGE(bufoff, gbase, ld) PG8_STAGE_X(Rr, bufoff, gbase, ld)
#define PG8_STAGEB(bufoff, gbase, ld) PG8_STAGE_X(RrB, bufoff, gbase, ld)
#define PG8_LDA(dst, b, h) do { _Pragma("unroll") for (int m = 0; m < 4; ++m) _Pragma("unroll") for (int k = 0; k < 2; ++k) dst[m][k] = *(const LAS bf16x8*)(lds + PG8_SA(b, h) + aoff + m * 2048 + k * 1024); } while (0)
#define PG8_LDB(dst, b, h) do { _Pragma("unroll") for (int n = 0; n < 2; ++n) _Pragma("unroll") for (int k = 0; k < 2; ++k) dst[n][k] = *(const LAS bf16x8*)(lds + PG8_SB(b, h) + boff + n * 2048 + k * 1024); } while (0)
#define PG8_MMA(ai, bj, At, Bt) do { __builtin_amdgcn_s_setprio(1); _Pragma("unroll") for (int m = 0; m < 4; ++m) _Pragma("unroll") for (int n = 0; n < 2; ++n) _Pragma("unroll") for (int k = 0; k < 2; ++k) \
        acc[ai][bj][m][n] = __builtin_amdgcn_mfma_f32_16x16x32_bf16(Bt[n][k], At[m][k], acc[ai][bj][m][n], 0, 0, 0); __builtin_amdgcn_s_setprio(0); } while (0)
#define PG8_WAIT_V(n) asm volatile("s_waitcnt vmcnt(" #n ")" ::: "memory")
#define PG8_WAIT_L(n) asm volatile("s_waitcnt lgkmcnt(" #n ")" ::: "memory")
#define PG8_BAR __builtin_amdgcn_s_barrier()
#define PG8_SCHED __builtin_amdgcn_sched_barrier(0)
    UnitX cur, nxt; int ui = 0;
    if (!P.next(0, cur)) return;
    f32x4 acc[2][2][4][2];
#pragma unroll
    for (int a = 0; a < 2; ++a)
#pragma unroll
        for (int b = 0; b < 2; ++b)
#pragma unroll
            for (int m = 0; m < 4; ++m)
#pragma unroll
                for (int n = 0; n < 2; ++n) acc[a][b][m][n] = (f32x4){0.f, 0.f, 0.f, 0.f};
    bf16x8 At[4][2], B0[2][2], B1[2][2];
    const char* cA; const char* cB; int lda, ldb, nt;
    P.desc(cur, cA, cB, lda, ldb, nt); cA = unip(cA); cB = unip(cB); lda = uni(lda); ldb = uni(ldb); nt = uni(nt);
    {   const size_t hA = (size_t)HALF * lda * 2, hB = (size_t)HALF * ldb * 2;
        PG8_STAGEB(PG8_SB(0, 0), cB, ldb); PG8_STAGEB(PG8_SB(0, 1), cB + hB, ldb); PG8_STAGE(PG8_SA(0, 0), cA, lda); PG8_STAGE(PG8_SA(0, 1), cA + hA, lda);
        if (wr == 1) PG8_BAR;
        PG8_WAIT_V(2); PG8_BAR;
        PG8_STAGEB(PG8_SB(1, 0), cB + kstep, ldb); PG8_STAGE(PG8_SA(1, 0), cA + kstep, lda); PG8_STAGEB(PG8_SB(1, 1), cB + hB + kstep, ldb);
        PG8_WAIT_V(6); PG8_BAR; }
    for (;;) {
        const bool has_next = P.next(ui + 1, nxt);
        const char* nA = cA; const char* nB = cB; int ldan = lda, ldbn = ldb, ntn = nt;
        if (has_next) P.desc(nxt, nA, nB, ldan, ldbn, ntn);
        nA = unip(nA); nB = unip(nB); ldan = uni(ldan); ldbn = uni(ldbn); ntn = uni(ntn);
        const size_t hAc = (size_t)HALF * lda * 2;
        for (int t = 0; t < nt; t += 2) {
            const bool last = (t == nt - 2);
            const char* a1 = cA + (size_t)(t + 1) * kstep;
            const char* a2 = last ? nA : cA + (size_t)(t + 2) * kstep; const char* b2 = last ? nB : cB + (size_t)(t + 2) * kstep;
            const int lda2 = last ? ldan : lda, ldb2 = last ? ldbn : ldb;
            const size_t hA2 = (size_t)HALF * lda2 * 2, hB2 = (size_t)HALF * ldb2 * 2;
            const char* a3 = a2 + kstep; const char* b3 = b2 + kstep;
            PG8_LDB(B0, 0, 0); PG8_LDB(B1, 0, 1); PG8_SCHED; PG8_LDA(At, 0, 0); PG8_STAGE(PG8_SA(1, 1), a1 + hAc, lda);
            PG8_WAIT_V(8); PG8_WAIT_L(0); PG8_BAR; PG8_MMA(0, 0, At, B0); PG8_MMA(0, 1, At, B1); PG8_BAR; PG8_SCHED;
            PG8_LDA(At, 0, 1); PG8_STAGEB(PG8_SB(0, 0), b2, ldb2); PG8_STAGEB(PG8_SB(0, 1), b2 + hB2, ldb2); PG8_STAGE(PG8_SA(0, 0), a2, lda2);
            PG8_WAIT_V(8); PG8_WAIT_L(0); PG8_BAR; PG8_MMA(1, 0, At, B0); PG8_MMA(1, 1, At, B1); PG8_BAR; PG8_SCHED;
            PG8_LDB(B0, 1, 0); PG8_LDB(B1, 1, 1); PG8_SCHED; PG8_LDA(At, 1, 0); PG8_STAGE(PG8_SA(0, 1), a2 + hA2, lda2);
            PG8_WAIT_V(8); PG8_WAIT_L(0); PG8_BAR; PG8_MMA(0, 0, At, B0); PG8_MMA(0, 1, At, B1); PG8_BAR; PG8_SCHED;
            PG8_LDA(At, 1, 1); PG8_STAGEB(PG8_SB(1, 0), b3, ldb2); PG8_STAGEB(PG8_SB(1, 1), b3 + hB2, ldb2); PG8_STAGE(PG8_SA(1, 0), a3, lda2);
            PG8_WAIT_V(8); PG8_WAIT_L(0); PG8_BAR; PG8_MMA(1, 0, At, B0); PG8_MMA(1, 1, At, B1); PG8_BAR; PG8_SCHED;
        }
        if (wr == 0) PG8_BAR;
        E(acc, cur, wr, wc, fr, fq);
        if (!has_next) break;
#pragma unroll
        for (int a = 0; a < 2; ++a)
#pragma unroll
            for (int b = 0; b < 2; ++b)
#pragma unroll
                for (int m = 0; m < 4; ++m)
#pragma unroll
                    for (int n = 0; n < 2; ++n) acc[a][b][m][n] = (f32x4){0.f, 0.f, 0.f, 0.f};
        cur = nxt; cA = nA; cB = nB; lda = ldan; ldb = ldbn; nt = ntn; ++ui;
        if (wr == 1) PG8_BAR;
    }
    PG8_WAIT_V(0);
    PG8_BAR;
#undef PG8_SA
#undef PG8_SB
#undef PG8_STAGE
#undef PG8_STAGEB
#undef PG8_STAGE_X
#undef PG8_LDA
#undef PG8_LDB
#undef PG8_MMA
#undef PG8_WAIT_V
#undef PG8_WAIT_L
#undef PG8_BAR
#undef PG8_SCHED
}

#define EPI_ROWS_BEGIN  _Pragma("unroll") for (int ai = 0; ai < 2; ++ai) _Pragma("unroll") for (int m = 0; m < 4; ++m) { const int row = u.pm * BM + ai * HALF + wr * 64 + m * 16 + fr;
#define EPI_COLS_BEGIN  _Pragma("unroll") for (int bj = 0; bj < 2; ++bj) _Pragma("unroll") for (int n = 0; n < 2; ++n) { const int col = bj * HALF + wc * 32 + 8 * fq + 4 * n; f32x4 v = acc[ai][bj][m][n];
#define EPI_END } }
#define EPI_COLS8_BEGIN  _Pragma("unroll") for (int bj = 0; bj < 2; ++bj) { const int col = bj * HALF + wc * 32 + 8 * fq; const f32x4 v0 = acc[ai][bj][m][0], v1 = acc[ai][bj][m][1];

struct EpiG1 {
    const float* rs; bf16_t* ZM; bf16_t* ZT;
    __device__ __forceinline__ void operator()(const f32x4 (&acc)[2][2][4][2], const Unit& u, int wr, int wc, int fr, int fq) const {
        const int pn = u.pn;
        if (pn >= 4 && pn < 6) {
            const int d0 = (pn - 4) * 256;
            EPI_ROWS_BEGIN
            EPI_COLS_BEGIN
                GAS bf16_t* d = (GAS bf16_t*)ZT + ((size_t)(row >> 6) * 512 + d0 + col) * 64 + (row & 63);
                const unsigned w0 = pk2(v[0], v[1]), w1 = pk2(v[2], v[3]);
                d[0] = (bf16_t)w0; d[64] = (bf16_t)(w0 >> 16); d[128] = (bf16_t)w1; d[192] = (bf16_t)(w1 >> 16);
            EPI_END
        } else if (pn >= 6 && pn < 8) {
            const int j0 = (pn - 6) * 256;
            EPI_ROWS_BEGIN
            EPI_COLS_BEGIN
                GAS bf16_t* d = (GAS bf16_t*)ZT + (size_t)MTOK * 512 + ((size_t)(row >> 9) * 512 + j0 + col) * 512 + (row & 511);
                const unsigned w0 = pk2(v[0], v[1]), w1 = pk2(v[2], v[3]);
                d[0] = (bf16_t)w0; d[512] = (bf16_t)(w0 >> 16); d[1024] = (bf16_t)w1; d[1536] = (bf16_t)(w1 >> 16);
            EPI_END
        } else {
            const int cm = (pn < 4 ? pn : pn - 4) * 256;
            EPI_ROWS_BEGIN
            EPI_COLS8_BEGIN
                u32x4 w; w.x = pk2(v0[0], v0[1]); w.y = pk2(v0[2], v0[3]); w.z = pk2(v1[0], v1[1]); w.w = pk2(v1[2], v1[3]);
                *(GAS u32x4*)((GAS bf16_t*)ZM + (size_t)row * ZMW + cm + col) = w;
            EPI_END
        }
    }
};
struct EpiDFT {
    bf16_t* Y;
    __device__ __forceinline__ void operator()(const f32x4 (&acc)[2][2][4][2], const Unit& u, int wr, int wc, int fr, int fq) const {
        int tok0, R, q;
        if (u.pm < 128) { tok0 = (u.pm >> 2) * 2048; R = 4; q = u.pm & 3; } else { const int t = u.pm - 128; tok0 = MP + (t >> 4) * 8192; R = 16; q = t & 15; }
        EPI_ROWS_BEGIN const int p = row - u.pm * BM;
        EPI_COLS_BEGIN
            const int k0 = u.pn * BM + col;
            GAS bf16_t* d = (GAS bf16_t*)Y + (size_t)(tok0 + R * k0 + q) * DM + 512 + p;
            const unsigned w0 = pk2(v[0], v[1]), w1 = pk2(v[2], v[3]);
            d[0] = (bf16_t)w0; d[(size_t)R * DM] = (bf16_t)(w0 >> 16); d[(size_t)2 * R * DM] = (bf16_t)w1; d[(size_t)3 * R * DM] = (bf16_t)(w1 >> 16);
        EPI_END
    }
};
struct EpiG2 {
    const float* rs; bf16_t* Y;
    __device__ __forceinline__ void operator()(const f32x4 (&acc)[2][2][4][2], const Unit& u, int wr, int wc, int fr, int fq) const {
        EPI_ROWS_BEGIN
        EPI_COLS8_BEGIN
            GAS u32x4* p = (GAS u32x4*)((GAS bf16_t*)Y + (size_t)row * DM + u.pn * BM + col);
            const u32x4 y = *p; u32x4 w;
            w.x = pk2(bflo(y.x) * siluf_(v0[0]), bfhi(y.x) * siluf_(v0[1])); w.y = pk2(bflo(y.y) * siluf_(v0[2]), bfhi(y.y) * siluf_(v0[3]));
            w.z = pk2(bflo(y.z) * siluf_(v1[0]), bfhi(y.z) * siluf_(v1[1])); w.w = pk2(bflo(y.w) * siluf_(v1[2]), bfhi(y.w) * siluf_(v1[3]));
            *p = w;
        EPI_END
    }
};
struct ProgG34 {
    StaticOrder S; const bf16_t* Y; const bf16_t* XB; const char* wsb; const bf16_t* WM; int layer;
    __device__ __forceinline__ bool next(int i, UnitX& u) const { Unit t; if (!S.next(i / 6, t)) return false; u.pm = t.pm; u.pn = t.pn; u.seg = i % 6; return true; }
    __device__ __forceinline__ void desc(const UnitX& u, const char*& A, const char*& B, int& lda, int& ldb, int& nt) const {
        const int b = u.seg >> 1; lda = DM;
        if (u.seg & 1) { A = (const char*)(XB + (size_t)u.pm * BM * DM); B = (const char*)(WM + (size_t)b * DM * DM + (size_t)u.pn * BM * DM); ldb = DM; nt = DM / BK; }
        else { const int kb = (b == 0) ? 512 : 256, ac = (b == 0) ? 0 : (b == 1 ? 512 : 768);
            const size_t woff = (size_t)((b == 0) ? 26 : 27 + b) * MiB + (size_t)layer * ((b == 0) ? MiB : MiB / 2);
            const bf16_t* w = (const bf16_t*)(wsb + woff);
            A = (const char*)(Y + (size_t)u.pm * BM * DM + ac); B = (const char*)(w + (size_t)u.pn * BM * kb); ldb = kb; nt = kb / BK; }
    }
};
struct EpiG34 {
    const float* rs; bf16_t* PT; bf16_t* MT; bf16_t* MG;
    __device__ __forceinline__ void operator()(const f32x4 (&acc)[2][2][4][2], const UnitX& u, int wr, int wc, int fr_, int fq_) const {
        int fr = fr_, fq = fq_; asm volatile("" : "+v"(fr), "+v"(fq));
        if ((u.seg & 1) == 0) {
            EPI_ROWS_BEGIN
            EPI_COLS8_BEGIN
                u32x4 w; w.x = pk2(v0[0], v0[1]); w.y = pk2(v0[2], v0[3]); w.z = pk2(v1[0], v1[1]); w.w = pk2(v1[2], v1[3]);
                *(GAS u32x4*)(PT + (size_t)(row - u.pm * BM) * 256 + col) = w;
            EPI_END
        } else {
            const int mode = u.seg >> 1;
            GAS bf16_t* dst = (mode == 2) ? (GAS bf16_t*)MG + (size_t)u.pm * BM * DM + u.pn * BM : (GAS bf16_t*)MT;
            const int dld = (mode == 2) ? DM : 256;
            const int rl0 = wr * 64 + fr, c0 = wc * 32 + 8 * fq;
#pragma unroll
            for (int ai = 0; ai < 2; ++ai) {
                u32x4 pv[4][2], mv[4][2];
#pragma unroll
                for (int m = 0; m < 4; ++m)
#pragma unroll
                    for (int bj = 0; bj < 2; ++bj) pv[m][bj] = *(const GAS u32x4*)(PT + (size_t)(ai * HALF + rl0 + m * 16) * 256 + bj * HALF + c0);
                if (mode != 0) {
#pragma unroll
                    for (int m = 0; m < 4; ++m)
#pragma unroll
                        for (int bj = 0; bj < 2; ++bj) mv[m][bj] = *(const GAS u32x4*)(MT + (size_t)(ai * HALF + rl0 + m * 16) * 256 + bj * HALF + c0);
                } else {
#pragma unroll
                    for (int m = 0; m < 4; ++m)
#pragma unroll
                        for (int bj = 0; bj < 2; ++bj) mv[m][bj] = (u32x4){0u, 0u, 0u, 0u};
                }
                __builtin_amdgcn_sched_barrier(0);
#pragma unroll
                for (int m = 0; m < 4; ++m)
#pragma unroll
                    for (int bj = 0; bj < 2; ++bj) {
                        const f32x4 v0 = acc[ai][bj][m][0], v1 = acc[ai][bj][m][1]; const u32x4 p = pv[m][bj], q = mv[m][bj];
                        const float r0 = bflo(q.x) + bflo(p.x) * sigmoidf_(v0[0]), r1 = bfhi(q.x) + bfhi(p.x) * sigmoidf_(v0[1]), r2 = bflo(q.y) + bflo(p.y) * sigmoidf_(v0[2]), r3 = bfhi(q.y) + bfhi(p.y) * sigmoidf_(v0[3]);
                        const float r4 = bflo(q.z) + bflo(p.z) * sigmoidf_(v1[0]), r5 = bfhi(q.z) + bfhi(p.z) * sigmoidf_(v1[1]), r6 = bflo(q.w) + bflo(p.w) * sigmoidf_(v1[2]), r7 = bfhi(q.w) + bfhi(p.w) * sigmoidf_(v1[3]);
                        u32x4 w; w.x = pk2(r0, r1); w.y = pk2(r2, r3); w.z = pk2(r4, r5); w.w = pk2(r6, r7);
                        *(GAS u32x4*)(dst + (size_t)(ai * HALF + rl0 + m * 16) * dld + bj * HALF + c0) = w;
                    }
                __builtin_amdgcn_sched_barrier(0);
            }
        }
    }
};
struct EpiG5 {
    bf16_t* O; float* ss;
    __device__ __forceinline__ void operator()(const f32x4 (&acc)[2][2][4][2], const Unit& u, int wr, int wc, int fr, int fq) const {
        EPI_ROWS_BEGIN float q = 0.f;
        EPI_COLS8_BEGIN
            u32x4 w; w.x = pk2(v0[0], v0[1]); w.y = pk2(v0[2], v0[3]); w.z = pk2(v1[0], v1[1]); w.w = pk2(v1[2], v1[3]);
            *(GAS u32x4*)((GAS bf16_t*)O + (size_t)row * DM + u.pn * BM + col) = w;
            q += ((v0[0] * v0[0] + v0[1] * v0[1]) + (v0[2] * v0[2] + v0[3] * v0[3])) + ((v1[0] * v1[0] + v1[1] * v1[1]) + (v1[2] * v1[2] + v1[3] * v1[3]));
        }
            q += __shfl_xor(q, 16); q += __shfl_xor(q, 32);
            if (fq == 0) atomicAdd(ss + row, q);
        }
    }
};
}

__device__ __forceinline__ void transpose_item(const float* W, int K, int pitch, int c0, int ncols, bf16_t* WT, int row_off, const float* g, float scale, LAS float* scr, int item, int lane) {
    const int nblk = ncols / 32, kb = item / nblk, nb = item % nblk, k0 = 64 * kb, n0 = 32 * nb;
#pragma unroll 8
    for (int i = 0; i < 32; ++i) { const int kk = 2 * i + (lane >> 5); float w = W[(size_t)(k0 + kk) * pitch + c0 + n0 + (lane & 31)] * scale; if (g) w *= g[k0 + kk]; scr[kk * 33 + (lane & 31)] = w; }
    LDS_WAIT(); asm volatile("" ::: "memory");
    const int c = lane & 7;
#pragma unroll
    for (int j = 0; j < 4; ++j) { const int n = (lane >> 3) + 8 * j; const LAS float* s = scr + (8 * c) * 33 + n;
        u32x4 o; o.x = pk2(s[0 * 33], s[1 * 33]); o.y = pk2(s[2 * 33], s[3 * 33]); o.z = pk2(s[4 * 33], s[5 * 33]); o.w = pk2(s[6 * 33], s[7 * 33]);
        *(u32x4*)(WT + (size_t)(row_off + n0 + n) * K + k0 + 8 * c) = o; }
    LDS_WAIT(); asm volatile("" ::: "memory");
}

struct Args { const float* in[14]; float* out; unsigned char* ws; int ph_lo, ph_hi; };

__device__ __forceinline__ void grid_row_info(int gr, int& seqbase, int& r, int& nrows) {
    if (gr < 1024) { seqbase = (gr >> 5) << 11; r = gr & 31; nrows = 32; } else { const int g2 = gr - 1024; seqbase = MP + ((g2 >> 7) << 13); r = g2 & 127; nrows = 128; }
}

constexpr int AT_NSLOT = 9, AT_KSLOT = 9216, AT_VSLOT = 8704, AT_VOFF = AT_NSLOT * AT_KSLOT, AT_BOFF = AT_VOFF + AT_NSLOT * AT_VSLOT;
static_assert(AT_BOFF + 465 * 4 <= LDS_BYTES, "attention LDS map");
__device__ __forceinline__ void attn_fill_issue(const GAS bf16_t* ZM, const GAS bf16_t* ZT, int tok0, int head, int tid, u32x4& kreg, u32x4& vreg) {
    kreg = *(const GAS u32x4*)(ZM + (size_t)(tok0 + (tid >> 3)) * ZMW + 512 + head * 64 + (tid & 7) * 8);
    vreg = *(const GAS u32x4*)(ZT + ((size_t)(tok0 >> 6) * 512 + head * 64) * 64 + tid * 8);
}
__device__ __forceinline__ void attn_fill_write(LAS unsigned char* lds, int slot, int tid, const u32x4 kreg, const u32x4 vreg) {
    *(LAS u32x4*)(lds + slot * AT_KSLOT + (tid >> 3) * 144 + (tid & 7) * 16) = kreg;
    LAS u32x2* vp = (LAS u32x2*)(lds + AT_VOFF + slot * AT_VSLOT + (tid >> 3) * 136 + (tid & 7) * 16);
    u32x2 a; a.x = vreg.x; a.y = vreg.y; u32x2 b; b.x = vreg.z; b.y = vreg.w;
    vp[0] = a; vp[1] = b;
}
__device__ __forceinline__ void attn_row_lds(LAS unsigned char* lds, int seqbase, int r, int rs, int head, int lane, int wave, const bf16x8 bq0, const bf16x8 bq1, GAS bf16_t* Y, const unsigned (&bcp)[32]) {
    const int g = wave & 3;
    const int qi = lane & 15, h4 = lane >> 4;
    const int cs = (g == 0) ? 0 : (g == 1) ? 8 : (g == 2) ? 24 : 32;
    const int qc = 16 * g + qi;
    const int qtok = seqbase + r * 64 + qc;
    const int sb = rs % AT_NSLOT;
    f32x4 S[16];
    float mx = -3.0e38f;
#pragma unroll
    for (int hb = 0; hb < 2; ++hb) {
        bf16x8 ak[8][2];
#pragma unroll
        for (int tt = 0; tt < 8; ++tt) {
            const int t = hb * 8 + tt, kr = t >> 1, hf = t & 1;
            int slot = sb + kr; slot = slot >= AT_NSLOT ? slot - AT_NSLOT : slot;
            const LAS unsigned char* kp = lds + slot * AT_KSLOT + (cs + 16 * hf + qi) * 144 + h4 * 16;
            ak[tt][0] = *(const LAS bf16x8*)kp; ak[tt][1] = *(const LAS bf16x8*)(kp + 64);
        }
        __builtin_amdgcn_sched_barrier(0);
#pragma unroll
        for (int tt = 0; tt < 8; ++tt) {
            const int t = hb * 8 + tt;
            f32x4 s = {0.f, 0.f, 0.f, 0.f};
            s = __builtin_amdgcn_mfma_f32_16x16x32_bf16(ak[tt][0], bq0, s, 0, 0, 0);
            s = __builtin_amdgcn_mfma_f32_16x16x32_bf16(ak[tt][1], bq1, s, 0, 0, 0);
            s[0] += bflo(bcp[2 * t]); s[1] += bfhi(bcp[2 * t]); s[2] += bflo(bcp[2 * t + 1]); s[3] += bfhi(bcp[2 * t + 1]);
            mx = fmaxf(mx, fmaxf(fmaxf(s[0], s[1]), fmaxf(s[2], s[3])));
            S[t] = s;
        }
        __builtin_amdgcn_sched_barrier(0);
    }
    mx = fmaxf(mx, __shfl_xor(mx, 16)); mx = fmaxf(mx, __shfl_xor(mx, 32));
    float sum = 0.f;
    bf16x8 pf[8];
#pragma unroll
    for (int kr = 0; kr < 8; ++kr) {
        const f32x4 a = S[kr * 2], b = S[kr * 2 + 1];
        const float p0 = __expf(a[0] - mx), p1 = __expf(a[1] - mx), p2 = __expf(a[2] - mx), p3 = __expf(a[3] - mx);
        const float p4 = __expf(b[0] - mx), p5 = __expf(b[1] - mx), p6 = __expf(b[2] - mx), p7 = __expf(b[3] - mx);
        sum += ((p0 + p1) + (p2 + p3)) + ((p4 + p5) + (p6 + p7));
        u32x4 w; w.x = pk2(p0, p1); w.y = pk2(p2, p3); w.z = pk2(p4, p5); w.w = pk2(p6, p7);
        pf[kr] = __builtin_bit_cast(bf16x8, w);
    }
    sum += __shfl_xor(sum, 16); sum += __shfl_xor(sum, 32);
    const float inv = __builtin_amdgcn_rcpf(sum);
    GAS bf16_t* yp = Y + (size_t)qtok * DM + head * 64 + 4 * h4;
#pragma unroll
    for (int dp = 0; dp < 2; ++dp) {
        u32x2 vf[2][8][2];
#pragma unroll
        for (int dti = 0; dti < 2; ++dti)
#pragma unroll
            for (int kr = 0; kr < 8; ++kr) {
                int slot = sb + kr; slot = slot >= AT_NSLOT ? slot - AT_NSLOT : slot;
                const LAS unsigned char* vp = lds + AT_VOFF + slot * AT_VSLOT + ((2 * dp + dti) * 16 + qi) * 136 + (cs + 4 * h4) * 2;
                vf[dti][kr][0] = *(const LAS u32x2*)vp; vf[dti][kr][1] = *(const LAS u32x2*)(vp + 32);
            }
        __builtin_amdgcn_sched_barrier(0);
#pragma unroll
        for (int dti = 0; dti < 2; ++dti) {
            f32x4 o = {0.f, 0.f, 0.f, 0.f};
#pragma unroll
            for (int kr = 0; kr < 8; ++kr) {
                u32x4 w; w.x = vf[dti][kr][0].x; w.y = vf[dti][kr][0].y; w.z = vf[dti][kr][1].x; w.w = vf[dti][kr][1].y;
                o = __builtin_amdgcn_mfma_f32_16x16x32_bf16(__builtin_bit_cast(bf16x8, w), pf[kr], o, 0, 0, 0);
            }
            u32x2 w; w.x = pk2(o[0] * inv, o[1] * inv); w.y = pk2(o[2] * inv, o[3] * inv);
            *(GAS u32x2*)(yp + (2 * dp + dti) * 16) = w;
        }
        __builtin_amdgcn_sched_barrier(0);
    }
}
#define ATT_RS(r_) ((r_) - 4 < 0 ? 0 : ((r_) - 4 > nrows - 8 ? nrows - 8 : (r_) - 4))
__device__ __forceinline__ void attn_unit(LAS unsigned char* lds, int seqbase, int nrows, int ra, int rb, int head, int tid, int lane, int wave,
                                          const bf16_t* ZM_, const bf16_t* ZT_, bf16_t* Y_, const float* rpb) {
    const GAS bf16_t* ZM = (const GAS bf16_t*)ZM_; const GAS bf16_t* ZT = (const GAS bf16_t*)ZT_; GAS bf16_t* Y = (GAS bf16_t*)Y_;
    const int rsel = wave >> 2;
    const int lo = ATT_RS(ra);
    int top = lo + 8;
    {   u32x4 kreg[9], vreg[9];
#pragma unroll
        for (int k = 0; k < 9; ++k) { int row = lo + k; row = row > nrows - 1 ? nrows - 1 : row; attn_fill_issue(ZM, ZT, seqbase + row * 64, head, tid, kreg[k], vreg[k]); }
        LAS float* bw = (LAS float*)(lds + AT_BOFF);
        if (tid < 465) bw[tid] = rpb[head * 465 + tid];
#pragma unroll
        for (int k = 0; k < 9; ++k) attn_fill_write(lds, (lo + k) % AT_NSLOT, tid, kreg[k], vreg[k]);
    }
    const GAS bf16_t* qbase = ZM + (size_t)(seqbase + 16 * (wave & 3) + (lane & 15)) * ZMW + head * 64 + 8 * (lane >> 4);
    bf16x8 q0 = *(const GAS bf16x8*)(qbase + (size_t)(ra + rsel) * 64 * ZMW), q1 = *(const GAS bf16x8*)(qbase + (size_t)(ra + rsel) * 64 * ZMW + 32);
    __syncthreads();
    unsigned bcp[32]; int cdelta = 1000;
#pragma unroll
    for (int i = 0; i < 32; ++i) bcp[i] = 0u;
#pragma unroll 1
    for (int r = ra; r < rb; r += 2) {
        const int rr = r + rsel, rs = ATT_RS(rr);
        if (rs - rr != cdelta) {
            cdelta = rs - rr;
            const LAS float* bias = (const LAS float*)(lds + AT_BOFF);
            const int g_ = wave & 3, qi_ = lane & 15, h4_ = lane >> 4, cs_ = (g_ == 0) ? 0 : (g_ == 1) ? 8 : (g_ == 2) ? 24 : 32, qc_ = 16 * g_ + qi_;
            int cst_ = qc_ - 8; cst_ = cst_ < 0 ? 0 : cst_; cst_ = cst_ > 48 ? 48 : cst_;
#pragma unroll
            for (int t = 0; t < 16; ++t) {
                float bv[4];
#pragma unroll
                for (int e = 0; e < 4; ++e) {
                    const int kc = cs_ + 16 * (t & 1) + 4 * h4_ + e; int dc = kc - qc_ + 15; dc = dc < 0 ? 0 : dc; dc = dc > 30 ? 30 : dc;
                    const float b = bias[(cdelta + (t >> 1) + 7) * 31 + dc];
                    bv[e] = ((kc >= cst_) && (kc < cst_ + 16)) ? b : -1.0e30f;
                }
                bcp[2 * t] = pk2(bv[0], bv[1]); bcp[2 * t + 1] = pk2(bv[2], bv[3]);
            }
        }
        const int rqn = (r + 2 < rb) ? rr + 2 : rr;
        const bf16x8 nq0 = *(const GAS bf16x8*)(qbase + (size_t)rqn * 64 * ZMW), nq1 = *(const GAS bf16x8*)(qbase + (size_t)rqn * 64 * ZMW + 32);
        int ntop = (r + 2 < rb) ? ATT_RS(r + 3) + 7 : top; ntop = ntop < top ? top : ntop;
        const int nnew = ntop - top;
        u32x4 kreg0 = {0u, 0u, 0u, 0u}, vreg0 = {0u, 0u, 0u, 0u}, kreg1 = {0u, 0u, 0u, 0u}, vreg1 = {0u, 0u, 0u, 0u};
        if (nnew >= 1) attn_fill_issue(ZM, ZT, seqbase + (top + 1) * 64, head, tid, kreg0, vreg0);
        if (nnew >= 2) attn_fill_issue(ZM, ZT, seqbase + (top + 2) * 64, head, tid, kreg1, vreg1);
        attn_row_lds(lds, seqbase, rr, rs, head, lane, wave, q0, q1, Y, bcp);
        LDS_WAIT(); __builtin_amdgcn_s_barrier(); asm volatile("" ::: "memory");
        if (nnew >= 1) attn_fill_write(lds, (top + 1) % AT_NSLOT, tid, kreg0, vreg0);
        if (nnew >= 2) attn_fill_write(lds, (top + 2) % AT_NSLOT, tid, kreg1, vreg1);
        LDS_WAIT(); __builtin_amdgcn_s_barrier(); asm volatile("" ::: "memory");
        top = ntop; q0 = nq0; q1 = nq1;
    }
}

#define DFT4(r0, i0, r1, i1, r2, i2, r3, i3) do { \
    const float ar_ = r0 + r2, ai_ = i0 + i2, br_ = r0 - r2, bi_ = i0 - i2, cr_ = r1 + r3, ci_ = i1 + i3, dr_ = r1 - r3, di_ = i1 - i3; \
    r0 = ar_ + cr_; i0 = ai_ + ci_; r1 = br_ + di_; i1 = bi_ - dr_; r2 = ar_ - cr_; i2 = ai_ - ci_; r3 = br_ - di_; i3 = bi_ + dr_; } while (0)
template <int R, int NU>
__device__ __forceinline__ void butterfly_unit(int tok0, int rowbase  , int p0, int t, const bf16_t* ZT_, bf16_t* YQ_, const float (&twr)[2][R], const float (&twi)[2][R]) {
    const GAS unsigned* zre = (const GAS unsigned*)((const GAS bf16_t*)ZT_ + (size_t)MTOK * 512 + ((size_t)(tok0 >> 9) * 512 + p0) * 512) + t;
    const GAS unsigned* zim = zre + 256 * 256;
    float xr[NU][2][R], xi[NU][2][R];
#pragma unroll
    for (int u = 0; u < NU; ++u)
#pragma unroll
        for (int s = 0; s < R; ++s) {
            const unsigned wr_ = zre[(size_t)s * 512 * 256 + u * 256], wi_ = zim[(size_t)s * 512 * 256 + u * 256];
            xr[u][0][s] = bflo(wr_); xr[u][1][s] = bfhi(wr_); xi[u][0][s] = bflo(wi_); xi[u][1][s] = bfhi(wi_);
        }
#pragma unroll
    for (int u = 0; u < NU; ++u) {
#pragma unroll
        for (int h = 0; h < 2; ++h) {
            if constexpr (R == 4) {
                DFT4(xr[u][h][0], xi[u][h][0], xr[u][h][1], xi[u][h][1], xr[u][h][2], xi[u][h][2], xr[u][h][3], xi[u][h][3]);
            } else {
#pragma unroll
                for (int b = 0; b < 4; ++b) DFT4(xr[u][h][b], xi[u][h][b], xr[u][h][4 + b], xi[u][h][4 + b], xr[u][h][8 + b], xi[u][h][8 + b], xr[u][h][12 + b], xi[u][h][12 + b]);
                constexpr float WR[10] = {1.f, 0.9238795325f, 0.7071067812f, 0.3826834324f, 0.f, 0.f, -0.7071067812f, 0.f, 0.f, -0.9238795325f};
                constexpr float WI[10] = {0.f, -0.3826834324f, -0.7071067812f, -0.9238795325f, -1.f, 0.f, -0.7071067812f, 0.f, 0.f, 0.3826834324f};
#pragma unroll
                for (int c = 1; c < 4; ++c)
#pragma unroll
                    for (int b = 1; b < 4; ++b) { const float w0 = WR[c * b], w1 = WI[c * b]; const float tr = xr[u][h][4 * c + b] * w0 - xi[u][h][4 * c + b] * w1, ti = xr[u][h][4 * c + b] * w1 + xi[u][h][4 * c + b] * w0; xr[u][h][4 * c + b] = tr; xi[u][h][4 * c + b] = ti; }
#pragma unroll
                for (int c = 0; c < 4; ++c) DFT4(xr[u][h][4 * c], xi[u][h][4 * c], xr[u][h][4 * c + 1], xi[u][h][4 * c + 1], xr[u][h][4 * c + 2], xi[u][h][4 * c + 2], xr[u][h][4 * c + 3], xi[u][h][4 * c + 3]);
            }
        }
        GAS unsigned* d0 = (GAS unsigned*)((GAS bf16_t*)YQ_ + (size_t)(rowbase + u) * 1024) + t;
#pragma unroll
        for (int q = 0; q < R; ++q) {
            const int sl = (R == 16) ? 4 * (q & 3) + (q >> 2) : q;
            const float r0 = xr[u][0][sl] * twr[0][q] - xi[u][0][sl] * twi[0][q], i0 = xr[u][0][sl] * twi[0][q] + xi[u][0][sl] * twr[0][q];
            const float r1 = xr[u][1][sl] * twr[1][q] - xi[u][1][sl] * twi[1][q], i1 = xr[u][1][sl] * twi[1][q] + xi[u][1][sl] * twr[1][q];
            GAS unsigned* d = d0 + (size_t)q * 256 * 512;
            d[0] = pk2(r0, r1); d[256] = pk2(i0, i1);
        }
    }
}

template <int MODE>
__device__ __forceinline__ void row_pass(int gw, int NGW, int lane, const float* x_prompt, const float* x_sample, float* out, bf16_t* XB, const bf16_t* O, float* RS, float* SS, const float* gpost) {
    for (int m = gw; m < MTOK; m += NGW) {
        f32x4 v[4];
        GAS u32x2* xbrow = (GAS u32x2*)((GAS bf16_t*)XB + (size_t)m * DM) + lane;
        if constexpr (MODE == 2) {
            u32x2 xv[4];
#pragma unroll
            for (int j = 0; j < 4; ++j) xv[j] = xbrow[64 * j];
            const float irs = RS[m];
#pragma unroll
            for (int j = 0; j < 4; ++j) { v[j][0] = bflo(xv[j].x) * irs; v[j][1] = bfhi(xv[j].x) * irs; v[j][2] = bflo(xv[j].y) * irs; v[j][3] = bfhi(xv[j].y) * irs; }
        } else {
            const GAS f32x4* xr = (const GAS f32x4*)((m < MP) ? x_prompt + (size_t)m * DM : x_sample + (size_t)(m - MP) * DM) + lane;
#pragma unroll
            for (int j = 0; j < 4; ++j) v[j] = xr[64 * j];
        }
        if constexpr (MODE != 0) {
            const float rq = rsqrtf(SS[m] * (1.0f / DM) + EPS);
            const GAS u32x2* orow = (const GAS u32x2*)((const GAS bf16_t*)O + (size_t)m * DM) + lane;
#pragma unroll
            for (int j = 0; j < 4; ++j) { const u32x2 ov = orow[64 * j]; const f32x4 gp = *((const GAS f32x4*)gpost + lane + 64 * j);
                v[j][0] += bflo(ov.x) * rq * gp[0]; v[j][1] += bfhi(ov.x) * rq * gp[1]; v[j][2] += bflo(ov.y) * rq * gp[2]; v[j][3] += bfhi(ov.y) * rq * gp[3]; }
            if constexpr (MODE == 2) {
                GAS f32x4* orow2 = (GAS f32x4*)(out + (size_t)m * DM) + lane;
#pragma unroll
                for (int j = 0; j < 4; ++j) orow2[64 * j] = v[j];
            }
        }
        if constexpr (MODE != 2) {
            float s = 0.f;
#pragma unroll
            for (int j = 0; j < 4; ++j) s += (v[j][0] * v[j][0] + v[j][1] * v[j][1]) + (v[j][2] * v[j][2] + v[j][3] * v[j][3]);
            s = wave_sum(s);
            const float ms = s * (1.0f / DM) + EPS;
            const float rsv = rsqrtf(ms);
#pragma unroll
            for (int j = 0; j < 4; ++j) { u32x2 w; w.x = pk2(v[j][0] * rsv, v[j][1] * rsv); w.y = pk2(v[j][2] * rsv, v[j][3] * rsv); xbrow[64 * j] = w; }
            if (lane == 0) { RS[m] = sqrtf(ms); SS[m] = 0.f; }
        }
    }
}

__global__ void __launch_bounds__(NWAVES * 64, 2) fwd_kernel(Args args) {
    extern __shared__ __attribute__((aligned(16))) unsigned char lds_raw[];
    LAS unsigned char* lds = (LAS unsigned char*)lds_raw;
    const int G = gridDim.x, bx = blockIdx.x;
    for (int ph = args.ph_lo; ph < args.ph_hi; ++ph) {
        if (ph > args.ph_lo) { cg::this_grid().sync(); }
        int tid = threadIdx.x; asm volatile("" : "+v"(tid));
        const int lane = tid & 63, wave = __builtin_amdgcn_readfirstlane(tid >> 6);
        const int gw = bx * NWAVES + wave, NGW = G * NWAVES;
        unsigned char* ws = args.ws; asm volatile("" : "+s"(ws));
        const float* x_prompt = args.in[0]; const float* x_sample = args.in[1];
        float* out = args.out;
        bf16_t* XB = (bf16_t*)(ws + WS_XB); bf16_t* OB = XB;
        bf16_t* ZM = (bf16_t*)(ws + WS_ZM); bf16_t* PB = ZM;
        bf16_t* ZT = (bf16_t*)(ws + WS_ZT); bf16_t* MG = ZT;
        bf16_t* YQ = (bf16_t*)(ws + WS_YQ);
        bf16_t* Y = (bf16_t*)(ws + WS_Y);
        bf16_t* TT = (bf16_t*)(ws + WS_T);
        float* RS = (float*)(ws + WS_RS); float* SS = (float*)(ws + WS_SS);
        const int layer = (ph == 0) ? 0 : (ph - 1) / 7;
        const int sub = (ph == 0) ? -1 : (ph - 1) % 7;
        const bf16_t* WIN = (const bf16_t*)(ws + WS_WIN) + (size_t)layer * NG1 * DM;
        const bf16_t* WG = (const bf16_t*)(ws + WS_WG) + (size_t)layer * DM * DM;
        const bf16_t* WM = (const bf16_t*)(ws + WS_WM) + (size_t)layer * 3072 * DM;
        const bf16_t* WA = (const bf16_t*)(ws + WS_WA) + (size_t)layer * DM * 512;
        const bf16_t* WB = (const bf16_t*)(ws + WS_WB) + (size_t)layer * DM * 256;
        const bf16_t* WC = (const bf16_t*)(ws + WS_WC) + (size_t)layer * DM * 256;
        const bf16_t* WO = (const bf16_t*)(ws + WS_WO) + (size_t)layer * DM * DM;

        if (PHON(0) && ph == 0) {
            LAS float* scr = (LAS float*)(lds + wave * 16384);
            for (int l = 0; l < 2; ++l) {
                const float* w_in = args.in[4] + (size_t)l * DM * DIN;
                const float* gpre = args.in[2] + l * DM;
                bf16_t* win = (bf16_t*)(ws + WS_WIN) + (size_t)l * NG1 * DM;
                bf16_t* wg = (bf16_t*)(ws + WS_WG) + (size_t)l * DM * DM;
                bf16_t* wm = (bf16_t*)(ws + WS_WM) + (size_t)l * 3072 * DM;
                for (int job = 0; job < 7; ++job) {
                    int c0, nc, ro; bf16_t* dst; float sc = 1.f;
                    switch (job) {
                        case 0: c0 = 0; nc = 512; dst = win; ro = 0; sc = 0.125f; break;
                        case 1: c0 = 512; nc = 1024; dst = win; ro = 512; break;
                        case 2: c0 = 2560; nc = 512; dst = win; ro = 2048; break;
                        case 3: c0 = 1536; nc = 512; dst = wg; ro = 0; break;
                        case 4: c0 = 2304; nc = 256; dst = wg; ro = 512; break;
                        case 5: c0 = 3072; nc = 256; dst = wg; ro = 768; break;
                        default: c0 = 3328; nc = 3072; dst = wm; ro = 0; break;
                    }
                    const int nitems = (DM / 64) * (nc / 32);
                    for (int it = gw; it < nitems; it += NGW) transpose_item(w_in, DM, DIN, c0, nc, dst, ro, gpre, sc, scr, it, lane);
                }
                {   const int ni = (512 / 64) * (DM / 32);
                    for (int it = gw; it < ni; it += NGW) transpose_item(args.in[10] + (size_t)l * 512 * DM, 512, DM, 0, DM, (bf16_t*)(ws + WS_WA) + (size_t)l * DM * 512, 0, nullptr, 1.f, scr, it, lane); }
                {   const int ni = (256 / 64) * (DM / 32);
                    for (int it = gw; it < ni; it += NGW) transpose_item(args.in[11] + (size_t)l * 256 * DM, 256, DM, 0, DM, (bf16_t*)(ws + WS_WB) + (size_t)l * DM * 256, 0, nullptr, 1.f, scr, it, lane);
                    for (int it = gw; it < ni; it += NGW) transpose_item(args.in[12] + (size_t)l * 256 * DM, 256, DM, 0, DM, (bf16_t*)(ws + WS_WC) + (size_t)l * DM * 256, 0, nullptr, 1.f, scr, it, lane); }
                {   const int ni = (DM / 64) * (DM / 32);
                    for (int it = gw; it < ni; it += NGW) transpose_item(args.in[13] + (size_t)l * DM * DM, DM, DM, 0, DM, (bf16_t*)(ws + WS_WO) + (size_t)l * DM * DM, 0, nullptr, 1.f, scr, it, lane); }
                LAS float* ctab = (LAS float*)(lds + 131072);
                if (l == 0) { if (tid < 64) { float sn, cs; sincospif((float)tid * (1.0f / 32.0f), &sn, &cs); ctab[tid] = cs; ctab[64 + tid] = sn; } __syncthreads(); }
                for (int idx = bx * 512 + tid; idx < DM * 256; idx += G * 512) {
                    const int k = idx >> 8, p = idx & 255, grp = p >> 6, mm = p & 63;
                    const f32x4* wrow = (const f32x4*)(w_in + (size_t)k * DIN + 2048 + grp * 64);
                    float are = 0.f, aim = 0.f;
#pragma unroll 4
                    for (int c4 = 0; c4 < 16; ++c4) { const f32x4 w = wrow[c4];
#pragma unroll
                        for (int e = 0; e < 4; ++e) { const int t = (mm * (4 * c4 + e)) & 63; are += w[e] * ctab[t]; aim -= w[e] * ctab[64 + t]; } }
                    const float gk = gpre[k];
                    win[(size_t)(1536 + p) * DM + k] = (bf16_t)f2bf(are * gk);
                    win[(size_t)(1536 + 256 + p) * DM + k] = (bf16_t)f2bf(aim * gk);
                }
            }
            for (int idx = bx * 512 + tid; idx < 512 * 512; idx += G * 512) {
                const int kp = idx >> 9, lp = idx & 511; float sn, cs; sincospif((float)((kp * lp) & 511) * (1.0f / 256.0f), &sn, &cs);
                TT[(size_t)kp * 1024 + lp] = (bf16_t)f2bf(cs); TT[(size_t)kp * 1024 + 512 + lp] = (bf16_t)f2bf(sn);
            }
        }
        if (PHON(1) && (ph == 0 || sub == 6)) {
            const float* gpost = args.in[3] + layer * DM;
            if (ph == 0) row_pass<0>(gw, NGW, lane, x_prompt, x_sample, out, XB, Y, RS, SS, gpost);
            else if (layer == 0) row_pass<1>(gw, NGW, lane, x_prompt, x_sample, out, XB, Y, RS, SS, gpost);
            else row_pass<2>(gw, NGW, lane, x_prompt, x_sample, out, XB, Y, RS, SS, gpost);
        } else if (PHON(2) && sub == 0) {
            pg8::Gemm g{XB, WIN, MTOK, NG1, DM, DM, DM}; pg8::StaticOrder S; S.init(MTOK, NG1, G, bx);
            pg8::EpiG1 E{RS, ZM, ZT};
            pg8::gemm_phase<pg8::EpiG1, pg8::StaticOrder, true>(lds, g, S, E);
        } else if (sub == 1) {
            if (PHON(3)) {
                const float* rpb = args.in[5] + (size_t)layer * 8 * 15 * 31;
                for (int un = bx; un < 512; un += G) {
                    if (un < 256) attn_unit(lds, (un >> 3) * 2048, 32, 0, 32, un & 7, tid, lane, wave, ZM, ZT, Y, rpb);
                    else { const int v = un - 256, st = v & 7; attn_unit(lds, MP + (v >> 6) * 8192, 128, st * 16, st * 16 + 16, (v >> 3) & 7, tid, lane, wave, ZM, ZT, Y, rpb); }
                }
            }
            if (PHON(4)) {
                constexpr int CT = 64, HR = CT + 30, NIT = (HR * 32 + 511) / 512, TPH = CT / 2, NHV = TPH + 30, LNT = CT / 8;
                static_assert((HR + CT) * 1024 <= LDS_BYTES, "conv LDS map");
                LAS float* hbuf = (LAS float*)lds; LAS float* cbuf = (LAS float*)(lds + HR * 1024);
                const float* dww = args.in[6] + (size_t)layer * 31 * 256; const float* dwb = args.in[7] + layer * 256;
                const float* lng = args.in[8] + layer * 256; const float* lnb = args.in[9] + layer * 256;
                const int c = tid & 255, half = tid >> 8;
                float w[31];
#pragma unroll
                for (int j = 0; j < 31; ++j) w[j] = dww[j * 256 + c];
                const float bc = dwb[c];
                const f32x4 lg = *((const f32x4*)lng + lane), lb = *((const f32x4*)lnb + lane);
                u32x4 pa[NIT], pb[NIT];
#define CONV_ISSUE(cu_) do { const int t0g_ = (cu_) * CT; \
                    int sbeg_, send_; if (t0g_ < MP) { sbeg_ = t0g_ & ~2047; send_ = sbeg_ + 2048; } else { sbeg_ = MP + ((t0g_ - MP) & ~8191); send_ = sbeg_ + 8192; } \
                    _Pragma("unroll") for (int k = 0; k < NIT; ++k) { \
                        const int it = tid + k * 512, i = it >> 5, c8 = (it & 31) * 8; const int tok = t0g_ - 15 + i; \
                        int tokc = tok < sbeg_ ? sbeg_ : tok; tokc = tokc > send_ - 1 ? send_ - 1 : tokc;     \
                        const u32x4 la_ = *(const GAS u32x4*)((const GAS bf16_t*)ZM + (size_t)tokc * ZMW + 1024 + c8), lb_ = *(const GAS u32x4*)((const GAS bf16_t*)ZM + (size_t)tokc * ZMW + 1280 + c8); \
                        const unsigned keep_ = (tok >= sbeg_ && tok < send_) ? 0xffffffffu : 0u; \
                        pa[k].x = la_.x & keep_; pa[k].y = la_.y & keep_; pa[k].z = la_.z & keep_; pa[k].w = la_.w & keep_; pb[k] = lb_; \
                    } } while (0)
                for (int cu = bx; cu < MTOK / CT; cu += G) {
                    const int t0g = cu * CT;
                    CONV_ISSUE(cu);
#pragma unroll
                    for (int k = 0; k < NIT; ++k) {
                        const int it = tid + k * 512, i = it >> 5, c8 = (it & 31) * 8;
                        if (it < HR * 32) {
                            const u32x4 a = pa[k], b = pb[k]; f32x4 h0, h1;
                            h0[0] = bflo(a.x) * sigmoidf_(bflo(b.x)); h0[1] = bfhi(a.x) * sigmoidf_(bfhi(b.x)); h0[2] = bflo(a.y) * sigmoidf_(bflo(b.y)); h0[3] = bfhi(a.y) * sigmoidf_(bfhi(b.y));
                            h1[0] = bflo(a.z) * sigmoidf_(bflo(b.z)); h1[1] = bfhi(a.z) * sigmoidf_(bfhi(b.z)); h1[2] = bflo(a.w) * sigmoidf_(bflo(b.w)); h1[3] = bfhi(a.w) * sigmoidf_(bfhi(b.w));
                            *(LAS f32x4*)(hbuf + i * 256 + c8) = h0; *(LAS f32x4*)(hbuf + i * 256 + c8 + 4) = h1;
                        }
                    }
                    __syncthreads();
                    {   float hv[NHV];
#pragma unroll
                        for (int i = 0; i < NHV; ++i) hv[i] = hbuf[(half * TPH + i) * 256 + c];
#pragma unroll
                        for (int tt = 0; tt < TPH; ++tt) {
                            float a = bc;
#pragma unroll
                            for (int j = 0; j < 31; ++j) a += w[j] * hv[tt + j];
                            cbuf[(half * TPH + tt) * 256 + c] = a;
                        }
                    }
                    __syncthreads();
#pragma unroll 4
                    for (int tt = 0; tt < LNT; ++tt) {
                        const int t = wave * LNT + tt;
                        const f32x4 xv = *(const LAS f32x4*)(cbuf + t * 256 + 4 * lane);
                        const float mean = wave_sum((xv[0] + xv[1]) + (xv[2] + xv[3])) * (1.0f / 256.0f);
                        const f32x4 d = xv - mean;
                        const float var = wave_sum((d[0] * d[0] + d[1] * d[1]) + (d[2] * d[2] + d[3] * d[3])) * (1.0f / 256.0f);
                        const float rstd = rsqrtf(var + EPS);
                        const float y0 = siluf_(d[0] * rstd * lg[0] + lb[0]), y1 = siluf_(d[1] * rstd * lg[1] + lb[1]), y2 = siluf_(d[2] * rstd * lg[2] + lb[2]), y3 = siluf_(d[3] * rstd * lg[3] + lb[3]);
                        u32x2 wv; wv.x = pk2(y0, y1); wv.y = pk2(y2, y3);
                        *(GAS u32x2*)((GAS bf16_t*)Y + (size_t)(t0g + t) * DM + 768 + 4 * lane) = wv;
                    }
                }
            }
            if (PHON(5)) {
                float t4r[2][4], t4i[2][4], t16r[2][16], t16i[2][16];
                const int bt = tid & 255, bh = tid >> 8;
                {   const float s4 = rsqrtf(64.0f * 2048.0f), s16 = rsqrtf(64.0f * 8192.0f);
#pragma unroll
                    for (int h = 0; h < 2; ++h) {
#pragma unroll
                        for (int q = 0; q < 4; ++q) { float sn, cs; sincospif(-2.0f * (float)(q * (2 * bt + h)) / 2048.0f, &sn, &cs); t4r[h][q] = cs * s4; t4i[h][q] = sn * s4; }
#pragma unroll
                        for (int q = 0; q < 16; ++q) { float sn, cs; sincospif(-2.0f * (float)(q * (2 * bt + h)) / 8192.0f, &sn, &cs); t16r[h][q] = cs * s16; t16i[h][q] = sn * s16; } } }
                for (int un = bx; un < 32 * 32; un += G) { const int seq = un >> 5, p = (un & 31) * 8 + bh * 4; butterfly_unit<4, 4>(seq * 2048, seq * 1024 + p, p, bt, ZT, YQ, t4r, t4i); }
                for (int un = bx; un < 4 * 128; un += G) { const int seq = un >> 7, p = (un & 127) * 2 + bh; butterfly_unit<16, 1>(MP + seq * 8192, 32768 + seq * 4096 + p, p, bt, ZT, YQ, t16r, t16i); }
            }
        } else if (PHON(6) && sub == 2) {
            pg8::Gemm g{YQ, TT, NYQ, 512, 1024, 1024, 1024}; pg8::StaticOrder S; S.init(NYQ, 512, G, bx);
            pg8::EpiDFT E{Y};
            pg8::gemm_phase<pg8::EpiDFT, pg8::StaticOrder, true>(lds, g, S, E);
        } else if (PHON(7) && sub == 3) {
            pg8::Gemm g{XB, WG, MTOK, DM, DM, DM, DM}; pg8::StaticOrder S; S.init(MTOK, DM, G, bx);
            pg8::EpiG2 E{RS, Y};
            pg8::gemm_phase<pg8::EpiG2, pg8::StaticOrder, true>(lds, g, S, E);
        } else if (sub == 4) {
            pg8::ProgG34 PG; PG.S.init(MTOK, DM, G, bx); PG.Y = Y; PG.XB = XB; PG.wsb = (const char*)ws; PG.WM = WM; PG.layer = layer;
            pg8::EpiG34 EG{RS, PB + (size_t)bx * 65536, PB + (size_t)(256 + bx) * 65536, MG};
            pg8::gemm_multi<pg8::EpiG34, pg8::ProgG34>(lds, PG, EG);
        } else if (PHON(10) && sub == 5) {
            pg8::Gemm g{MG, WO, MTOK, DM, DM, DM, DM}; pg8::StaticOrder S; S.init(MTOK, DM, G, bx);
            pg8::EpiG5 E{Y, SS};
            pg8::gemm_phase<pg8::EpiG5, pg8::StaticOrder, true>(lds, g, S, E);
        }
    }
}

extern "C" void kernel_launch(void* const* d_in, const int* in_sizes, int n_in, void* d_out, int out_size, void* d_ws, size_t ws_size, hipStream_t stream) {
    static int grid = 0;
    if (grid == 0) {
        if (n_in != 14 || ws_size < WS_END) { fprintf(stderr, "kernel_launch: bad inputs (n_in %d, ws %zu < %zu)\n", n_in, ws_size, (size_t)WS_END); grid = -1; return; }
        int dev = 0, cus = 0, per_cu = 0;
        hipGetDevice(&dev); hipDeviceGetAttribute(&cus, hipDeviceAttributeMultiprocessorCount, dev);
        if (hipFuncSetAttribute((const void*)fwd_kernel, hipFuncAttributeMaxDynamicSharedMemorySize, LDS_BYTES) != hipSuccess) { fprintf(stderr, "hipFuncSetAttribute failed\n"); grid = -1; return; }
        hipOccupancyMaxActiveBlocksPerMultiprocessor(&per_cu, (const void*)fwd_kernel, NWAVES * 64, LDS_BYTES);
        (void)hipGetLastError();
        if (per_cu < 1) { fprintf(stderr, "occupancy query says 0 blocks per CU\n"); }
        grid = cus;
    }
    if (grid < 0) return;
    Args a{};
    for (int i = 0; i < 14; ++i) a.in[i] = (const float*)d_in[i];
    a.out = (float*)d_out; a.ws = (unsigned char*)d_ws;
#if MK_ONE_LAUNCH
    a.ph_lo = 0; a.ph_hi = 15;
    void* kargs[] = {&a};
    hipError_t e = hipLaunchCooperativeKernel((const void*)fwd_kernel, dim3(grid), dim3(NWAVES * 64), kargs, LDS_BYTES, stream);
    if (e != hipSuccess) fprintf(stderr, "cooperative launch failed: %s (grid %d)\n", hipGetErrorString(e), grid);
#else
    for (int ph = 0; ph < 15; ++ph) {
        a.ph_lo = ph; a.ph_hi = ph + 1;
        hipLaunchKernelGGL(fwd_kernel, dim3(grid), dim3(NWAVES * 64), LDS_BYTES, stream, a);
    }
#endif
}
```

```cpp
#include <hip/hip_runtime.h>
#include <hip/hip_cooperative_groups.h>
#include <cstdio>
#include <cstdint>
namespace cg = cooperative_groups;

#ifndef MK_ONE_LAUNCH
#define MK_ONE_LAUNCH 1
#endif

#ifndef PH_MASK
#define PH_MASK 0xFFFF
#endif
#define PHON(k) (((PH_MASK) >> (k)) & 1)
#define LAS __attribute__((address_space(3)))
typedef unsigned short bf16_t;
typedef short bf16x8 __attribute__((ext_vector_type(8)));
typedef short s16x4 __attribute__((ext_vector_type(4)));
typedef float f32x4 __attribute__((ext_vector_type(4)));
typedef unsigned u32x4 __attribute__((ext_vector_type(4)));
typedef unsigned u32x2 __attribute__((ext_vector_type(2)));

constexpr int DM = 1024;
constexpr int MP = 65536;
constexpr int MTOK = 98304;
constexpr int DIN = 6400;
constexpr int NG1 = 3584;
constexpr int ZMW = 1536;
constexpr int NYQ = 49152;
constexpr float EPS = 1e-6f;

constexpr size_t MiB = 1u << 20;
constexpr size_t WS_WIN = 0;
constexpr size_t WS_WG = 10 * MiB;
constexpr size_t WS_WM = 14 * MiB;
constexpr size_t WS_WA = 26 * MiB;
constexpr size_t WS_WB = 28 * MiB;
constexpr size_t WS_WC = 29 * MiB;
constexpr size_t WS_WO = 30 * MiB;
constexpr size_t WS_T = 34 * MiB;
constexpr size_t WS_RS = 35 * MiB;
constexpr size_t WS_SS = 35 * MiB + 512 * 1024;
constexpr size_t WS_XB = 36 * MiB;
constexpr size_t WS_ZM = 228 * MiB;
constexpr size_t WS_ZT = 516 * MiB;
constexpr size_t WS_YQ = 708 * MiB;
constexpr size_t WS_Y = 804 * MiB;
constexpr size_t WS_END = 996 * MiB;

constexpr int NWAVES = 8;
constexpr int LDS_BYTES = 163840;

__device__ __forceinline__ unsigned f2bf(float f) { unsigned u = __builtin_bit_cast(unsigned, f); return (u + 0x7fffu + ((u >> 16) & 1u)) >> 16; }
__device__ __forceinline__ unsigned pk2(float lo, float hi) { unsigned r; asm("v_cvt_pk_bf16_f32 %0, %1, %2" : "=v"(r) : "v"(lo), "v"(hi)); return r; }
__device__ __forceinline__ float bf2f(unsigned b) { return __builtin_bit_cast(float, b << 16); }
__device__ __forceinline__ float bflo(unsigned w) { return __builtin_bit_cast(float, w << 16); }
__device__ __forceinline__ float bfhi(unsigned w) { return __builtin_bit_cast(float, w & 0xffff0000u); }
__device__ __forceinline__ float sigmoidf_(float x) { return __builtin_amdgcn_rcpf(1.0f + __expf(-x)); }
__device__ __forceinline__ float siluf_(float x) { return x * __builtin_amdgcn_rcpf(1.0f + __expf(-x)); }
__device__ __forceinline__ float wave_sum(float v) {
#pragma unroll
    for (int o = 1; o < 64; o <<= 1) v += __shfl_xor(v, o);
    return v;
}
#define LDS_WAIT() asm volatile("s_waitcnt lgkmcnt(0)" ::: "memory")
#define GAS __attribute__((address_space(1)))

namespace pg8 {
constexpr int BM = 256, BK = 64, HALF = 128, HTB = HALF * BK * 2, STAGE_BYTES = 8 * HTB, NXCD = 8, WGM = 8;
__device__ __forceinline__ int lds_byte(int r, int c) { const int st = (r >> 4) * 2 + (c >> 5), rr = r & 15, cc = c & 31, ob = rr * 64 + cc * 2; return st * 1024 + (ob ^ (((ob >> 9) & 1) << 5)); }
__device__ __forceinline__ void stage_rc(int b, int& R, int& C) { const int st = b / 1024, sb = b % 1024, swz = sb ^ (((sb >> 9) & 1) << 5); R = (st >> 1) * 16 + swz / 64; C = (st & 1) * 32 + (swz % 64) / 2; }

__device__ __forceinline__ int perm32(int rho) { const int n = rho >> 4, i = rho & 15; return 8 * (i >> 2) + 4 * n + (i & 3); }
struct Unit { int pm, pn; };
struct Gemm { const bf16_t* A; const bf16_t* Bt; int M, N, K, lda, ldb; };

struct StaticOrder {
    int nM, nN, nwg, G, c;
    __device__ __forceinline__ void init(int M, int N, int G_, int c_) { nM = M / BM; nN = N / BM; nwg = nM * nN; G = G_; c = c_; }
    __device__ __forceinline__ bool next(int i, Unit& u) const {
        const long L = (long)i * G + c; if (L >= nwg) return false;
        int wgid = (int)L; { const int q = nwg / NXCD, r = nwg % NXCD, xcd = wgid % NXCD, off = wgid / NXCD; wgid = (xcd < r ? xcd * (q + 1) : r * (q + 1) + (xcd - r) * q) + off; }
        const int nig = WGM * nN, gid = wgid / nig, fm = gid * WGM, gsz = (nM - fm) < WGM ? (nM - fm) : WGM;
        u.pm = fm + ((wgid % nig) % gsz); u.pn = (wgid % nig) / gsz; return true;
    }
};

struct SingleUnit { Unit u; __device__ bool next(int i, Unit& o) const { if (i) return false; o = u; return true; } };
template <class Epi, class Sched, bool ALIGN_EPI>
__device__ __forceinline__ void gemm_phase(LAS unsigned char* lds, const Gemm g, const Sched& S, const Epi& E) {
    int tid = threadIdx.x; asm volatile("" : "+v"(tid));
    const int wid = __builtin_amdgcn_readfirstlane(tid >> 6), lane = tid & 63, wr = wid >> 2, wc = wid & 3, fr = lane & 15, fq = lane >> 4;
    const int K = g.K, nt = K / BK;
    unsigned voffA[2], voffB[2];
#pragma unroll
    for (int i = 0; i < 2; ++i) { int R, C; stage_rc(tid * 16 + i * 8192, R, C);
        const int Rb = (R & ~31) + perm32(R & 31);
        voffA[i] = (unsigned)(R * g.lda + C) * 2u; voffB[i] = (unsigned)(Rb * g.ldb + C) * 2u; }
    const size_t kstep = (size_t)(BK * 2);
    const size_t hstepA = (size_t)HALF * g.lda * 2, hstepB = (size_t)HALF * g.ldb * 2;
    const size_t tstepA = 2 * hstepA, tstepB = 2 * hstepB;
    const unsigned ldsw = (unsigned)wid * 1024u;
    const int aoff = lds_byte(wr * 64 + fr, fq * 8), boff = lds_byte(wc * 32 + fr, fq * 8);
#define PG8_SA(b, h) (((b) * 2 + (h)) * HTB)
#define PG8_SB(b, h) ((4 + (b) * 2 + (h)) * HTB)
#define PG8_STAGE(bufoff, gbase, voff) do { _Pragma("unroll") for (int _i = 0; _i < 2; ++_i) \
        __builtin_amdgcn_global_load_lds((const unsigned*)((const char*)(gbase) + (voff)[_i]), (LAS unsigned*)(lds + (bufoff) + ldsw + _i * 8192), 16, 0, 0); } while (0)
#define PG8_LDA(dst, b, h) do { _Pragma("unroll") for (int m = 0; m < 4; ++m) _Pragma("unroll") for (int k = 0; k < 2; ++k) dst[m][k] = *(const LAS bf16x8*)(lds + PG8_SA(b, h) + aoff + m * 2048 + k * 1024); } while (0)
#define PG8_LDB(dst, b, h) do { _Pragma("unroll") for (int n = 0; n < 2; ++n) _Pragma("unroll") for (int k = 0; k < 2; ++k) dst[n][k] = *(const LAS bf16x8*)(lds + PG8_SB(b, h) + boff + n * 2048 + k * 1024); } while (0)
#define PG8_MMA(ai, bj, At, Bt) do { __builtin_amdgcn_s_setprio(1); _Pragma("unroll") for (int m = 0; m < 4; ++m) _Pragma("unroll") for (int n = 0; n < 2; ++n) _Pragma("unroll") for (int k = 0; k < 2; ++k) \
        acc[ai][bj][m][n] = __builtin_amdgcn_mfma_f32_16x16x32_bf16(Bt[n][k], At[m][k], acc[ai][bj][m][n], 0, 0, 0); __builtin_amdgcn_s_setprio(0); } while (0)
#define PG8_WAIT_V(n) asm volatile("s_waitcnt vmcnt(" #n ")" ::: "memory")
#define PG8_WAIT_L(n) asm volatile("s_waitcnt lgkmcnt(" #n ")" ::: "memory")
#define PG8_BAR __builtin_amdgcn_s_barrier()
#define PG8_SCHED __builtin_amdgcn_sched_barrier(0)
    Unit cur, nxt; int ui = 0;
    if (!S.next(0, cur)) return;
    f32x4 acc[2][2][4][2];
#pragma unroll
    for (int a = 0; a < 2; ++a)
#pragma unroll
        for (int b = 0; b < 2; ++b)
#pragma unroll
            for (int m = 0; m < 4; ++m)
#pragma unroll
                for (int n = 0; n < 2; ++n) acc[a][b][m][n] = (f32x4){0.f, 0.f, 0.f, 0.f};
    bf16x8 At[4][2], B0[2][2], B1[2][2];
    const char* cA = (const char*)g.A + (size_t)cur.pm * tstepA; const char* cB = (const char*)g.Bt + (size_t)cur.pn * tstepB;
    PG8_STAGE(PG8_SB(0, 0), cB, voffB); PG8_STAGE(PG8_SB(0, 1), cB + hstepB, voffB); PG8_STAGE(PG8_SA(0, 0), cA, voffA); PG8_STAGE(PG8_SA(0, 1), cA + hstepA, voffA);
    if (wr == 1) PG8_BAR;
    PG8_WAIT_V(2); PG8_BAR;
    PG8_STAGE(PG8_SB(1, 0), cB + kstep, voffB); PG8_STAGE(PG8_SA(1, 0), cA + kstep, voffA); PG8_STAGE(PG8_SB(1, 1), cB + hstepB + kstep, voffB);
    PG8_WAIT_V(6); PG8_BAR;
    for (;;) {
        const bool has_next = S.next(ui + 1, nxt);
        const char* nA = has_next ? (const char*)g.A + (size_t)nxt.pm * tstepA : cA; const char* nB = has_next ? (const char*)g.Bt + (size_t)nxt.pn * tstepB : cB;
        for (int t = 0; t < nt; t += 2) {
            const bool last = (t == nt - 2);
            const char* a1 = cA + (size_t)(t + 1) * kstep;
            const char* a2 = last ? nA : cA + (size_t)(t + 2) * kstep; const char* b2 = last ? nB : cB + (size_t)(t + 2) * kstep;
            const char* a3 = a2 + kstep; const char* b3 = b2 + kstep;
            PG8_LDB(B0, 0, 0); PG8_LDB(B1, 0, 1); PG8_SCHED; PG8_LDA(At, 0, 0); PG8_STAGE(PG8_SA(1, 1), a1 + hstepA, voffA);
            PG8_WAIT_V(8); PG8_WAIT_L(0); PG8_BAR; PG8_MMA(0, 0, At, B0); PG8_MMA(0, 1, At, B1); PG8_BAR; PG8_SCHED;
            PG8_LDA(At, 0, 1); PG8_STAGE(PG8_SB(0, 0), b2, voffB); PG8_STAGE(PG8_SB(0, 1), b2 + hstepB, voffB); PG8_STAGE(PG8_SA(0, 0), a2, voffA);
            PG8_WAIT_V(8); PG8_WAIT_L(0); PG8_BAR; PG8_MMA(1, 0, At, B0); PG8_MMA(1, 1, At, B1); PG8_BAR; PG8_SCHED;
            PG8_LDB(B0, 1, 0); PG8_LDB(B1, 1, 1); PG8_SCHED; PG8_LDA(At, 1, 0); PG8_STAGE(PG8_SA(0, 1), a2 + hstepA, voffA);
            PG8_WAIT_V(8); PG8_WAIT_L(0); PG8_BAR; PG8_MMA(0, 0, At, B0); PG8_MMA(0, 1, At, B1); PG8_BAR; PG8_SCHED;
            PG8_LDA(At, 1, 1); PG8_STAGE(PG8_SB(1, 0), b3, voffB); PG8_STAGE(PG8_SB(1, 1), b3 + hstepB, voffB); PG8_STAGE(PG8_SA(1, 0), a3, voffA);
            PG8_WAIT_V(8); PG8_WAIT_L(0); PG8_BAR; PG8_MMA(1, 0, At, B0); PG8_MMA(1, 1, At, B1); PG8_BAR; PG8_SCHED;
        }
        if constexpr (ALIGN_EPI) { if (wr == 0) PG8_BAR; }
        E(acc, cur, wr, wc, fr, fq);
        if (!has_next) break;
#pragma unroll
        for (int a = 0; a < 2; ++a)
#pragma unroll
            for (int b = 0; b < 2; ++b)
#pragma unroll
                for (int m = 0; m < 4; ++m)
#pragma unroll
                    for (int n = 0; n < 2; ++n) acc[a][b][m][n] = (f32x4){0.f, 0.f, 0.f, 0.f};
        cur = nxt; cA = nA; cB = nB; ++ui;
        if constexpr (ALIGN_EPI) { if (wr == 1) PG8_BAR; }
    }
    PG8_WAIT_V(0);
    if constexpr (!ALIGN_EPI) { if (wr == 0) PG8_BAR; }
    PG8_BAR;
#undef PG8_SA
#undef PG8_SB
#undef PG8_STAGE
#undef PG8_LDA
#undef PG8_LDB
#undef PG8_MMA
#undef PG8_WAIT_V
#undef PG8_WAIT_L
#undef PG8_BAR
#undef PG8_SCHED
}

struct UnitX { int pm, pn, seg; };
__device__ __forceinline__ int uni(int v) { return __builtin_amdgcn_readfirstlane(v); }
__device__ __forceinline__ const char* unip(const char* p) { const unsigned long long v = (unsigned long long)p; const unsigned lo = (unsigned)__builtin_amdgcn_readfirstlane((int)(unsigned)v), hi = (unsigned)__builtin_amdgcn_readfirstlane((int)(unsigned)(v >> 32)); return (const char*)(((unsigned long long)hi << 32) | lo); }
template <class Epi, class Prog>
__device__ __forceinline__ void gemm_multi(LAS unsigned char* lds, const Prog& P, const Epi& E) {
    int tid = threadIdx.x; asm volatile("" : "+v"(tid));
    const int wid = __builtin_amdgcn_readfirstlane(tid >> 6), lane = tid & 63, wr = wid >> 2, wc = wid & 3, fr = lane & 15, fq = lane >> 4;
    unsigned Rr[2], RrB[2], Cc2[2];
#pragma unroll
    for (int i = 0; i < 2; ++i) { int R, C; stage_rc(tid * 16 + i * 8192, R, C); Rr[i] = (unsigned)R * 2u; RrB[i] = (unsigned)((R & ~31) + perm32(R & 31)) * 2u; Cc2[i] = (unsigned)C * 2u; }
    const size_t kstep = (size_t)(BK * 2);
    const unsigned ldsw = (unsigned)wid * 1024u;
    const int aoff = lds_byte(wr * 64 + fr, fq * 8), boff = lds_byte(wc * 32 + fr, fq * 8);
#define PG8_SA(b, h) (((b) * 2 + (h)) * HTB)
#define PG8_SB(b, h) ((4 + (b) * 2 + (h)) * HTB)
#define PG8_STAGE_X(RR, bufoff, gbase, ld) do { _Pragma("unroll") for (int _i = 0; _i < 2; ++_i) \
        __builtin_amdgcn_global_load_lds((const unsigned*)((const char*)(gbase) + (RR[_i] * (unsigned)(ld) + Cc2[_i])), (LAS unsigned*)(lds + (bufoff) + ldsw + _i * 8192), 16, 0, 0); } while (0)
#define PG8_STAGE(bufoff, gbase, ld) PG8_STAGE_X(Rr, bufoff, gbase, ld)
#define PG8_STAGEB(bufoff, gbase, ld) PG8_STAGE_X(RrB, bufoff, gbase, ld)
#define PG8_LDA(dst, b, h) do { _Pragma("unroll") for (int m = 0; m < 4; ++m) _Pragma("unroll") for (int k = 0; k < 2; ++k) dst[m][k] = *(const LAS bf16x8*)(lds + PG8_SA(b, h) + aoff + m * 2048 + k * 1024); } while (0)
#define PG8_LDB(dst, b, h) do { _Pragma("unroll") for (int n = 0; n < 2; ++n) _Pragma("unroll") for (int k = 0; k < 2; ++k) dst[n][k] = *(const LAS bf16x8*)(lds + PG8_SB(b, h) + boff + n * 2048 + k * 1024); } while (0)
#define PG8_MMA(ai, bj, At, Bt) do { __builtin_amdgcn_s_setprio(1); _Pragma("unroll") for (int m = 0; m < 4; ++m) _Pragma("unroll") for (int n = 0; n < 2; ++n) _Pragma("unroll") for (int k = 0; k < 2; ++k) \
        acc[ai][bj][m][n] = __builtin_amdgcn_mfma_f32_16x16x32_bf16(Bt[n][k], At[m][k], acc[ai][bj][m][n], 0, 0, 0); __builtin_amdgcn_s_setprio(0); } while (0)
#define PG8_WAIT_V(n) asm volatile("s_waitcnt vmcnt(" #n ")" ::: "memory")
#define PG8_WAIT_L(n) asm volatile("s_waitcnt lgkmcnt(" #n ")" ::: "memory")
#define PG8_BAR __builtin_amdgcn_s_barrier()
#define PG8_SCHED __builtin_amdgcn_sched_barrier(0)
    UnitX cur, nxt; int ui = 0;
    if (!P.next(0, cur)) return;
    f32x4 acc[2][2][4][2];
#pragma unroll
    for (int a = 0; a < 2; ++a)
#pragma unroll
        for (int b = 0; b < 2; ++b)
#pragma unroll
            for (int m = 0; m < 4; ++m)
#pragma unroll
                for (int n = 0; n < 2; ++n) acc[a][b][m][n] = (f32x4){0.f, 0.f, 0.f, 0.f};
    bf16x8 At[4][2], B0[2][2], B1[2][2];
    const char* cA; const char* cB; int lda, ldb, nt;
    P.desc(cur, cA, cB, lda, ldb, nt); cA = unip(cA); cB = unip(cB); lda = uni(lda); ldb = uni(ldb); nt = uni(nt);
    {   const size_t hA = (size_t)HALF * lda * 2, hB = (size_t)HALF * ldb * 2;
        PG8_STAGEB(PG8_SB(0, 0), cB, ldb); PG8_STAGEB(PG8_SB(0, 1), cB + hB, ldb); PG8_STAGE(PG8_SA(0, 0), cA, lda); PG8_STAGE(PG8_SA(0, 1), cA + hA, lda);
        if (wr == 1) PG8_BAR;
        PG8_WAIT_V(2); PG8_BAR;
        PG8_STAGEB(PG8_SB(1, 0), cB + kstep, ldb); PG8_STAGE(PG8_SA(1, 0), cA + kstep, lda); PG8_STAGEB(PG8_SB(1, 1), cB + hB + kstep, ldb);
        PG8_WAIT_V(6); PG8_BAR; }
    for (;;) {
        const bool has_next = P.next(ui + 1, nxt);
        const char* nA = cA; const char* nB = cB; int ldan = lda, ldbn = ldb, ntn = nt;
        if (has_next) P.desc(nxt, nA, nB, ldan, ldbn, ntn);
        nA = unip(nA); nB = unip(nB); ldan = uni(ldan); ldbn = uni(ldbn); ntn = uni(ntn);
        const size_t hAc = (size_t)HALF * lda * 2;
        for (int t = 0; t < nt; t += 2) {
            const bool last = (t == nt - 2);
            const char* a1 = cA + (size_t)(t + 1) * kstep;
            const char* a2 = last ? nA : cA + (size_t)(t + 2) * kstep; const char* b2 = last ? nB : cB + (size_t)(t + 2) * kstep;
            const int lda2 = last ? ldan : lda, ldb2 = last ? ldbn : ldb;
            const size_t hA2 = (size_t)HALF * lda2 * 2, hB2 = (size_t)HALF * ldb2 * 2;
            const char* a3 = a2 + kstep; const char* b3 = b2 + kstep;
            PG8_LDB(B0, 0, 0); PG8_LDB(B1, 0, 1); PG8_SCHED; PG8_LDA(At, 0, 0); PG8_STAGE(PG8_SA(1, 1), a1 + hAc, lda);
            PG8_WAIT_V(8); PG8_WAIT_L(0); PG8_BAR; PG8_MMA(0, 0, At, B0); PG8_MMA(0, 1, At, B1); PG8_BAR; PG8_SCHED;
            PG8_LDA(At, 0, 1); PG8_STAGEB(PG8_SB(0, 0), b2, ldb2); PG8_STAGEB(PG8_SB(0, 1), b2 + hB2, ldb2); PG8_STAGE(PG8_SA(0, 0), a2, lda2);
            PG8_WAIT_V(8); PG8_WAIT_L(0); PG8_BAR; PG8_MMA(1, 0, At, B0); PG8_MMA(1, 1, At, B1); PG8_BAR; PG8_SCHED;
            PG8_LDB(B0, 1, 0); PG8_LDB(B1, 1, 1); PG8_SCHED; PG8_LDA(At, 1, 0); PG8_STAGE(PG8_SA(0, 1), a2 + hA2, lda2);
            PG8_WAIT_V(8); PG8_WAIT_L(0); PG8_BAR; PG8_MMA(0, 0, At, B0); PG8_MMA(0, 1, At, B1); PG8_BAR; PG8_SCHED;
            PG8_LDA(At, 1, 1); PG8_STAGEB(PG8_SB(1, 0), b3, ldb2); PG8_STAGEB(PG8_SB(1, 1), b3 + hB2, ldb2); PG8_STAGE(PG8_SA(1, 0), a3, lda2);
            PG8_WAIT_V(8); PG8_WAIT_L(0); PG8_BAR; PG8_MMA(1, 0, At, B0); PG8_MMA(1, 1, At, B1); PG8_BAR; PG8_SCHED;
        }
        if (wr == 0) PG8_BAR;
        E(acc, cur, wr, wc, fr, fq);
        if (!has_next) break;
#pragma unroll
        for (int a = 0; a < 2; ++a)
#pragma unroll
            for (int b = 0; b < 2; ++b)
#pragma unroll
                for (int m = 0; m < 4; ++m)
#pragma unroll
                    for (int n = 0; n < 2; ++n) acc[a][b][m][n] = (f32x4){0.f, 0.f, 0.f, 0.f};
        cur = nxt; cA = nA; cB = nB; lda = ldan; ldb = ldbn; nt = ntn; ++ui;
        if (wr == 1) PG8_BAR;
    }
    PG8_WAIT_V(0);
    PG8_BAR;
#undef PG8_SA
#undef PG8_SB
#undef PG8_STAGE
#undef PG8_STAGEB
#undef PG8_STAGE_X
#undef PG8_LDA
#undef PG8_LDB
#undef PG8_MMA
#undef PG8_WAIT_V
#undef PG8_WAIT_L
#undef PG8_BAR
#undef PG8_SCHED
}

#define EPI_ROWS_BEGIN  _Pragma("unroll") for (int ai = 0; ai < 2; ++ai) _Pragma("unroll") for (int m = 0; m < 4; ++m) { const int row = u.pm * BM + ai * HALF + wr * 64 + m * 16 + fr;
#define EPI_COLS_BEGIN  _Pragma("unroll") for (int bj = 0; bj < 2; ++bj) _Pragma("unroll") for (int n = 0; n < 2; ++n) { const int col = bj * HALF + wc * 32 + 8 * fq + 4 * n; f32x4 v = acc[ai][bj][m][n];
#define EPI_END } }
#define EPI_COLS8_BEGIN  _Pragma("unroll") for (int bj = 0; bj < 2; ++bj) { const int col = bj * HALF + wc * 32 + 8 * fq; const f32x4 v0 = acc[ai][bj][m][0], v1 = acc[ai][bj][m][1];

struct EpiG1 {
    const float* rs; bf16_t* ZM; bf16_t* ZT; bf16_t* Y;
    __device__ __forceinline__ void operator()(const f32x4 (&acc)[2][2][4][2], const Unit& u, int wr, int wc, int fr, int fq) const {
        const int pn = u.pn;
        if (pn >= 10) {
            const int cm = (pn - 10) * 256;
            EPI_ROWS_BEGIN
            EPI_COLS8_BEGIN
                u32x4 w; w.x = pk2(siluf_(v0[0]), siluf_(v0[1])); w.y = pk2(siluf_(v0[2]), siluf_(v0[3])); w.z = pk2(siluf_(v1[0]), siluf_(v1[1])); w.w = pk2(siluf_(v1[2]), siluf_(v1[3]));
                *(GAS u32x4*)((GAS bf16_t*)Y + (size_t)row * DM + cm + col) = w;
            EPI_END
            return;
        }
        if (pn >= 4 && pn < 6) {
            const int d0 = (pn - 4) * 256;
            EPI_ROWS_BEGIN
            EPI_COLS_BEGIN
                GAS bf16_t* d = (GAS bf16_t*)ZT + ((size_t)(row >> 6) * 512 + d0 + col) * 64 + (row & 63);
                const unsigned w0 = pk2(v[0], v[1]), w1 = pk2(v[2], v[3]);
                d[0] = (bf16_t)w0; d[64] = (bf16_t)(w0 >> 16); d[128] = (bf16_t)w1; d[192] = (bf16_t)(w1 >> 16);
            EPI_END
        } else if (pn >= 6 && pn < 8) {
            const int j0 = (pn - 6) * 256;
            EPI_ROWS_BEGIN
            EPI_COLS_BEGIN
                GAS bf16_t* d = (GAS bf16_t*)ZT + (size_t)MTOK * 512 + ((size_t)(row >> 9) * 512 + j0 + col) * 512 + (row & 511);
                const unsigned w0 = pk2(v[0], v[1]), w1 = pk2(v[2], v[3]);
                d[0] = (bf16_t)w0; d[512] = (bf16_t)(w0 >> 16); d[1024] = (bf16_t)w1; d[1536] = (bf16_t)(w1 >> 16);
            EPI_END
        } else {
            const int cm = (pn < 4 ? pn : pn - 4) * 256;
            EPI_ROWS_BEGIN
            EPI_COLS8_BEGIN
                u32x4 w; w.x = pk2(v0[0], v0[1]); w.y = pk2(v0[2], v0[3]); w.z = pk2(v1[0], v1[1]); w.w = pk2(v1[2], v1[3]);
                *(GAS u32x4*)((GAS bf16_t*)ZM + (size_t)row * ZMW + cm + col) = w;
            EPI_END
        }
    }
};
struct EpiDFT {
    bf16_t* Y;
    __device__ __forceinline__ void operator()(const f32x4 (&acc)[2][2][4][2], const Unit& u, int wr, int wc, int fr, int fq) const {
        int tok0, R, q;
        if (u.pm < 128) { tok0 = (u.pm >> 2) * 2048; R = 4; q = u.pm & 3; } else { const int t = u.pm - 128; tok0 = MP + (t >> 4) * 8192; R = 16; q = t & 15; }
#pragma unroll
        for (int ai = 0; ai < 2; ++ai)
#pragma unroll
            for (int m = 0; m < 4; ++m) {
                const int p = ai * HALF + wr * 64 + m * 16 + fr;
                GAS bf16_t* db = (GAS bf16_t*)Y + (size_t)(tok0 + q) * DM + 512 + p;
                bf16_t gv[2][2][4];
#pragma unroll
                for (int bj = 0; bj < 2; ++bj)
#pragma unroll
                    for (int n = 0; n < 2; ++n)
#pragma unroll
                        for (int e = 0; e < 4; ++e) gv[bj][n][e] = db[(size_t)R * (u.pn * BM + bj * HALF + wc * 32 + 8 * fq + 4 * n + e) * DM];
                __builtin_amdgcn_sched_barrier(0);
#pragma unroll
                for (int bj = 0; bj < 2; ++bj)
#pragma unroll
                    for (int n = 0; n < 2; ++n) {
                        const f32x4 v = acc[ai][bj][m][n];
                        const unsigned w0 = pk2(v[0] * bf2f(gv[bj][n][0]), v[1] * bf2f(gv[bj][n][1])), w1 = pk2(v[2] * bf2f(gv[bj][n][2]), v[3] * bf2f(gv[bj][n][3]));
                        GAS bf16_t* d = db + (size_t)R * (u.pn * BM + bj * HALF + wc * 32 + 8 * fq + 4 * n) * DM;
                        d[0] = (bf16_t)w0; d[(size_t)R * DM] = (bf16_t)(w0 >> 16); d[(size_t)2 * R * DM] = (bf16_t)w1; d[(size_t)3 * R * DM] = (bf16_t)(w1 >> 16);
                    }
                __builtin_amdgcn_sched_barrier(0);
            }
    }
};
struct EpiG2 {
    const float* rs; bf16_t* Y;
    __device__ __forceinline__ void operator()(const f32x4 (&acc)[2][2][4][2], const Unit& u, int wr, int wc, int fr, int fq) const {
        EPI_ROWS_BEGIN
        EPI_COLS8_BEGIN
            GAS u32x4* p = (GAS u32x4*)((GAS bf16_t*)Y + (size_t)row * DM + u.pn * BM + col);
            const u32x4 y = *p; u32x4 w;
            w.x = pk2(bflo(y.x) * siluf_(v0[0]), bfhi(y.x) * siluf_(v0[1])); w.y = pk2(bflo(y.y) * siluf_(v0[2]), bfhi(y.y) * siluf_(v0[3]));
            w.z = pk2(bflo(y.z) * siluf_(v1[0]), bfhi(y.z) * siluf_(v1[1])); w.w = pk2(bflo(y.w) * siluf_(v1[2]), bfhi(y.w) * siluf_(v1[3]));
            *p = w;
        EPI_END
    }
};
struct ProgG34 {
    StaticOrder S; const bf16_t* Y; const bf16_t* XB; const char* wsb; const bf16_t* WM; int layer;
    __device__ __forceinline__ bool next(int i, UnitX& u) const { Unit t; if (!S.next(i / 6, t)) return false; u.pm = t.pm; u.pn = t.pn; u.seg = i % 6; return true; }
    __device__ __forceinline__ void desc(const UnitX& u, const char*& A, const char*& B, int& lda, int& ldb, int& nt) const {
        const int b = u.seg >> 1; lda = DM;
        if (u.seg & 1) { A = (const char*)(XB + (size_t)u.pm * BM * DM); B = (const char*)(WM + (size_t)b * DM * DM + (size_t)u.pn * BM * DM); ldb = DM; nt = DM / BK; }
        else { const int kb = (b == 0) ? 512 : 256, ac = (b == 0) ? 0 : (b == 1 ? 512 : 768);
            const size_t woff = (size_t)((b == 0) ? 26 : 27 + b) * MiB + (size_t)layer * ((b == 0) ? MiB : MiB / 2);
            const bf16_t* w = (const bf16_t*)(wsb + woff);
            A = (const char*)(Y + (size_t)u.pm * BM * DM + ac); B = (const char*)(w + (size_t)u.pn * BM * kb); ldb = kb; nt = kb / BK; }
    }
};
struct EpiG34 {
    const float* rs; bf16_t* PT; bf16_t* MT; bf16_t* MG;
    __device__ __forceinline__ void operator()(const f32x4 (&acc)[2][2][4][2], const UnitX& u, int wr, int wc, int fr_, int fq_) const {
        int fr = fr_, fq = fq_; asm volatile("" : "+v"(fr), "+v"(fq));
        if ((u.seg & 1) == 0) {
            EPI_ROWS_BEGIN
            EPI_COLS8_BEGIN
                u32x4 w; w.x = pk2(v0[0], v0[1]); w.y = pk2(v0[2], v0[3]); w.z = pk2(v1[0], v1[1]); w.w = pk2(v1[2], v1[3]);
                *(GAS u32x4*)(PT + (size_t)(row - u.pm * BM) * 256 + col) = w;
            EPI_END
        } else {
            const int mode = u.seg >> 1;
            GAS bf16_t* dst = (mode == 2) ? (GAS bf16_t*)MG + (size_t)u.pm * BM * DM + u.pn * BM : (GAS bf16_t*)MT;
            const int dld = (mode == 2) ? DM : 256;
            const int rl0 = wr * 64 + fr, c0 = wc * 32 + 8 * fq;
#pragma unroll
            for (int ai = 0; ai < 2; ++ai) {
                u32x4 pv[4][2], mv[4][2];
#pragma unroll
                for (int m = 0; m < 4; ++m)
#pragma unroll
                    for (int bj = 0; bj < 2; ++bj) pv[m][bj] = *(const GAS u32x4*)(PT + (size_t)(ai * HALF + rl0 + m * 16) * 256 + bj * HALF + c0);
                if (mode != 0) {
#pragma unroll
                    for (int m = 0; m < 4; ++m)
#pragma unroll
                        for (int bj = 0; bj < 2; ++bj) mv[m][bj] = *(const GAS u32x4*)(MT + (size_t)(ai * HALF + rl0 + m * 16) * 256 + bj * HALF + c0);
                } else {
#pragma unroll
                    for (int m = 0; m < 4; ++m)
#pragma unroll
                        for (int bj = 0; bj < 2; ++bj) mv[m][bj] = (u32x4){0u, 0u, 0u, 0u};
                }
                __builtin_amdgcn_sched_barrier(0);
#pragma unroll
                for (int m = 0; m < 4; ++m)
#pragma unroll
                    for (int bj = 0; bj < 2; ++bj) {
                        const f32x4 v0 = acc[ai][bj][m][0], v1 = acc[ai][bj][m][1]; const u32x4 p = pv[m][bj], q = mv[m][bj];
                        const float r0 = bflo(q.x) + bflo(p.x) * sigmoidf_(v0[0]), r1 = bfhi(q.x) + bfhi(p.x) * sigmoidf_(v0[1]), r2 = bflo(q.y) + bflo(p.y) * sigmoidf_(v0[2]), r3 = bfhi(q.y) + bfhi(p.y) * sigmoidf_(v0[3]);
                        const float r4 = bflo(q.z) + bflo(p.z) * sigmoidf_(v1[0]), r5 = bfhi(q.z) + bfhi(p.z) * sigmoidf_(v1[1]), r6 = bflo(q.w) + bflo(p.w) * sigmoidf_(v1[2]), r7 = bfhi(q.w) + bfhi(p.w) * sigmoidf_(v1[3]);
                        u32x4 w; w.x = pk2(r0, r1); w.y = pk2(r2, r3); w.z = pk2(r4, r5); w.w = pk2(r6, r7);
                        *(GAS u32x4*)(dst + (size_t)(ai * HALF + rl0 + m * 16) * dld + bj * HALF + c0) = w;
                    }
                __builtin_amdgcn_sched_barrier(0);
            }
        }
    }
};
struct EpiG5 {
    bf16_t* O; float* ss;
    __device__ __forceinline__ void operator()(const f32x4 (&acc)[2][2][4][2], const Unit& u, int wr, int wc, int fr, int fq) const {
        EPI_ROWS_BEGIN float q = 0.f;
        EPI_COLS8_BEGIN
            u32x4 w; w.x = pk2(v0[0], v0[1]); w.y = pk2(v0[2], v0[3]); w.z = pk2(v1[0], v1[1]); w.w = pk2(v1[2], v1[3]);
            *(GAS u32x4*)((GAS bf16_t*)O + (size_t)row * DM + u.pn * BM + col) = w;
            q += ((v0[0] * v0[0] + v0[1] * v0[1]) + (v0[2] * v0[2] + v0[3] * v0[3])) + ((v1[0] * v1[0] + v1[1] * v1[1]) + (v1[2] * v1[2] + v1[3] * v1[3]));
        }
            q += __shfl_xor(q, 16); q += __shfl_xor(q, 32);
            if (fq == 0) atomicAdd(ss + row, q);
        }
    }
};
}

__device__ __forceinline__ void transpose_item(const float* W, int K, int pitch, int c0, int ncols, bf16_t* WT, int row_off, const float* g, float scale, LAS float* scr, int item, int lane) {
    const int nblk = ncols / 32, kb = item / nblk, nb = item % nblk, k0 = 64 * kb, n0 = 32 * nb;
#pragma unroll 8
    for (int i = 0; i < 32; ++i) { const int kk = 2 * i + (lane >> 5); float w = W[(size_t)(k0 + kk) * pitch + c0 + n0 + (lane & 31)] * scale; if (g) w *= g[k0 + kk]; scr[kk * 33 + (lane & 31)] = w; }
    LDS_WAIT(); asm volatile("" ::: "memory");
    const int c = lane & 7;
#pragma unroll
    for (int j = 0; j < 4; ++j) { const int n = (lane >> 3) + 8 * j; const LAS float* s = scr + (8 * c) * 33 + n;
        u32x4 o; o.x = pk2(s[0 * 33], s[1 * 33]); o.y = pk2(s[2 * 33], s[3 * 33]); o.z = pk2(s[4 * 33], s[5 * 33]); o.w = pk2(s[6 * 33], s[7 * 33]);
        *(u32x4*)(WT + (size_t)(row_off + n0 + n) * K + k0 + 8 * c) = o; }
    LDS_WAIT(); asm volatile("" ::: "memory");
}

struct Args { const float* in[14]; float* out; unsigned char* ws; int ph_lo, ph_hi; };

__device__ __forceinline__ void grid_row_info(int gr, int& seqbase, int& r, int& nrows) {
    if (gr < 1024) { seqbase = (gr >> 5) << 11; r = gr & 31; nrows = 32; } else { const int g2 = gr - 1024; seqbase = MP + ((g2 >> 7) << 13); r = g2 & 127; nrows = 128; }
}

constexpr int AT_NSLOT = 9, AT_KSLOT = 9216, AT_VSLOT = 8704, AT_VOFF = AT_NSLOT * AT_KSLOT, AT_BOFF = AT_VOFF + AT_NSLOT * AT_VSLOT;
static_assert(AT_BOFF + 465 * 4 <= LDS_BYTES, "attention LDS map");
__device__ __forceinline__ void attn_fill_issue(const GAS bf16_t* ZM, const GAS bf16_t* ZT, int tok0, int head, int tid, u32x4& kreg, u32x4& vreg) {
    kreg = *(const GAS u32x4*)(ZM + (size_t)(tok0 + (tid >> 3)) * ZMW + 512 + head * 64 + (tid & 7) * 8);
    vreg = *(const GAS u32x4*)(ZT + ((size_t)(tok0 >> 6) * 512 + head * 64) * 64 + tid * 8);
}
__device__ __forceinline__ void attn_fill_write(LAS unsigned char* lds, int slot, int tid, const u32x4 kreg, const u32x4 vreg) {
    *(LAS u32x4*)(lds + slot * AT_KSLOT + (tid >> 3) * 144 + (tid & 7) * 16) = kreg;
    LAS u32x2* vp = (LAS u32x2*)(lds + AT_VOFF + slot * AT_VSLOT + (tid >> 3) * 136 + (tid & 7) * 16);
    u32x2 a; a.x = vreg.x; a.y = vreg.y; u32x2 b; b.x = vreg.z; b.y = vreg.w;
    vp[0] = a; vp[1] = b;
}
__device__ __forceinline__ void attn_row_lds(LAS unsigned char* lds, int seqbase, int r, int rs, int head, int lane, int wave, const bf16x8 bq0, const bf16x8 bq1, GAS bf16_t* Y, const unsigned (&bcp)[32]) {
    const int g = wave & 3;
    const int qi = lane & 15, h4 = lane >> 4;
    const int cs = (g == 0) ? 0 : (g == 1) ? 8 : (g == 2) ? 24 : 32;
    const int qc = 16 * g + qi;
    const int qtok = seqbase + r * 64 + qc;
    const int sb = rs % AT_NSLOT;
    GAS bf16_t* yp = Y + (size_t)qtok * DM + head * 64 + 4 * h4;
    u32x2 gt[4];
#pragma unroll
    for (int dt = 0; dt < 4; ++dt) gt[dt] = *(const GAS u32x2*)(yp + dt * 16);
    f32x4 S[16];
    float mx = -3.0e38f;
#pragma unroll
    for (int hb = 0; hb < 2; ++hb) {
        bf16x8 ak[8][2];
#pragma unroll
        for (int tt = 0; tt < 8; ++tt) {
            const int t = hb * 8 + tt, kr = t >> 1, hf = t & 1;
            int slot = sb + kr; slot = slot >= AT_NSLOT ? slot - AT_NSLOT : slot;
            const LAS unsigned char* kp = lds + slot * AT_KSLOT + (cs + 16 * hf + qi) * 144 + h4 * 16;
            ak[tt][0] = *(const LAS bf16x8*)kp; ak[tt][1] = *(const LAS bf16x8*)(kp + 64);
        }
        __builtin_amdgcn_sched_barrier(0);
#pragma unroll
        for (int tt = 0; tt < 8; ++tt) {
            const int t = hb * 8 + tt;
            f32x4 s = {0.f, 0.f, 0.f, 0.f};
            s = __builtin_amdgcn_mfma_f32_16x16x32_bf16(ak[tt][0], bq0, s, 0, 0, 0);
            s = __builtin_amdgcn_mfma_f32_16x16x32_bf16(ak[tt][1], bq1, s, 0, 0, 0);
            s[0] += bflo(bcp[2 * t]); s[1] += bfhi(bcp[2 * t]); s[2] += bflo(bcp[2 * t + 1]); s[3] += bfhi(bcp[2 * t + 1]);
            mx = fmaxf(mx, fmaxf(fmaxf(s[0], s[1]), fmaxf(s[2], s[3])));
            S[t] = s;
        }
        __builtin_amdgcn_sched_barrier(0);
    }
    mx = fmaxf(mx, __shfl_xor(mx, 16)); mx = fmaxf(mx, __shfl_xor(mx, 32));
    float sum = 0.f;
    bf16x8 pf[8];
#pragma unroll
    for (int kr = 0; kr < 8; ++kr) {
        const f32x4 a = S[kr * 2], b = S[kr * 2 + 1];
        const float p0 = __expf(a[0] - mx), p1 = __expf(a[1] - mx), p2 = __expf(a[2] - mx), p3 = __expf(a[3] - mx);
        const float p4 = __expf(b[0] - mx), p5 = __expf(b[1] - mx), p6 = __expf(b[2] - mx), p7 = __expf(b[3] - mx);
        sum += ((p0 + p1) + (p2 + p3)) + ((p4 + p5) + (p6 + p7));
        u32x4 w; w.x = pk2(p0, p1); w.y = pk2(p2, p3); w.z = pk2(p4, p5); w.w = pk2(p6, p7);
        pf[kr] = __builtin_bit_cast(bf16x8, w);
    }
    sum += __shfl_xor(sum, 16); sum += __shfl_xor(sum, 32);
    const float inv = __builtin_amdgcn_rcpf(sum);
#pragma unroll
    for (int dp = 0; dp < 2; ++dp) {
        u32x2 vf[2][8][2];
#pragma unroll
        for (int dti = 0; dti < 2; ++dti)
#pragma unroll
            for (int kr = 0; kr < 8; ++kr) {
                int slot = sb + kr; slot = slot >= AT_NSLOT ? slot - AT_NSLOT : slot;
                const LAS unsigned char* vp = lds + AT_VOFF + slot * AT_VSLOT + ((2 * dp + dti) * 16 + qi) * 136 + (cs + 4 * h4) * 2;
                vf[dti][kr][0] = *(const LAS u32x2*)vp; vf[dti][kr][1] = *(const LAS u32x2*)(vp + 32);
            }
        __builtin_amdgcn_sched_barrier(0);
#pragma unroll
        for (int dti = 0; dti < 2; ++dti) {
            f32x4 o = {0.f, 0.f, 0.f, 0.f};
#pragma unroll
            for (int kr = 0; kr < 8; ++kr) {
                u32x4 w; w.x = vf[dti][kr][0].x; w.y = vf[dti][kr][0].y; w.z = vf[dti][kr][1].x; w.w = vf[dti][kr][1].y;
                o = __builtin_amdgcn_mfma_f32_16x16x32_bf16(__builtin_bit_cast(bf16x8, w), pf[kr], o, 0, 0, 0);
            }
            const u32x2 gq = gt[2 * dp + dti];
            u32x2 w; w.x = pk2(o[0] * inv * bflo(gq.x), o[1] * inv * bfhi(gq.x)); w.y = pk2(o[2] * inv * bflo(gq.y), o[3] * inv * bfhi(gq.y));
            *(GAS u32x2*)(yp + (2 * dp + dti) * 16) = w;
        }
        __builtin_amdgcn_sched_barrier(0);
    }
}
#define ATT_RS(r_) ((r_) - 4 < 0 ? 0 : ((r_) - 4 > nrows - 8 ? nrows - 8 : (r_) - 4))
__device__ __forceinline__ void attn_unit(LAS unsigned char* lds, int seqbase, int nrows, int ra, int rb, int head, int tid, int lane, int wave,
                                          const bf16_t* ZM_, const bf16_t* ZT_, bf16_t* Y_, const float* rpb) {
    const GAS bf16_t* ZM = (const GAS bf16_t*)ZM_; const GAS bf16_t* ZT = (const GAS bf16_t*)ZT_; GAS bf16_t* Y = (GAS bf16_t*)Y_;
    const int rsel = wave >> 2;
    const int lo = ATT_RS(ra);
    int top = lo + 8;
    {   u32x4 kreg[9], vreg[9];
#pragma unroll
        for (int k = 0; k < 9; ++k) { int row = lo + k; row = row > nrows - 1 ? nrows - 1 : row; attn_fill_issue(ZM, ZT, seqbase + row * 64, head, tid, kreg[k], vreg[k]); }
        LAS float* bw = (LAS float*)(lds + AT_BOFF);
        if (tid < 465) bw[tid] = rpb[head * 465 + tid];
#pragma unroll
        for (int k = 0; k < 9; ++k) attn_fill_write(lds, (lo + k) % AT_NSLOT, tid, kreg[k], vreg[k]);
    }
    const GAS bf16_t* qbase = ZM + (size_t)(seqbase + 16 * (wave & 3) + (lane & 15)) * ZMW + head * 64 + 8 * (lane >> 4);
    bf16x8 q0 = *(const GAS bf16x8*)(qbase + (size_t)(ra + rsel) * 64 * ZMW), q1 = *(const GAS bf16x8*)(qbase + (size_t)(ra + rsel) * 64 * ZMW + 32);
    __syncthreads();
    unsigned bcp[32]; int cdelta = 1000;
#pragma unroll
    for (int i = 0; i < 32; ++i) bcp[i] = 0u;
#pragma unroll 1
    for (int r = ra; r < rb; r += 2) {
        const int rr = r + rsel, rs = ATT_RS(rr);
        if (rs - rr != cdelta) {
            cdelta = rs - rr;
            const LAS float* bias = (const LAS float*)(lds + AT_BOFF);
            const int g_ = wave & 3, qi_ = lane & 15, h4_ = lane >> 4, cs_ = (g_ == 0) ? 0 : (g_ == 1) ? 8 : (g_ == 2) ? 24 : 32, qc_ = 16 * g_ + qi_;
            int cst_ = qc_ - 8; cst_ = cst_ < 0 ? 0 : cst_; cst_ = cst_ > 48 ? 48 : cst_;
#pragma unroll
            for (int t = 0; t < 16; ++t) {
                float bv[4];
#pragma unroll
                for (int e = 0; e < 4; ++e) {
                    const int kc = cs_ + 16 * (t & 1) + 4 * h4_ + e; int dc = kc - qc_ + 15; dc = dc < 0 ? 0 : dc; dc = dc > 30 ? 30 : dc;
                    const float b = bias[(cdelta + (t >> 1) + 7) * 31 + dc];
                    bv[e] = ((kc >= cst_) && (kc < cst_ + 16)) ? b : -1.0e30f;
                }
                bcp[2 * t] = pk2(bv[0], bv[1]); bcp[2 * t + 1] = pk2(bv[2], bv[3]);
            }
        }
        const int rqn = (r + 2 < rb) ? rr + 2 : rr;
        const bf16x8 nq0 = *(const GAS bf16x8*)(qbase + (size_t)rqn * 64 * ZMW), nq1 = *(const GAS bf16x8*)(qbase + (size_t)rqn * 64 * ZMW + 32);
        int ntop = (r + 2 < rb) ? ATT_RS(r + 3) + 7 : top; ntop = ntop < top ? top : ntop;
        const int nnew = ntop - top;
        u32x4 kreg0 = {0u, 0u, 0u, 0u}, vreg0 = {0u, 0u, 0u, 0u}, kreg1 = {0u, 0u, 0u, 0u}, vreg1 = {0u, 0u, 0u, 0u};
        if (nnew >= 1) attn_fill_issue(ZM, ZT, seqbase + (top + 1) * 64, head, tid, kreg0, vreg0);
        if (nnew >= 2) attn_fill_issue(ZM, ZT, seqbase + (top + 2) * 64, head, tid, kreg1, vreg1);
        attn_row_lds(lds, seqbase, rr, rs, head, lane, wave, q0, q1, Y, bcp);
        LDS_WAIT(); __builtin_amdgcn_s_barrier(); asm volatile("" ::: "memory");
        if (nnew >= 1) attn_fill_write(lds, (top + 1) % AT_NSLOT, tid, kreg0, vreg0);
        if (nnew >= 2) attn_fill_write(lds, (top + 2) % AT_NSLOT, tid, kreg1, vreg1);
        LDS_WAIT(); __builtin_amdgcn_s_barrier(); asm volatile("" ::: "memory");
        top = ntop; q0 = nq0; q1 = nq1;
    }
}

#define DFT4(r0, i0, r1, i1, r2, i2, r3, i3) do { \
    const float ar_ = r0 + r2, ai_ = i0 + i2, br_ = r0 - r2, bi_ = i0 - i2, cr_ = r1 + r3, ci_ = i1 + i3, dr_ = r1 - r3, di_ = i1 - i3; \
    r0 = ar_ + cr_; i0 = ai_ + ci_; r1 = br_ + di_; i1 = bi_ - dr_; r2 = ar_ - cr_; i2 = ai_ - ci_; r3 = br_ - di_; i3 = bi_ + dr_; } while (0)
template <int R, int NU>
__device__ __forceinline__ void butterfly_unit(int tok0, int rowbase  , int p0, int t, const bf16_t* ZT_, bf16_t* YQ_, const float (&twr)[2][R], const float (&twi)[2][R]) {
    const GAS unsigned* zre = (const GAS unsigned*)((const GAS bf16_t*)ZT_ + (size_t)MTOK * 512 + ((size_t)(tok0 >> 9) * 512 + p0) * 512) + t;
    const GAS unsigned* zim = zre + 256 * 256;
    float xr[NU][2][R], xi[NU][2][R];
#pragma unroll
    for (int u = 0; u < NU; ++u)
#pragma unroll
        for (int s = 0; s < R; ++s) {
            const unsigned wr_ = zre[(size_t)s * 512 * 256 + u * 256], wi_ = zim[(size_t)s * 512 * 256 + u * 256];
            xr[u][0][s] = bflo(wr_); xr[u][1][s] = bfhi(wr_); xi[u][0][s] = bflo(wi_); xi[u][1][s] = bfhi(wi_);
        }
#pragma unroll
    for (int u = 0; u < NU; ++u) {
#pragma unroll
        for (int h = 0; h < 2; ++h) {
            if constexpr (R == 4) {
                DFT4(xr[u][h][0], xi[u][h][0], xr[u][h][1], xi[u][h][1], xr[u][h][2], xi[u][h][2], xr[u][h][3], xi[u][h][3]);
            } else {
#pragma unroll
                for (int b = 0; b < 4; ++b) DFT4(xr[u][h][b], xi[u][h][b], xr[u][h][4 + b], xi[u][h][4 + b], xr[u][h][8 + b], xi[u][h][8 + b], xr[u][h][12 + b], xi[u][h][12 + b]);
                constexpr float WR[10] = {1.f, 0.9238795325f, 0.7071067812f, 0.3826834324f, 0.f, 0.f, -0.7071067812f, 0.f, 0.f, -0.9238795325f};
                constexpr float WI[10] = {0.f, -0.3826834324f, -0.7071067812f, -0.9238795325f, -1.f, 0.f, -0.7071067812f, 0.f, 0.f, 0.3826834324f};
#pragma unroll
                for (int c = 1; c < 4; ++c)
#pragma unroll
                    for (int b = 1; b < 4; ++b) { const float w0 = WR[c * b], w1 = WI[c * b]; const float tr = xr[u][h][4 * c + b] * w0 - xi[u][h][4 * c + b] * w1, ti = xr[u][h][4 * c + b] * w1 + xi[u][h][4 * c + b] * w0; xr[u][h][4 * c + b] = tr; xi[u][h][4 * c + b] = ti; }
#pragma unroll
                for (int c = 0; c < 4; ++c) DFT4(xr[u][h][4 * c], xi[u][h][4 * c], xr[u][h][4 * c + 1], xi[u][h][4 * c + 1], xr[u][h][4 * c + 2], xi[u][h][4 * c + 2], xr[u][h][4 * c + 3], xi[u][h][4 * c + 3]);
            }
        }
        GAS unsigned* d0 = (GAS unsigned*)((GAS bf16_t*)YQ_ + (size_t)(rowbase + u) * 1024) + t;
#pragma unroll
        for (int q = 0; q < R; ++q) {
            const int sl = (R == 16) ? 4 * (q & 3) + (q >> 2) : q;
            const float r0 = xr[u][0][sl] * twr[0][q] - xi[u][0][sl] * twi[0][q], i0 = xr[u][0][sl] * twi[0][q] + xi[u][0][sl] * twr[0][q];
            const float r1 = xr[u][1][sl] * twr[1][q] - xi[u][1][sl] * twi[1][q], i1 = xr[u][1][sl] * twi[1][q] + xi[u][1][sl] * twr[1][q];
            GAS unsigned* d = d0 + (size_t)q * 256 * 512;
            d[0] = pk2(r0, r1); d[256] = pk2(i0, i1);
        }
    }
}

template <int MODE>
__device__ __forceinline__ void row_pass(int gw, int NGW, int lane, const float* x_prompt, const float* x_sample, float* out, bf16_t* XB, const bf16_t* O, float* RS, float* SS, const float* gpost) {
    for (int m = gw; m < MTOK; m += NGW) {
        f32x4 v[4];
        GAS u32x2* xbrow = (GAS u32x2*)((GAS bf16_t*)XB + (size_t)m * DM) + lane;
        if constexpr (MODE == 2) {
            u32x2 xv[4];
#pragma unroll
            for (int j = 0; j < 4; ++j) xv[j] = xbrow[64 * j];
            const float irs = RS[m];
#pragma unroll
            for (int j = 0; j < 4; ++j) { v[j][0] = bflo(xv[j].x) * irs; v[j][1] = bfhi(xv[j].x) * irs; v[j][2] = bflo(xv[j].y) * irs; v[j][3] = bfhi(xv[j].y) * irs; }
        } else {
            const GAS f32x4* xr = (const GAS f32x4*)((m < MP) ? x_prompt + (size_t)m * DM : x_sample + (size_t)(m - MP) * DM) + lane;
#pragma unroll
            for (int j = 0; j < 4; ++j) v[j] = xr[64 * j];
        }
        if constexpr (MODE != 0) {
            const float rq = rsqrtf(SS[m] * (1.0f / DM) + EPS);
            const GAS u32x2* orow = (const GAS u32x2*)((const GAS bf16_t*)O + (size_t)m * DM) + lane;
#pragma unroll
            for (int j = 0; j < 4; ++j) { const u32x2 ov = orow[64 * j]; const f32x4 gp = *((const GAS f32x4*)gpost + lane + 64 * j);
                v[j][0] += bflo(ov.x) * rq * gp[0]; v[j][1] += bfhi(ov.x) * rq * gp[1]; v[j][2] += bflo(ov.y) * rq * gp[2]; v[j][3] += bfhi(ov.y) * rq * gp[3]; }
            if constexpr (MODE == 2) {
                GAS f32x4* orow2 = (GAS f32x4*)(out + (size_t)m * DM) + lane;
#pragma unroll
                for (int j = 0; j < 4; ++j) orow2[64 * j] = v[j];
            }
        }
        if constexpr (MODE != 2) {
            float s = 0.f;
#pragma unroll
            for (int j = 0; j < 4; ++j) s += (v[j][0] * v[j][0] + v[j][1] * v[j][1]) + (v[j][2] * v[j][2] + v[j][3] * v[j][3]);
            s = wave_sum(s);
            const float ms = s * (1.0f / DM) + EPS;
            const float rsv = rsqrtf(ms);
#pragma unroll
            for (int j = 0; j < 4; ++j) { u32x2 w; w.x = pk2(v[j][0] * rsv, v[j][1] * rsv); w.y = pk2(v[j][2] * rsv, v[j][3] * rsv); xbrow[64 * j] = w; }
            if (lane == 0) { RS[m] = sqrtf(ms); SS[m] = 0.f; }
        }
    }
}

__global__ void __launch_bounds__(NWAVES * 64, 2) fwd_kernel(Args args) {
    extern __shared__ __attribute__((aligned(16))) unsigned char lds_raw[];
    LAS unsigned char* lds = (LAS unsigned char*)lds_raw;
    const int G = gridDim.x, bx = blockIdx.x;
    for (int ph = args.ph_lo; ph < args.ph_hi; ++ph) {
        if (ph > args.ph_lo) { cg::this_grid().sync(); }
        int tid = threadIdx.x; asm volatile("" : "+v"(tid));
        const int lane = tid & 63, wave = __builtin_amdgcn_readfirstlane(tid >> 6);
        const int gw = bx * NWAVES + wave, NGW = G * NWAVES;
        unsigned char* ws = args.ws; asm volatile("" : "+s"(ws));
        const float* x_prompt = args.in[0]; const float* x_sample = args.in[1];
        float* out = args.out;
        bf16_t* XB = (bf16_t*)(ws + WS_XB); bf16_t* OB = XB;
        bf16_t* ZM = (bf16_t*)(ws + WS_ZM); bf16_t* PB = ZM;
        bf16_t* ZT = (bf16_t*)(ws + WS_ZT); bf16_t* MG = ZT;
        bf16_t* YQ = (bf16_t*)(ws + WS_YQ);
        bf16_t* Y = (bf16_t*)(ws + WS_Y);
        bf16_t* TT = (bf16_t*)(ws + WS_T);
        float* RS = (float*)(ws + WS_RS); float* SS = (float*)(ws + WS_SS);
        const int layer = (ph == 0) ? 0 : (ph - 1) / 6;
        const int sub = (ph == 0) ? -1 : (ph - 1) % 6;
        const bf16_t* WIN = (const bf16_t*)(ws + WS_WIN) + (size_t)layer * NG1 * DM;
        const bf16_t* WM = (const bf16_t*)(ws + WS_WM) + (size_t)layer * 3072 * DM;
        const bf16_t* WA = (const bf16_t*)(ws + WS_WA) + (size_t)layer * DM * 512;
        const bf16_t* WB = (const bf16_t*)(ws + WS_WB) + (size_t)layer * DM * 256;
        const bf16_t* WC = (const bf16_t*)(ws + WS_WC) + (size_t)layer * DM * 256;
        const bf16_t* WO = (const bf16_t*)(ws + WS_WO) + (size_t)layer * DM * DM;

        if (PHON(0) && ph == 0) {
            LAS float* scr = (LAS float*)(lds + wave * 16384);
            for (int l = 0; l < 2; ++l) {
                const float* w_in = args.in[4] + (size_t)l * DM * DIN;
                const float* gpre = args.in[2] + l * DM;
                bf16_t* win = (bf16_t*)(ws + WS_WIN) + (size_t)l * NG1 * DM;
                bf16_t* wm = (bf16_t*)(ws + WS_WM) + (size_t)l * 3072 * DM;
                for (int job = 0; job < 7; ++job) {
                    int c0, nc, ro; bf16_t* dst; float sc = 1.f;
                    switch (job) {
                        case 0: c0 = 0; nc = 512; dst = win; ro = 0; sc = 0.125f; break;
                        case 1: c0 = 512; nc = 1024; dst = win; ro = 512; break;
                        case 2: c0 = 2560; nc = 512; dst = win; ro = 2048; break;
                        case 3: c0 = 1536; nc = 512; dst = win; ro = 2560; break;
                        case 4: c0 = 2304; nc = 256; dst = win; ro = 3072; break;
                        case 5: c0 = 3072; nc = 256; dst = win; ro = 3328; break;
                        default: c0 = 3328; nc = 3072; dst = wm; ro = 0; break;
                    }
                    const int nitems = (DM / 64) * (nc / 32);
                    for (int it = gw; it < nitems; it += NGW) transpose_item(w_in, DM, DIN, c0, nc, dst, ro, gpre, sc, scr, it, lane);
                }
                {   const int ni = (512 / 64) * (DM / 32);
                    for (int it = gw; it < ni; it += NGW) transpose_item(args.in[10] + (size_t)l * 512 * DM, 512, DM, 0, DM, (bf16_t*)(ws + WS_WA) + (size_t)l * DM * 512, 0, nullptr, 1.f, scr, it, lane); }
                {   const int ni = (256 / 64) * (DM / 32);
                    for (int it = gw; it < ni; it += NGW) transpose_item(args.in[11] + (size_t)l * 256 * DM, 256, DM, 0, DM, (bf16_t*)(ws + WS_WB) + (size_t)l * DM * 256, 0, nullptr, 1.f, scr, it, lane);
                    for (int it = gw; it < ni; it += NGW) transpose_item(args.in[12] + (size_t)l * 256 * DM, 256, DM, 0, DM, (bf16_t*)(ws + WS_WC) + (size_t)l * DM * 256, 0, nullptr, 1.f, scr, it, lane); }
                {   const int ni = (DM / 64) * (DM / 32);
                    for (int it = gw; it < ni; it += NGW) transpose_item(args.in[13] + (size_t)l * DM * DM, DM, DM, 0, DM, (bf16_t*)(ws + WS_WO) + (size_t)l * DM * DM, 0, nullptr, 1.f, scr, it, lane); }
                LAS float* ctab = (LAS float*)(lds + 131072);
                if (l == 0) { if (tid < 64) { float sn, cs; sincospif((float)tid * (1.0f / 32.0f), &sn, &cs); ctab[tid] = cs; ctab[64 + tid] = sn; } __syncthreads(); }
                for (int idx = bx * 512 + tid; idx < DM * 256; idx += G * 512) {
                    const int k = idx >> 8, p = idx & 255, grp = p >> 6, mm = p & 63;
                    const f32x4* wrow = (const f32x4*)(w_in + (size_t)k * DIN + 2048 + grp * 64);
                    float are = 0.f, aim = 0.f;
#pragma unroll 4
                    for (int c4 = 0; c4 < 16; ++c4) { const f32x4 w = wrow[c4];
#pragma unroll
                        for (int e = 0; e < 4; ++e) { const int t = (mm * (4 * c4 + e)) & 63; are += w[e] * ctab[t]; aim -= w[e] * ctab[64 + t]; } }
                    const float gk = gpre[k];
                    win[(size_t)(1536 + p) * DM + k] = (bf16_t)f2bf(are * gk);
                    win[(size_t)(1536 + 256 + p) * DM + k] = (bf16_t)f2bf(aim * gk);
                }
            }
            for (int idx = bx * 512 + tid; idx < 512 * 512; idx += G * 512) {
                const int kp = idx >> 9, lp = idx & 511; float sn, cs; sincospif((float)((kp * lp) & 511) * (1.0f / 256.0f), &sn, &cs);
                TT[(size_t)kp * 1024 + lp] = (bf16_t)f2bf(cs); TT[(size_t)kp * 1024 + 512 + lp] = (bf16_t)f2bf(sn);
            }
        }
        if (PHON(1) && (ph == 0 || sub == 5)) {
            const float* gpost = args.in[3] + layer * DM;
            if (ph == 0) row_pass<0>(gw, NGW, lane, x_prompt, x_sample, out, XB, Y, RS, SS, gpost);
            else if (layer == 0) row_pass<1>(gw, NGW, lane, x_prompt, x_sample, out, XB, Y, RS, SS, gpost);
            else row_pass<2>(gw, NGW, lane, x_prompt, x_sample, out, XB, Y, RS, SS, gpost);
        } else if (PHON(2) && sub == 0) {
            pg8::Gemm g{XB, WIN, MTOK, NG1, DM, DM, DM}; pg8::StaticOrder S; S.init(MTOK, NG1, G, bx);
            pg8::EpiG1 E{RS, ZM, ZT, Y};
            pg8::gemm_phase<pg8::EpiG1, pg8::StaticOrder, true>(lds, g, S, E);
        } else if (sub == 1) {
            if (PHON(3)) {
                const float* rpb = args.in[5] + (size_t)layer * 8 * 15 * 31;
                for (int un = bx; un < 512; un += G) {
                    if (un < 256) attn_unit(lds, (un >> 3) * 2048, 32, 0, 32, un & 7, tid, lane, wave, ZM, ZT, Y, rpb);
                    else { const int v = un - 256, st = v & 7; attn_unit(lds, MP + (v >> 6) * 8192, 128, st * 16, st * 16 + 16, (v >> 3) & 7, tid, lane, wave, ZM, ZT, Y, rpb); }
                }
            }
            if (PHON(4)) {
                constexpr int CT = 64, HR = CT + 30, NIT = (HR * 32 + 511) / 512, TPH = CT / 2, NHV = TPH + 30, LNT = CT / 8;
                static_assert((HR + CT) * 1024 <= LDS_BYTES, "conv LDS map");
                LAS float* hbuf = (LAS float*)lds; LAS float* cbuf = (LAS float*)(lds + HR * 1024);
                const float* dww = args.in[6] + (size_t)layer * 31 * 256; const float* dwb = args.in[7] + layer * 256;
                const float* lng = args.in[8] + layer * 256; const float* lnb = args.in[9] + layer * 256;
                const int c = tid & 255, half = tid >> 8;
                float w[31];
#pragma unroll
                for (int j = 0; j < 31; ++j) w[j] = dww[j * 256 + c];
                const float bc = dwb[c];
                const f32x4 lg = *((const f32x4*)lng + lane), lb = *((const f32x4*)lnb + lane);
                u32x4 pa[NIT], pb[NIT];
#define CONV_ISSUE(cu_) do { const int t0g_ = (cu_) * CT; \
                    int sbeg_, send_; if (t0g_ < MP) { sbeg_ = t0g_ & ~2047; send_ = sbeg_ + 2048; } else { sbeg_ = MP + ((t0g_ - MP) & ~8191); send_ = sbeg_ + 8192; } \
                    _Pragma("unroll") for (int k = 0; k < NIT; ++k) { \
                        const int it = tid + k * 512, i = it >> 5, c8 = (it & 31) * 8; const int tok = t0g_ - 15 + i; \
                        int tokc = tok < sbeg_ ? sbeg_ : tok; tokc = tokc > send_ - 1 ? send_ - 1 : tokc;     \
                        const u32x4 la_ = *(const GAS u32x4*)((const GAS bf16_t*)ZM + (size_t)tokc * ZMW + 1024 + c8), lb_ = *(const GAS u32x4*)((const GAS bf16_t*)ZM + (size_t)tokc * ZMW + 1280 + c8); \
                        const unsigned keep_ = (tok >= sbeg_ && tok < send_) ? 0xffffffffu : 0u; \
                        pa[k].x = la_.x & keep_; pa[k].y = la_.y & keep_; pa[k].z = la_.z & keep_; pa[k].w = la_.w & keep_; pb[k] = lb_; \
                    } } while (0)
                for (int cu = bx; cu < MTOK / CT; cu += G) {
                    const int t0g = cu * CT;
                    CONV_ISSUE(cu);
#pragma unroll
                    for (int k = 0; k < NIT; ++k) {
                        const int it = tid + k * 512, i = it >> 5, c8 = (it & 31) * 8;
                        if (it < HR * 32) {
                            const u32x4 a = pa[k], b = pb[k]; f32x4 h0, h1;
                            h0[0] = bflo(a.x) * sigmoidf_(bflo(b.x)); h0[1] = bfhi(a.x) * sigmoidf_(bfhi(b.x)); h0[2] = bflo(a.y) * sigmoidf_(bflo(b.y)); h0[3] = bfhi(a.y) * sigmoidf_(bfhi(b.y));
                            h1[0] = bflo(a.z) * sigmoidf_(bflo(b.z)); h1[1] = bfhi(a.z) * sigmoidf_(bfhi(b.z)); h1[2] = bflo(a.w) * sigmoidf_(bflo(b.w)); h1[3] = bfhi(a.w) * sigmoidf_(bfhi(b.w));
                            *(LAS f32x4*)(hbuf + i * 256 + c8) = h0; *(LAS f32x4*)(hbuf + i * 256 + c8 + 4) = h1;
                        }
                    }
                    __syncthreads();
                    {   float hv[NHV];
#pragma unroll
                        for (int i = 0; i < NHV; ++i) hv[i] = hbuf[(half * TPH + i) * 256 + c];
#pragma unroll
                        for (int tt = 0; tt < TPH; ++tt) {
                            float a = bc;
#pragma unroll
                            for (int j = 0; j < 31; ++j) a += w[j] * hv[tt + j];
                            cbuf[(half * TPH + tt) * 256 + c] = a;
                        }
                    }
                    __syncthreads();
#pragma unroll 4
                    for (int tt = 0; tt < LNT; ++tt) {
                        const int t = wave * LNT + tt;
                        const f32x4 xv = *(const LAS f32x4*)(cbuf + t * 256 + 4 * lane);
                        const float mean = wave_sum((xv[0] + xv[1]) + (xv[2] + xv[3])) * (1.0f / 256.0f);
                        const f32x4 d = xv - mean;
                        const float var = wave_sum((d[0] * d[0] + d[1] * d[1]) + (d[2] * d[2] + d[3] * d[3])) * (1.0f / 256.0f);
                        const float rstd = rsqrtf(var + EPS);
                        const float y0 = siluf_(d[0] * rstd * lg[0] + lb[0]), y1 = siluf_(d[1] * rstd * lg[1] + lb[1]), y2 = siluf_(d[2] * rstd * lg[2] + lb[2]), y3 = siluf_(d[3] * rstd * lg[3] + lb[3]);
                        GAS u32x2* yo = (GAS u32x2*)((GAS bf16_t*)Y + (size_t)(t0g + t) * DM + 768 + 4 * lane);
                        const u32x2 gq = *yo;
                        u32x2 wv; wv.x = pk2(y0 * bflo(gq.x), y1 * bfhi(gq.x)); wv.y = pk2(y2 * bflo(gq.y), y3 * bfhi(gq.y));
                        *yo = wv;
                    }
                }
            }
            if (PHON(5)) {
                float t4r[2][4], t4i[2][4], t16r[2][16], t16i[2][16];
                const int bt = tid & 255, bh = tid >> 8;
                {   const float s4 = rsqrtf(64.0f * 2048.0f), s16 = rsqrtf(64.0f * 8192.0f);
#pragma unroll
                    for (int h = 0; h < 2; ++h) {
#pragma unroll
                        for (int q = 0; q < 4; ++q) { float sn, cs; sincospif(-2.0f * (float)(q * (2 * bt + h)) / 2048.0f, &sn, &cs); t4r[h][q] = cs * s4; t4i[h][q] = sn * s4; }
#pragma unroll
                        for (int q = 0; q < 16; ++q) { float sn, cs; sincospif(-2.0f * (float)(q * (2 * bt + h)) / 8192.0f, &sn, &cs); t16r[h][q] = cs * s16; t16i[h][q] = sn * s16; } } }
                for (int un = bx; un < 32 * 32; un += G) { const int seq = un >> 5, p = (un & 31) * 8 + bh * 4; butterfly_unit<4, 4>(seq * 2048, seq * 1024 + p, p, bt, ZT, YQ, t4r, t4i); }
                for (int un = bx; un < 4 * 128; un += G) { const int seq = un >> 7, p = (un & 127) * 2 + bh; butterfly_unit<16, 1>(MP + seq * 8192, 32768 + seq * 4096 + p, p, bt, ZT, YQ, t16r, t16i); }
            }
        } else if (PHON(6) && sub == 2) {
            pg8::Gemm g{YQ, TT, NYQ, 512, 1024, 1024, 1024}; pg8::StaticOrder S; S.init(NYQ, 512, G, bx);
            pg8::EpiDFT E{Y};
            pg8::gemm_phase<pg8::EpiDFT, pg8::StaticOrder, true>(lds, g, S, E);
        } else if (sub == 3) {
            pg8::ProgG34 PG; PG.S.init(MTOK, DM, G, bx); PG.Y = Y; PG.XB = XB; PG.wsb = (const char*)ws; PG.WM = WM; PG.layer = layer;
            pg8::EpiG34 EG{RS, PB + (size_t)bx * 65536, PB + (size_t)(256 + bx) * 65536, MG};
            pg8::gemm_multi<pg8::EpiG34, pg8::ProgG34>(lds, PG, EG);
        } else if (PHON(10) && sub == 4) {
            pg8::Gemm g{MG, WO, MTOK, DM, DM, DM, DM}; pg8::StaticOrder S; S.init(MTOK, DM, G, bx);
            pg8::EpiG5 E{Y, SS};
            pg8::gemm_phase<pg8::EpiG5, pg8::StaticOrder, true>(lds, g, S, E);
        }
    }
}

extern "C" void kernel_launch(void* const* d_in, const int* in_sizes, int n_in, void* d_out, int out_size, void* d_ws, size_t ws_size, hipStream_t stream) {
    static int grid = 0;
    if (grid == 0) {
        if (n_in != 14 || ws_size < WS_END) { fprintf(stderr, "kernel_launch: bad inputs (n_in %d, ws %zu < %zu)\n", n_in, ws_size, (size_t)WS_END); grid = -1; return; }
        int dev = 0, cus = 0, per_cu = 0;
        hipGetDevice(&dev); hipDeviceGetAttribute(&cus, hipDeviceAttributeMultiprocessorCount, dev);
        if (hipFuncSetAttribute((const void*)fwd_kernel, hipFuncAttributeMaxDynamicSharedMemorySize, LDS_BYTES) != hipSuccess) { fprintf(stderr, "hipFuncSetAttribute failed\n"); grid = -1; return; }
        hipOccupancyMaxActiveBlocksPerMultiprocessor(&per_cu, (const void*)fwd_kernel, NWAVES * 64, LDS_BYTES);
        (void)hipGetLastError();
        if (per_cu < 1) { fprintf(stderr, "occupancy query says 0 blocks per CU\n"); }
        grid = cus;
    }
    if (grid < 0) return;
    Args a{};
    for (int i = 0; i < 14; ++i) a.in[i] = (const float*)d_in[i];
    a.out = (float*)d_out; a.ws = (unsigned char*)d_ws;
#if MK_ONE_LAUNCH
    a.ph_lo = 0; a.ph_hi = 13;
    void* kargs[] = {&a};
    hipError_t e = hipLaunchCooperativeKernel((const void*)fwd_kernel, dim3(grid), dim3(NWAVES * 64), kargs, LDS_BYTES, stream);
    if (e != hipSuccess) fprintf(stderr, "cooperative launch failed: %s (grid %d)\n", hipGetErrorString(e), grid);
#else
    for (int ph = 0; ph < 13; ++ph) {
        a.ph_lo = ph; a.ph_hi = ph + 1;
        hipLaunchKernelGGL(fwd_kernel, dim3(grid), dim3(NWAVES * 64), LDS_BYTES, stream, a);
    }
#endif
}
```

```cpp
#include <hip/hip_runtime.h>
#include <hip/hip_cooperative_groups.h>
#include <cstdio>
#include <cstdint>
namespace cg = cooperative_groups;

#ifndef MK_ONE_LAUNCH
#define MK_ONE_LAUNCH 1
#endif

#ifndef PH_MASK
#define PH_MASK 0xFFFF
#endif
#define PHON(k) (((PH_MASK) >> (k)) & 1)
#define LAS __attribute__((address_space(3)))
typedef unsigned short bf16_t;
typedef short bf16x8 __attribute__((ext_vector_type(8)));
typedef short s16x4 __attribute__((ext_vector_type(4)));
typedef float f32x4 __attribute__((ext_vector_type(4)));
typedef unsigned u32x4 __attribute__((ext_vector_type(4)));
typedef unsigned u32x2 __attribute__((ext_vector_type(2)));

constexpr int DM = 1024;
constexpr int MP = 65536;
constexpr int MTOK = 98304;
constexpr int DIN = 6400;
constexpr int NG1 = 3584;
constexpr int ZMW = 1536;
constexpr int NYQ = 49152;
constexpr float EPS = 1e-6f;

constexpr size_t MiB = 1u << 20;
constexpr size_t WS_WIN = 0;
constexpr size_t WS_WG = 10 * MiB;
constexpr size_t WS_WM = 14 * MiB;
constexpr size_t WS_WA = 26 * MiB;
constexpr size_t WS_WB = 28 * MiB;
constexpr size_t WS_WC = 29 * MiB;
constexpr size_t WS_WO = 30 * MiB;
constexpr size_t WS_T = 34 * MiB;
constexpr size_t WS_RS = 35 * MiB;
constexpr size_t WS_SS = 35 * MiB + 512 * 1024;
constexpr size_t WS_XB = 36 * MiB;
constexpr size_t WS_ZM = 228 * MiB;
constexpr size_t WS_ZT = 516 * MiB;
constexpr size_t WS_YQ = 708 * MiB;
constexpr size_t WS_Y = 804 * MiB;
constexpr size_t WS_END = 996 * MiB;

constexpr int NWAVES = 8;
constexpr int LDS_BYTES = 163840;

__device__ __forceinline__ unsigned f2bf(float f) { unsigned u = __builtin_bit_cast(unsigned, f); return (u + 0x7fffu + ((u >> 16) & 1u)) >> 16; }
__device__ __forceinline__ unsigned pk2(float lo, float hi) { unsigned r; asm("v_cvt_pk_bf16_f32 %0, %1, %2" : "=v"(r) : "v"(lo), "v"(hi)); return r; }
__device__ __forceinline__ float bf2f(unsigned b) { return __builtin_bit_cast(float, b << 16); }
__device__ __forceinline__ float bflo(unsigned w) { return __builtin_bit_cast(float, w << 16); }
__device__ __forceinline__ float bfhi(unsigned w) { return __builtin_bit_cast(float, w & 0xffff0000u); }
__device__ __forceinline__ float sigmoidf_(float x) { return __builtin_amdgcn_rcpf(1.0f + __expf(-x)); }
__device__ __forceinline__ float siluf_(float x) { return x * __builtin_amdgcn_rcpf(1.0f + __expf(-x)); }
__device__ __forceinline__ float wave_sum(float v) {
#pragma unroll
    for (int o = 1; o < 64; o <<= 1) v += __shfl_xor(v, o);
    return v;
}
#define LDS_WAIT() asm volatile("s_waitcnt lgkmcnt(0)" ::: "memory")
#define GAS __attribute__((address_space(1)))

namespace pg8 {
constexpr int BM = 256, BK = 64, HALF = 128, HTB = HALF * BK * 2, STAGE_BYTES = 8 * HTB, NXCD = 8, WGM = 8;
__device__ __forceinline__ int lds_byte(int r, int c) { const int st = (r >> 4) * 2 + (c >> 5), rr = r & 15, cc = c & 31, ob = rr * 64 + cc * 2; return st * 1024 + (ob ^ (((ob >> 9) & 1) << 5)); }
__device__ __forceinline__ void stage_rc(int b, int& R, int& C) { const int st = b / 1024, sb = b % 1024, swz = sb ^ (((sb >> 9) & 1) << 5); R = (st >> 1) * 16 + swz / 64; C = (st & 1) * 32 + (swz % 64) / 2; }

__device__ __forceinline__ int perm32(int rho) { const int n = rho >> 4, i = rho & 15; return 8 * (i >> 2) + 4 * n + (i & 3); }
struct Unit { int pm, pn; };
struct Gemm { const bf16_t* A; const bf16_t* Bt; int M, N, K, lda, ldb; };

struct StaticOrder {
    int nM, nN, nwg, G, c;
    __device__ __forceinline__ void init(int M, int N, int G_, int c_) { nM = M / BM; nN = N / BM; nwg = nM * nN; G = G_; c = c_; }
    __device__ __forceinline__ bool next(int i, Unit& u) const {
        const long L = (long)i * G + c; if (L >= nwg) return false;
        int wgid = (int)L; { const int q = nwg / NXCD, r = nwg % NXCD, xcd = wgid % NXCD, off = wgid / NXCD; wgid = (xcd < r ? xcd * (q + 1) : r * (q + 1) + (xcd - r) * q) + off; }
        const int nig = WGM * nN, gid = wgid / nig, fm = gid * WGM, gsz = (nM - fm) < WGM ? (nM - fm) : WGM;
        u.pm = fm + ((wgid % nig) % gsz); u.pn = (wgid % nig) / gsz; return true;
    }
};

struct SingleUnit { Unit u; __device__ bool next(int i, Unit& o) const { if (i) return false; o = u; return true; } };
template <class Epi, class Sched, bool ALIGN_EPI>
__device__ __forceinline__ void gemm_phase(LAS unsigned char* lds, const Gemm g, const Sched& S, const Epi& E) {
    int tid = threadIdx.x; asm volatile("" : "+v"(tid));
    const int wid = __builtin_amdgcn_readfirstlane(tid >> 6), lane = tid & 63, wr = wid >> 2, wc = wid & 3, fr = lane & 15, fq = lane >> 4;
    const int K = g.K, nt = K / BK;
    unsigned voffA[2], voffB[2];
#pragma unroll
    for (int i = 0; i < 2; ++i) { int R, C; stage_rc(tid * 16 + i * 8192, R, C);
        const int Rb = (R & ~31) + perm32(R & 31);
        voffA[i] = (unsigned)(R * g.lda + C) * 2u; voffB[i] = (unsigned)(Rb * g.ldb + C) * 2u; }
    const size_t kstep = (size_t)(BK * 2);
    const size_t hstepA = (size_t)HALF * g.lda * 2, hstepB = (size_t)HALF * g.ldb * 2;
    const size_t tstepA = 2 * hstepA, tstepB = 2 * hstepB;
    const unsigned ldsw = (unsigned)wid * 1024u;
    const int aoff = lds_byte(wr * 64 + fr, fq * 8), boff = lds_byte(wc * 32 + fr, fq * 8);
#define PG8_SA(b, h) (((b) * 2 + (h)) * HTB)
#define PG8_SB(b, h) ((4 + (b) * 2 + (h)) * HTB)
#define PG8_STAGE(bufoff, gbase, voff) do { _Pragma("unroll") for (int _i = 0; _i < 2; ++_i) \
        __builtin_amdgcn_global_load_lds((const unsigned*)((const char*)(gbase) + (voff)[_i]), (LAS unsigned*)(lds + (bufoff) + ldsw + _i * 8192), 16, 0, 0); } while (0)
#define PG8_LDA(dst, b, h) do { _Pragma("unroll") for (int m = 0; m < 4; ++m) _Pragma("unroll") for (int k = 0; k < 2; ++k) dst[m][k] = *(const LAS bf16x8*)(lds + PG8_SA(b, h) + aoff + m * 2048 + k * 1024); } while (0)
#define PG8_LDB(dst, b, h) do { _Pragma("unroll") for (int n = 0; n < 2; ++n) _Pragma("unroll") for (int k = 0; k < 2; ++k) dst[n][k] = *(const LAS bf16x8*)(lds + PG8_SB(b, h) + boff + n * 2048 + k * 1024); } while (0)
#define PG8_MMA(ai, bj, At, Bt) do { __builtin_amdgcn_s_setprio(1); _Pragma("unroll") for (int m = 0; m < 4; ++m) _Pragma("unroll") for (int n = 0; n < 2; ++n) _Pragma("unroll") for (int k = 0; k < 2; ++k) \
        acc[ai][bj][m][n] = __builtin_amdgcn_mfma_f32_16x16x32_bf16(Bt[n][k], At[m][k], acc[ai][bj][m][n], 0, 0, 0); __builtin_amdgcn_s_setprio(0); } while (0)
#define PG8_WAIT_V(n) asm volatile("s_waitcnt vmcnt(" #n ")" ::: "memory")
#define PG8_WAIT_L(n) asm volatile("s_waitcnt lgkmcnt(" #n ")" ::: "memory")
#define PG8_BAR __builtin_amdgcn_s_barrier()
#define PG8_SCHED __builtin_amdgcn_sched_barrier(0)
    Unit cur, nxt; int ui = 0;
    if (!S.next(0, cur)) return;
    f32x4 acc[2][2][4][2];
#pragma unroll
    for (int a = 0; a < 2; ++a)
#pragma unroll
        for (int b = 0; b < 2; ++b)
#pragma unroll
            for (int m = 0; m < 4; ++m)
#pragma unroll
                for (int n = 0; n < 2; ++n) acc[a][b][m][n] = (f32x4){0.f, 0.f, 0.f, 0.f};
    bf16x8 At[4][2], B0[2][2], B1[2][2];
    const char* cA = (const char*)g.A + (size_t)cur.pm * tstepA; const char* cB = (const char*)g.Bt + (size_t)cur.pn * tstepB;
    PG8_STAGE(PG8_SB(0, 0), cB, voffB); PG8_STAGE(PG8_SB(0, 1), cB + hstepB, voffB); PG8_STAGE(PG8_SA(0, 0), cA, voffA); PG8_STAGE(PG8_SA(0, 1), cA + hstepA, voffA);
    if (wr == 1) PG8_BAR;
    PG8_WAIT_V(2); PG8_BAR;
    PG8_STAGE(PG8_SB(1, 0), cB + kstep, voffB); PG8_STAGE(PG8_SA(1, 0), cA + kstep, voffA); PG8_STAGE(PG8_SB(1, 1), cB + hstepB + kstep, voffB);
    PG8_WAIT_V(6); PG8_BAR;
    for (;;) {
        const bool has_next = S.next(ui + 1, nxt);
        const char* nA = has_next ? (const char*)g.A + (size_t)nxt.pm * tstepA : cA; const char* nB = has_next ? (const char*)g.Bt + (size_t)nxt.pn * tstepB : cB;
        for (int t = 0; t < nt; t += 2) {
            const bool last = (t == nt - 2);
            const char* a1 = cA + (size_t)(t + 1) * kstep;
            const char* a2 = last ? nA : cA + (size_t)(t + 2) * kstep; const char* b2 = last ? nB : cB + (size_t)(t + 2) * kstep;
            const char* a3 = a2 + kstep; const char* b3 = b2 + kstep;
            PG8_LDB(B0, 0, 0); PG8_LDB(B1, 0, 1); PG8_SCHED; PG8_LDA(At, 0, 0); PG8_STAGE(PG8_SA(1, 1), a1 + hstepA, voffA);
            PG8_WAIT_V(8); PG8_WAIT_L(0); PG8_BAR; PG8_MMA(0, 0, At, B0); PG8_MMA(0, 1, At, B1); PG8_BAR; PG8_SCHED;
            PG8_LDA(At, 0, 1); PG8_STAGE(PG8_SB(0, 0), b2, voffB); PG8_STAGE(PG8_SB(0, 1), b2 + hstepB, voffB); PG8_STAGE(PG8_SA(0, 0), a2, voffA);
            PG8_WAIT_V(8); PG8_WAIT_L(0); PG8_BAR; PG8_MMA(1, 0, At, B0); PG8_MMA(1, 1, At, B1); PG8_BAR; PG8_SCHED;
            PG8_LDB(B0, 1, 0); PG8_LDB(B1, 1, 1); PG8_SCHED; PG8_LDA(At, 1, 0); PG8_STAGE(PG8_SA(0, 1), a2 + hstepA, voffA);
            PG8_WAIT_V(8); PG8_WAIT_L(0); PG8_BAR; PG8_MMA(0, 0, At, B0); PG8_MMA(0, 1, At, B1); PG8_BAR; PG8_SCHED;
            PG8_LDA(At, 1, 1); PG8_STAGE(PG8_SB(1, 0), b3, voffB); PG8_STAGE(PG8_SB(1, 1), b3 + hstepB, voffB); PG8_STAGE(PG8_SA(1, 0), a3, voffA);
            PG8_WAIT_V(8); PG8_WAIT_L(0); PG8_BAR; PG8_MMA(1, 0, At, B0); PG8_MMA(1, 1, At, B1); PG8_BAR; PG8_SCHED;
        }
        if constexpr (ALIGN_EPI) { if (wr == 0) PG8_BAR; }
        E(acc, cur, wr, wc, fr, fq);
        if (!has_next) break;
#pragma unroll
        for (int a = 0; a < 2; ++a)
#pragma unroll
            for (int b = 0; b < 2; ++b)
#pragma unroll
                for (int m = 0; m < 4; ++m)
#pragma unroll
                    for (int n = 0; n < 2; ++n) acc[a][b][m][n] = (f32x4){0.f, 0.f, 0.f, 0.f};
        cur = nxt; cA = nA; cB = nB; ++ui;
        if constexpr (ALIGN_EPI) { if (wr == 1) PG8_BAR; }
    }
    PG8_WAIT_V(0);
    if constexpr (!ALIGN_EPI) { if (wr == 0) PG8_BAR; }
    PG8_BAR;
#undef PG8_SA
#undef PG8_SB
#undef PG8_STAGE
#undef PG8_LDA
#undef PG8_LDB
#undef PG8_MMA
#undef PG8_WAIT_V
#undef PG8_WAIT_L
#undef PG8_BAR
#undef PG8_SCHED
}

struct UnitX { int pm, pn, seg; };
__device__ __forceinline__ int uni(int v) { return __builtin_amdgcn_readfirstlane(v); }
__device__ __forceinline__ const char* unip(const char* p) { const unsigned long long v = (unsigned long long)p; const unsigned lo = (unsigned)__builtin_amdgcn_readfirstlane((int)(unsigned)v), hi = (unsigned)__builtin_amdgcn_readfirstlane((int)(unsigned)(v >> 32)); return (const char*)(((unsigned long long)hi << 32) | lo); }
template <class Epi, class Prog>
__device__ __forceinline__ void gemm_multi(LAS unsigned char* lds, const Prog& P, const Epi& E) {
    int tid = threadIdx.x; asm volatile("" : "+v"(tid));
    const int wid = __builtin_amdgcn_readfirstlane(tid >> 6), lane = tid & 63, wr = wid >> 2, wc = wid & 3, fr = lane & 15, fq = lane >> 4;
    unsigned Rr[2], RrB[2], Cc2[2];
#pragma unroll
    for (int i = 0; i < 2; ++i) { int R, C; stage_rc(tid * 16 + i * 8192, R, C); Rr[i] = (unsigned)R * 2u; RrB[i] = (unsigned)((R & ~31) + perm32(R & 31)) * 2u; Cc2[i] = (unsigned)C * 2u; }
    const size_t kstep = (size_t)(BK * 2);
    const unsigned ldsw = (unsigned)wid * 1024u;
    const int aoff = lds_byte(wr * 64 + fr, fq * 8), boff = lds_byte(wc * 32 + fr, fq * 8);
#define PG8_SA(b, h) (((b) * 2 + (h)) * HTB)
#define PG8_SB(b, h) ((4 + (b) * 2 + (h)) * HTB)
#define PG8_STAGE_X(RR, bufoff, gbase, ld) do { _Pragma("unroll") for (int _i = 0; _i < 2; ++_i) \
        __builtin_amdgcn_global_load_lds((const unsigned*)((const char*)(gbase) + (RR[_i] * (unsigned)(ld) + Cc2[_i])), (LAS unsigned*)(lds + (bufoff) + ldsw + _i * 8192), 16, 0, 0); } while (0)
#define PG8_STAGE(bufoff, gbase, ld) PG8_STAGE_X(Rr, bufoff, gbase, ld)
#define PG8_STAGEB(bufoff, gbase, ld) PG8_STAGE_X(RrB, bufoff, gbase, ld)
#define PG8_LDA(dst, b, h) do { _Pragma("unroll") for (int m = 0; m < 4; ++m) _Pragma("unroll") for (int k = 0; k < 2; ++k) dst[m][k] = *(const LAS bf16x8*)(lds + PG8_SA(b, h) + aoff + m * 2048 + k * 1024); } while (0)
#define PG8_LDB(dst, b, h) do { _Pragma("unroll") for (int n = 0; n < 2; ++n) _Pragma("unroll") for (int k = 0; k < 2; ++k) dst[n][k] = *(const LAS bf16x8*)(lds + PG8_SB(b, h) + boff + n * 2048 + k * 1024); } while (0)
#define PG8_MMA(ai, bj, At, Bt) do { __builtin_amdgcn_s_setprio(1); _Pragma("unroll") for (int m = 0; m < 4; ++m) _Pragma("unroll") for (int n = 0; n < 2; ++n) _Pragma("unroll") for (int k = 0; k < 2; ++k) \
        acc[ai][bj][m][n] = __builtin_amdgcn_mfma_f32_16x16x32_bf16(Bt[n][k], At[m][k], acc[ai][bj][m][n], 0, 0, 0); __builtin_amdgcn_s_setprio(0); } while (0)
#define PG8_WAIT_V(n) asm volatile("s_waitcnt vmcnt(" #n ")" ::: "memory")
#define PG8_WAIT_L(n) asm volatile("s_waitcnt lgkmcnt(" #n ")" ::: "memory")
#define PG8_BAR __builtin_amdgcn_s_barrier()
#define PG8_SCHED __builtin_amdgcn_sched_barrier(0)
    UnitX cur, nxt; int ui = 0;
    if (!P.next(0, cur)) return;
    f32x4 acc[2][2][4][2];
#pragma unroll
    for (int a = 0; a < 2; ++a)
#pragma unroll
        for (int b = 0; b < 2; ++b)
#pragma unroll
            for (int m = 0; m < 4; ++m)
#pragma unroll
                for (int n = 0; n < 2; ++n) acc[a][b][m][n] = (f32x4){0.f, 0.f, 0.f, 0.f};
    bf16x8 At[4][2], B0[2][2], B1[2][2];
    const char* cA; const char* cB; int lda, ldb, nt;
    P.desc(cur, cA, cB, lda, ldb, nt); cA = unip(cA); cB = unip(cB); lda = uni(lda); ldb = uni(ldb); nt = uni(nt);
    {   const size_t hA = (size_t)HALF * lda * 2, hB = (size_t)HALF * ldb * 2;
        PG8_STAGEB(PG8_SB(0, 0), cB, ldb); PG8_STAGEB(PG8_SB(0, 1), cB + hB, ldb); PG8_STAGE(PG8_SA(0, 0), cA, lda); PG8_STAGE(PG8_SA(0, 1), cA + hA, lda);
        if (wr == 1) PG8_BAR;
        PG8_WAIT_V(2); PG8_BAR;
        PG8_STAGEB(PG8_SB(1, 0), cB + kstep, ldb); PG8_STAGE(PG8_SA(1, 0), cA + kstep, lda); PG8_STAGEB(PG8_SB(1, 1), cB + hB + kstep, ldb);
        PG8_WAIT_V(6); PG8_BAR; }
    for (;;) {
        const bool has_next = P.next(ui + 1, nxt);
        const char* nA = cA; const char* nB = cB; int ldan = lda, ldbn = ldb, ntn = nt;
        if (has_next) P.desc(nxt, nA, nB, ldan, ldbn, ntn);
        nA = unip(nA); nB = unip(nB); ldan = uni(ldan); ldbn = uni(ldbn); ntn = uni(ntn);
        const size_t hAc = (size_t)HALF * lda * 2;
        for (int t = 0; t < nt; t += 2) {
            const bool last = (t == nt - 2);
            const char* a1 = cA + (size_t)(t + 1) * kstep;
            const char* a2 = last ? nA : cA + (size_t)(t + 2) * kstep; const char* b2 = last ? nB : cB + (size_t)(t + 2) * kstep;
            const int lda2 = last ? ldan : lda, ldb2 = last ? ldbn : ldb;
            const size_t hA2 = (size_t)HALF * lda2 * 2, hB2 = (size_t)HALF * ldb2 * 2;
            const char* a3 = a2 + kstep; const char* b3 = b2 + kstep;
            PG8_LDB(B0, 0, 0); PG8_LDB(B1, 0, 1); PG8_SCHED; PG8_LDA(At, 0, 0); PG8_STAGE(PG8_SA(1, 1), a1 + hAc, lda);
            PG8_WAIT_V(8); PG8_WAIT_L(0); PG8_BAR; PG8_MMA(0, 0, At, B0); PG8_MMA(0, 1, At, B1); PG8_BAR; PG8_SCHED;
            PG8_LDA(At, 0, 1); PG8_STAGEB(PG8_SB(0, 0), b2, ldb2); PG8_STAGEB(PG8_SB(0, 1), b2 + hB2, ldb2); PG8_STAGE(PG8_SA(0, 0), a2, lda2);
            PG8_WAIT_V(8); PG8_WAIT_L(0); PG8_BAR; PG8_MMA(1, 0, At, B0); PG8_MMA(1, 1, At, B1); PG8_BAR; PG8_SCHED;
            PG8_LDB(B0, 1, 0); PG8_LDB(B1, 1, 1); PG8_SCHED; PG8_LDA(At, 1, 0); PG8_STAGE(PG8_SA(0, 1), a2 + hA2, lda2);
            PG8_WAIT_V(8); PG8_WAIT_L(0); PG8_BAR; PG8_MMA(0, 0, At, B0); PG8_MMA(0, 1, At, B1); PG8_BAR; PG8_SCHED;
            PG8_LDA(At, 1, 1); PG8_STAGEB(PG8_SB(1, 0), b3, ldb2); PG8_STAGEB(PG8_SB(1, 1), b3 + hB2, ldb2); PG8_STAGE(PG8_SA(1, 0), a3, lda2);
            PG8_WAIT_V(8); PG8_WAIT_L(0); PG8_BAR; PG8_MMA(1, 0, At, B0); PG8_MMA(1, 1, At, B1); PG8_BAR; PG8_SCHED;
        }
        if (wr == 0) PG8_BAR;
        E(acc, cur, wr, wc, fr, fq);
        if (!has_next) break;
#pragma unroll
        for (int a = 0; a < 2; ++a)
#pragma unroll
            for (int b = 0; b < 2; ++b)
#pragma unroll
                for (int m = 0; m < 4; ++m)
#pragma unroll
                    for (int n = 0; n < 2; ++n) acc[a][b][m][n] = (f32x4){0.f, 0.f, 0.f, 0.f};
        cur = nxt; cA = nA; cB = nB; lda = ldan; ldb = ldbn; nt = ntn; ++ui;
        if (wr == 1) PG8_BAR;
    }
    PG8_WAIT_V(0);
    PG8_BAR;
#undef PG8_SA
#undef PG8_SB
#undef PG8_STAGE
#undef PG8_STAGEB
#undef PG8_STAGE_X
#undef PG8_LDA
#undef PG8_LDB
#undef PG8_MMA
#undef PG8_WAIT_V
#undef PG8_WAIT_L
#undef PG8_BAR
#undef PG8_SCHED
}

#define EPI_ROWS_BEGIN  _Pragma("unroll") for (int ai = 0; ai < 2; ++ai) _Pragma("unroll") for (int m = 0; m < 4; ++m) { const int row = u.pm * BM + ai * HALF + wr * 64 + m * 16 + fr;
#define EPI_COLS_BEGIN  _Pragma("unroll") for (int bj = 0; bj < 2; ++bj) _Pragma("unroll") for (int n = 0; n < 2; ++n) { const int col = bj * HALF + wc * 32 + 8 * fq + 4 * n; f32x4 v = acc[ai][bj][m][n];
#define EPI_END } }
#define EPI_COLS8_BEGIN  _Pragma("unroll") for (int bj = 0; bj < 2; ++bj) { const int col = bj * HALF + wc * 32 + 8 * fq; const f32x4 v0 = acc[ai][bj][m][0], v1 = acc[ai][bj][m][1];

struct EpiG1 {
    const float* rs; bf16_t* ZM; bf16_t* ZT; bf16_t* Y;
    __device__ __forceinline__ void operator()(const f32x4 (&acc)[2][2][4][2], const Unit& u, int wr, int wc, int fr, int fq) const {
        const int pn = u.pn;
        if (pn >= 10) {
            const int cm = (pn - 10) * 256;
            EPI_ROWS_BEGIN
            EPI_COLS8_BEGIN
                u32x4 w; w.x = pk2(siluf_(v0[0]), siluf_(v0[1])); w.y = pk2(siluf_(v0[2]), siluf_(v0[3])); w.z = pk2(siluf_(v1[0]), siluf_(v1[1])); w.w = pk2(siluf_(v1[2]), siluf_(v1[3]));
                *(GAS u32x4*)((GAS bf16_t*)Y + (size_t)row * DM + cm + col) = w;
            EPI_END
            return;
        }
        if (pn >= 4 && pn < 6) {
            const int d0 = (pn - 4) * 256;
            EPI_ROWS_BEGIN
            EPI_COLS_BEGIN
                GAS bf16_t* d = (GAS bf16_t*)ZT + ((size_t)(row >> 6) * 512 + d0 + col) * 64 + (row & 63);
                const unsigned w0 = pk2(v[0], v[1]), w1 = pk2(v[2], v[3]);
                d[0] = (bf16_t)w0; d[64] = (bf16_t)(w0 >> 16); d[128] = (bf16_t)w1; d[192] = (bf16_t)(w1 >> 16);
            EPI_END
        } else if (pn >= 6 && pn < 8) {
            const int j0 = (pn - 6) * 256;
            EPI_ROWS_BEGIN
            EPI_COLS_BEGIN
                GAS bf16_t* d = (GAS bf16_t*)ZT + (size_t)MTOK * 512 + ((size_t)(row >> 9) * 512 + j0 + col) * 512 + (row & 511);
                const unsigned w0 = pk2(v[0], v[1]), w1 = pk2(v[2], v[3]);
                d[0] = (bf16_t)w0; d[512] = (bf16_t)(w0 >> 16); d[1024] = (bf16_t)w1; d[1536] = (bf16_t)(w1 >> 16);
            EPI_END
        } else {
            const int cm = (pn < 4 ? pn : pn - 4) * 256;
            EPI_ROWS_BEGIN
            EPI_COLS8_BEGIN
                u32x4 w; w.x = pk2(v0[0], v0[1]); w.y = pk2(v0[2], v0[3]); w.z = pk2(v1[0], v1[1]); w.w = pk2(v1[2], v1[3]);
                *(GAS u32x4*)((GAS bf16_t*)ZM + (size_t)row * ZMW + cm + col) = w;
            EPI_END
        }
    }
};
struct EpiDFT {
    bf16_t* Y;
    __device__ __forceinline__ void operator()(const f32x4 (&acc)[2][2][4][2], const Unit& u, int wr, int wc, int fr, int fq) const {
        int tok0, R, q;
        if (u.pm < 128) { tok0 = (u.pm >> 2) * 2048; R = 4; q = u.pm & 3; } else { const int t = u.pm - 128; tok0 = MP + (t >> 4) * 8192; R = 16; q = t & 15; }
#pragma unroll
        for (int ai = 0; ai < 2; ++ai)
#pragma unroll
            for (int m = 0; m < 4; ++m) {
                const int p = ai * HALF + wr * 64 + m * 16 + fr;
                GAS bf16_t* db = (GAS bf16_t*)Y + (size_t)(tok0 + q) * DM + 512 + p;
                bf16_t gv[2][2][4];
#pragma unroll
                for (int bj = 0; bj < 2; ++bj)
#pragma unroll
                    for (int n = 0; n < 2; ++n)
#pragma unroll
                        for (int e = 0; e < 4; ++e) gv[bj][n][e] = db[(size_t)R * (u.pn * BM + bj * HALF + wc * 32 + 8 * fq + 4 * n + e) * DM];
                __builtin_amdgcn_sched_barrier(0);
#pragma unroll
                for (int bj = 0; bj < 2; ++bj)
#pragma unroll
                    for (int n = 0; n < 2; ++n) {
                        const f32x4 v = acc[ai][bj][m][n];
                        const unsigned w0 = pk2(v[0] * bf2f(gv[bj][n][0]), v[1] * bf2f(gv[bj][n][1])), w1 = pk2(v[2] * bf2f(gv[bj][n][2]), v[3] * bf2f(gv[bj][n][3]));
                        GAS bf16_t* d = db + (size_t)R * (u.pn * BM + bj * HALF + wc * 32 + 8 * fq + 4 * n) * DM;
                        d[0] = (bf16_t)w0; d[(size_t)R * DM] = (bf16_t)(w0 >> 16); d[(size_t)2 * R * DM] = (bf16_t)w1; d[(size_t)3 * R * DM] = (bf16_t)(w1 >> 16);
                    }
                __builtin_amdgcn_sched_barrier(0);
            }
    }
};
struct EpiG2 {
    const float* rs; bf16_t* Y;
    __device__ __forceinline__ void operator()(const f32x4 (&acc)[2][2][4][2], const Unit& u, int wr, int wc, int fr, int fq) const {
        EPI_ROWS_BEGIN
        EPI_COLS8_BEGIN
            GAS u32x4* p = (GAS u32x4*)((GAS bf16_t*)Y + (size_t)row * DM + u.pn * BM + col);
            const u32x4 y = *p; u32x4 w;
            w.x = pk2(bflo(y.x) * siluf_(v0[0]), bfhi(y.x) * siluf_(v0[1])); w.y = pk2(bflo(y.y) * siluf_(v0[2]), bfhi(y.y) * siluf_(v0[3]));
            w.z = pk2(bflo(y.z) * siluf_(v1[0]), bfhi(y.z) * siluf_(v1[1])); w.w = pk2(bflo(y.w) * siluf_(v1[2]), bfhi(y.w) * siluf_(v1[3]));
            *p = w;
        EPI_END
    }
};
struct ProgG34 {
    StaticOrder S; const bf16_t* Y; const bf16_t* XB; const char* wsb; const bf16_t* WM; int layer;
    __device__ __forceinline__ bool next(int i, UnitX& u) const { Unit t; if (!S.next(i / 6, t)) return false; u.pm = t.pm; u.pn = t.pn; u.seg = i % 6; return true; }
    __device__ __forceinline__ void desc(const UnitX& u, const char*& A, const char*& B, int& lda, int& ldb, int& nt) const {
        const int b = u.seg >> 1; lda = DM;
        if (u.seg & 1) { A = (const char*)(XB + (size_t)u.pm * BM * DM); B = (const char*)(WM + (size_t)b * DM * DM + (size_t)u.pn * BM * DM); ldb = DM; nt = DM / BK; }
        else { const int kb = (b == 0) ? 512 : 256, ac = (b == 0) ? 0 : (b == 1 ? 512 : 768);
            const size_t woff = (size_t)((b == 0) ? 26 : 27 + b) * MiB + (size_t)layer * ((b == 0) ? MiB : MiB / 2);
            const bf16_t* w = (const bf16_t*)(wsb + woff);
            A = (const char*)(Y + (size_t)u.pm * BM * DM + ac); B = (const char*)(w + (size_t)u.pn * BM * kb); ldb = kb; nt = kb / BK; }
    }
};
struct EpiG34 {
    const float* rs; bf16_t* PT; bf16_t* MT; bf16_t* MG;
    __device__ __forceinline__ void operator()(const f32x4 (&acc)[2][2][4][2], const UnitX& u, int wr, int wc, int fr_, int fq_) const {
        int fr = fr_, fq = fq_; asm volatile("" : "+v"(fr), "+v"(fq));
        if ((u.seg & 1) == 0) {
            EPI_ROWS_BEGIN
            EPI_COLS8_BEGIN
                u32x4 w; w.x = pk2(v0[0], v0[1]); w.y = pk2(v0[2], v0[3]); w.z = pk2(v1[0], v1[1]); w.w = pk2(v1[2], v1[3]);
                *(GAS u32x4*)(PT + (size_t)(row - u.pm * BM) * 256 + col) = w;
            EPI_END
        } else {
            const int mode = u.seg >> 1;
            GAS bf16_t* dst = (mode == 2) ? (GAS bf16_t*)MG + (size_t)u.pm * BM * DM + u.pn * BM : (GAS bf16_t*)MT;
            const int dld = (mode == 2) ? DM : 256;
            const int rl0 = wr * 64 + fr, c0 = wc * 32 + 8 * fq;
#pragma unroll
            for (int ai = 0; ai < 2; ++ai) {
                u32x4 pv[4][2], mv[4][2];
#pragma unroll
                for (int m = 0; m < 4; ++m)
#pragma unroll
                    for (int bj = 0; bj < 2; ++bj) pv[m][bj] = *(const GAS u32x4*)(PT + (size_t)(ai * HALF + rl0 + m * 16) * 256 + bj * HALF + c0);
                if (mode != 0) {
#pragma unroll
                    for (int m = 0; m < 4; ++m)
#pragma unroll
                        for (int bj = 0; bj < 2; ++bj) mv[m][bj] = *(const GAS u32x4*)(MT + (size_t)(ai * HALF + rl0 + m * 16) * 256 + bj * HALF + c0);
                } else {
#pragma unroll
                    for (int m = 0; m < 4; ++m)
#pragma unroll
                        for (int bj = 0; bj < 2; ++bj) mv[m][bj] = (u32x4){0u, 0u, 0u, 0u};
                }
                __builtin_amdgcn_sched_barrier(0);
#pragma unroll
                for (int m = 0; m < 4; ++m)
#pragma unroll
                    for (int bj = 0; bj < 2; ++bj) {
                        const f32x4 v0 = acc[ai][bj][m][0], v1 = acc[ai][bj][m][1]; const u32x4 p = pv[m][bj], q = mv[m][bj];
                        const float r0 = bflo(q.x) + bflo(p.x) * sigmoidf_(v0[0]), r1 = bfhi(q.x) + bfhi(p.x) * sigmoidf_(v0[1]), r2 = bflo(q.y) + bflo(p.y) * sigmoidf_(v0[2]), r3 = bfhi(q.y) + bfhi(p.y) * sigmoidf_(v0[3]);
                        const float r4 = bflo(q.z) + bflo(p.z) * sigmoidf_(v1[0]), r5 = bfhi(q.z) + bfhi(p.z) * sigmoidf_(v1[1]), r6 = bflo(q.w) + bflo(p.w) * sigmoidf_(v1[2]), r7 = bfhi(q.w) + bfhi(p.w) * sigmoidf_(v1[3]);
                        u32x4 w; w.x = pk2(r0, r1); w.y = pk2(r2, r3); w.z = pk2(r4, r5); w.w = pk2(r6, r7);
                        *(GAS u32x4*)(dst + (size_t)(ai * HALF + rl0 + m * 16) * dld + bj * HALF + c0) = w;
                    }
                __builtin_amdgcn_sched_barrier(0);
            }
        }
    }
};
struct EpiG5 {
    bf16_t* O; float* ss;
    __device__ __forceinline__ void operator()(const f32x4 (&acc)[2][2][4][2], const Unit& u, int wr, int wc, int fr, int fq) const {
        EPI_ROWS_BEGIN float q = 0.f;
        EPI_COLS8_BEGIN
            u32x4 w; w.x = pk2(v0[0], v0[1]); w.y = pk2(v0[2], v0[3]); w.z = pk2(v1[0], v1[1]); w.w = pk2(v1[2], v1[3]);
            *(GAS u32x4*)((GAS bf16_t*)O + (size_t)row * DM + u.pn * BM + col) = w;
            q += ((v0[0] * v0[0] + v0[1] * v0[1]) + (v0[2] * v0[2] + v0[3] * v0[3])) + ((v1[0] * v1[0] + v1[1] * v1[1]) + (v1[2] * v1[2] + v1[3] * v1[3]));
        }
            q += __shfl_xor(q, 16); q += __shfl_xor(q, 32);
            if (fq == 0) atomicAdd(ss + row, q);
        }
    }
};
}

__device__ __forceinline__ void transpose_item(const float* W_, int K, int pitch, int c0, int ncols, bf16_t* WT_, int row_off, const float* g_, float scale, LAS float* scr, int item, int lane) {
    const GAS float* W = (const GAS float*)W_; GAS bf16_t* WT = (GAS bf16_t*)WT_;
    const int nblk = ncols / 32, kb = item / nblk, nb = item % nblk, k0 = 64 * kb, n0 = 32 * nb;
    float wv[32];
#pragma unroll
    for (int i = 0; i < 32; ++i) wv[i] = W[(size_t)(k0 + 2 * i + (lane >> 5)) * pitch + c0 + n0 + (lane & 31)];
#pragma unroll
    for (int i = 0; i < 32; ++i) scr[(2 * i + (lane >> 5)) * 33 + (lane & 31)] = wv[i];
    LDS_WAIT(); asm volatile("" ::: "memory");
    const int c = lane & 7;
    f32x4 g0 = {scale, scale, scale, scale}, g1 = g0;
    if (g_) { const GAS f32x4* gp = (const GAS f32x4*)((const GAS float*)g_ + k0 + 8 * c); g0 = gp[0] * scale; g1 = gp[1] * scale; }
#pragma unroll
    for (int j = 0; j < 4; ++j) { const int n = (lane >> 3) + 8 * j; const LAS float* sp = scr + (8 * c) * 33 + n;
        u32x4 o; o.x = pk2(sp[0 * 33] * g0[0], sp[1 * 33] * g0[1]); o.y = pk2(sp[2 * 33] * g0[2], sp[3 * 33] * g0[3]); o.z = pk2(sp[4 * 33] * g1[0], sp[5 * 33] * g1[1]); o.w = pk2(sp[6 * 33] * g1[2], sp[7 * 33] * g1[3]);
        *(GAS u32x4*)(WT + (size_t)(row_off + n0 + n) * K + k0 + 8 * c) = o; }
    LDS_WAIT(); asm volatile("" ::: "memory");
}

struct Args { const float* in[14]; float* out; unsigned char* ws; int ph_lo, ph_hi; };

__device__ __forceinline__ void grid_row_info(int gr, int& seqbase, int& r, int& nrows) {
    if (gr < 1024) { seqbase = (gr >> 5) << 11; r = gr & 31; nrows = 32; } else { const int g2 = gr - 1024; seqbase = MP + ((g2 >> 7) << 13); r = g2 & 127; nrows = 128; }
}

constexpr int AT_NSLOT = 9, AT_KSLOT = 9216, AT_VSLOT = 8704, AT_VOFF = AT_NSLOT * AT_KSLOT, AT_BOFF = AT_VOFF + AT_NSLOT * AT_VSLOT;
static_assert(AT_BOFF + 465 * 4 <= LDS_BYTES, "attention LDS map");
__device__ __forceinline__ void attn_fill_issue(const GAS bf16_t* ZM, const GAS bf16_t* ZT, int tok0, int head, int tid, u32x4& kreg, u32x4& vreg) {
    kreg = *(const GAS u32x4*)(ZM + (size_t)(tok0 + (tid >> 3)) * ZMW + 512 + head * 64 + (tid & 7) * 8);
    vreg = *(const GAS u32x4*)(ZT + ((size_t)(tok0 >> 6) * 512 + head * 64) * 64 + tid * 8);
}
__device__ __forceinline__ void attn_fill_write(LAS unsigned char* lds, int slot, int tid, const u32x4 kreg, const u32x4 vreg) {
    *(LAS u32x4*)(lds + slot * AT_KSLOT + (tid >> 3) * 144 + (tid & 7) * 16) = kreg;
    LAS u32x2* vp = (LAS u32x2*)(lds + AT_VOFF + slot * AT_VSLOT + (tid >> 3) * 136 + (tid & 7) * 16);
    u32x2 a; a.x = vreg.x; a.y = vreg.y; u32x2 b; b.x = vreg.z; b.y = vreg.w;
    vp[0] = a; vp[1] = b;
}
__device__ __forceinline__ void attn_row_lds(LAS unsigned char* lds, int seqbase, int r, int rs, int head, int lane, int wave, const bf16x8 bq0, const bf16x8 bq1, GAS bf16_t* Y, const unsigned (&bcp)[32]) {
    const int g = wave & 3;
    const int qi = lane & 15, h4 = lane >> 4;
    const int cs = (g == 0) ? 0 : (g == 1) ? 8 : (g == 2) ? 24 : 32;
    const int qc = 16 * g + qi;
    const int qtok = seqbase + r * 64 + qc;
    const int sb = rs % AT_NSLOT;
    GAS bf16_t* yp = Y + (size_t)qtok * DM + head * 64 + 4 * h4;
    u32x2 gt[4];
#pragma unroll
    for (int dt = 0; dt < 4; ++dt) gt[dt] = *(const GAS u32x2*)(yp + dt * 16);
    f32x4 S[16];
    float mx = -3.0e38f;
#pragma unroll
    for (int hb = 0; hb < 2; ++hb) {
        bf16x8 ak[8][2];
#pragma unroll
        for (int tt = 0; tt < 8; ++tt) {
            const int t = hb * 8 + tt, kr = t >> 1, hf = t & 1;
            int slot = sb + kr; slot = slot >= AT_NSLOT ? slot - AT_NSLOT : slot;
            const LAS unsigned char* kp = lds + slot * AT_KSLOT + (cs + 16 * hf + qi) * 144 + h4 * 16;
            ak[tt][0] = *(const LAS bf16x8*)kp; ak[tt][1] = *(const LAS bf16x8*)(kp + 64);
        }
        __builtin_amdgcn_sched_barrier(0);
#pragma unroll
        for (int tt = 0; tt < 8; ++tt) {
            const int t = hb * 8 + tt;
            f32x4 s = {0.f, 0.f, 0.f, 0.f};
            s = __builtin_amdgcn_mfma_f32_16x16x32_bf16(ak[tt][0], bq0, s, 0, 0, 0);
            s = __builtin_amdgcn_mfma_f32_16x16x32_bf16(ak[tt][1], bq1, s, 0, 0, 0);
            s[0] += bflo(bcp[2 * t]); s[1] += bfhi(bcp[2 * t]); s[2] += bflo(bcp[2 * t + 1]); s[3] += bfhi(bcp[2 * t + 1]);
            mx = fmaxf(mx, fmaxf(fmaxf(s[0], s[1]), fmaxf(s[2], s[3])));
            S[t] = s;
        }
        __builtin_amdgcn_sched_barrier(0);
    }
    mx = fmaxf(mx, __shfl_xor(mx, 16)); mx = fmaxf(mx, __shfl_xor(mx, 32));
    float sum = 0.f;
    bf16x8 pf[8];
#pragma unroll
    for (int kr = 0; kr < 8; ++kr) {
        const f32x4 a = S[kr * 2], b = S[kr * 2 + 1];
        const float p0 = __expf(a[0] - mx), p1 = __expf(a[1] - mx), p2 = __expf(a[2] - mx), p3 = __expf(a[3] - mx);
        const float p4 = __expf(b[0] - mx), p5 = __expf(b[1] - mx), p6 = __expf(b[2] - mx), p7 = __expf(b[3] - mx);
        sum += ((p0 + p1) + (p2 + p3)) + ((p4 + p5) + (p6 + p7));
        u32x4 w; w.x = pk2(p0, p1); w.y = pk2(p2, p3); w.z = pk2(p4, p5); w.w = pk2(p6, p7);
        pf[kr] = __builtin_bit_cast(bf16x8, w);
    }
    sum += __shfl_xor(sum, 16); sum += __shfl_xor(sum, 32);
    const float inv = __builtin_amdgcn_rcpf(sum);
#pragma unroll
    for (int dp = 0; dp < 2; ++dp) {
        u32x2 vf[2][8][2];
#pragma unroll
        for (int dti = 0; dti < 2; ++dti)
#pragma unroll
            for (int kr = 0; kr < 8; ++kr) {
                int slot = sb + kr; slot = slot >= AT_NSLOT ? slot - AT_NSLOT : slot;
                const LAS unsigned char* vp = lds + AT_VOFF + slot * AT_VSLOT + ((2 * dp + dti) * 16 + qi) * 136 + (cs + 4 * h4) * 2;
                vf[dti][kr][0] = *(const LAS u32x2*)vp; vf[dti][kr][1] = *(const LAS u32x2*)(vp + 32);
            }
        __builtin_amdgcn_sched_barrier(0);
#pragma unroll
        for (int dti = 0; dti < 2; ++dti) {
            f32x4 o = {0.f, 0.f, 0.f, 0.f};
#pragma unroll
            for (int kr = 0; kr < 8; ++kr) {
                u32x4 w; w.x = vf[dti][kr][0].x; w.y = vf[dti][kr][0].y; w.z = vf[dti][kr][1].x; w.w = vf[dti][kr][1].y;
                o = __builtin_amdgcn_mfma_f32_16x16x32_bf16(__builtin_bit_cast(bf16x8, w), pf[kr], o, 0, 0, 0);
            }
            const u32x2 gq = gt[2 * dp + dti];
            u32x2 w; w.x = pk2(o[0] * inv * bflo(gq.x), o[1] * inv * bfhi(gq.x)); w.y = pk2(o[2] * inv * bflo(gq.y), o[3] * inv * bfhi(gq.y));
            *(GAS u32x2*)(yp + (2 * dp + dti) * 16) = w;
        }
        __builtin_amdgcn_sched_barrier(0);
    }
}
#define ATT_RS(r_) ((r_) - 4 < 0 ? 0 : ((r_) - 4 > nrows - 8 ? nrows - 8 : (r_) - 4))
__device__ __forceinline__ void attn_unit(LAS unsigned char* lds, int seqbase, int nrows, int ra, int rb, int head, int tid, int lane, int wave,
                                          const bf16_t* ZM_, const bf16_t* ZT_, bf16_t* Y_, const float* rpb) {
    const GAS bf16_t* ZM = (const GAS bf16_t*)ZM_; const GAS bf16_t* ZT = (const GAS bf16_t*)ZT_; GAS bf16_t* Y = (GAS bf16_t*)Y_;
    const int rsel = wave >> 2;
    const int lo = ATT_RS(ra);
    int top = lo + 8;
    {   u32x4 kreg[9], vreg[9];
#pragma unroll
        for (int k = 0; k < 9; ++k) { int row = lo + k; row = row > nrows - 1 ? nrows - 1 : row; attn_fill_issue(ZM, ZT, seqbase + row * 64, head, tid, kreg[k], vreg[k]); }
        LAS float* bw = (LAS float*)(lds + AT_BOFF);
        if (tid < 465) bw[tid] = rpb[head * 465 + tid];
#pragma unroll
        for (int k = 0; k < 9; ++k) attn_fill_write(lds, (lo + k) % AT_NSLOT, tid, kreg[k], vreg[k]);
    }
    const GAS bf16_t* qbase = ZM + (size_t)(seqbase + 16 * (wave & 3) + (lane & 15)) * ZMW + head * 64 + 8 * (lane >> 4);
    bf16x8 q0 = *(const GAS bf16x8*)(qbase + (size_t)(ra + rsel) * 64 * ZMW), q1 = *(const GAS bf16x8*)(qbase + (size_t)(ra + rsel) * 64 * ZMW + 32);
    __syncthreads();
    unsigned bcp[32]; int cdelta = 1000;
#pragma unroll
    for (int i = 0; i < 32; ++i) bcp[i] = 0u;
#pragma unroll 1
    for (int r = ra; r < rb; r += 2) {
        const int rr = r + rsel, rs = ATT_RS(rr);
        if (rs - rr != cdelta) {
            cdelta = rs - rr;
            const LAS float* bias = (const LAS float*)(lds + AT_BOFF);
            const int g_ = wave & 3, qi_ = lane & 15, h4_ = lane >> 4, cs_ = (g_ == 0) ? 0 : (g_ == 1) ? 8 : (g_ == 2) ? 24 : 32, qc_ = 16 * g_ + qi_;
            int cst_ = qc_ - 8; cst_ = cst_ < 0 ? 0 : cst_; cst_ = cst_ > 48 ? 48 : cst_;
#pragma unroll
            for (int t = 0; t < 16; ++t) {
                float bv[4];
#pragma unroll
                for (int e = 0; e < 4; ++e) {
                    const int kc = cs_ + 16 * (t & 1) + 4 * h4_ + e; int dc = kc - qc_ + 15; dc = dc < 0 ? 0 : dc; dc = dc > 30 ? 30 : dc;
                    const float b = bias[(cdelta + (t >> 1) + 7) * 31 + dc];
                    bv[e] = ((kc >= cst_) && (kc < cst_ + 16)) ? b : -1.0e30f;
                }
                bcp[2 * t] = pk2(bv[0], bv[1]); bcp[2 * t + 1] = pk2(bv[2], bv[3]);
            }
        }
        const int rqn = (r + 2 < rb) ? rr + 2 : rr;
        const bf16x8 nq0 = *(const GAS bf16x8*)(qbase + (size_t)rqn * 64 * ZMW), nq1 = *(const GAS bf16x8*)(qbase + (size_t)rqn * 64 * ZMW + 32);
        int ntop = (r + 2 < rb) ? ATT_RS(r + 3) + 7 : top; ntop = ntop < top ? top : ntop;
        const int nnew = ntop - top;
        u32x4 kreg0 = {0u, 0u, 0u, 0u}, vreg0 = {0u, 0u, 0u, 0u}, kreg1 = {0u, 0u, 0u, 0u}, vreg1 = {0u, 0u, 0u, 0u};
        if (nnew >= 1) attn_fill_issue(ZM, ZT, seqbase + (top + 1) * 64, head, tid, kreg0, vreg0);
        if (nnew >= 2) attn_fill_issue(ZM, ZT, seqbase + (top + 2) * 64, head, tid, kreg1, vreg1);
        attn_row_lds(lds, seqbase, rr, rs, head, lane, wave, q0, q1, Y, bcp);
        LDS_WAIT(); __builtin_amdgcn_s_barrier(); asm volatile("" ::: "memory");
        if (nnew >= 1) attn_fill_write(lds, (top + 1) % AT_NSLOT, tid, kreg0, vreg0);
        if (nnew >= 2) attn_fill_write(lds, (top + 2) % AT_NSLOT, tid, kreg1, vreg1);
        LDS_WAIT(); __builtin_amdgcn_s_barrier(); asm volatile("" ::: "memory");
        top = ntop; q0 = nq0; q1 = nq1;
    }
}

#define DFT4(r0, i0, r1, i1, r2, i2, r3, i3) do { \
    const float ar_ = r0 + r2, ai_ = i0 + i2, br_ = r0 - r2, bi_ = i0 - i2, cr_ = r1 + r3, ci_ = i1 + i3, dr_ = r1 - r3, di_ = i1 - i3; \
    r0 = ar_ + cr_; i0 = ai_ + ci_; r1 = br_ + di_; i1 = bi_ - dr_; r2 = ar_ - cr_; i2 = ai_ - ci_; r3 = br_ - di_; i3 = bi_ + dr_; } while (0)
template <int R, int NU>
__device__ __forceinline__ void butterfly_unit(int tok0, int rowbase  , int p0, int t, const bf16_t* ZT_, bf16_t* YQ_, const float (&twr)[2][R], const float (&twi)[2][R]) {
    const GAS unsigned* zre = (const GAS unsigned*)((const GAS bf16_t*)ZT_ + (size_t)MTOK * 512 + ((size_t)(tok0 >> 9) * 512 + p0) * 512) + t;
    const GAS unsigned* zim = zre + 256 * 256;
    float xr[NU][2][R], xi[NU][2][R];
    {   unsigned rawr[NU][R], rawi[NU][R];
#pragma unroll
        for (int u = 0; u < NU; ++u)
#pragma unroll
            for (int s = 0; s < R; ++s) { rawr[u][s] = zre[(size_t)s * 512 * 256 + u * 256]; rawi[u][s] = zim[(size_t)s * 512 * 256 + u * 256]; }
        __builtin_amdgcn_sched_barrier(0);
#pragma unroll
        for (int u = 0; u < NU; ++u)
#pragma unroll
            for (int s = 0; s < R; ++s) { xr[u][0][s] = bflo(rawr[u][s]); xr[u][1][s] = bfhi(rawr[u][s]); xi[u][0][s] = bflo(rawi[u][s]); xi[u][1][s] = bfhi(rawi[u][s]); }
    }
#pragma unroll
    for (int u = 0; u < NU; ++u) {
#pragma unroll
        for (int h = 0; h < 2; ++h) {
            if constexpr (R == 4) {
                DFT4(xr[u][h][0], xi[u][h][0], xr[u][h][1], xi[u][h][1], xr[u][h][2], xi[u][h][2], xr[u][h][3], xi[u][h][3]);
            } else {
#pragma unroll
                for (int b = 0; b < 4; ++b) DFT4(xr[u][h][b], xi[u][h][b], xr[u][h][4 + b], xi[u][h][4 + b], xr[u][h][8 + b], xi[u][h][8 + b], xr[u][h][12 + b], xi[u][h][12 + b]);
                constexpr float WR[10] = {1.f, 0.9238795325f, 0.7071067812f, 0.3826834324f, 0.f, 0.f, -0.7071067812f, 0.f, 0.f, -0.9238795325f};
                constexpr float WI[10] = {0.f, -0.3826834324f, -0.7071067812f, -0.9238795325f, -1.f, 0.f, -0.7071067812f, 0.f, 0.f, 0.3826834324f};
#pragma unroll
                for (int c = 1; c < 4; ++c)
#pragma unroll
                    for (int b = 1; b < 4; ++b) { const float w0 = WR[c * b], w1 = WI[c * b]; const float tr = xr[u][h][4 * c + b] * w0 - xi[u][h][4 * c + b] * w1, ti = xr[u][h][4 * c + b] * w1 + xi[u][h][4 * c + b] * w0; xr[u][h][4 * c + b] = tr; xi[u][h][4 * c + b] = ti; }
#pragma unroll
                for (int c = 0; c < 4; ++c) DFT4(xr[u][h][4 * c], xi[u][h][4 * c], xr[u][h][4 * c + 1], xi[u][h][4 * c + 1], xr[u][h][4 * c + 2], xi[u][h][4 * c + 2], xr[u][h][4 * c + 3], xi[u][h][4 * c + 3]);
            }
        }
        GAS unsigned* d0 = (GAS unsigned*)((GAS bf16_t*)YQ_ + (size_t)(rowbase + u) * 1024) + t;
#pragma unroll
        for (int q = 0; q < R; ++q) {
            const int sl = (R == 16) ? 4 * (q & 3) + (q >> 2) : q;
            const float r0 = xr[u][0][sl] * twr[0][q] - xi[u][0][sl] * twi[0][q], i0 = xr[u][0][sl] * twi[0][q] + xi[u][0][sl] * twr[0][q];
            const float r1 = xr[u][1][sl] * twr[1][q] - xi[u][1][sl] * twi[1][q], i1 = xr[u][1][sl] * twi[1][q] + xi[u][1][sl] * twr[1][q];
            GAS unsigned* d = d0 + (size_t)q * 256 * 512;
            d[0] = pk2(r0, r1); d[256] = pk2(i0, i1);
        }
    }
}

template <int MODE>
__device__ __forceinline__ void row_pass(int gw, int NGW, int lane, const float* x_prompt, const float* x_sample, float* out, bf16_t* XB, const bf16_t* O, float* RS, float* SS, const float* gpost) {
    for (int m = gw; m < MTOK; m += NGW) {
        f32x4 v[4];
        GAS u32x2* xbrow = (GAS u32x2*)((GAS bf16_t*)XB + (size_t)m * DM) + lane;
        if constexpr (MODE == 2) {
            u32x2 xv[4];
#pragma unroll
            for (int j = 0; j < 4; ++j) xv[j] = xbrow[64 * j];
            const float irs = RS[m];
#pragma unroll
            for (int j = 0; j < 4; ++j) { v[j][0] = bflo(xv[j].x) * irs; v[j][1] = bfhi(xv[j].x) * irs; v[j][2] = bflo(xv[j].y) * irs; v[j][3] = bfhi(xv[j].y) * irs; }
        } else {
            const GAS f32x4* xr = (const GAS f32x4*)((m < MP) ? x_prompt + (size_t)m * DM : x_sample + (size_t)(m - MP) * DM) + lane;
#pragma unroll
            for (int j = 0; j < 4; ++j) v[j] = xr[64 * j];
        }
        if constexpr (MODE != 0) {
            const float rq = rsqrtf(SS[m] * (1.0f / DM) + EPS);
            const GAS u32x2* orow = (const GAS u32x2*)((const GAS bf16_t*)O + (size_t)m * DM) + lane;
#pragma unroll
            for (int j = 0; j < 4; ++j) { const u32x2 ov = orow[64 * j]; const f32x4 gp = *((const GAS f32x4*)gpost + lane + 64 * j);
                v[j][0] += bflo(ov.x) * rq * gp[0]; v[j][1] += bfhi(ov.x) * rq * gp[1]; v[j][2] += bflo(ov.y) * rq * gp[2]; v[j][3] += bfhi(ov.y) * rq * gp[3]; }
            if constexpr (MODE == 2) {
                GAS f32x4* orow2 = (GAS f32x4*)(out + (size_t)m * DM) + lane;
#pragma unroll
                for (int j = 0; j < 4; ++j) orow2[64 * j] = v[j];
            }
        }
        if constexpr (MODE != 2) {
            float s = 0.f;
#pragma unroll
            for (int j = 0; j < 4; ++j) s += (v[j][0] * v[j][0] + v[j][1] * v[j][1]) + (v[j][2] * v[j][2] + v[j][3] * v[j][3]);
            s = wave_sum(s);
            const float ms = s * (1.0f / DM) + EPS;
            const float rsv = rsqrtf(ms);
#pragma unroll
            for (int j = 0; j < 4; ++j) { u32x2 w; w.x = pk2(v[j][0] * rsv, v[j][1] * rsv); w.y = pk2(v[j][2] * rsv, v[j][3] * rsv); xbrow[64 * j] = w; }
            if (lane == 0) { RS[m] = sqrtf(ms); SS[m] = 0.f; }
        }
    }
}

__global__ void __launch_bounds__(NWAVES * 64, 2) fwd_kernel(Args args) {
    extern __shared__ __attribute__((aligned(16))) unsigned char lds_raw[];
    LAS unsigned char* lds = (LAS unsigned char*)lds_raw;
    const int G = gridDim.x, bx = blockIdx.x;
    for (int ph = args.ph_lo; ph < args.ph_hi; ++ph) {
        if (ph > args.ph_lo) { cg::this_grid().sync(); }
        int tid = threadIdx.x; asm volatile("" : "+v"(tid));
        const int lane = tid & 63, wave = __builtin_amdgcn_readfirstlane(tid >> 6);
        const int gw = bx * NWAVES + wave, NGW = G * NWAVES;
        unsigned char* ws = args.ws; asm volatile("" : "+s"(ws));
        const float* x_prompt = args.in[0]; const float* x_sample = args.in[1];
        float* out = args.out;
        bf16_t* XB = (bf16_t*)(ws + WS_XB); bf16_t* OB = XB;
        bf16_t* ZM = (bf16_t*)(ws + WS_ZM); bf16_t* PB = ZM;
        bf16_t* ZT = (bf16_t*)(ws + WS_ZT); bf16_t* MG = ZT;
        bf16_t* YQ = (bf16_t*)(ws + WS_YQ);
        bf16_t* Y = (bf16_t*)(ws + WS_Y);
        bf16_t* TT = (bf16_t*)(ws + WS_T);
        float* RS = (float*)(ws + WS_RS); float* SS = (float*)(ws + WS_SS);
        const int layer = (ph == 0) ? 0 : (ph - 1) / 6;
        const int sub = (ph == 0) ? -1 : (ph - 1) % 6;
        const bf16_t* WIN = (const bf16_t*)(ws + WS_WIN) + (size_t)layer * NG1 * DM;
        const bf16_t* WM = (const bf16_t*)(ws + WS_WM) + (size_t)layer * 3072 * DM;
        const bf16_t* WA = (const bf16_t*)(ws + WS_WA) + (size_t)layer * DM * 512;
        const bf16_t* WB = (const bf16_t*)(ws + WS_WB) + (size_t)layer * DM * 256;
        const bf16_t* WC = (const bf16_t*)(ws + WS_WC) + (size_t)layer * DM * 256;
        const bf16_t* WO = (const bf16_t*)(ws + WS_WO) + (size_t)layer * DM * DM;

        if (PHON(0) && ph == 0) {
            LAS float* scr = (LAS float*)(lds + wave * 16384);
            for (int l = 0; l < 2; ++l) {
                const float* w_in = args.in[4] + (size_t)l * DM * DIN;
                const float* gpre = args.in[2] + l * DM;
                bf16_t* win = (bf16_t*)(ws + WS_WIN) + (size_t)l * NG1 * DM;
                bf16_t* wm = (bf16_t*)(ws + WS_WM) + (size_t)l * 3072 * DM;
                for (int job = 0; job < 7; ++job) {
                    int c0, nc, ro; bf16_t* dst; float sc = 1.f;
                    switch (job) {
                        case 0: c0 = 0; nc = 512; dst = win; ro = 0; sc = 0.125f; break;
                        case 1: c0 = 512; nc = 1024; dst = win; ro = 512; break;
                        case 2: c0 = 2560; nc = 512; dst = win; ro = 2048; break;
                        case 3: c0 = 1536; nc = 512; dst = win; ro = 2560; break;
                        case 4: c0 = 2304; nc = 256; dst = win; ro = 3072; break;
                        case 5: c0 = 3072; nc = 256; dst = win; ro = 3328; break;
                        default: c0 = 3328; nc = 3072; dst = wm; ro = 0; break;
                    }
                    const int nitems = (DM / 64) * (nc / 32);
                    for (int it = gw; it < nitems; it += NGW) transpose_item(w_in, DM, DIN, c0, nc, dst, ro, gpre, sc, scr, it, lane);
                }
                {   const int ni = (512 / 64) * (DM / 32);
                    for (int it = gw; it < ni; it += NGW) transpose_item(args.in[10] + (size_t)l * 512 * DM, 512, DM, 0, DM, (bf16_t*)(ws + WS_WA) + (size_t)l * DM * 512, 0, nullptr, 1.f, scr, it, lane); }
                {   const int ni = (256 / 64) * (DM / 32);
                    for (int it = gw; it < ni; it += NGW) transpose_item(args.in[11] + (size_t)l * 256 * DM, 256, DM, 0, DM, (bf16_t*)(ws + WS_WB) + (size_t)l * DM * 256, 0, nullptr, 1.f, scr, it, lane);
                    for (int it = gw; it < ni; it += NGW) transpose_item(args.in[12] + (size_t)l * 256 * DM, 256, DM, 0, DM, (bf16_t*)(ws + WS_WC) + (size_t)l * DM * 256, 0, nullptr, 1.f, scr, it, lane); }
                {   const int ni = (DM / 64) * (DM / 32);
                    for (int it = gw; it < ni; it += NGW) transpose_item(args.in[13] + (size_t)l * DM * DM, DM, DM, 0, DM, (bf16_t*)(ws + WS_WO) + (size_t)l * DM * DM, 0, nullptr, 1.f, scr, it, lane); }
                LAS float* ctab = (LAS float*)(lds + 131072);
                if (l == 0) { if (tid < 64) { float sn, cs; sincospif((float)tid * (1.0f / 32.0f), &sn, &cs); ctab[tid] = cs; ctab[64 + tid] = sn; } __syncthreads(); }
                for (int idx = bx * 512 + tid; idx < DM * 256; idx += G * 512) {
                    const int k = idx >> 8, p = idx & 255, grp = p >> 6, mm = p & 63;
                    const f32x4* wrow = (const f32x4*)(w_in + (size_t)k * DIN + 2048 + grp * 64);
                    float are = 0.f, aim = 0.f;
#pragma unroll 4
                    for (int c4 = 0; c4 < 16; ++c4) { const f32x4 w = wrow[c4];
#pragma unroll
                        for (int e = 0; e < 4; ++e) { const int t = (mm * (4 * c4 + e)) & 63; are += w[e] * ctab[t]; aim -= w[e] * ctab[64 + t]; } }
                    const float gk = gpre[k];
                    win[(size_t)(1536 + p) * DM + k] = (bf16_t)f2bf(are * gk);
                    win[(size_t)(1536 + 256 + p) * DM + k] = (bf16_t)f2bf(aim * gk);
                }
            }
            for (int idx = bx * 512 + tid; idx < 512 * 512; idx += G * 512) {
                const int kp = idx >> 9, lp = idx & 511; float sn, cs; sincospif((float)((kp * lp) & 511) * (1.0f / 256.0f), &sn, &cs);
                TT[(size_t)kp * 1024 + lp] = (bf16_t)f2bf(cs); TT[(size_t)kp * 1024 + 512 + lp] = (bf16_t)f2bf(sn);
            }
        }
        if (PHON(1) && (ph == 0 || sub == 5)) {
            const float* gpost = args.in[3] + layer * DM;
            if (ph == 0) row_pass<0>(gw, NGW, lane, x_prompt, x_sample, out, XB, Y, RS, SS, gpost);
            else if (layer == 0) row_pass<1>(gw, NGW, lane, x_prompt, x_sample, out, XB, Y, RS, SS, gpost);
            else row_pass<2>(gw, NGW, lane, x_prompt, x_sample, out, XB, Y, RS, SS, gpost);
        } else if (PHON(2) && sub == 0) {
            pg8::Gemm g{XB, WIN, MTOK, NG1, DM, DM, DM}; pg8::StaticOrder S; S.init(MTOK, NG1, G, bx);
            pg8::EpiG1 E{RS, ZM, ZT, Y};
            pg8::gemm_phase<pg8::EpiG1, pg8::StaticOrder, true>(lds, g, S, E);
        } else if (sub == 1) {
            if (PHON(3)) {
                const float* rpb = args.in[5] + (size_t)layer * 8 * 15 * 31;
                for (int un = bx; un < 512; un += G) {
                    if (un < 256) attn_unit(lds, (un >> 3) * 2048, 32, 0, 32, un & 7, tid, lane, wave, ZM, ZT, Y, rpb);
                    else { const int v = un - 256, st = v & 7; attn_unit(lds, MP + (v >> 6) * 8192, 128, st * 16, st * 16 + 16, (v >> 3) & 7, tid, lane, wave, ZM, ZT, Y, rpb); }
                }
            }
            if (PHON(4)) {
                constexpr int CT = 64, HR = CT + 30, NIT = (HR * 32 + 511) / 512, TPH = CT / 2, NHV = TPH + 30, LNT = CT / 8;
                static_assert((HR + CT) * 1024 <= LDS_BYTES, "conv LDS map");
                LAS float* hbuf = (LAS float*)lds; LAS float* cbuf = (LAS float*)(lds + HR * 1024);
                const float* dww = args.in[6] + (size_t)layer * 31 * 256; const float* dwb = args.in[7] + layer * 256;
                const float* lng = args.in[8] + layer * 256; const float* lnb = args.in[9] + layer * 256;
                const int c = tid & 255, half = tid >> 8;
                float w[31];
#pragma unroll
                for (int j = 0; j < 31; ++j) w[j] = dww[j * 256 + c];
                const float bc = dwb[c];
                const f32x4 lg = *((const f32x4*)lng + lane), lb = *((const f32x4*)lnb + lane);
                u32x4 pa[NIT], pb[NIT];
#define CONV_ISSUE(cu_) do { const int t0g_ = (cu_) * CT; \
                    int sbeg_, send_; if (t0g_ < MP) { sbeg_ = t0g_ & ~2047; send_ = sbeg_ + 2048; } else { sbeg_ = MP + ((t0g_ - MP) & ~8191); send_ = sbeg_ + 8192; } \
                    _Pragma("unroll") for (int k = 0; k < NIT; ++k) { \
                        const int it = tid + k * 512, i = it >> 5, c8 = (it & 31) * 8; const int tok = t0g_ - 15 + i; \
                        int tokc = tok < sbeg_ ? sbeg_ : tok; tokc = tokc > send_ - 1 ? send_ - 1 : tokc;     \
                        const u32x4 la_ = *(const GAS u32x4*)((const GAS bf16_t*)ZM + (size_t)tokc * ZMW + 1024 + c8), lb_ = *(const GAS u32x4*)((const GAS bf16_t*)ZM + (size_t)tokc * ZMW + 1280 + c8); \
                        const unsigned keep_ = (tok >= sbeg_ && tok < send_) ? 0xffffffffu : 0u; \
                        pa[k].x = la_.x & keep_; pa[k].y = la_.y & keep_; pa[k].z = la_.z & keep_; pa[k].w = la_.w & keep_; pb[k] = lb_; \
                    } } while (0)
                for (int cu = bx; cu < MTOK / CT; cu += G) {
                    const int t0g = cu * CT;
                    CONV_ISSUE(cu);
#pragma unroll
                    for (int k = 0; k < NIT; ++k) {
                        const int it = tid + k * 512, i = it >> 5, c8 = (it & 31) * 8;
                        if (it < HR * 32) {
                            const u32x4 a = pa[k], b = pb[k]; f32x4 h0, h1;
                            h0[0] = bflo(a.x) * sigmoidf_(bflo(b.x)); h0[1] = bfhi(a.x) * sigmoidf_(bfhi(b.x)); h0[2] = bflo(a.y) * sigmoidf_(bflo(b.y)); h0[3] = bfhi(a.y) * sigmoidf_(bfhi(b.y));
                            h1[0] = bflo(a.z) * sigmoidf_(bflo(b.z)); h1[1] = bfhi(a.z) * sigmoidf_(bfhi(b.z)); h1[2] = bflo(a.w) * sigmoidf_(bflo(b.w)); h1[3] = bfhi(a.w) * sigmoidf_(bfhi(b.w));
                            *(LAS f32x4*)(hbuf + i * 256 + c8) = h0; *(LAS f32x4*)(hbuf + i * 256 + c8 + 4) = h1;
                        }
                    }
                    __syncthreads();
                    {   float hv[NHV];
#pragma unroll
                        for (int i = 0; i < NHV; ++i) hv[i] = hbuf[(half * TPH + i) * 256 + c];
#pragma unroll
                        for (int tt = 0; tt < TPH; ++tt) {
                            float a = bc;
#pragma unroll
                            for (int j = 0; j < 31; ++j) a += w[j] * hv[tt + j];
                            cbuf[(half * TPH + tt) * 256 + c] = a;
                        }
                    }
                    __syncthreads();
#pragma unroll 4
                    for (int tt = 0; tt < LNT; ++tt) {
                        const int t = wave * LNT + tt;
                        const f32x4 xv = *(const LAS f32x4*)(cbuf + t * 256 + 4 * lane);
                        const float mean = wave_sum((xv[0] + xv[1]) + (xv[2] + xv[3])) * (1.0f / 256.0f);
                        const f32x4 d = xv - mean;
                        const float var = wave_sum((d[0] * d[0] + d[1] * d[1]) + (d[2] * d[2] + d[3] * d[3])) * (1.0f / 256.0f);
                        const float rstd = rsqrtf(var + EPS);
                        const float y0 = siluf_(d[0] * rstd * lg[0] + lb[0]), y1 = siluf_(d[1] * rstd * lg[1] + lb[1]), y2 = siluf_(d[2] * rstd * lg[2] + lb[2]), y3 = siluf_(d[3] * rstd * lg[3] + lb[3]);
                        GAS u32x2* yo = (GAS u32x2*)((GAS bf16_t*)Y + (size_t)(t0g + t) * DM + 768 + 4 * lane);
                        const u32x2 gq = *yo;
                        u32x2 wv; wv.x = pk2(y0 * bflo(gq.x), y1 * bfhi(gq.x)); wv.y = pk2(y2 * bflo(gq.y), y3 * bfhi(gq.y));
                        *yo = wv;
                    }
                }
            }
            if (PHON(5)) {
                float t4r[2][4], t4i[2][4], t16r[2][16], t16i[2][16];
                const int bt = tid & 255, bh = tid >> 8;
                {   const float s4 = rsqrtf(64.0f * 2048.0f), s16 = rsqrtf(64.0f * 8192.0f);
#pragma unroll
                    for (int h = 0; h < 2; ++h) {
#pragma unroll
                        for (int q = 0; q < 4; ++q) { float sn, cs; sincospif(-2.0f * (float)(q * (2 * bt + h)) / 2048.0f, &sn, &cs); t4r[h][q] = cs * s4; t4i[h][q] = sn * s4; }
#pragma unroll
                        for (int q = 0; q < 16; ++q) { float sn, cs; sincospif(-2.0f * (float)(q * (2 * bt + h)) / 8192.0f, &sn, &cs); t16r[h][q] = cs * s16; t16i[h][q] = sn * s16; } } }
                for (int un = bx; un < 32 * 32; un += G) { const int seq = un >> 5, p = (un & 31) * 8 + bh * 4; butterfly_unit<4, 4>(seq * 2048, seq * 1024 + p, p, bt, ZT, YQ, t4r, t4i); }
                for (int un = bx; un < 4 * 128; un += G) { const int seq = un >> 7, p = (un & 127) * 2 + bh; butterfly_unit<16, 1>(MP + seq * 8192, 32768 + seq * 4096 + p, p, bt, ZT, YQ, t16r, t16i); }
            }
        } else if (PHON(6) && sub == 2) {
            pg8::Gemm g{YQ, TT, NYQ, 512, 1024, 1024, 1024}; pg8::StaticOrder S; S.init(NYQ, 512, G, bx);
            pg8::EpiDFT E{Y};
            pg8::gemm_phase<pg8::EpiDFT, pg8::StaticOrder, true>(lds, g, S, E);
        } else if (sub == 3) {
            pg8::ProgG34 PG; PG.S.init(MTOK, DM, G, bx); PG.Y = Y; PG.XB = XB; PG.wsb = (const char*)ws; PG.WM = WM; PG.layer = layer;
            pg8::EpiG34 EG{RS, PB + (size_t)bx * 65536, PB + (size_t)(256 + bx) * 65536, MG};
            pg8::gemm_multi<pg8::EpiG34, pg8::ProgG34>(lds, PG, EG);
        } else if (PHON(10) && sub == 4) {
            pg8::Gemm g{MG, WO, MTOK, DM, DM, DM, DM}; pg8::StaticOrder S; S.init(MTOK, DM, G, bx);
            pg8::EpiG5 E{Y, SS};
            pg8::gemm_phase<pg8::EpiG5, pg8::StaticOrder, true>(lds, g, S, E);
        }
    }
}

extern "C" void kernel_launch(void* const* d_in, const int* in_sizes, int n_in, void* d_out, int out_size, void* d_ws, size_t ws_size, hipStream_t stream) {
    static int grid = 0;
    if (grid == 0) {
        if (n_in != 14 || ws_size < WS_END) { fprintf(stderr, "kernel_launch: bad inputs (n_in %d, ws %zu < %zu)\n", n_in, ws_size, (size_t)WS_END); grid = -1; return; }
        int dev = 0, cus = 0, per_cu = 0;
        hipGetDevice(&dev); hipDeviceGetAttribute(&cus, hipDeviceAttributeMultiprocessorCount, dev);
        if (hipFuncSetAttribute((const void*)fwd_kernel, hipFuncAttributeMaxDynamicSharedMemorySize, LDS_BYTES) != hipSuccess) { fprintf(stderr, "hipFuncSetAttribute failed\n"); grid = -1; return; }
        hipOccupancyMaxActiveBlocksPerMultiprocessor(&per_cu, (const void*)fwd_kernel, NWAVES * 64, LDS_BYTES);
        (void)hipGetLastError();
        if (per_cu < 1) { fprintf(stderr, "occupancy query says 0 blocks per CU\n"); }
        grid = cus;
    }
    if (grid < 0) return;
    Args a{};
    for (int i = 0; i < 14; ++i) a.in[i] = (const float*)d_in[i];
    a.out = (float*)d_out; a.ws = (unsigned char*)d_ws;
#if MK_ONE_LAUNCH
    a.ph_lo = 0; a.ph_hi = 13;
    void* kargs[] = {&a};
    hipError_t e = hipLaunchCooperativeKernel((const void*)fwd_kernel, dim3(grid), dim3(NWAVES * 64), kargs, LDS_BYTES, stream);
    if (e != hipSuccess) fprintf(stderr, "cooperative launch failed: %s (grid %d)\n", hipGetErrorString(e), grid);
#else
    for (int ph = 0; ph < 13; ++ph) {
        a.ph_lo = ph; a.ph_hi = ph + 1;
        hipLaunchKernelGGL(fwd_kernel, dim3(grid), dim3(NWAVES * 64), LDS_BYTES, stream, a);
    }
#endif
}
```

```cpp
#include <hip/hip_runtime.h>
#include <hip/hip_cooperative_groups.h>
#include <cstdio>
#include <cstdint>
namespace cg = cooperative_groups;

#ifndef MK_ONE_LAUNCH
#define MK_ONE_LAUNCH 1
#endif

#ifndef PH_MASK
#define PH_MASK 0xFFFF
#endif
#define PHON(k) (((PH_MASK) >> (k)) & 1)
#define LAS __attribute__((address_space(3)))
typedef unsigned short bf16_t;
typedef short bf16x8 __attribute__((ext_vector_type(8)));
typedef short s16x4 __attribute__((ext_vector_type(4)));
typedef float f32x4 __attribute__((ext_vector_type(4)));
typedef unsigned u32x4 __attribute__((ext_vector_type(4)));
typedef unsigned u32x2 __attribute__((ext_vector_type(2)));

constexpr int DM = 1024;
constexpr int MP = 65536;
constexpr int MTOK = 98304;
constexpr int DIN = 6400;
constexpr int NG1 = 3584;
constexpr int ZMW = 1536;
constexpr int NYQ = 49152;
constexpr float EPS = 1e-6f;

constexpr size_t MiB = 1u << 20;
constexpr size_t WS_WIN = 0;
constexpr size_t WS_WG = 10 * MiB;
constexpr size_t WS_WM = 14 * MiB;
constexpr size_t WS_WA = 26 * MiB;
constexpr size_t WS_WB = 28 * MiB;
constexpr size_t WS_WC = 29 * MiB;
constexpr size_t WS_WO = 30 * MiB;
constexpr size_t WS_T = 34 * MiB;
constexpr size_t WS_RS = 35 * MiB;
constexpr size_t WS_SS = 35 * MiB + 512 * 1024;
constexpr size_t WS_XB = 36 * MiB;
constexpr size_t WS_ZM = 228 * MiB;
constexpr size_t WS_ZT = 516 * MiB;
constexpr size_t WS_YQ = 708 * MiB;
constexpr size_t WS_Y = 804 * MiB;
constexpr size_t WS_END = 996 * MiB;

constexpr int NWAVES = 8;
constexpr int LDS_BYTES = 163840;

__device__ __forceinline__ unsigned f2bf(float f) { unsigned u = __builtin_bit_cast(unsigned, f); return (u + 0x7fffu + ((u >> 16) & 1u)) >> 16; }
__device__ __forceinline__ unsigned pk2(float lo, float hi) { unsigned r; asm("v_cvt_pk_bf16_f32 %0, %1, %2" : "=v"(r) : "v"(lo), "v"(hi)); return r; }
__device__ __forceinline__ float bf2f(unsigned b) { return __builtin_bit_cast(float, b << 16); }
__device__ __forceinline__ float bflo(unsigned w) { return __builtin_bit_cast(float, w << 16); }
__device__ __forceinline__ float bfhi(unsigned w) { return __builtin_bit_cast(float, w & 0xffff0000u); }
__device__ __forceinline__ float sigmoidf_(float x) { return __builtin_amdgcn_rcpf(1.0f + __expf(-x)); }
__device__ __forceinline__ float siluf_(float x) { return x * __builtin_amdgcn_rcpf(1.0f + __expf(-x)); }
__device__ __forceinline__ float wave_sum(float v) {
#pragma unroll
    for (int o = 1; o < 64; o <<= 1) v += __shfl_xor(v, o);
    return v;
}
#define LDS_WAIT() asm volatile("s_waitcnt lgkmcnt(0)" ::: "memory")
#define GAS __attribute__((address_space(1)))

namespace pg8 {
constexpr int BM = 256, BK = 64, HALF = 128, HTB = HALF * BK * 2, STAGE_BYTES = 8 * HTB, NXCD = 8, WGM = 8;
__device__ __forceinline__ int lds_byte(int r, int c) { const int st = (r >> 4) * 2 + (c >> 5), rr = r & 15, cc = c & 31, ob = rr * 64 + cc * 2; return st * 1024 + (ob ^ (((ob >> 9) & 1) << 5)); }
__device__ __forceinline__ void stage_rc(int b, int& R, int& C) { const int st = b / 1024, sb = b % 1024, swz = sb ^ (((sb >> 9) & 1) << 5); R = (st >> 1) * 16 + swz / 64; C = (st & 1) * 32 + (swz % 64) / 2; }

__device__ __forceinline__ int perm32(int rho) { const int n = rho >> 4, i = rho & 15; return 8 * (i >> 2) + 4 * n + (i & 3); }
struct Unit { int pm, pn; };
struct Gemm { const bf16_t* A; const bf16_t* Bt; int M, N, K, lda, ldb; };

struct StaticOrder {
    int nM, nN, nwg, G, c;
    __device__ __forceinline__ void init(int M, int N, int G_, int c_) { nM = M / BM; nN = N / BM; nwg = nM * nN; G = G_; c = c_; }
    __device__ __forceinline__ bool next(int i, Unit& u) const {
        const long L = (long)i * G + c; if (L >= nwg) return false;
        int wgid = (int)L; { const int q = nwg / NXCD, r = nwg % NXCD, xcd = wgid % NXCD, off = wgid / NXCD; wgid = (xcd < r ? xcd * (q + 1) : r * (q + 1) + (xcd - r) * q) + off; }
        const int nig = WGM * nN, gid = wgid / nig, fm = gid * WGM, gsz = (nM - fm) < WGM ? (nM - fm) : WGM;
        u.pm = fm + ((wgid % nig) % gsz); u.pn = (wgid % nig) / gsz; return true;
    }
};

struct SingleUnit { Unit u; __device__ bool next(int i, Unit& o) const { if (i) return false; o = u; return true; } };
template <class Epi, class Sched, bool ALIGN_EPI>
__device__ __forceinline__ void gemm_phase(LAS unsigned char* lds, const Gemm g, const Sched& S, const Epi& E) {
    int tid = threadIdx.x; asm volatile("" : "+v"(tid));
    const int wid = __builtin_amdgcn_readfirstlane(tid >> 6), lane = tid & 63, wr = wid >> 2, wc = wid & 3, fr = lane & 15, fq = lane >> 4;
    const int K = g.K, nt = K / BK;
    unsigned voffA[2], voffB[2];
#pragma unroll
    for (int i = 0; i < 2; ++i) { int R, C; stage_rc(tid * 16 + i * 8192, R, C);
        const int Rb = (R & ~31) + perm32(R & 31);
        voffA[i] = (unsigned)(R * g.lda + C) * 2u; voffB[i] = (unsigned)(Rb * g.ldb + C) * 2u; }
    const size_t kstep = (size_t)(BK * 2);
    const size_t hstepA = (size_t)HALF * g.lda * 2, hstepB = (size_t)HALF * g.ldb * 2;
    const size_t tstepA = 2 * hstepA, tstepB = 2 * hstepB;
    const unsigned ldsw = (unsigned)wid * 1024u;
    const int aoff = lds_byte(wr * 64 + fr, fq * 8), boff = lds_byte(wc * 32 + fr, fq * 8);
#define PG8_SA(b, h) (((b) * 2 + (h)) * HTB)
#define PG8_SB(b, h) ((4 + (b) * 2 + (h)) * HTB)
#define PG8_STAGE(bufoff, gbase, voff) do { _Pragma("unroll") for (int _i = 0; _i < 2; ++_i) \
        __builtin_amdgcn_global_load_lds((const unsigned*)((const char*)(gbase) + (voff)[_i]), (LAS unsigned*)(lds + (bufoff) + ldsw + _i * 8192), 16, 0, 0); } while (0)
#define PG8_LDA(dst, b, h) do { _Pragma("unroll") for (int m = 0; m < 4; ++m) _Pragma("unroll") for (int k = 0; k < 2; ++k) dst[m][k] = *(const LAS bf16x8*)(lds + PG8_SA(b, h) + aoff + m * 2048 + k * 1024); } while (0)
#define PG8_LDB(dst, b, h) do { _Pragma("unroll") for (int n = 0; n < 2; ++n) _Pragma("unroll") for (int k = 0; k < 2; ++k) dst[n][k] = *(const LAS bf16x8*)(lds + PG8_SB(b, h) + boff + n * 2048 + k * 1024); } while (0)
#define PG8_MMA(ai, bj, At, Bt) do { __builtin_amdgcn_s_setprio(1); _Pragma("unroll") for (int m = 0; m < 4; ++m) _Pragma("unroll") for (int n = 0; n < 2; ++n) _Pragma("unroll") for (int k = 0; k < 2; ++k) \
        acc[ai][bj][m][n] = __builtin_amdgcn_mfma_f32_16x16x32_bf16(Bt[n][k], At[m][k], acc[ai][bj][m][n], 0, 0, 0); __builtin_amdgcn_s_setprio(0); } while (0)
#define PG8_WAIT_V(n) asm volatile("s_waitcnt vmcnt(" #n ")" ::: "memory")
#define PG8_WAIT_L(n) asm volatile("s_waitcnt lgkmcnt(" #n ")" ::: "memory")
#define PG8_BAR __builtin_amdgcn_s_barrier()
#define PG8_SCHED __builtin_amdgcn_sched_barrier(0)
    Unit cur, nxt; int ui = 0;
    if (!S.next(0, cur)) return;
    f32x4 acc[2][2][4][2];
#pragma unroll
    for (int a = 0; a < 2; ++a)
#pragma unroll
        for (int b = 0; b < 2; ++b)
#pragma unroll
            for (int m = 0; m < 4; ++m)
#pragma unroll
                for (int n = 0; n < 2; ++n) acc[a][b][m][n] = (f32x4){0.f, 0.f, 0.f, 0.f};
    bf16x8 At[4][2], B0[2][2], B1[2][2];
    const char* cA = (const char*)g.A + (size_t)cur.pm * tstepA; const char* cB = (const char*)g.Bt + (size_t)cur.pn * tstepB;
    PG8_STAGE(PG8_SB(0, 0), cB, voffB); PG8_STAGE(PG8_SB(0, 1), cB + hstepB, voffB); PG8_STAGE(PG8_SA(0, 0), cA, voffA); PG8_STAGE(PG8_SA(0, 1), cA + hstepA, voffA);
    if (wr == 1) PG8_BAR;
    PG8_WAIT_V(2); PG8_BAR;
    PG8_STAGE(PG8_SB(1, 0), cB + kstep, voffB); PG8_STAGE(PG8_SA(1, 0), cA + kstep, voffA); PG8_STAGE(PG8_SB(1, 1), cB + hstepB + kstep, voffB);
    PG8_WAIT_V(6); PG8_BAR;
    for (;;) {
        const bool has_next = S.next(ui + 1, nxt);
        const char* nA = has_next ? (const char*)g.A + (size_t)nxt.pm * tstepA : cA; const char* nB = has_next ? (const char*)g.Bt + (size_t)nxt.pn * tstepB : cB;
        for (int t = 0; t < nt; t += 2) {
            const bool last = (t == nt - 2);
            const char* a1 = cA + (size_t)(t + 1) * kstep;
            const char* a2 = last ? nA : cA + (size_t)(t + 2) * kstep; const char* b2 = last ? nB : cB + (size_t)(t + 2) * kstep;
            const char* a3 = a2 + kstep; const char* b3 = b2 + kstep;
            PG8_LDB(B0, 0, 0); PG8_LDB(B1, 0, 1); PG8_SCHED; PG8_LDA(At, 0, 0); PG8_STAGE(PG8_SA(1, 1), a1 + hstepA, voffA);
            PG8_WAIT_V(8); PG8_WAIT_L(0); PG8_BAR; PG8_MMA(0, 0, At, B0); PG8_MMA(0, 1, At, B1); PG8_BAR; PG8_SCHED;
            PG8_LDA(At, 0, 1); PG8_STAGE(PG8_SB(0, 0), b2, voffB); PG8_STAGE(PG8_SB(0, 1), b2 + hstepB, voffB); PG8_STAGE(PG8_SA(0, 0), a2, voffA);
            PG8_WAIT_V(8); PG8_WAIT_L(0); PG8_BAR; PG8_MMA(1, 0, At, B0); PG8_MMA(1, 1, At, B1); PG8_BAR; PG8_SCHED;
            PG8_LDB(B0, 1, 0); PG8_LDB(B1, 1, 1); PG8_SCHED; PG8_LDA(At, 1, 0); PG8_STAGE(PG8_SA(0, 1), a2 + hstepA, voffA);
            PG8_WAIT_V(8); PG8_WAIT_L(0); PG8_BAR; PG8_MMA(0, 0, At, B0); PG8_MMA(0, 1, At, B1); PG8_BAR; PG8_SCHED;
            PG8_LDA(At, 1, 1); PG8_STAGE(PG8_SB(1, 0), b3, voffB); PG8_STAGE(PG8_SB(1, 1), b3 + hstepB, voffB); PG8_STAGE(PG8_SA(1, 0), a3, voffA);
            PG8_WAIT_V(8); PG8_WAIT_L(0); PG8_BAR; PG8_MMA(1, 0, At, B0); PG8_MMA(1, 1, At, B1); PG8_BAR; PG8_SCHED;
        }
        if constexpr (ALIGN_EPI) { if (wr == 0) PG8_BAR; }
        E(acc, cur, wr, wc, fr, fq);
        if (!has_next) break;
#pragma unroll
        for (int a = 0; a < 2; ++a)
#pragma unroll
            for (int b = 0; b < 2; ++b)
#pragma unroll
                for (int m = 0; m < 4; ++m)
#pragma unroll
                    for (int n = 0; n < 2; ++n) acc[a][b][m][n] = (f32x4){0.f, 0.f, 0.f, 0.f};
        cur = nxt; cA = nA; cB = nB; ++ui;
        if constexpr (ALIGN_EPI) { if (wr == 1) PG8_BAR; }
    }
    PG8_WAIT_V(0);
    if constexpr (!ALIGN_EPI) { if (wr == 0) PG8_BAR; }
    PG8_BAR;
#undef PG8_SA
#undef PG8_SB
#undef PG8_STAGE
#undef PG8_LDA
#undef PG8_LDB
#undef PG8_MMA
#undef PG8_WAIT_V
#undef PG8_WAIT_L
#undef PG8_BAR
#undef PG8_SCHED
}

struct UnitX { int pm, pn, seg; };
__device__ __forceinline__ int uni(int v) { return __builtin_amdgcn_readfirstlane(v); }
__device__ __forceinline__ const char* unip(const char* p) { const unsigned long long v = (unsigned long long)p; const unsigned lo = (unsigned)__builtin_amdgcn_readfirstlane((int)(unsigned)v), hi = (unsigned)__builtin_amdgcn_readfirstlane((int)(unsigned)(v >> 32)); return (const char*)(((unsigned long long)hi << 32) | lo); }
template <class Epi, class Prog>
__device__ __forceinline__ void gemm_multi(LAS unsigned char* lds, const Prog& P, const Epi& E) {
    int tid = threadIdx.x; asm volatile("" : "+v"(tid));
    const int wid = __builtin_amdgcn_readfirstlane(tid >> 6), lane = tid & 63, wr = wid >> 2, wc = wid & 3, fr = lane & 15, fq = lane >> 4;
    unsigned Rr[2], RrB[2], Cc2[2];
#pragma unroll
    for (int i = 0; i < 2; ++i) { int R, C; stage_rc(tid * 16 + i * 8192, R, C); Rr[i] = (unsigned)R * 2u; RrB[i] = (unsigned)((R & ~31) + perm32(R & 31)) * 2u; Cc2[i] = (unsigned)C * 2u; }
    const size_t kstep = (size_t)(BK * 2);
    const unsigned ldsw = (unsigned)wid * 1024u;
    const int aoff = lds_byte(wr * 64 + fr, fq * 8), boff = lds_byte(wc * 32 + fr, fq * 8);
#define PG8_SA(b, h) (((b) * 2 + (h)) * HTB)
#define PG8_SB(b, h) ((4 + (b) * 2 + (h)) * HTB)
#define PG8_STAGE_X(RR, bufoff, gbase, ld) do { _Pragma("unroll") for (int _i = 0; _i < 2; ++_i) \
        __builtin_amdgcn_global_load_lds((const unsigned*)((const char*)(gbase) + (RR[_i] * (unsigned)(ld) + Cc2[_i])), (LAS unsigned*)(lds + (bufoff) + ldsw + _i * 8192), 16, 0, 0); } while (0)
#define PG8_STAGE(bufoff, gbase, ld) PG8_STAGE_X(Rr, bufoff, gbase, ld)
#define PG8_STAGEB(bufoff, gbase, ld) PG8_STAGE_X(RrB, bufoff, gbase, ld)
#define PG8_LDA(dst, b, h) do { _Pragma("unroll") for (int m = 0; m < 4; ++m) _Pragma("unroll") for (int k = 0; k < 2; ++k) dst[m][k] = *(const LAS bf16x8*)(lds + PG8_SA(b, h) + aoff + m * 2048 + k * 1024); } while (0)
#define PG8_LDB(dst, b, h) do { _Pragma("unroll") for (int n = 0; n < 2; ++n) _Pragma("unroll") for (int k = 0; k < 2; ++k) dst[n][k] = *(const LAS bf16x8*)(lds + PG8_SB(b, h) + boff + n * 2048 + k * 1024); } while (0)
#define PG8_MMA(ai, bj, At, Bt) do { __builtin_amdgcn_s_setprio(1); _Pragma("unroll") for (int m = 0; m < 4; ++m) _Pragma("unroll") for (int n = 0; n < 2; ++n) _Pragma("unroll") for (int k = 0; k < 2; ++k) \
        acc[ai][bj][m][n] = __builtin_amdgcn_mfma_f32_16x16x32_bf16(Bt[n][k], At[m][k], acc[ai][bj][m][n], 0, 0, 0); __builtin_amdgcn_s_setprio(0); } while (0)
#define PG8_WAIT_V(n) asm volatile("s_waitcnt vmcnt(" #n ")" ::: "memory")
#define PG8_WAIT_L(n) asm volatile("s_waitcnt lgkmcnt(" #n ")" ::: "memory")
#define PG8_BAR __builtin_amdgcn_s_barrier()
#define PG8_SCHED __builtin_amdgcn_sched_barrier(0)
    UnitX cur, nxt; int ui = 0;
    if (!P.next(0, cur)) return;
    f32x4 acc[2][2][4][2];
#pragma unroll
    for (int a = 0; a < 2; ++a)
#pragma unroll
        for (int b = 0; b < 2; ++b)
#pragma unroll
            for (int m = 0; m < 4; ++m)
#pragma unroll
                for (int n = 0; n < 2; ++n) acc[a][b][m][n] = (f32x4){0.f, 0.f, 0.f, 0.f};
    bf16x8 At[4][2], B0[2][2], B1[2][2];
    const char* cA; const char* cB; int lda, ldb, nt;
    P.desc(cur, cA, cB, lda, ldb, nt); cA = unip(cA); cB = unip(cB); lda = uni(lda); ldb = uni(ldb); nt = uni(nt);
    {   const size_t hA = (size_t)HALF * lda * 2, hB = (size_t)HALF * ldb * 2;
        PG8_STAGEB(PG8_SB(0, 0), cB, ldb); PG8_STAGEB(PG8_SB(0, 1), cB + hB, ldb); PG8_STAGE(PG8_SA(0, 0), cA, lda); PG8_STAGE(PG8_SA(0, 1), cA + hA, lda);
        if (wr == 1) PG8_BAR;
        PG8_WAIT_V(2); PG8_BAR;
        PG8_STAGEB(PG8_SB(1, 0), cB + kstep, ldb); PG8_STAGE(PG8_SA(1, 0), cA + kstep, lda); PG8_STAGEB(PG8_SB(1, 1), cB + hB + kstep, ldb);
        PG8_WAIT_V(6); PG8_BAR; }
    for (;;) {
        const bool has_next = P.next(ui + 1, nxt);
        const char* nA = cA; const char* nB = cB; int ldan = lda, ldbn = ldb, ntn = nt;
        if (has_next) P.desc(nxt, nA, nB, ldan, ldbn, ntn);
        nA = unip(nA); nB = unip(nB); ldan = uni(ldan); ldbn = uni(ldbn); ntn = uni(ntn);
        const size_t hAc = (size_t)HALF * lda * 2;
        for (int t = 0; t < nt; t += 2) {
            const bool last = (t == nt - 2);
            const char* a1 = cA + (size_t)(t + 1) * kstep;
            const char* a2 = last ? nA : cA + (size_t)(t + 2) * kstep; const char* b2 = last ? nB : cB + (size_t)(t + 2) * kstep;
            const int lda2 = last ? ldan : lda, ldb2 = last ? ldbn : ldb;
            const size_t hA2 = (size_t)HALF * lda2 * 2, hB2 = (size_t)HALF * ldb2 * 2;
            const char* a3 = a2 + kstep; const char* b3 = b2 + kstep;
            PG8_LDB(B0, 0, 0); PG8_LDB(B1, 0, 1); PG8_SCHED; PG8_LDA(At, 0, 0); PG8_STAGE(PG8_SA(1, 1), a1 + hAc, lda);
            PG8_WAIT_V(8); PG8_WAIT_L(0); PG8_BAR; PG8_MMA(0, 0, At, B0); PG8_MMA(0, 1, At, B1); PG8_BAR; PG8_SCHED;
            PG8_LDA(At, 0, 1); PG8_STAGEB(PG8_SB(0, 0), b2, ldb2); PG8_STAGEB(PG8_SB(0, 1), b2 + hB2, ldb2); PG8_STAGE(PG8_SA(0, 0), a2, lda2);
            PG8_WAIT_V(8); PG8_WAIT_L(0); PG8_BAR; PG8_MMA(1, 0, At, B0); PG8_MMA(1, 1, At, B1); PG8_BAR; PG8_SCHED;
            PG8_LDB(B0, 1, 0); PG8_LDB(B1, 1, 1); PG8_SCHED; PG8_LDA(At, 1, 0); PG8_STAGE(PG8_SA(0, 1), a2 + hA2, lda2);
            PG8_WAIT_V(8); PG8_WAIT_L(0); PG8_BAR; PG8_MMA(0, 0, At, B0); PG8_MMA(0, 1, At, B1); PG8_BAR; PG8_SCHED;
            PG8_LDA(At, 1, 1); PG8_STAGEB(PG8_SB(1, 0), b3, ldb2); PG8_STAGEB(PG8_SB(1, 1), b3 + hB2, ldb2); PG8_STAGE(PG8_SA(1, 0), a3, lda2);
            PG8_WAIT_V(8); PG8_WAIT_L(0); PG8_BAR; PG8_MMA(1, 0, At, B0); PG8_MMA(1, 1, At, B1); PG8_BAR; PG8_SCHED;
        }
        if (wr == 0) PG8_BAR;
        E(acc, cur, wr, wc, fr, fq);
        if (!has_next) break;
#pragma unroll
        for (int a = 0; a < 2; ++a)
#pragma unroll
            for (int b = 0; b < 2; ++b)
#pragma unroll
                for (int m = 0; m < 4; ++m)
#pragma unroll
                    for (int n = 0; n < 2; ++n) acc[a][b][m][n] = (f32x4){0.f, 0.f, 0.f, 0.f};
        cur = nxt; cA = nA; cB = nB; lda = ldan; ldb = ldbn; nt = ntn; ++ui;
        if (wr == 1) PG8_BAR;
    }
    PG8_WAIT_V(0);
    PG8_BAR;
#undef PG8_SA
#undef PG8_SB
#undef PG8_STAGE
#undef PG8_STAGEB
#undef PG8_STAGE_X
#undef PG8_LDA
#undef PG8_LDB
#undef PG8_MMA
#undef PG8_WAIT_V
#undef PG8_WAIT_L
#undef PG8_BAR
#undef PG8_SCHED
}

#define EPI_ROWS_BEGIN  _Pragma("unroll") for (int ai = 0; ai < 2; ++ai) _Pragma("unroll") for (int m = 0; m < 4; ++m) { const int row = u.pm * BM + ai * HALF + wr * 64 + m * 16 + fr;
#define EPI_COLS_BEGIN  _Pragma("unroll") for (int bj = 0; bj < 2; ++bj) _Pragma("unroll") for (int n = 0; n < 2; ++n) { const int col = bj * HALF + wc * 32 + 8 * fq + 4 * n; f32x4 v = acc[ai][bj][m][n];
#define EPI_END } }
#define EPI_COLS8_BEGIN  _Pragma("unroll") for (int bj = 0; bj < 2; ++bj) { const int col = bj * HALF + wc * 32 + 8 * fq; const f32x4 v0 = acc[ai][bj][m][0], v1 = acc[ai][bj][m][1];

struct EpiG1 {
    const float* rs; bf16_t* ZM; bf16_t* ZT; bf16_t* Y;
    __device__ __forceinline__ void operator()(const f32x4 (&acc)[2][2][4][2], const Unit& u, int wr, int wc, int fr, int fq) const {
        const int pn = u.pn;
        if (pn >= 10) {
            const int cm = (pn - 10) * 256;
            EPI_ROWS_BEGIN
            EPI_COLS8_BEGIN
                u32x4 w; w.x = pk2(siluf_(v0[0]), siluf_(v0[1])); w.y = pk2(siluf_(v0[2]), siluf_(v0[3])); w.z = pk2(siluf_(v1[0]), siluf_(v1[1])); w.w = pk2(siluf_(v1[2]), siluf_(v1[3]));
                *(GAS u32x4*)((GAS bf16_t*)Y + (size_t)row * DM + cm + col) = w;
            EPI_END
            return;
        }
        if (pn >= 4 && pn < 6) {
            const int d0 = (pn - 4) * 256;
            EPI_ROWS_BEGIN
            EPI_COLS_BEGIN
                GAS bf16_t* d = (GAS bf16_t*)ZT + ((size_t)(row >> 6) * 512 + d0 + col) * 64 + (row & 63);
                const unsigned w0 = pk2(v[0], v[1]), w1 = pk2(v[2], v[3]);
                d[0] = (bf16_t)w0; d[64] = (bf16_t)(w0 >> 16); d[128] = (bf16_t)w1; d[192] = (bf16_t)(w1 >> 16);
            EPI_END
        } else if (pn >= 6 && pn < 8) {
            const int j0 = (pn - 6) * 256;
            EPI_ROWS_BEGIN
            EPI_COLS_BEGIN
                GAS bf16_t* d = (GAS bf16_t*)ZT + (size_t)MTOK * 512 + ((size_t)(row >> 9) * 512 + j0 + col) * 512 + (row & 511);
                const unsigned w0 = pk2(v[0], v[1]), w1 = pk2(v[2], v[3]);
                d[0] = (bf16_t)w0; d[512] = (bf16_t)(w0 >> 16); d[1024] = (bf16_t)w1; d[1536] = (bf16_t)(w1 >> 16);
            EPI_END
        } else {
            const int cm = (pn < 4 ? pn : pn - 4) * 256;
            EPI_ROWS_BEGIN
            EPI_COLS8_BEGIN
                u32x4 w; w.x = pk2(v0[0], v0[1]); w.y = pk2(v0[2], v0[3]); w.z = pk2(v1[0], v1[1]); w.w = pk2(v1[2], v1[3]);
                *(GAS u32x4*)((GAS bf16_t*)ZM + (size_t)row * ZMW + cm + col) = w;
            EPI_END
        }
    }
};
struct EpiDFT {
    bf16_t* Y;
    __device__ __forceinline__ void operator()(const f32x4 (&acc)[2][2][4][2], const Unit& u, int wr, int wc, int fr, int fq) const {
        int tok0, R, q;
        if (u.pm < 128) { tok0 = (u.pm >> 2) * 2048; R = 4; q = u.pm & 3; } else { const int t = u.pm - 128; tok0 = MP + (t >> 4) * 8192; R = 16; q = t & 15; }
#pragma unroll
        for (int ai = 0; ai < 2; ++ai)
#pragma unroll
            for (int m = 0; m < 4; ++m) {
                const int p = ai * HALF + wr * 64 + m * 16 + fr;
                GAS bf16_t* db = (GAS bf16_t*)Y + (size_t)(tok0 + q) * DM + 512 + p;
                bf16_t gv[2][2][4];
#pragma unroll
                for (int bj = 0; bj < 2; ++bj)
#pragma unroll
                    for (int n = 0; n < 2; ++n)
#pragma unroll
                        for (int e = 0; e < 4; ++e) gv[bj][n][e] = db[(size_t)R * (u.pn * BM + bj * HALF + wc * 32 + 8 * fq + 4 * n + e) * DM];
                __builtin_amdgcn_sched_barrier(0);
#pragma unroll
                for (int bj = 0; bj < 2; ++bj)
#pragma unroll
                    for (int n = 0; n < 2; ++n) {
                        const f32x4 v = acc[ai][bj][m][n];
                        const unsigned w0 = pk2(v[0] * bf2f(gv[bj][n][0]), v[1] * bf2f(gv[bj][n][1])), w1 = pk2(v[2] * bf2f(gv[bj][n][2]), v[3] * bf2f(gv[bj][n][3]));
                        GAS bf16_t* d = db + (size_t)R * (u.pn * BM + bj * HALF + wc * 32 + 8 * fq + 4 * n) * DM;
                        d[0] = (bf16_t)w0; d[(size_t)R * DM] = (bf16_t)(w0 >> 16); d[(size_t)2 * R * DM] = (bf16_t)w1; d[(size_t)3 * R * DM] = (bf16_t)(w1 >> 16);
                    }
                __builtin_amdgcn_sched_barrier(0);
            }
    }
};
struct EpiG2 {
    const float* rs; bf16_t* Y;
    __device__ __forceinline__ void operator()(const f32x4 (&acc)[2][2][4][2], const Unit& u, int wr, int wc, int fr, int fq) const {
        EPI_ROWS_BEGIN
        EPI_COLS8_BEGIN
            GAS u32x4* p = (GAS u32x4*)((GAS bf16_t*)Y + (size_t)row * DM + u.pn * BM + col);
            const u32x4 y = *p; u32x4 w;
            w.x = pk2(bflo(y.x) * siluf_(v0[0]), bfhi(y.x) * siluf_(v0[1])); w.y = pk2(bflo(y.y) * siluf_(v0[2]), bfhi(y.y) * siluf_(v0[3]));
            w.z = pk2(bflo(y.z) * siluf_(v1[0]), bfhi(y.z) * siluf_(v1[1])); w.w = pk2(bflo(y.w) * siluf_(v1[2]), bfhi(y.w) * siluf_(v1[3]));
            *p = w;
        EPI_END
    }
};
struct ProgG34 {
    StaticOrder S; const bf16_t* Y; const bf16_t* XB; const char* wsb; const bf16_t* WM; int layer;
    __device__ __forceinline__ bool next(int i, UnitX& u) const { Unit t; if (!S.next(i / 6, t)) return false; u.pm = t.pm; u.pn = t.pn; u.seg = i % 6; return true; }
    __device__ __forceinline__ void desc(const UnitX& u, const char*& A, const char*& B, int& lda, int& ldb, int& nt) const {
        const int b = u.seg >> 1; lda = DM;
        if (u.seg & 1) { A = (const char*)(XB + (size_t)u.pm * BM * DM); B = (const char*)(WM + (size_t)b * DM * DM + (size_t)u.pn * BM * DM); ldb = DM; nt = DM / BK; }
        else { const int kb = (b == 0) ? 512 : 256, ac = (b == 0) ? 0 : (b == 1 ? 512 : 768);
            const size_t woff = (size_t)((b == 0) ? 26 : 27 + b) * MiB + (size_t)layer * ((b == 0) ? MiB : MiB / 2);
            const bf16_t* w = (const bf16_t*)(wsb + woff);
            A = (const char*)(Y + (size_t)u.pm * BM * DM + ac); B = (const char*)(w + (size_t)u.pn * BM * kb); ldb = kb; nt = kb / BK; }
    }
};
struct EpiG34 {
    const float* rs; bf16_t* PT; bf16_t* MT; bf16_t* MG;
    __device__ __forceinline__ void operator()(const f32x4 (&acc)[2][2][4][2], const UnitX& u, int wr, int wc, int fr_, int fq_) const {
        int fr = fr_, fq = fq_; asm volatile("" : "+v"(fr), "+v"(fq));
        if ((u.seg & 1) == 0) {
            EPI_ROWS_BEGIN
            EPI_COLS8_BEGIN
                u32x4 w; w.x = pk2(v0[0], v0[1]); w.y = pk2(v0[2], v0[3]); w.z = pk2(v1[0], v1[1]); w.w = pk2(v1[2], v1[3]);
                *(GAS u32x4*)(PT + (size_t)(row - u.pm * BM) * 256 + col) = w;
            EPI_END
        } else {
            const int mode = u.seg >> 1;
            GAS bf16_t* dst = (mode == 2) ? (GAS bf16_t*)MG + (size_t)u.pm * BM * DM + u.pn * BM : (GAS bf16_t*)MT;
            const int dld = (mode == 2) ? DM : 256;
            const int rl0 = wr * 64 + fr, c0 = wc * 32 + 8 * fq;
#pragma unroll
            for (int ai = 0; ai < 2; ++ai) {
                u32x4 pv[4][2], mv[4][2];
#pragma unroll
                for (int m = 0; m < 4; ++m)
#pragma unroll
                    for (int bj = 0; bj < 2; ++bj) pv[m][bj] = *(const GAS u32x4*)(PT + (size_t)(ai * HALF + rl0 + m * 16) * 256 + bj * HALF + c0);
                if (mode != 0) {
#pragma unroll
                    for (int m = 0; m < 4; ++m)
#pragma unroll
                        for (int bj = 0; bj < 2; ++bj) mv[m][bj] = *(const GAS u32x4*)(MT + (size_t)(ai * HALF + rl0 + m * 16) * 256 + bj * HALF + c0);
                } else {
#pragma unroll
                    for (int m = 0; m < 4; ++m)
#pragma unroll
                        for (int bj = 0; bj < 2; ++bj) mv[m][bj] = (u32x4){0u, 0u, 0u, 0u};
                }
                __builtin_amdgcn_sched_barrier(0);
#pragma unroll
                for (int m = 0; m < 4; ++m)
#pragma unroll
                    for (int bj = 0; bj < 2; ++bj) {
                        const f32x4 v0 = acc[ai][bj][m][0], v1 = acc[ai][bj][m][1]; const u32x4 p = pv[m][bj], q = mv[m][bj];
                        const float r0 = bflo(q.x) + bflo(p.x) * sigmoidf_(v0[0]), r1 = bfhi(q.x) + bfhi(p.x) * sigmoidf_(v0[1]), r2 = bflo(q.y) + bflo(p.y) * sigmoidf_(v0[2]), r3 = bfhi(q.y) + bfhi(p.y) * sigmoidf_(v0[3]);
                        const float r4 = bflo(q.z) + bflo(p.z) * sigmoidf_(v1[0]), r5 = bfhi(q.z) + bfhi(p.z) * sigmoidf_(v1[1]), r6 = bflo(q.w) + bflo(p.w) * sigmoidf_(v1[2]), r7 = bfhi(q.w) + bfhi(p.w) * sigmoidf_(v1[3]);
                        u32x4 w; w.x = pk2(r0, r1); w.y = pk2(r2, r3); w.z = pk2(r4, r5); w.w = pk2(r6, r7);
                        *(GAS u32x4*)(dst + (size_t)(ai * HALF + rl0 + m * 16) * dld + bj * HALF + c0) = w;
                    }
                __builtin_amdgcn_sched_barrier(0);
            }
        }
    }
};
struct EpiG5 {
    bf16_t* O; float* ss;
    __device__ __forceinline__ void operator()(const f32x4 (&acc)[2][2][4][2], const Unit& u, int wr, int wc, int fr, int fq) const {
        EPI_ROWS_BEGIN float q = 0.f;
        EPI_COLS8_BEGIN
            u32x4 w; w.x = pk2(v0[0], v0[1]); w.y = pk2(v0[2], v0[3]); w.z = pk2(v1[0], v1[1]); w.w = pk2(v1[2], v1[3]);
            *(GAS u32x4*)((GAS bf16_t*)O + (size_t)row * DM + u.pn * BM + col) = w;
            q += ((v0[0] * v0[0] + v0[1] * v0[1]) + (v0[2] * v0[2] + v0[3] * v0[3])) + ((v1[0] * v1[0] + v1[1] * v1[1]) + (v1[2] * v1[2] + v1[3] * v1[3]));
        }
            q += __shfl_xor(q, 16); q += __shfl_xor(q, 32);
            if (fq == 0) atomicAdd(ss + row, q);
        }
    }
};
}

__device__ __forceinline__ void transpose_item(const float* W_, int K, int pitch, int c0, int ncols, bf16_t* WT_, int row_off, const float* g_, float scale, LAS float* scr, int item, int lane) {
    const GAS float* W = (const GAS float*)W_; GAS bf16_t* WT = (GAS bf16_t*)WT_;
    const int nblk = ncols / 32, kb = item / nblk, nb = item % nblk, k0 = 64 * kb, n0 = 32 * nb;
    float wv[32];
#pragma unroll
    for (int i = 0; i < 32; ++i) wv[i] = W[(size_t)(k0 + 2 * i + (lane >> 5)) * pitch + c0 + n0 + (lane & 31)];
#pragma unroll
    for (int i = 0; i < 32; ++i) scr[(2 * i + (lane >> 5)) * 33 + (lane & 31)] = wv[i];
    LDS_WAIT(); asm volatile("" ::: "memory");
    const int c = lane & 7;
    f32x4 g0 = {scale, scale, scale, scale}, g1 = g0;
    if (g_) { const GAS f32x4* gp = (const GAS f32x4*)((const GAS float*)g_ + k0 + 8 * c); g0 = gp[0] * scale; g1 = gp[1] * scale; }
#pragma unroll
    for (int j = 0; j < 4; ++j) { const int n = (lane >> 3) + 8 * j; const LAS float* sp = scr + (8 * c) * 33 + n;
        u32x4 o; o.x = pk2(sp[0 * 33] * g0[0], sp[1 * 33] * g0[1]); o.y = pk2(sp[2 * 33] * g0[2], sp[3 * 33] * g0[3]); o.z = pk2(sp[4 * 33] * g1[0], sp[5 * 33] * g1[1]); o.w = pk2(sp[6 * 33] * g1[2], sp[7 * 33] * g1[3]);
        *(GAS u32x4*)(WT + (size_t)(row_off + n0 + n) * K + k0 + 8 * c) = o; }
    LDS_WAIT(); asm volatile("" ::: "memory");
}

struct Args { const float* in[14]; float* out; unsigned char* ws; int ph_lo, ph_hi; };

__device__ __forceinline__ void grid_row_info(int gr, int& seqbase, int& r, int& nrows) {
    if (gr < 1024) { seqbase = (gr >> 5) << 11; r = gr & 31; nrows = 32; } else { const int g2 = gr - 1024; seqbase = MP + ((g2 >> 7) << 13); r = g2 & 127; nrows = 128; }
}

constexpr int AT_NSLOT = 9, AT_KSLOT = 9216, AT_VSLOT = 8704, AT_VOFF = AT_NSLOT * AT_KSLOT, AT_BOFF = AT_VOFF + AT_NSLOT * AT_VSLOT;
static_assert(AT_BOFF + 465 * 4 <= LDS_BYTES, "attention LDS map");
__device__ __forceinline__ void attn_fill_issue(const GAS bf16_t* ZM, const GAS bf16_t* ZT, int tok0, int head, int tid, u32x4& kreg, u32x4& vreg) {
    kreg = *(const GAS u32x4*)(ZM + (size_t)(tok0 + (tid >> 3)) * ZMW + 512 + head * 64 + (tid & 7) * 8);
    vreg = *(const GAS u32x4*)(ZT + ((size_t)(tok0 >> 6) * 512 + head * 64) * 64 + tid * 8);
}
__device__ __forceinline__ void attn_fill_write(LAS unsigned char* lds, int slot, int tid, const u32x4 kreg, const u32x4 vreg) {
    *(LAS u32x4*)(lds + slot * AT_KSLOT + (tid >> 3) * 144 + (tid & 7) * 16) = kreg;
    LAS u32x2* vp = (LAS u32x2*)(lds + AT_VOFF + slot * AT_VSLOT + (tid >> 3) * 136 + (tid & 7) * 16);
    u32x2 a; a.x = vreg.x; a.y = vreg.y; u32x2 b; b.x = vreg.z; b.y = vreg.w;
    vp[0] = a; vp[1] = b;
}
__device__ __forceinline__ void attn_row_lds(LAS unsigned char* lds, int seqbase, int r, int rs, int head, int lane, int wave, const bf16x8 bq0, const bf16x8 bq1, GAS bf16_t* Y, const unsigned (&bcp)[32]) {
    const int g = wave & 3;
    const int qi = lane & 15, h4 = lane >> 4;
    const int cs = (g == 0) ? 0 : (g == 1) ? 8 : (g == 2) ? 24 : 32;
    const int qc = 16 * g + qi;
    const int qtok = seqbase + r * 64 + qc;
    const int sb = rs % AT_NSLOT;
    GAS bf16_t* yp = Y + (size_t)qtok * DM + head * 64 + 4 * h4;
    u32x2 gt[4];
#pragma unroll
    for (int dt = 0; dt < 4; ++dt) gt[dt] = *(const GAS u32x2*)(yp + dt * 16);
    f32x4 S[16];
    float mx = -3.0e38f;
#pragma unroll
    for (int hb = 0; hb < 2; ++hb) {
        bf16x8 ak[8][2];
#pragma unroll
        for (int tt = 0; tt < 8; ++tt) {
            const int t = hb * 8 + tt, kr = t >> 1, hf = t & 1;
            int slot = sb + kr; slot = slot >= AT_NSLOT ? slot - AT_NSLOT : slot;
            const LAS unsigned char* kp = lds + slot * AT_KSLOT + (cs + 16 * hf + qi) * 144 + h4 * 16;
            ak[tt][0] = *(const LAS bf16x8*)kp; ak[tt][1] = *(const LAS bf16x8*)(kp + 64);
        }
        __builtin_amdgcn_sched_barrier(0);
#pragma unroll
        for (int tt = 0; tt < 8; ++tt) {
            const int t = hb * 8 + tt;
            f32x4 s = {0.f, 0.f, 0.f, 0.f};
            s = __builtin_amdgcn_mfma_f32_16x16x32_bf16(ak[tt][0], bq0, s, 0, 0, 0);
            s = __builtin_amdgcn_mfma_f32_16x16x32_bf16(ak[tt][1], bq1, s, 0, 0, 0);
            s[0] += bflo(bcp[2 * t]); s[1] += bfhi(bcp[2 * t]); s[2] += bflo(bcp[2 * t + 1]); s[3] += bfhi(bcp[2 * t + 1]);
            mx = fmaxf(mx, fmaxf(fmaxf(s[0], s[1]), fmaxf(s[2], s[3])));
            S[t] = s;
        }
        __builtin_amdgcn_sched_barrier(0);
    }
    mx = fmaxf(mx, __shfl_xor(mx, 16)); mx = fmaxf(mx, __shfl_xor(mx, 32));
    float sum = 0.f;
    bf16x8 pf[8];
#pragma unroll
    for (int kr = 0; kr < 8; ++kr) {
        const f32x4 a = S[kr * 2], b = S[kr * 2 + 1];
        const float p0 = __expf(a[0] - mx), p1 = __expf(a[1] - mx), p2 = __expf(a[2] - mx), p3 = __expf(a[3] - mx);
        const float p4 = __expf(b[0] - mx), p5 = __expf(b[1] - mx), p6 = __expf(b[2] - mx), p7 = __expf(b[3] - mx);
        sum += ((p0 + p1) + (p2 + p3)) + ((p4 + p5) + (p6 + p7));
        u32x4 w; w.x = pk2(p0, p1); w.y = pk2(p2, p3); w.z = pk2(p4, p5); w.w = pk2(p6, p7);
        pf[kr] = __builtin_bit_cast(bf16x8, w);
    }
    sum += __shfl_xor(sum, 16); sum += __shfl_xor(sum, 32);
    const float inv = __builtin_amdgcn_rcpf(sum);
#pragma unroll
    for (int dp = 0; dp < 2; ++dp) {
        u32x2 vf[2][8][2];
#pragma unroll
        for (int dti = 0; dti < 2; ++dti)
#pragma unroll
            for (int kr = 0; kr < 8; ++kr) {
                int slot = sb + kr; slot = slot >= AT_NSLOT ? slot - AT_NSLOT : slot;
                const LAS unsigned char* vp = lds + AT_VOFF + slot * AT_VSLOT + ((2 * dp + dti) * 16 + qi) * 136 + (cs + 4 * h4) * 2;
                vf[dti][kr][0] = *(const LAS u32x2*)vp; vf[dti][kr][1] = *(const LAS u32x2*)(vp + 32);
            }
        __builtin_amdgcn_sched_barrier(0);
#pragma unroll
        for (int dti = 0; dti < 2; ++dti) {
            f32x4 o = {0.f, 0.f, 0.f, 0.f};
#pragma unroll
            for (int kr = 0; kr < 8; ++kr) {
                u32x4 w; w.x = vf[dti][kr][0].x; w.y = vf[dti][kr][0].y; w.z = vf[dti][kr][1].x; w.w = vf[dti][kr][1].y;
                o = __builtin_amdgcn_mfma_f32_16x16x32_bf16(__builtin_bit_cast(bf16x8, w), pf[kr], o, 0, 0, 0);
            }
            const u32x2 gq = gt[2 * dp + dti];
            u32x2 w; w.x = pk2(o[0] * inv * bflo(gq.x), o[1] * inv * bfhi(gq.x)); w.y = pk2(o[2] * inv * bflo(gq.y), o[3] * inv * bfhi(gq.y));
            *(GAS u32x2*)(yp + (2 * dp + dti) * 16) = w;
        }
        __builtin_amdgcn_sched_barrier(0);
    }
}
#define ATT_RS(r_) ((r_) - 4 < 0 ? 0 : ((r_) - 4 > nrows - 8 ? nrows - 8 : (r_) - 4))
__device__ __forceinline__ void attn_unit(LAS unsigned char* lds, int seqbase, int nrows, int ra, int rb, int head, int tid, int lane, int wave,
                                          const bf16_t* ZM_, const bf16_t* ZT_, bf16_t* Y_, const float* rpb) {
    const GAS bf16_t* ZM = (const GAS bf16_t*)ZM_; const GAS bf16_t* ZT = (const GAS bf16_t*)ZT_; GAS bf16_t* Y = (GAS bf16_t*)Y_;
    const int rsel = wave >> 2;
    const int lo = ATT_RS(ra);
    int top = lo + 8;
    {   u32x4 kreg[9], vreg[9];
#pragma unroll
        for (int k = 0; k < 9; ++k) { int row = lo + k; row = row > nrows - 1 ? nrows - 1 : row; attn_fill_issue(ZM, ZT, seqbase + row * 64, head, tid, kreg[k], vreg[k]); }
        LAS float* bw = (LAS float*)(lds + AT_BOFF);
        if (tid < 465) bw[tid] = rpb[head * 465 + tid];
#pragma unroll
        for (int k = 0; k < 9; ++k) attn_fill_write(lds, (lo + k) % AT_NSLOT, tid, kreg[k], vreg[k]);
    }
    const GAS bf16_t* qbase = ZM + (size_t)(seqbase + 16 * (wave & 3) + (lane & 15)) * ZMW + head * 64 + 8 * (lane >> 4);
    bf16x8 q0 = *(const GAS bf16x8*)(qbase + (size_t)(ra + rsel) * 64 * ZMW), q1 = *(const GAS bf16x8*)(qbase + (size_t)(ra + rsel) * 64 * ZMW + 32);
    __syncthreads();
    unsigned bcp[32]; int cdelta = 1000;
#pragma unroll
    for (int i = 0; i < 32; ++i) bcp[i] = 0u;
#pragma unroll 1
    for (int r = ra; r < rb; r += 2) {
        const int rr = r + rsel, rs = ATT_RS(rr);
        if (rs - rr != cdelta) {
            cdelta = rs - rr;
            const LAS float* bias = (const LAS float*)(lds + AT_BOFF);
            const int g_ = wave & 3, qi_ = lane & 15, h4_ = lane >> 4, cs_ = (g_ == 0) ? 0 : (g_ == 1) ? 8 : (g_ == 2) ? 24 : 32, qc_ = 16 * g_ + qi_;
            int cst_ = qc_ - 8; cst_ = cst_ < 0 ? 0 : cst_; cst_ = cst_ > 48 ? 48 : cst_;
#pragma unroll
            for (int t = 0; t < 16; ++t) {
                float bv[4];
#pragma unroll
                for (int e = 0; e < 4; ++e) {
                    const int kc = cs_ + 16 * (t & 1) + 4 * h4_ + e; int dc = kc - qc_ + 15; dc = dc < 0 ? 0 : dc; dc = dc > 30 ? 30 : dc;
                    const float b = bias[(cdelta + (t >> 1) + 7) * 31 + dc];
                    bv[e] = ((kc >= cst_) && (kc < cst_ + 16)) ? b : -1.0e30f;
                }
                bcp[2 * t] = pk2(bv[0], bv[1]); bcp[2 * t + 1] = pk2(bv[2], bv[3]);
            }
        }
        const int rqn = (r + 2 < rb) ? rr + 2 : rr;
        const bf16x8 nq0 = *(const GAS bf16x8*)(qbase + (size_t)rqn * 64 * ZMW), nq1 = *(const GAS bf16x8*)(qbase + (size_t)rqn * 64 * ZMW + 32);
        int ntop = (r + 2 < rb) ? ATT_RS(r + 3) + 7 : top; ntop = ntop < top ? top : ntop;
        const int nnew = ntop - top;
        u32x4 kreg0 = {0u, 0u, 0u, 0u}, vreg0 = {0u, 0u, 0u, 0u}, kreg1 = {0u, 0u, 0u, 0u}, vreg1 = {0u, 0u, 0u, 0u};
        if (nnew >= 1) attn_fill_issue(ZM, ZT, seqbase + (top + 1) * 64, head, tid, kreg0, vreg0);
        if (nnew >= 2) attn_fill_issue(ZM, ZT, seqbase + (top + 2) * 64, head, tid, kreg1, vreg1);
        attn_row_lds(lds, seqbase, rr, rs, head, lane, wave, q0, q1, Y, bcp);
        LDS_WAIT(); __builtin_amdgcn_s_barrier(); asm volatile("" ::: "memory");
        if (nnew >= 1) attn_fill_write(lds, (top + 1) % AT_NSLOT, tid, kreg0, vreg0);
        if (nnew >= 2) attn_fill_write(lds, (top + 2) % AT_NSLOT, tid, kreg1, vreg1);
        LDS_WAIT(); __builtin_amdgcn_s_barrier(); asm volatile("" ::: "memory");
        top = ntop; q0 = nq0; q1 = nq1;
    }
}

#define DFT4(r0, i0, r1, i1, r2, i2, r3, i3) do { \
    const float ar_ = r0 + r2, ai_ = i0 + i2, br_ = r0 - r2, bi_ = i0 - i2, cr_ = r1 + r3, ci_ = i1 + i3, dr_ = r1 - r3, di_ = i1 - i3; \
    r0 = ar_ + cr_; i0 = ai_ + ci_; r1 = br_ + di_; i1 = bi_ - dr_; r2 = ar_ - cr_; i2 = ai_ - ci_; r3 = br_ - di_; i3 = bi_ + dr_; } while (0)
template <int R, int NU>
__device__ __forceinline__ void butterfly_unit(int tok0, int rowbase  , int p0, int t, const bf16_t* ZT_, bf16_t* YQ_, const float (&twr)[2][R], const float (&twi)[2][R]) {
    const GAS unsigned* zre = (const GAS unsigned*)((const GAS bf16_t*)ZT_ + (size_t)MTOK * 512 + ((size_t)(tok0 >> 9) * 512 + p0) * 512) + t;
    const GAS unsigned* zim = zre + 256 * 256;
    float xr[NU][2][R], xi[NU][2][R];
    {   unsigned rawr[NU][R], rawi[NU][R];
#pragma unroll
        for (int u = 0; u < NU; ++u)
#pragma unroll
            for (int s = 0; s < R; ++s) { rawr[u][s] = zre[(size_t)s * 512 * 256 + u * 256]; rawi[u][s] = zim[(size_t)s * 512 * 256 + u * 256]; }
        __builtin_amdgcn_sched_barrier(0);
#pragma unroll
        for (int u = 0; u < NU; ++u)
#pragma unroll
            for (int s = 0; s < R; ++s) { xr[u][0][s] = bflo(rawr[u][s]); xr[u][1][s] = bfhi(rawr[u][s]); xi[u][0][s] = bflo(rawi[u][s]); xi[u][1][s] = bfhi(rawi[u][s]); }
    }
#pragma unroll
    for (int u = 0; u < NU; ++u) {
#pragma unroll
        for (int h = 0; h < 2; ++h) {
            if constexpr (R == 4) {
                DFT4(xr[u][h][0], xi[u][h][0], xr[u][h][1], xi[u][h][1], xr[u][h][2], xi[u][h][2], xr[u][h][3], xi[u][h][3]);
            } else {
#pragma unroll
                for (int b = 0; b < 4; ++b) DFT4(xr[u][h][b], xi[u][h][b], xr[u][h][4 + b], xi[u][h][4 + b], xr[u][h][8 + b], xi[u][h][8 + b], xr[u][h][12 + b], xi[u][h][12 + b]);
                constexpr float WR[10] = {1.f, 0.9238795325f, 0.7071067812f, 0.3826834324f, 0.f, 0.f, -0.7071067812f, 0.f, 0.f, -0.9238795325f};
                constexpr float WI[10] = {0.f, -0.3826834324f, -0.7071067812f, -0.9238795325f, -1.f, 0.f, -0.7071067812f, 0.f, 0.f, 0.3826834324f};
#pragma unroll
                for (int c = 1; c < 4; ++c)
#pragma unroll
                    for (int b = 1; b < 4; ++b) { const float w0 = WR[c * b], w1 = WI[c * b]; const float tr = xr[u][h][4 * c + b] * w0 - xi[u][h][4 * c + b] * w1, ti = xr[u][h][4 * c + b] * w1 + xi[u][h][4 * c + b] * w0; xr[u][h][4 * c + b] = tr; xi[u][h][4 * c + b] = ti; }
#pragma unroll
                for (int c = 0; c < 4; ++c) DFT4(xr[u][h][4 * c], xi[u][h][4 * c], xr[u][h][4 * c + 1], xi[u][h][4 * c + 1], xr[u][h][4 * c + 2], xi[u][h][4 * c + 2], xr[u][h][4 * c + 3], xi[u][h][4 * c + 3]);
            }
        }
        GAS unsigned* d0 = (GAS unsigned*)((GAS bf16_t*)YQ_ + (size_t)(rowbase + u) * 1024) + t;
#pragma unroll
        for (int q = 0; q < R; ++q) {
            const int sl = (R == 16) ? 4 * (q & 3) + (q >> 2) : q;
            const float r0 = xr[u][0][sl] * twr[0][q] - xi[u][0][sl] * twi[0][q], i0 = xr[u][0][sl] * twi[0][q] + xi[u][0][sl] * twr[0][q];
            const float r1 = xr[u][1][sl] * twr[1][q] - xi[u][1][sl] * twi[1][q], i1 = xr[u][1][sl] * twi[1][q] + xi[u][1][sl] * twr[1][q];
            GAS unsigned* d = d0 + (size_t)q * 256 * 512;
            d[0] = pk2(r0, r1); d[256] = pk2(i0, i1);
        }
    }
}

template <int MODE>
__device__ __forceinline__ void row_pass(int gw, int NGW, int lane, const float* x_prompt, const float* x_sample, float* out, bf16_t* XB, const bf16_t* O, float* RS, float* SS, const float* gpost) {
    for (int m = gw; m < MTOK; m += NGW) {
        f32x4 v[4];
        GAS u32x2* xbrow = (GAS u32x2*)((GAS bf16_t*)XB + (size_t)m * DM) + lane;
        if constexpr (MODE != 0) {
            u32x2 xv[4];
#pragma unroll
            for (int j = 0; j < 4; ++j) xv[j] = xbrow[64 * j];
            const float irs = RS[m];
#pragma unroll
            for (int j = 0; j < 4; ++j) { v[j][0] = bflo(xv[j].x) * irs; v[j][1] = bfhi(xv[j].x) * irs; v[j][2] = bflo(xv[j].y) * irs; v[j][3] = bfhi(xv[j].y) * irs; }
        } else {
            const GAS f32x4* xr = (const GAS f32x4*)((m < MP) ? x_prompt + (size_t)m * DM : x_sample + (size_t)(m - MP) * DM) + lane;
#pragma unroll
            for (int j = 0; j < 4; ++j) v[j] = xr[64 * j];
        }
        if constexpr (MODE != 0) {
            const float rq = rsqrtf(SS[m] * (1.0f / DM) + EPS);
            const GAS u32x2* orow = (const GAS u32x2*)((const GAS bf16_t*)O + (size_t)m * DM) + lane;
#pragma unroll
            for (int j = 0; j < 4; ++j) { const u32x2 ov = orow[64 * j]; const f32x4 gp = *((const GAS f32x4*)gpost + lane + 64 * j);
                v[j][0] += bflo(ov.x) * rq * gp[0]; v[j][1] += bfhi(ov.x) * rq * gp[1]; v[j][2] += bflo(ov.y) * rq * gp[2]; v[j][3] += bfhi(ov.y) * rq * gp[3]; }
            if constexpr (MODE == 2) {
                GAS f32x4* orow2 = (GAS f32x4*)(out + (size_t)m * DM) + lane;
#pragma unroll
                for (int j = 0; j < 4; ++j) orow2[64 * j] = v[j];
            }
        }
        if constexpr (MODE != 2) {
            float s = 0.f;
#pragma unroll
            for (int j = 0; j < 4; ++j) s += (v[j][0] * v[j][0] + v[j][1] * v[j][1]) + (v[j][2] * v[j][2] + v[j][3] * v[j][3]);
            s = wave_sum(s);
            const float ms = s * (1.0f / DM) + EPS;
            const float rsv = rsqrtf(ms);
#pragma unroll
            for (int j = 0; j < 4; ++j) { u32x2 w; w.x = pk2(v[j][0] * rsv, v[j][1] * rsv); w.y = pk2(v[j][2] * rsv, v[j][3] * rsv); xbrow[64 * j] = w; }
            if (lane == 0) { RS[m] = sqrtf(ms); SS[m] = 0.f; }
        }
    }
}

__global__ void __launch_bounds__(NWAVES * 64, 2) fwd_kernel(Args args) {
    extern __shared__ __attribute__((aligned(16))) unsigned char lds_raw[];
    LAS unsigned char* lds = (LAS unsigned char*)lds_raw;
    const int G = gridDim.x, bx = blockIdx.x;
    for (int ph = args.ph_lo; ph < args.ph_hi; ++ph) {
        if (ph > args.ph_lo) { cg::this_grid().sync(); }
        int tid = threadIdx.x; asm volatile("" : "+v"(tid));
        const int lane = tid & 63, wave = __builtin_amdgcn_readfirstlane(tid >> 6);
        const int gw = bx * NWAVES + wave, NGW = G * NWAVES;
        unsigned char* ws = args.ws; asm volatile("" : "+s"(ws));
        const float* x_prompt = args.in[0]; const float* x_sample = args.in[1];
        float* out = args.out;
        bf16_t* XB = (bf16_t*)(ws + WS_XB); bf16_t* OB = XB;
        bf16_t* ZM = (bf16_t*)(ws + WS_ZM); bf16_t* PB = ZM;
        bf16_t* ZT = (bf16_t*)(ws + WS_ZT); bf16_t* MG = ZT;
        bf16_t* YQ = (bf16_t*)(ws + WS_YQ);
        bf16_t* Y = (bf16_t*)(ws + WS_Y);
        bf16_t* TT = (bf16_t*)(ws + WS_T);
        float* RS = (float*)(ws + WS_RS); float* SS = (float*)(ws + WS_SS);
        const int layer = (ph == 0) ? 0 : (ph - 1) / 6;
        const int sub = (ph == 0) ? -1 : (ph - 1) % 6;
        const bf16_t* WIN = (const bf16_t*)(ws + WS_WIN) + (size_t)layer * NG1 * DM;
        const bf16_t* WM = (const bf16_t*)(ws + WS_WM) + (size_t)layer * 3072 * DM;
        const bf16_t* WA = (const bf16_t*)(ws + WS_WA) + (size_t)layer * DM * 512;
        const bf16_t* WB = (const bf16_t*)(ws + WS_WB) + (size_t)layer * DM * 256;
        const bf16_t* WC = (const bf16_t*)(ws + WS_WC) + (size_t)layer * DM * 256;
        const bf16_t* WO = (const bf16_t*)(ws + WS_WO) + (size_t)layer * DM * DM;

        if (PHON(0) && ph == 0) {
            LAS float* scr = (LAS float*)(lds + wave * 16384);
            for (int l = 0; l < 2; ++l) {
                const float* w_in = args.in[4] + (size_t)l * DM * DIN;
                const float* gpre = args.in[2] + l * DM;
                bf16_t* win = (bf16_t*)(ws + WS_WIN) + (size_t)l * NG1 * DM;
                bf16_t* wm = (bf16_t*)(ws + WS_WM) + (size_t)l * 3072 * DM;
                for (int job = 0; job < 7; ++job) {
                    int c0, nc, ro; bf16_t* dst; float sc = 1.f;
                    switch (job) {
                        case 0: c0 = 0; nc = 512; dst = win; ro = 0; sc = 0.125f; break;
                        case 1: c0 = 512; nc = 1024; dst = win; ro = 512; break;
                        case 2: c0 = 2560; nc = 512; dst = win; ro = 2048; break;
                        case 3: c0 = 1536; nc = 512; dst = win; ro = 2560; break;
                        case 4: c0 = 2304; nc = 256; dst = win; ro = 3072; break;
                        case 5: c0 = 3072; nc = 256; dst = win; ro = 3328; break;
                        default: c0 = 3328; nc = 3072; dst = wm; ro = 0; break;
                    }
                    const int nitems = (DM / 64) * (nc / 32);
                    for (int it = gw; it < nitems; it += NGW) transpose_item(w_in, DM, DIN, c0, nc, dst, ro, gpre, sc, scr, it, lane);
                }
                {   const int ni = (512 / 64) * (DM / 32);
                    for (int it = gw; it < ni; it += NGW) transpose_item(args.in[10] + (size_t)l * 512 * DM, 512, DM, 0, DM, (bf16_t*)(ws + WS_WA) + (size_t)l * DM * 512, 0, nullptr, 1.f, scr, it, lane); }
                {   const int ni = (256 / 64) * (DM / 32);
                    for (int it = gw; it < ni; it += NGW) transpose_item(args.in[11] + (size_t)l * 256 * DM, 256, DM, 0, DM, (bf16_t*)(ws + WS_WB) + (size_t)l * DM * 256, 0, nullptr, 1.f, scr, it, lane);
                    for (int it = gw; it < ni; it += NGW) transpose_item(args.in[12] + (size_t)l * 256 * DM, 256, DM, 0, DM, (bf16_t*)(ws + WS_WC) + (size_t)l * DM * 256, 0, nullptr, 1.f, scr, it, lane); }
                {   const int ni = (DM / 64) * (DM / 32);
                    for (int it = gw; it < ni; it += NGW) transpose_item(args.in[13] + (size_t)l * DM * DM, DM, DM, 0, DM, (bf16_t*)(ws + WS_WO) + (size_t)l * DM * DM, 0, nullptr, 1.f, scr, it, lane); }
                LAS float* ctab = (LAS float*)(lds + 131072);
                if (l == 0) { if (tid < 64) { float sn, cs; sincospif((float)tid * (1.0f / 32.0f), &sn, &cs); ctab[tid] = cs; ctab[64 + tid] = sn; } __syncthreads(); }
                for (int idx = bx * 512 + tid; idx < DM * 256; idx += G * 512) {
                    const int k = idx >> 8, p = idx & 255, grp = p >> 6, mm = p & 63;
                    const f32x4* wrow = (const f32x4*)(w_in + (size_t)k * DIN + 2048 + grp * 64);
                    float are = 0.f, aim = 0.f;
#pragma unroll 4
                    for (int c4 = 0; c4 < 16; ++c4) { const f32x4 w = wrow[c4];
#pragma unroll
                        for (int e = 0; e < 4; ++e) { const int t = (mm * (4 * c4 + e)) & 63; are += w[e] * ctab[t]; aim -= w[e] * ctab[64 + t]; } }
                    const float gk = gpre[k];
                    win[(size_t)(1536 + p) * DM + k] = (bf16_t)f2bf(are * gk);
                    win[(size_t)(1536 + 256 + p) * DM + k] = (bf16_t)f2bf(aim * gk);
                }
            }
            for (int idx = bx * 512 + tid; idx < 512 * 512; idx += G * 512) {
                const int kp = idx >> 9, lp = idx & 511; float sn, cs; sincospif((float)((kp * lp) & 511) * (1.0f / 256.0f), &sn, &cs);
                TT[(size_t)kp * 1024 + lp] = (bf16_t)f2bf(cs); TT[(size_t)kp * 1024 + 512 + lp] = (bf16_t)f2bf(sn);
            }
        }
        if (PHON(1) && (ph == 0 || sub == 5)) {
            const float* gpost = args.in[3] + layer * DM;
            if (ph == 0) row_pass<0>(gw, NGW, lane, x_prompt, x_sample, out, XB, Y, RS, SS, gpost);
            else if (layer == 0) row_pass<1>(gw, NGW, lane, x_prompt, x_sample, out, XB, Y, RS, SS, gpost);
            else row_pass<2>(gw, NGW, lane, x_prompt, x_sample, out, XB, Y, RS, SS, gpost);
        } else if (PHON(2) && sub == 0) {
            pg8::Gemm g{XB, WIN, MTOK, NG1, DM, DM, DM}; pg8::StaticOrder S; S.init(MTOK, NG1, G, bx);
            pg8::EpiG1 E{RS, ZM, ZT, Y};
            pg8::gemm_phase<pg8::EpiG1, pg8::StaticOrder, true>(lds, g, S, E);
        } else if (sub == 1) {
            if (PHON(3)) {
                const float* rpb = args.in[5] + (size_t)layer * 8 * 15 * 31;
                for (int un = bx; un < 512; un += G) {
                    if (un < 256) attn_unit(lds, (un >> 3) * 2048, 32, 0, 32, un & 7, tid, lane, wave, ZM, ZT, Y, rpb);
                    else { const int v = un - 256, st = v & 7; attn_unit(lds, MP + (v >> 6) * 8192, 128, st * 16, st * 16 + 16, (v >> 3) & 7, tid, lane, wave, ZM, ZT, Y, rpb); }
                }
            }
            if (PHON(4)) {
                constexpr int CT = 64, HR = CT + 30, NIT = (HR * 32 + 511) / 512, TPH = CT / 2, NHV = TPH + 30, LNT = CT / 8;
                static_assert((HR + CT) * 1024 <= LDS_BYTES, "conv LDS map");
                LAS float* hbuf = (LAS float*)lds; LAS float* cbuf = (LAS float*)(lds + HR * 1024);
                const float* dww = args.in[6] + (size_t)layer * 31 * 256; const float* dwb = args.in[7] + layer * 256;
                const float* lng = args.in[8] + layer * 256; const float* lnb = args.in[9] + layer * 256;
                const int c = tid & 255, half = tid >> 8;
                float w[31];
#pragma unroll
                for (int j = 0; j < 31; ++j) w[j] = dww[j * 256 + c];
                const float bc = dwb[c];
                const f32x4 lg = *((const f32x4*)lng + lane), lb = *((const f32x4*)lnb + lane);
                u32x4 pa[NIT], pb[NIT];
#define CONV_ISSUE(cu_) do { const int t0g_ = (cu_) * CT; \
                    int sbeg_, send_; if (t0g_ < MP) { sbeg_ = t0g_ & ~2047; send_ = sbeg_ + 2048; } else { sbeg_ = MP + ((t0g_ - MP) & ~8191); send_ = sbeg_ + 8192; } \
                    _Pragma("unroll") for (int k = 0; k < NIT; ++k) { \
                        const int it = tid + k * 512, i = it >> 5, c8 = (it & 31) * 8; const int tok = t0g_ - 15 + i; \
                        int tokc = tok < sbeg_ ? sbeg_ : tok; tokc = tokc > send_ - 1 ? send_ - 1 : tokc;     \
                        const u32x4 la_ = *(const GAS u32x4*)((const GAS bf16_t*)ZM + (size_t)tokc * ZMW + 1024 + c8), lb_ = *(const GAS u32x4*)((const GAS bf16_t*)ZM + (size_t)tokc * ZMW + 1280 + c8); \
                        const unsigned keep_ = (tok >= sbeg_ && tok < send_) ? 0xffffffffu : 0u; \
                        pa[k].x = la_.x & keep_; pa[k].y = la_.y & keep_; pa[k].z = la_.z & keep_; pa[k].w = la_.w & keep_; pb[k] = lb_; \
                    } } while (0)
                for (int cu = bx; cu < MTOK / CT; cu += G) {
                    const int t0g = cu * CT;
                    CONV_ISSUE(cu);
#pragma unroll
                    for (int k = 0; k < NIT; ++k) {
                        const int it = tid + k * 512, i = it >> 5, c8 = (it & 31) * 8;
                        if (it < HR * 32) {
                            const u32x4 a = pa[k], b = pb[k]; f32x4 h0, h1;
                            h0[0] = bflo(a.x) * sigmoidf_(bflo(b.x)); h0[1] = bfhi(a.x) * sigmoidf_(bfhi(b.x)); h0[2] = bflo(a.y) * sigmoidf_(bflo(b.y)); h0[3] = bfhi(a.y) * sigmoidf_(bfhi(b.y));
                            h1[0] = bflo(a.z) * sigmoidf_(bflo(b.z)); h1[1] = bfhi(a.z) * sigmoidf_(bfhi(b.z)); h1[2] = bflo(a.w) * sigmoidf_(bflo(b.w)); h1[3] = bfhi(a.w) * sigmoidf_(bfhi(b.w));
                            *(LAS f32x4*)(hbuf + i * 256 + c8) = h0; *(LAS f32x4*)(hbuf + i * 256 + c8 + 4) = h1;
                        }
                    }
                    __syncthreads();
                    {   float hv[NHV];
#pragma unroll
                        for (int i = 0; i < NHV; ++i) hv[i] = hbuf[(half * TPH + i) * 256 + c];
#pragma unroll
                        for (int tt = 0; tt < TPH; ++tt) {
                            float a = bc;
#pragma unroll
                            for (int j = 0; j < 31; ++j) a += w[j] * hv[tt + j];
                            cbuf[(half * TPH + tt) * 256 + c] = a;
                        }
                    }
                    __syncthreads();
#pragma unroll 4
                    for (int tt = 0; tt < LNT; ++tt) {
                        const int t = wave * LNT + tt;
                        const f32x4 xv = *(const LAS f32x4*)(cbuf + t * 256 + 4 * lane);
                        const float mean = wave_sum((xv[0] + xv[1]) + (xv[2] + xv[3])) * (1.0f / 256.0f);
                        const f32x4 d = xv - mean;
                        const float var = wave_sum((d[0] * d[0] + d[1] * d[1]) + (d[2] * d[2] + d[3] * d[3])) * (1.0f / 256.0f);
                        const float rstd = rsqrtf(var + EPS);
                        const float y0 = siluf_(d[0] * rstd * lg[0] + lb[0]), y1 = siluf_(d[1] * rstd * lg[1] + lb[1]), y2 = siluf_(d[2] * rstd * lg[2] + lb[2]), y3 = siluf_(d[3] * rstd * lg[3] + lb[3]);
                        GAS u32x2* yo = (GAS u32x2*)((GAS bf16_t*)Y + (size_t)(t0g + t) * DM + 768 + 4 * lane);
                        const u32x2 gq = *yo;
                        u32x2 wv; wv.x = pk2(y0 * bflo(gq.x), y1 * bfhi(gq.x)); wv.y = pk2(y2 * bflo(gq.y), y3 * bfhi(gq.y));
                        *yo = wv;
                    }
                }
            }
            if (PHON(5)) {
                float t4r[2][4], t4i[2][4], t16r[2][16], t16i[2][16];
                const int bt = tid & 255, bh = tid >> 8;
                {   const float s4 = rsqrtf(64.0f * 2048.0f), s16 = rsqrtf(64.0f * 8192.0f);
#pragma unroll
                    for (int h = 0; h < 2; ++h) {
#pragma unroll
                        for (int q = 0; q < 4; ++q) { float sn, cs; sincospif(-2.0f * (float)(q * (2 * bt + h)) / 2048.0f, &sn, &cs); t4r[h][q] = cs * s4; t4i[h][q] = sn * s4; }
#pragma unroll
                        for (int q = 0; q < 16; ++q) { float sn, cs; sincospif(-2.0f * (float)(q * (2 * bt + h)) / 8192.0f, &sn, &cs); t16r[h][q] = cs * s16; t16i[h][q] = sn * s16; } } }
                for (int un = bx; un < 32 * 32; un += G) { const int seq = un >> 5, p = (un & 31) * 8 + bh * 4; butterfly_unit<4, 4>(seq * 2048, seq * 1024 + p, p, bt, ZT, YQ, t4r, t4i); }
                for (int un = bx; un < 4 * 128; un += G) { const int seq = un >> 7, p = (un & 127) * 2 + bh; butterfly_unit<16, 1>(MP + seq * 8192, 32768 + seq * 4096 + p, p, bt, ZT, YQ, t16r, t16i); }
            }
        } else if (PHON(6) && sub == 2) {
            pg8::Gemm g{YQ, TT, NYQ, 512, 1024, 1024, 1024}; pg8::StaticOrder S; S.init(NYQ, 512, G, bx);
            pg8::EpiDFT E{Y};
            pg8::gemm_phase<pg8::EpiDFT, pg8::StaticOrder, true>(lds, g, S, E);
        } else if (sub == 3) {
            pg8::ProgG34 PG; PG.S.init(MTOK, DM, G, bx); PG.Y = Y; PG.XB = XB; PG.wsb = (const char*)ws; PG.WM = WM; PG.layer = layer;
            pg8::EpiG34 EG{RS, PB + (size_t)bx * 65536, PB + (size_t)(256 + bx) * 65536, MG};
            pg8::gemm_multi<pg8::EpiG34, pg8::ProgG34>(lds, PG, EG);
        } else if (PHON(10) && sub == 4) {
            pg8::Gemm g{MG, WO, MTOK, DM, DM, DM, DM}; pg8::StaticOrder S; S.init(MTOK, DM, G, bx);
            pg8::EpiG5 E{Y, SS};
            pg8::gemm_phase<pg8::EpiG5, pg8::StaticOrder, true>(lds, g, S, E);
        }
    }
}

extern "C" void kernel_launch(void* const* d_in, const int* in_sizes, int n_in, void* d_out, int out_size, void* d_ws, size_t ws_size, hipStream_t stream) {
    static int grid = 0;
    if (grid == 0) {
        if (n_in != 14 || ws_size < WS_END) { fprintf(stderr, "kernel_launch: bad inputs (n_in %d, ws %zu < %zu)\n", n_in, ws_size, (size_t)WS_END); grid = -1; return; }
        int dev = 0, cus = 0, per_cu = 0;
        hipGetDevice(&dev); hipDeviceGetAttribute(&cus, hipDeviceAttributeMultiprocessorCount, dev);
        if (hipFuncSetAttribute((const void*)fwd_kernel, hipFuncAttributeMaxDynamicSharedMemorySize, LDS_BYTES) != hipSuccess) { fprintf(stderr, "hipFuncSetAttribute failed\n"); grid = -1; return; }
        hipOccupancyMaxActiveBlocksPerMultiprocessor(&per_cu, (const void*)fwd_kernel, NWAVES * 64, LDS_BYTES);
        (void)hipGetLastError();
        if (per_cu < 1) { fprintf(stderr, "occupancy query says 0 blocks per CU\n"); }
        grid = cus;
    }
    if (grid < 0) return;
    Args a{};
    for (int i = 0; i < 14; ++i) a.in[i] = (const float*)d_in[i];
    a.out = (float*)d_out; a.ws = (unsigned char*)d_ws;
#if MK_ONE_LAUNCH
    a.ph_lo = 0; a.ph_hi = 13;
    void* kargs[] = {&a};
    hipError_t e = hipLaunchCooperativeKernel((const void*)fwd_kernel, dim3(grid), dim3(NWAVES * 64), kargs, LDS_BYTES, stream);
    if (e != hipSuccess) fprintf(stderr, "cooperative launch failed: %s (grid %d)\n", hipGetErrorString(e), grid);
#else
    for (int ph = 0; ph < 13; ++ph) {
        a.ph_lo = ph; a.ph_hi = ph + 1;
        hipLaunchKernelGGL(fwd_kernel, dim3(grid), dim3(NWAVES * 64), LDS_BYTES, stream, a);
    }
#endif
}
```

```cpp
#include <hip/hip_runtime.h>
#include <hip/hip_cooperative_groups.h>
#include <cstdio>
#include <cstdint>
namespace cg = cooperative_groups;

#ifndef MK_ONE_LAUNCH
#define MK_ONE_LAUNCH 1
#endif

#ifndef PH_MASK
#define PH_MASK 0xFFFF
#endif
#define PHON(k) (((PH_MASK) >> (k)) & 1)
#define LAS __attribute__((address_space(3)))
typedef unsigned short bf16_t;
typedef short bf16x8 __attribute__((ext_vector_type(8)));
typedef short s16x4 __attribute__((ext_vector_type(4)));
typedef float f32x4 __attribute__((ext_vector_type(4)));
typedef unsigned u32x4 __attribute__((ext_vector_type(4)));
typedef unsigned u32x2 __attribute__((ext_vector_type(2)));

constexpr int DM = 1024;
constexpr int MP = 65536;
constexpr int MTOK = 98304;
constexpr int DIN = 6400;
constexpr int NG1 = 3584;
constexpr int ZMW = 1536;
constexpr int NYQ = 49152;
constexpr float EPS = 1e-6f;

constexpr size_t MiB = 1u << 20;
constexpr size_t WS_WIN = 0;
constexpr size_t WS_WG = 10 * MiB;
constexpr size_t WS_WM = 14 * MiB;
constexpr size_t WS_WA = 26 * MiB;
constexpr size_t WS_WB = 28 * MiB;
constexpr size_t WS_WC = 29 * MiB;
constexpr size_t WS_WO = 30 * MiB;
constexpr size_t WS_T = 34 * MiB;
constexpr size_t WS_RS = 35 * MiB;
constexpr size_t WS_SS = 35 * MiB + 512 * 1024;
constexpr size_t WS_XB = 36 * MiB;
constexpr size_t WS_ZM = 228 * MiB;
constexpr size_t WS_ZT = 516 * MiB;
constexpr size_t WS_YQ = 708 * MiB;
constexpr size_t WS_Y = 804 * MiB;
constexpr size_t WS_END = 996 * MiB;

constexpr int NWAVES = 8;
constexpr int LDS_BYTES = 163840;

__device__ __forceinline__ unsigned f2bf(float f) { unsigned u = __builtin_bit_cast(unsigned, f); return (u + 0x7fffu + ((u >> 16) & 1u)) >> 16; }
__device__ __forceinline__ unsigned pk2(float lo, float hi) { unsigned r; asm("v_cvt_pk_bf16_f32 %0, %1, %2" : "=v"(r) : "v"(lo), "v"(hi)); return r; }
__device__ __forceinline__ float bf2f(unsigned b) { return __builtin_bit_cast(float, b << 16); }
__device__ __forceinline__ float bflo(unsigned w) { return __builtin_bit_cast(float, w << 16); }
__device__ __forceinline__ float bfhi(unsigned w) { return __builtin_bit_cast(float, w & 0xffff0000u); }
__device__ __forceinline__ float sigmoidf_(float x) { return __builtin_amdgcn_rcpf(1.0f + __expf(-x)); }
__device__ __forceinline__ float siluf_(float x) { return x * __builtin_amdgcn_rcpf(1.0f + __expf(-x)); }
__device__ __forceinline__ float wave_sum(float v) {
#pragma unroll
    for (int o = 1; o < 64; o <<= 1) v += __shfl_xor(v, o);
    return v;
}
#define LDS_WAIT() asm volatile("s_waitcnt lgkmcnt(0)" ::: "memory")
#define GAS __attribute__((address_space(1)))

namespace pg8 {
constexpr int BM = 256, BK = 64, HALF = 128, HTB = HALF * BK * 2, STAGE_BYTES = 8 * HTB, NXCD = 8, WGM = 8;
__device__ __forceinline__ int lds_byte(int r, int c) { const int st = (r >> 4) * 2 + (c >> 5), rr = r & 15, cc = c & 31, ob = rr * 64 + cc * 2; return st * 1024 + (ob ^ (((ob >> 9) & 1) << 5)); }
__device__ __forceinline__ void stage_rc(int b, int& R, int& C) { const int st = b / 1024, sb = b % 1024, swz = sb ^ (((sb >> 9) & 1) << 5); R = (st >> 1) * 16 + swz / 64; C = (st & 1) * 32 + (swz % 64) / 2; }

__device__ __forceinline__ int perm32(int rho) { const int n = rho >> 4, i = rho & 15; return 8 * (i >> 2) + 4 * n + (i & 3); }
struct Unit { int pm, pn; };
struct Gemm { const bf16_t* A; const bf16_t* Bt; int M, N, K, lda, ldb; };

struct StaticOrder {
    int nM, nN, nwg, G, c;
    __device__ __forceinline__ void init(int M, int N, int G_, int c_) { nM = M / BM; nN = N / BM; nwg = nM * nN; G = G_; c = c_; }
    __device__ __forceinline__ bool next(int i, Unit& u) const {
        const long L = (long)i * G + c; if (L >= nwg) return false;
        int wgid = (int)L; { const int q = nwg / NXCD, r = nwg % NXCD, xcd = wgid % NXCD, off = wgid / NXCD; wgid = (xcd < r ? xcd * (q + 1) : r * (q + 1) + (xcd - r) * q) + off; }
        const int nig = WGM * nN, gid = wgid / nig, fm = gid * WGM, gsz = (nM - fm) < WGM ? (nM - fm) : WGM;
        u.pm = fm + ((wgid % nig) % gsz); u.pn = (wgid % nig) / gsz; return true;
    }
};

struct SingleUnit { Unit u; __device__ bool next(int i, Unit& o) const { if (i) return false; o = u; return true; } };
template <class Epi, class Sched, bool ALIGN_EPI>
__device__ __forceinline__ void gemm_phase(LAS unsigned char* lds, const Gemm g, const Sched& S, const Epi& E) {
    int tid = threadIdx.x; asm volatile("" : "+v"(tid));
    const int wid = __builtin_amdgcn_readfirstlane(tid >> 6), lane = tid & 63, wr = wid >> 2, wc = wid & 3, fr = lane & 15, fq = lane >> 4;
    const int K = g.K, nt = K / BK;
    unsigned voffA[2], voffB[2];
#pragma unroll
    for (int i = 0; i < 2; ++i) { int R, C; stage_rc(tid * 16 + i * 8192, R, C);
        const int Rb = (R & ~31) + perm32(R & 31);
        voffA[i] = (unsigned)(R * g.lda + C) * 2u; voffB[i] = (unsigned)(Rb * g.ldb + C) * 2u; }
    const size_t kstep = (size_t)(BK * 2);
    const size_t hstepA = (size_t)HALF * g.lda * 2, hstepB = (size_t)HALF * g.ldb * 2;
    const size_t tstepA = 2 * hstepA, tstepB = 2 * hstepB;
    const unsigned ldsw = (unsigned)wid * 1024u;
    const int aoff = lds_byte(wr * 64 + fr, fq * 8), boff = lds_byte(wc * 32 + fr, fq * 8);
#define PG8_SA(b, h) (((b) * 2 + (h)) * HTB)
#define PG8_SB(b, h) ((4 + (b) * 2 + (h)) * HTB)
#define PG8_STAGE(bufoff, gbase, voff) do { _Pragma("unroll") for (int _i = 0; _i < 2; ++_i) \
        __builtin_amdgcn_global_load_lds((const unsigned*)((const char*)(gbase) + (voff)[_i]), (LAS unsigned*)(lds + (bufoff) + ldsw + _i * 8192), 16, 0, 0); } while (0)
#define PG8_LDA(dst, b, h) do { _Pragma("unroll") for (int m = 0; m < 4; ++m) _Pragma("unroll") for (int k = 0; k < 2; ++k) dst[m][k] = *(const LAS bf16x8*)(lds + PG8_SA(b, h) + aoff + m * 2048 + k * 1024); } while (0)
#define PG8_LDB(dst, b, h) do { _Pragma("unroll") for (int n = 0; n < 2; ++n) _Pragma("unroll") for (int k = 0; k < 2; ++k) dst[n][k] = *(const LAS bf16x8*)(lds + PG8_SB(b, h) + boff + n * 2048 + k * 1024); } while (0)
#define PG8_MMA(ai, bj, At, Bt) do { __builtin_amdgcn_s_setprio(1); _Pragma("unroll") for (int m = 0; m < 4; ++m) _Pragma("unroll") for (int n = 0; n < 2; ++n) _Pragma("unroll") for (int k = 0; k < 2; ++k) \
        acc[ai][bj][m][n] = __builtin_amdgcn_mfma_f32_16x16x32_bf16(Bt[n][k], At[m][k], acc[ai][bj][m][n], 0, 0, 0); __builtin_amdgcn_s_setprio(0); } while (0)
#define PG8_WAIT_V(n) asm volatile("s_waitcnt vmcnt(" #n ")" ::: "memory")
#define PG8_WAIT_L(n) asm volatile("s_waitcnt lgkmcnt(" #n ")" ::: "memory")
#define PG8_BAR __builtin_amdgcn_s_barrier()
#define PG8_SCHED __builtin_amdgcn_sched_barrier(0)
    Unit cur, nxt; int ui = 0;
    if (!S.next(0, cur)) return;
    f32x4 acc[2][2][4][2];
#pragma unroll
    for (int a = 0; a < 2; ++a)
#pragma unroll
        for (int b = 0; b < 2; ++b)
#pragma unroll
            for (int m = 0; m < 4; ++m)
#pragma unroll
                for (int n = 0; n < 2; ++n) acc[a][b][m][n] = (f32x4){0.f, 0.f, 0.f, 0.f};
    bf16x8 At[4][2], B0[2][2], B1[2][2];
    const char* cA = (const char*)g.A + (size_t)cur.pm * tstepA; const char* cB = (const char*)g.Bt + (size_t)cur.pn * tstepB;
    PG8_STAGE(PG8_SB(0, 0), cB, voffB); PG8_STAGE(PG8_SB(0, 1), cB + hstepB, voffB); PG8_STAGE(PG8_SA(0, 0), cA, voffA); PG8_STAGE(PG8_SA(0, 1), cA + hstepA, voffA);
    if (wr == 1) PG8_BAR;
    PG8_WAIT_V(2); PG8_BAR;
    PG8_STAGE(PG8_SB(1, 0), cB + kstep, voffB); PG8_STAGE(PG8_SA(1, 0), cA + kstep, voffA); PG8_STAGE(PG8_SB(1, 1), cB + hstepB + kstep, voffB);
    PG8_WAIT_V(6); PG8_BAR;
    for (;;) {
        const bool has_next = S.next(ui + 1, nxt);
        const char* nA = has_next ? (const char*)g.A + (size_t)nxt.pm * tstepA : cA; const char* nB = has_next ? (const char*)g.Bt + (size_t)nxt.pn * tstepB : cB;
        for (int t = 0; t < nt; t += 2) {
            const bool last = (t == nt - 2);
            const char* a1 = cA + (size_t)(t + 1) * kstep;
            const char* a2 = last ? nA : cA + (size_t)(t + 2) * kstep; const char* b2 = last ? nB : cB + (size_t)(t + 2) * kstep;
            const char* a3 = a2 + kstep; const char* b3 = b2 + kstep;
            PG8_LDB(B0, 0, 0); PG8_LDB(B1, 0, 1); PG8_SCHED; PG8_LDA(At, 0, 0); PG8_STAGE(PG8_SA(1, 1), a1 + hstepA, voffA);
            PG8_WAIT_V(8); PG8_WAIT_L(0); PG8_BAR; PG8_MMA(0, 0, At, B0); PG8_MMA(0, 1, At, B1); PG8_BAR; PG8_SCHED;
            PG8_LDA(At, 0, 1); PG8_STAGE(PG8_SB(0, 0), b2, voffB); PG8_STAGE(PG8_SB(0, 1), b2 + hstepB, voffB); PG8_STAGE(PG8_SA(0, 0), a2, voffA);
            PG8_WAIT_V(8); PG8_WAIT_L(0); PG8_BAR; PG8_MMA(1, 0, At, B0); PG8_MMA(1, 1, At, B1); PG8_BAR; PG8_SCHED;
            PG8_LDB(B0, 1, 0); PG8_LDB(B1, 1, 1); PG8_SCHED; PG8_LDA(At, 1, 0); PG8_STAGE(PG8_SA(0, 1), a2 + hstepA, voffA);
            PG8_WAIT_V(8); PG8_WAIT_L(0); PG8_BAR; PG8_MMA(0, 0, At, B0); PG8_MMA(0, 1, At, B1); PG8_BAR; PG8_SCHED;
            PG8_LDA(At, 1, 1); PG8_STAGE(PG8_SB(1, 0), b3, voffB); PG8_STAGE(PG8_SB(1, 1), b3 + hstepB, voffB); PG8_STAGE(PG8_SA(1, 0), a3, voffA);
            PG8_WAIT_V(8); PG8_WAIT_L(0); PG8_BAR; PG8_MMA(1, 0, At, B0); PG8_MMA(1, 1, At, B1); PG8_BAR; PG8_SCHED;
        }
        if constexpr (ALIGN_EPI) { if (wr == 0) PG8_BAR; }
        E(acc, cur, wr, wc, fr, fq);
        if (!has_next) break;
#pragma unroll
        for (int a = 0; a < 2; ++a)
#pragma unroll
            for (int b = 0; b < 2; ++b)
#pragma unroll
                for (int m = 0; m < 4; ++m)
#pragma unroll
                    for (int n = 0; n < 2; ++n) acc[a][b][m][n] = (f32x4){0.f, 0.f, 0.f, 0.f};
        cur = nxt; cA = nA; cB = nB; ++ui;
        if constexpr (ALIGN_EPI) { if (wr == 1) PG8_BAR; }
    }
    PG8_WAIT_V(0);
    if constexpr (!ALIGN_EPI) { if (wr == 0) PG8_BAR; }
    PG8_BAR;
#undef PG8_SA
#undef PG8_SB
#undef PG8_STAGE
#undef PG8_LDA
#undef PG8_LDB
#undef PG8_MMA
#undef PG8_WAIT_V
#undef PG8_WAIT_L
#undef PG8_BAR
#undef PG8_SCHED
}

struct UnitX { int pm, pn, seg; };
__device__ __forceinline__ int uni(int v) { return __builtin_amdgcn_readfirstlane(v); }
__device__ __forceinline__ const char* unip(const char* p) { const unsigned long long v = (unsigned long long)p; const unsigned lo = (unsigned)__builtin_amdgcn_readfirstlane((int)(unsigned)v), hi = (unsigned)__builtin_amdgcn_readfirstlane((int)(unsigned)(v >> 32)); return (const char*)(((unsigned long long)hi << 32) | lo); }
template <class Epi, class Prog>
__device__ __forceinline__ void gemm_multi(LAS unsigned char* lds, const Prog& P, const Epi& E) {
    int tid = threadIdx.x; asm volatile("" : "+v"(tid));
    const int wid = __builtin_amdgcn_readfirstlane(tid >> 6), lane = tid & 63, wr = wid >> 2, wc = wid & 3, fr = lane & 15, fq = lane >> 4;
    unsigned Rr[2], RrB[2], Cc2[2];
#pragma unroll
    for (int i = 0; i < 2; ++i) { int R, C; stage_rc(tid * 16 + i * 8192, R, C); Rr[i] = (unsigned)R * 2u; RrB[i] = (unsigned)((R & ~31) + perm32(R & 31)) * 2u; Cc2[i] = (unsigned)C * 2u; }
    const size_t kstep = (size_t)(BK * 2);
    const unsigned ldsw = (unsigned)wid * 1024u;
    const int aoff = lds_byte(wr * 64 + fr, fq * 8), boff = lds_byte(wc * 32 + fr, fq * 8);
#define PG8_SA(b, h) (((b) * 2 + (h)) * HTB)
#define PG8_SB(b, h) ((4 + (b) * 2 + (h)) * HTB)
#define PG8_STAGE_X(RR, bufoff, gbase, ld) do { _Pragma("unroll") for (int _i = 0; _i < 2; ++_i) \
        __builtin_amdgcn_global_load_lds((const unsigned*)((const char*)(gbase) + (RR[_i] * (unsigned)(ld) + Cc2[_i])), (LAS unsigned*)(lds + (bufoff) + ldsw + _i * 8192), 16, 0, 0); } while (0)
#define PG8_STAGE(bufoff, gbase, ld) PG8_STAGE_X(Rr, bufoff, gbase, ld)
#define PG8_STAGEB(bufoff, gbase, ld) PG8_STAGE_X(RrB, bufoff, gbase, ld)
#define PG8_LDA(dst, b, h) do { _Pragma("unroll") for (int m = 0; m < 4; ++m) _Pragma("unroll") for (int k = 0; k < 2; ++k) dst[m][k] = *(const LAS bf16x8*)(lds + PG8_SA(b, h) + aoff + m * 2048 + k * 1024); } while (0)
#define PG8_LDB(dst, b, h) do { _Pragma("unroll") for (int n = 0; n < 2; ++n) _Pragma("unroll") for (int k = 0; k < 2; ++k) dst[n][k] = *(const LAS bf16x8*)(lds + PG8_SB(b, h) + boff + n * 2048 + k * 1024); } while (0)
#define PG8_MMA(ai, bj, At, Bt) do { __builtin_amdgcn_s_setprio(1); _Pragma("unroll") for (int m = 0; m < 4; ++m) _Pragma("unroll") for (int n = 0; n < 2; ++n) _Pragma("unroll") for (int k = 0; k < 2; ++k) \
        acc[ai][bj][m][n] = __builtin_amdgcn_mfma_f32_16x16x32_bf16(Bt[n][k], At[m][k], acc[ai][bj][m][n], 0, 0, 0); __builtin_amdgcn_s_setprio(0); } while (0)
#define PG8_WAIT_V(n) asm volatile("s_waitcnt vmcnt(" #n ")" ::: "memory")
#define PG8_WAIT_L(n) asm volatile("s_waitcnt lgkmcnt(" #n ")" ::: "memory")
#define PG8_BAR __builtin_amdgcn_s_barrier()
#define PG8_SCHED __builtin_amdgcn_sched_barrier(0)
    UnitX cur, nxt; int ui = 0;
    if (!P.next(0, cur)) return;
    f32x4 acc[2][2][4][2];
#pragma unroll
    for (int a = 0; a < 2; ++a)
#pragma unroll
        for (int b = 0; b < 2; ++b)
#pragma unroll
            for (int m = 0; m < 4; ++m)
#pragma unroll
                for (int n = 0; n < 2; ++n) acc[a][b][m][n] = (f32x4){0.f, 0.f, 0.f, 0.f};
    bf16x8 At[4][2], B0[2][2], B1[2][2];
    const char* cA; const char* cB; int lda, ldb, nt;
    P.desc(cur, cA, cB, lda, ldb, nt); cA = unip(cA); cB = unip(cB); lda = uni(lda); ldb = uni(ldb); nt = uni(nt);
    {   const size_t hA = (size_t)HALF * lda * 2, hB = (size_t)HALF * ldb * 2;
        PG8_STAGEB(PG8_SB(0, 0), cB, ldb); PG8_STAGEB(PG8_SB(0, 1), cB + hB, ldb); PG8_STAGE(PG8_SA(0, 0), cA, lda); PG8_STAGE(PG8_SA(0, 1), cA + hA, lda);
        if (wr == 1) PG8_BAR;
        PG8_WAIT_V(2); PG8_BAR;
        PG8_STAGEB(PG8_SB(1, 0), cB + kstep, ldb); PG8_STAGE(PG8_SA(1, 0), cA + kstep, lda); PG8_STAGEB(PG8_SB(1, 1), cB + hB + kstep, ldb);
        PG8_WAIT_V(6); PG8_BAR; }
    for (;;) {
        const bool has_next = P.next(ui + 1, nxt);
        const char* nA = cA; const char* nB = cB; int ldan = lda, ldbn = ldb, ntn = nt;
        if (has_next) P.desc(nxt, nA, nB, ldan, ldbn, ntn);
        nA = unip(nA); nB = unip(nB); ldan = uni(ldan); ldbn = uni(ldbn); ntn = uni(ntn);
        const size_t hAc = (size_t)HALF * lda * 2;
        for (int t = 0; t < nt; t += 2) {
            const bool last = (t == nt - 2);
            const char* a1 = cA + (size_t)(t + 1) * kstep;
            const char* a2 = last ? nA : cA + (size_t)(t + 2) * kstep; const char* b2 = last ? nB : cB + (size_t)(t + 2) * kstep;
            const int lda2 = last ? ldan : lda, ldb2 = last ? ldbn : ldb;
            const size_t hA2 = (size_t)HALF * lda2 * 2, hB2 = (size_t)HALF * ldb2 * 2;
            const char* a3 = a2 + kstep; const char* b3 = b2 + kstep;
            PG8_LDB(B0, 0, 0); PG8_LDB(B1, 0, 1); PG8_SCHED; PG8_LDA(At, 0, 0); PG8_STAGE(PG8_SA(1, 1), a1 + hAc, lda);
            PG8_WAIT_V(8); PG8_WAIT_L(0); PG8_BAR; PG8_MMA(0, 0, At, B0); PG8_MMA(0, 1, At, B1); PG8_BAR; PG8_SCHED;
            PG8_LDA(At, 0, 1); PG8_STAGEB(PG8_SB(0, 0), b2, ldb2); PG8_STAGEB(PG8_SB(0, 1), b2 + hB2, ldb2); PG8_STAGE(PG8_SA(0, 0), a2, lda2);
            PG8_WAIT_V(8); PG8_WAIT_L(0); PG8_BAR; PG8_MMA(1, 0, At, B0); PG8_MMA(1, 1, At, B1); PG8_BAR; PG8_SCHED;
            PG8_LDB(B0, 1, 0); PG8_LDB(B1, 1, 1); PG8_SCHED; PG8_LDA(At, 1, 0); PG8_STAGE(PG8_SA(0, 1), a2 + hA2, lda2);
            PG8_WAIT_V(8); PG8_WAIT_L(0); PG8_BAR; PG8_MMA(0, 0, At, B0); PG8_MMA(0, 1, At, B1); PG8_BAR; PG8_SCHED;
            PG8_LDA(At, 1, 1); PG8_STAGEB(PG8_SB(1, 0), b3, ldb2); PG8_STAGEB(PG8_SB(1, 1), b3 + hB2, ldb2); PG8_STAGE(PG8_SA(1, 0), a3, lda2);
            PG8_WAIT_V(8); PG8_WAIT_L(0); PG8_BAR; PG8_MMA(1, 0, At, B0); PG8_MMA(1, 1, At, B1); PG8_BAR; PG8_SCHED;
        }
        if (wr == 0) PG8_BAR;
        E(acc, cur, wr, wc, fr, fq);
        if (!has_next) break;
#pragma unroll
        for (int a = 0; a < 2; ++a)
#pragma unroll
            for (int b = 0; b < 2; ++b)
#pragma unroll
                for (int m = 0; m < 4; ++m)
#pragma unroll
                    for (int n = 0; n < 2; ++n) acc[a][b][m][n] = (f32x4){0.f, 0.f, 0.f, 0.f};
        cur = nxt; cA = nA; cB = nB; lda = ldan; ldb = ldbn; nt = ntn; ++ui;
        if (wr == 1) PG8_BAR;
    }
    PG8_WAIT_V(0);
    PG8_BAR;
#undef PG8_SA
#undef PG8_SB
#undef PG8_STAGE
#undef PG8_STAGEB
#undef PG8_STAGE_X
#undef PG8_LDA
#undef PG8_LDB
#undef PG8_MMA
#undef PG8_WAIT_V
#undef PG8_WAIT_L
#undef PG8_BAR
#undef PG8_SCHED
}

#define EPI_ROWS_BEGIN  _Pragma("unroll") for (int ai = 0; ai < 2; ++ai) _Pragma("unroll") for (int m = 0; m < 4; ++m) { const int row = u.pm * BM + ai * HALF + wr * 64 + m * 16 + fr;
#define EPI_COLS_BEGIN  _Pragma("unroll") for (int bj = 0; bj < 2; ++bj) _Pragma("unroll") for (int n = 0; n < 2; ++n) { const int col = bj * HALF + wc * 32 + 8 * fq + 4 * n; f32x4 v = acc[ai][bj][m][n];
#define EPI_END } }
#define EPI_COLS8_BEGIN  _Pragma("unroll") for (int bj = 0; bj < 2; ++bj) { const int col = bj * HALF + wc * 32 + 8 * fq; const f32x4 v0 = acc[ai][bj][m][0], v1 = acc[ai][bj][m][1];

struct EpiG1 {
    const float* rs; bf16_t* ZM; bf16_t* ZT; bf16_t* Y;
    __device__ __forceinline__ void operator()(const f32x4 (&acc)[2][2][4][2], const Unit& u, int wr, int wc, int fr, int fq) const {
        const int pn = u.pn;
        if (pn >= 10) {
            const int cm = (pn - 10) * 256;
            EPI_ROWS_BEGIN
            EPI_COLS8_BEGIN
                u32x4 w; w.x = pk2(siluf_(v0[0]), siluf_(v0[1])); w.y = pk2(siluf_(v0[2]), siluf_(v0[3])); w.z = pk2(siluf_(v1[0]), siluf_(v1[1])); w.w = pk2(siluf_(v1[2]), siluf_(v1[3]));
                *(GAS u32x4*)((GAS bf16_t*)Y + (size_t)row * DM + cm + col) = w;
            EPI_END
            return;
        }
        if (pn >= 4 && pn < 6) {
            const int d0 = (pn - 4) * 256;
            EPI_ROWS_BEGIN
            EPI_COLS_BEGIN
                GAS bf16_t* d = (GAS bf16_t*)ZT + ((size_t)(row >> 6) * 512 + d0 + col) * 64 + (row & 63);
                const unsigned w0 = pk2(v[0], v[1]), w1 = pk2(v[2], v[3]);
                d[0] = (bf16_t)w0; d[64] = (bf16_t)(w0 >> 16); d[128] = (bf16_t)w1; d[192] = (bf16_t)(w1 >> 16);
            EPI_END
        } else if (pn >= 6 && pn < 8) {
            const int j0 = (pn - 6) * 256;
            EPI_ROWS_BEGIN
            EPI_COLS_BEGIN
                GAS bf16_t* d = (GAS bf16_t*)ZT + (size_t)MTOK * 512 + ((size_t)(row >> 9) * 512 + j0 + col) * 512 + (row & 511);
                const unsigned w0 = pk2(v[0], v[1]), w1 = pk2(v[2], v[3]);
                d[0] = (bf16_t)w0; d[512] = (bf16_t)(w0 >> 16); d[1024] = (bf16_t)w1; d[1536] = (bf16_t)(w1 >> 16);
            EPI_END
        } else {
            const int cm = (pn < 4 ? pn : pn - 4) * 256;
            EPI_ROWS_BEGIN
            EPI_COLS8_BEGIN
                u32x4 w; w.x = pk2(v0[0], v0[1]); w.y = pk2(v0[2], v0[3]); w.z = pk2(v1[0], v1[1]); w.w = pk2(v1[2], v1[3]);
                *(GAS u32x4*)((GAS bf16_t*)ZM + (size_t)row * ZMW + cm + col) = w;
            EPI_END
        }
    }
};
struct EpiDFT {
    bf16_t* Y;
    __device__ __forceinline__ void operator()(const f32x4 (&acc)[2][2][4][2], const Unit& u, int wr, int wc, int fr, int fq) const {
        int tok0, R, q;
        if (u.pm < 128) { tok0 = (u.pm >> 2) * 2048; R = 4; q = u.pm & 3; } else { const int t = u.pm - 128; tok0 = MP + (t >> 4) * 8192; R = 16; q = t & 15; }
#pragma unroll
        for (int ai = 0; ai < 2; ++ai)
#pragma unroll
            for (int m = 0; m < 4; ++m) {
                const int p = ai * HALF + wr * 64 + m * 16 + fr;
                GAS bf16_t* db = (GAS bf16_t*)Y + (size_t)(tok0 + q) * DM + 512 + p;
                bf16_t gv[2][2][4];
#pragma unroll
                for (int bj = 0; bj < 2; ++bj)
#pragma unroll
                    for (int n = 0; n < 2; ++n)
#pragma unroll
                        for (int e = 0; e < 4; ++e) gv[bj][n][e] = db[(size_t)R * (u.pn * BM + bj * HALF + wc * 32 + 8 * fq + 4 * n + e) * DM];
                __builtin_amdgcn_sched_barrier(0);
#pragma unroll
                for (int bj = 0; bj < 2; ++bj)
#pragma unroll
                    for (int n = 0; n < 2; ++n) {
                        const f32x4 v = acc[ai][bj][m][n];
                        const unsigned w0 = pk2(v[0] * bf2f(gv[bj][n][0]), v[1] * bf2f(gv[bj][n][1])), w1 = pk2(v[2] * bf2f(gv[bj][n][2]), v[3] * bf2f(gv[bj][n][3]));
                        GAS bf16_t* d = db + (size_t)R * (u.pn * BM + bj * HALF + wc * 32 + 8 * fq + 4 * n) * DM;
                        d[0] = (bf16_t)w0; d[(size_t)R * DM] = (bf16_t)(w0 >> 16); d[(size_t)2 * R * DM] = (bf16_t)w1; d[(size_t)3 * R * DM] = (bf16_t)(w1 >> 16);
                    }
                __builtin_amdgcn_sched_barrier(0);
            }
    }
};
struct EpiG2 {
    const float* rs; bf16_t* Y;
    __device__ __forceinline__ void operator()(const f32x4 (&acc)[2][2][4][2], const Unit& u, int wr, int wc, int fr, int fq) const {
        EPI_ROWS_BEGIN
        EPI_COLS8_BEGIN
            GAS u32x4* p = (GAS u32x4*)((GAS bf16_t*)Y + (size_t)row * DM + u.pn * BM + col);
            const u32x4 y = *p; u32x4 w;
            w.x = pk2(bflo(y.x) * siluf_(v0[0]), bfhi(y.x) * siluf_(v0[1])); w.y = pk2(bflo(y.y) * siluf_(v0[2]), bfhi(y.y) * siluf_(v0[3]));
            w.z = pk2(bflo(y.z) * siluf_(v1[0]), bfhi(y.z) * siluf_(v1[1])); w.w = pk2(bflo(y.w) * siluf_(v1[2]), bfhi(y.w) * siluf_(v1[3]));
            *p = w;
        EPI_END
    }
};
struct ProgG34 {
    StaticOrder S; const bf16_t* Y; const bf16_t* XB; const char* wsb; const bf16_t* WM; int layer;
    __device__ __forceinline__ bool next(int i, UnitX& u) const { Unit t; if (!S.next(i / 6, t)) return false; u.pm = t.pm; u.pn = t.pn; u.seg = i % 6; return true; }
    __device__ __forceinline__ void desc(const UnitX& u, const char*& A, const char*& B, int& lda, int& ldb, int& nt) const {
        const int b = u.seg >> 1; lda = DM;
        if (u.seg & 1) { A = (const char*)(XB + (size_t)u.pm * BM * DM); B = (const char*)(WM + (size_t)b * DM * DM + (size_t)u.pn * BM * DM); ldb = DM; nt = DM / BK; }
        else { const int kb = (b == 0) ? 512 : 256, ac = (b == 0) ? 0 : (b == 1 ? 512 : 768);
            const size_t woff = (size_t)((b == 0) ? 26 : 27 + b) * MiB + (size_t)layer * ((b == 0) ? MiB : MiB / 2);
            const bf16_t* w = (const bf16_t*)(wsb + woff);
            A = (const char*)(Y + (size_t)u.pm * BM * DM + ac); B = (const char*)(w + (size_t)u.pn * BM * kb); ldb = kb; nt = kb / BK; }
    }
};
struct EpiG34 {
    const float* rs; bf16_t* PT; bf16_t* MT; bf16_t* MG;
    __device__ __forceinline__ void operator()(const f32x4 (&acc)[2][2][4][2], const UnitX& u, int wr, int wc, int fr_, int fq_) const {
        int fr = fr_, fq = fq_; asm volatile("" : "+v"(fr), "+v"(fq));
        if ((u.seg & 1) == 0) {
            EPI_ROWS_BEGIN
            EPI_COLS8_BEGIN
                u32x4 w; w.x = pk2(v0[0], v0[1]); w.y = pk2(v0[2], v0[3]); w.z = pk2(v1[0], v1[1]); w.w = pk2(v1[2], v1[3]);
                *(GAS u32x4*)(PT + (size_t)(row - u.pm * BM) * 256 + col) = w;
            EPI_END
        } else {
            const int mode = u.seg >> 1;
            GAS bf16_t* dst = (mode == 2) ? (GAS bf16_t*)MG + (size_t)u.pm * BM * DM + u.pn * BM : (GAS bf16_t*)MT;
            const int dld = (mode == 2) ? DM : 256;
            const int rl0 = wr * 64 + fr, c0 = wc * 32 + 8 * fq;
#pragma unroll
            for (int ai = 0; ai < 2; ++ai) {
                u32x4 pv[4][2], mv[4][2];
#pragma unroll
                for (int m = 0; m < 4; ++m)
#pragma unroll
                    for (int bj = 0; bj < 2; ++bj) pv[m][bj] = *(const GAS u32x4*)(PT + (size_t)(ai * HALF + rl0 + m * 16) * 256 + bj * HALF + c0);
                if (mode != 0) {
#pragma unroll
                    for (int m = 0; m < 4; ++m)
#pragma unroll
                        for (int bj = 0; bj < 2; ++bj) mv[m][bj] = *(const GAS u32x4*)(MT + (size_t)(ai * HALF + rl0 + m * 16) * 256 + bj * HALF + c0);
                } else {
#pragma unroll
                    for (int m = 0; m < 4; ++m)
#pragma unroll
                        for (int bj = 0; bj < 2; ++bj) mv[m][bj] = (u32x4){0u, 0u, 0u, 0u};
                }
                __builtin_amdgcn_sched_barrier(0);
#pragma unroll
                for (int m = 0; m < 4; ++m)
#pragma unroll
                    for (int bj = 0; bj < 2; ++bj) {
                        const f32x4 v0 = acc[ai][bj][m][0], v1 = acc[ai][bj][m][1]; const u32x4 p = pv[m][bj], q = mv[m][bj];
                        const float r0 = bflo(q.x) + bflo(p.x) * sigmoidf_(v0[0]), r1 = bfhi(q.x) + bfhi(p.x) * sigmoidf_(v0[1]), r2 = bflo(q.y) + bflo(p.y) * sigmoidf_(v0[2]), r3 = bfhi(q.y) + bfhi(p.y) * sigmoidf_(v0[3]);
                        const float r4 = bflo(q.z) + bflo(p.z) * sigmoidf_(v1[0]), r5 = bfhi(q.z) + bfhi(p.z) * sigmoidf_(v1[1]), r6 = bflo(q.w) + bflo(p.w) * sigmoidf_(v1[2]), r7 = bfhi(q.w) + bfhi(p.w) * sigmoidf_(v1[3]);
                        u32x4 w; w.x = pk2(r0, r1); w.y = pk2(r2, r3); w.z = pk2(r4, r5); w.w = pk2(r6, r7);
                        *(GAS u32x4*)(dst + (size_t)(ai * HALF + rl0 + m * 16) * dld + bj * HALF + c0) = w;
                    }
                __builtin_amdgcn_sched_barrier(0);
            }
        }
    }
};
struct EpiG5 {
    bf16_t* O; float* ss;
    __device__ __forceinline__ void operator()(const f32x4 (&acc)[2][2][4][2], const Unit& u, int wr, int wc, int fr, int fq) const {
        EPI_ROWS_BEGIN float q = 0.f;
        EPI_COLS8_BEGIN
            u32x4 w; w.x = pk2(v0[0], v0[1]); w.y = pk2(v0[2], v0[3]); w.z = pk2(v1[0], v1[1]); w.w = pk2(v1[2], v1[3]);
            *(GAS u32x4*)((GAS bf16_t*)O + (size_t)row * DM + u.pn * BM + col) = w;
            q += ((v0[0] * v0[0] + v0[1] * v0[1]) + (v0[2] * v0[2] + v0[3] * v0[3])) + ((v1[0] * v1[0] + v1[1] * v1[1]) + (v1[2] * v1[2] + v1[3] * v1[3]));
        }
            q += __shfl_xor(q, 16); q += __shfl_xor(q, 32);
            if (fq == 0) atomicAdd(ss + row, q);
        }
    }
};
}

__device__ __forceinline__ void transpose_item(const float* W_, int K, int pitch, int c0, int ncols, bf16_t* WT_, int row_off, const float* g_, float scale, LAS float* scr, int item, int lane) {
    const GAS float* W = (const GAS float*)W_; GAS bf16_t* WT = (GAS bf16_t*)WT_;
    const int nblk = ncols / 32, kb = item / nblk, nb = item % nblk, k0 = 64 * kb, n0 = 32 * nb;
    float wv[32];
#pragma unroll
    for (int i = 0; i < 32; ++i) wv[i] = W[(size_t)(k0 + 2 * i + (lane >> 5)) * pitch + c0 + n0 + (lane & 31)];
#pragma unroll
    for (int i = 0; i < 32; ++i) scr[(2 * i + (lane >> 5)) * 33 + (lane & 31)] = wv[i];
    LDS_WAIT(); asm volatile("" ::: "memory");
    const int c = lane & 7;
    f32x4 g0 = {scale, scale, scale, scale}, g1 = g0;
    if (g_) { const GAS f32x4* gp = (const GAS f32x4*)((const GAS float*)g_ + k0 + 8 * c); g0 = gp[0] * scale; g1 = gp[1] * scale; }
#pragma unroll
    for (int j = 0; j < 4; ++j) { const int n = (lane >> 3) + 8 * j; const LAS float* sp = scr + (8 * c) * 33 + n;
        u32x4 o; o.x = pk2(sp[0 * 33] * g0[0], sp[1 * 33] * g0[1]); o.y = pk2(sp[2 * 33] * g0[2], sp[3 * 33] * g0[3]); o.z = pk2(sp[4 * 33] * g1[0], sp[5 * 33] * g1[1]); o.w = pk2(sp[6 * 33] * g1[2], sp[7 * 33] * g1[3]);
        *(GAS u32x4*)(WT + (size_t)(row_off + n0 + n) * K + k0 + 8 * c) = o; }
    LDS_WAIT(); asm volatile("" ::: "memory");
}

struct Args { const float* in[14]; float* out; unsigned char* ws; int ph_lo, ph_hi; };

__device__ __forceinline__ void grid_row_info(int gr, int& seqbase, int& r, int& nrows) {
    if (gr < 1024) { seqbase = (gr >> 5) << 11; r = gr & 31; nrows = 32; } else { const int g2 = gr - 1024; seqbase = MP + ((g2 >> 7) << 13); r = g2 & 127; nrows = 128; }
}

constexpr int AT_NSLOT = 9, AT_KSLOT = 9216, AT_VSLOT = 8704, AT_VOFF = AT_NSLOT * AT_KSLOT, AT_BOFF = AT_VOFF + AT_NSLOT * AT_VSLOT;
static_assert(AT_BOFF + 465 * 4 <= LDS_BYTES, "attention LDS map");
__device__ __forceinline__ void attn_fill_issue(const GAS bf16_t* ZM, const GAS bf16_t* ZT, int tok0, int head, int tid, u32x4& kreg, u32x4& vreg) {
    kreg = *(const GAS u32x4*)(ZM + (size_t)(tok0 + (tid >> 3)) * ZMW + 512 + head * 64 + (tid & 7) * 8);
    vreg = *(const GAS u32x4*)(ZT + ((size_t)(tok0 >> 6) * 512 + head * 64) * 64 + tid * 8);
}
__device__ __forceinline__ void attn_fill_write(LAS unsigned char* lds, int slot, int tid, const u32x4 kreg, const u32x4 vreg) {
    *(LAS u32x4*)(lds + slot * AT_KSLOT + (tid >> 3) * 144 + (tid & 7) * 16) = kreg;
    LAS u32x2* vp = (LAS u32x2*)(lds + AT_VOFF + slot * AT_VSLOT + (tid >> 3) * 136 + (tid & 7) * 16);
    u32x2 a; a.x = vreg.x; a.y = vreg.y; u32x2 b; b.x = vreg.z; b.y = vreg.w;
    vp[0] = a; vp[1] = b;
}
__device__ __forceinline__ void attn_row_lds(LAS unsigned char* lds, int seqbase, int r, int rs, int head, int lane, int wave, const bf16x8 bq0, const bf16x8 bq1, GAS bf16_t* Y, const unsigned (&bcp)[32]) {
    const int g = wave & 3;
    const int qi = lane & 15, h4 = lane >> 4;
    const int cs = (g == 0) ? 0 : (g == 1) ? 8 : (g == 2) ? 24 : 32;
    const int qc = 16 * g + qi;
    const int qtok = seqbase + r * 64 + qc;
    const int sb = rs % AT_NSLOT;
    GAS bf16_t* yp = Y + (size_t)qtok * DM + head * 64 + 4 * h4;
    u32x2 gt[4];
#pragma unroll
    for (int dt = 0; dt < 4; ++dt) gt[dt] = *(const GAS u32x2*)(yp + dt * 16);
    f32x4 S[16];
    float mx = -3.0e38f;
#pragma unroll
    for (int hb = 0; hb < 2; ++hb) {
        bf16x8 ak[8][2];
#pragma unroll
        for (int tt = 0; tt < 8; ++tt) {
            const int t = hb * 8 + tt, kr = t >> 1, hf = t & 1;
            int slot = sb + kr; slot = slot >= AT_NSLOT ? slot - AT_NSLOT : slot;
            const LAS unsigned char* kp = lds + slot * AT_KSLOT + (cs + 16 * hf + qi) * 144 + h4 * 16;
            ak[tt][0] = *(const LAS bf16x8*)kp; ak[tt][1] = *(const LAS bf16x8*)(kp + 64);
        }
        __builtin_amdgcn_sched_barrier(0);
#pragma unroll
        for (int tt = 0; tt < 8; ++tt) {
            const int t = hb * 8 + tt;
            f32x4 s = {0.f, 0.f, 0.f, 0.f};
            s = __builtin_amdgcn_mfma_f32_16x16x32_bf16(ak[tt][0], bq0, s, 0, 0, 0);
            s = __builtin_amdgcn_mfma_f32_16x16x32_bf16(ak[tt][1], bq1, s, 0, 0, 0);
            s[0] += bflo(bcp[2 * t]); s[1] += bfhi(bcp[2 * t]); s[2] += bflo(bcp[2 * t + 1]); s[3] += bfhi(bcp[2 * t + 1]);
            mx = fmaxf(mx, fmaxf(fmaxf(s[0], s[1]), fmaxf(s[2], s[3])));
            S[t] = s;
        }
        __builtin_amdgcn_sched_barrier(0);
    }
    mx = fmaxf(mx, __shfl_xor(mx, 16)); mx = fmaxf(mx, __shfl_xor(mx, 32));
    float sum = 0.f;
    bf16x8 pf[8];
#pragma unroll
    for (int kr = 0; kr < 8; ++kr) {
        const f32x4 a = S[kr * 2], b = S[kr * 2 + 1];
        const float p0 = __expf(a[0] - mx), p1 = __expf(a[1] - mx), p2 = __expf(a[2] - mx), p3 = __expf(a[3] - mx);
        const float p4 = __expf(b[0] - mx), p5 = __expf(b[1] - mx), p6 = __expf(b[2] - mx), p7 = __expf(b[3] - mx);
        sum += ((p0 + p1) + (p2 + p3)) + ((p4 + p5) + (p6 + p7));
        u32x4 w; w.x = pk2(p0, p1); w.y = pk2(p2, p3); w.z = pk2(p4, p5); w.w = pk2(p6, p7);
        pf[kr] = __builtin_bit_cast(bf16x8, w);
    }
    sum += __shfl_xor(sum, 16); sum += __shfl_xor(sum, 32);
    const float inv = __builtin_amdgcn_rcpf(sum);
#pragma unroll
    for (int dp = 0; dp < 2; ++dp) {
        u32x2 vf[2][8][2];
#pragma unroll
        for (int dti = 0; dti < 2; ++dti)
#pragma unroll
            for (int kr = 0; kr < 8; ++kr) {
                int slot = sb + kr; slot = slot >= AT_NSLOT ? slot - AT_NSLOT : slot;
                const LAS unsigned char* vp = lds + AT_VOFF + slot * AT_VSLOT + ((2 * dp + dti) * 16 + qi) * 136 + (cs + 4 * h4) * 2;
                vf[dti][kr][0] = *(const LAS u32x2*)vp; vf[dti][kr][1] = *(const LAS u32x2*)(vp + 32);
            }
        __builtin_amdgcn_sched_barrier(0);
#pragma unroll
        for (int dti = 0; dti < 2; ++dti) {
            f32x4 o = {0.f, 0.f, 0.f, 0.f};
#pragma unroll
            for (int kr = 0; kr < 8; ++kr) {
                u32x4 w; w.x = vf[dti][kr][0].x; w.y = vf[dti][kr][0].y; w.z = vf[dti][kr][1].x; w.w = vf[dti][kr][1].y;
                o = __builtin_amdgcn_mfma_f32_16x16x32_bf16(__builtin_bit_cast(bf16x8, w), pf[kr], o, 0, 0, 0);
            }
            const u32x2 gq = gt[2 * dp + dti];
            u32x2 w; w.x = pk2(o[0] * inv * bflo(gq.x), o[1] * inv * bfhi(gq.x)); w.y = pk2(o[2] * inv * bflo(gq.y), o[3] * inv * bfhi(gq.y));
            *(GAS u32x2*)(yp + (2 * dp + dti) * 16) = w;
        }
        __builtin_amdgcn_sched_barrier(0);
    }
}
#define ATT_RS(r_) ((r_) - 4 < 0 ? 0 : ((r_) - 4 > nrows - 8 ? nrows - 8 : (r_) - 4))
__device__ __forceinline__ void attn_unit(LAS unsigned char* lds, int seqbase, int nrows, int ra, int rb, int head, int tid, int lane, int wave,
                                          const bf16_t* ZM_, const bf16_t* ZT_, bf16_t* Y_, const float* rpb) {
    const GAS bf16_t* ZM = (const GAS bf16_t*)ZM_; const GAS bf16_t* ZT = (const GAS bf16_t*)ZT_; GAS bf16_t* Y = (GAS bf16_t*)Y_;
    const int rsel = wave >> 2;
    const int lo = ATT_RS(ra);
    int top = lo + 8;
    {   u32x4 kreg[9], vreg[9];
#pragma unroll
        for (int k = 0; k < 9; ++k) { int row = lo + k; row = row > nrows - 1 ? nrows - 1 : row; attn_fill_issue(ZM, ZT, seqbase + row * 64, head, tid, kreg[k], vreg[k]); }
        LAS float* bw = (LAS float*)(lds + AT_BOFF);
        if (tid < 465) bw[tid] = rpb[head * 465 + tid];
#pragma unroll
        for (int k = 0; k < 9; ++k) attn_fill_write(lds, (lo + k) % AT_NSLOT, tid, kreg[k], vreg[k]);
    }
    const GAS bf16_t* qbase = ZM + (size_t)(seqbase + 16 * (wave & 3) + (lane & 15)) * ZMW + head * 64 + 8 * (lane >> 4);
    bf16x8 q0 = *(const GAS bf16x8*)(qbase + (size_t)(ra + rsel) * 64 * ZMW), q1 = *(const GAS bf16x8*)(qbase + (size_t)(ra + rsel) * 64 * ZMW + 32);
    __syncthreads();
    unsigned bcp[32]; int cdelta = 1000;
#pragma unroll
    for (int i = 0; i < 32; ++i) bcp[i] = 0u;
#pragma unroll 1
    for (int r = ra; r < rb; r += 2) {
        const int rr = r + rsel, rs = ATT_RS(rr);
        if (rs - rr != cdelta) {
            cdelta = rs - rr;
            const LAS float* bias = (const LAS float*)(lds + AT_BOFF);
            const int g_ = wave & 3, qi_ = lane & 15, h4_ = lane >> 4, cs_ = (g_ == 0) ? 0 : (g_ == 1) ? 8 : (g_ == 2) ? 24 : 32, qc_ = 16 * g_ + qi_;
            int cst_ = qc_ - 8; cst_ = cst_ < 0 ? 0 : cst_; cst_ = cst_ > 48 ? 48 : cst_;
#pragma unroll
            for (int t = 0; t < 16; ++t) {
                float bv[4];
#pragma unroll
                for (int e = 0; e < 4; ++e) {
                    const int kc = cs_ + 16 * (t & 1) + 4 * h4_ + e; int dc = kc - qc_ + 15; dc = dc < 0 ? 0 : dc; dc = dc > 30 ? 30 : dc;
                    const float b = bias[(cdelta + (t >> 1) + 7) * 31 + dc];
                    bv[e] = ((kc >= cst_) && (kc < cst_ + 16)) ? b : -1.0e30f;
                }
                bcp[2 * t] = pk2(bv[0], bv[1]); bcp[2 * t + 1] = pk2(bv[2], bv[3]);
            }
        }
        const int rqn = (r + 2 < rb) ? rr + 2 : rr;
        const bf16x8 nq0 = *(const GAS bf16x8*)(qbase + (size_t)rqn * 64 * ZMW), nq1 = *(const GAS bf16x8*)(qbase + (size_t)rqn * 64 * ZMW + 32);
        int ntop = (r + 2 < rb) ? ATT_RS(r + 3) + 7 : top; ntop = ntop < top ? top : ntop;
        const int nnew = ntop - top;
        u32x4 kreg0 = {0u, 0u, 0u, 0u}, vreg0 = {0u, 0u, 0u, 0u}, kreg1 = {0u, 0u, 0u, 0u}, vreg1 = {0u, 0u, 0u, 0u};
        if (nnew >= 1) attn_fill_issue(ZM, ZT, seqbase + (top + 1) * 64, head, tid, kreg0, vreg0);
        if (nnew >= 2) attn_fill_issue(ZM, ZT, seqbase + (top + 2) * 64, head, tid, kreg1, vreg1);
        attn_row_lds(lds, seqbase, rr, rs, head, lane, wave, q0, q1, Y, bcp);
        LDS_WAIT(); __builtin_amdgcn_s_barrier(); asm volatile("" ::: "memory");
        if (nnew >= 1) attn_fill_write(lds, (top + 1) % AT_NSLOT, tid, kreg0, vreg0);
        if (nnew >= 2) attn_fill_write(lds, (top + 2) % AT_NSLOT, tid, kreg1, vreg1);
        LDS_WAIT(); __builtin_amdgcn_s_barrier(); asm volatile("" ::: "memory");
        top = ntop; q0 = nq0; q1 = nq1;
    }
}

#define DFT4(r0, i0, r1, i1, r2, i2, r3, i3) do { \
    const float ar_ = r0 + r2, ai_ = i0 + i2, br_ = r0 - r2, bi_ = i0 - i2, cr_ = r1 + r3, ci_ = i1 + i3, dr_ = r1 - r3, di_ = i1 - i3; \
    r0 = ar_ + cr_; i0 = ai_ + ci_; r1 = br_ + di_; i1 = bi_ - dr_; r2 = ar_ - cr_; i2 = ai_ - ci_; r3 = br_ - di_; i3 = bi_ + dr_; } while (0)
template <int R, int NU>
__device__ __forceinline__ void butterfly_unit(int tok0, int rowbase  , int p0, int t, const bf16_t* ZT_, bf16_t* YQ_, const float (&twr)[2][R], const float (&twi)[2][R]) {
    const GAS unsigned* zre = (const GAS unsigned*)((const GAS bf16_t*)ZT_ + (size_t)MTOK * 512 + ((size_t)(tok0 >> 9) * 512 + p0) * 512) + t;
    const GAS unsigned* zim = zre + 256 * 256;
    float xr[NU][2][R], xi[NU][2][R];
    {   unsigned rawr[NU][R], rawi[NU][R];
#pragma unroll
        for (int u = 0; u < NU; ++u)
#pragma unroll
            for (int s = 0; s < R; ++s) { rawr[u][s] = zre[(size_t)s * 512 * 256 + u * 256]; rawi[u][s] = zim[(size_t)s * 512 * 256 + u * 256]; }
        __builtin_amdgcn_sched_barrier(0);
#pragma unroll
        for (int u = 0; u < NU; ++u)
#pragma unroll
            for (int s = 0; s < R; ++s) { xr[u][0][s] = bflo(rawr[u][s]); xr[u][1][s] = bfhi(rawr[u][s]); xi[u][0][s] = bflo(rawi[u][s]); xi[u][1][s] = bfhi(rawi[u][s]); }
    }
#pragma unroll
    for (int u = 0; u < NU; ++u) {
#pragma unroll
        for (int h = 0; h < 2; ++h) {
            if constexpr (R == 4) {
                DFT4(xr[u][h][0], xi[u][h][0], xr[u][h][1], xi[u][h][1], xr[u][h][2], xi[u][h][2], xr[u][h][3], xi[u][h][3]);
            } else {
#pragma unroll
                for (int b = 0; b < 4; ++b) DFT4(xr[u][h][b], xi[u][h][b], xr[u][h][4 + b], xi[u][h][4 + b], xr[u][h][8 + b], xi[u][h][8 + b], xr[u][h][12 + b], xi[u][h][12 + b]);
                constexpr float WR[10] = {1.f, 0.9238795325f, 0.7071067812f, 0.3826834324f, 0.f, 0.f, -0.7071067812f, 0.f, 0.f, -0.9238795325f};
                constexpr float WI[10] = {0.f, -0.3826834324f, -0.7071067812f, -0.9238795325f, -1.f, 0.f, -0.7071067812f, 0.f, 0.f, 0.3826834324f};
#pragma unroll
                for (int c = 1; c < 4; ++c)
#pragma unroll
                    for (int b = 1; b < 4; ++b) { const float w0 = WR[c * b], w1 = WI[c * b]; const float tr = xr[u][h][4 * c + b] * w0 - xi[u][h][4 * c + b] * w1, ti = xr[u][h][4 * c + b] * w1 + xi[u][h][4 * c + b] * w0; xr[u][h][4 * c + b] = tr; xi[u][h][4 * c + b] = ti; }
#pragma unroll
                for (int c = 0; c < 4; ++c) DFT4(xr[u][h][4 * c], xi[u][h][4 * c], xr[u][h][4 * c + 1], xi[u][h][4 * c + 1], xr[u][h][4 * c + 2], xi[u][h][4 * c + 2], xr[u][h][4 * c + 3], xi[u][h][4 * c + 3]);
            }
        }
        GAS unsigned* d0 = (GAS unsigned*)((GAS bf16_t*)YQ_ + (size_t)(rowbase + u) * 1024) + t;
#pragma unroll
        for (int q = 0; q < R; ++q) {
            const int sl = (R == 16) ? 4 * (q & 3) + (q >> 2) : q;
            const float r0 = xr[u][0][sl] * twr[0][q] - xi[u][0][sl] * twi[0][q], i0 = xr[u][0][sl] * twi[0][q] + xi[u][0][sl] * twr[0][q];
            const float r1 = xr[u][1][sl] * twr[1][q] - xi[u][1][sl] * twi[1][q], i1 = xr[u][1][sl] * twi[1][q] + xi[u][1][sl] * twr[1][q];
            GAS unsigned* d = d0 + (size_t)q * 256 * 512;
            d[0] = pk2(r0, r1); d[256] = pk2(i0, i1);
        }
    }
}

template <int MODE>
__device__ __forceinline__ void row_pass(int gw, int NGW, int lane, const float* x_prompt, const float* x_sample, float* out, bf16_t* XB, const bf16_t* O, float* RS, float* SS, const float* gpost) {
    for (int m = gw; m < MTOK; m += NGW) {
        f32x4 v[4];
        GAS u32x2* xbrow = (GAS u32x2*)((GAS bf16_t*)XB + (size_t)m * DM) + lane;
        if constexpr (MODE != 0) {
            u32x2 xv[4];
#pragma unroll
            for (int j = 0; j < 4; ++j) xv[j] = xbrow[64 * j];
            const float irs = RS[m];
#pragma unroll
            for (int j = 0; j < 4; ++j) { v[j][0] = bflo(xv[j].x) * irs; v[j][1] = bfhi(xv[j].x) * irs; v[j][2] = bflo(xv[j].y) * irs; v[j][3] = bfhi(xv[j].y) * irs; }
        } else {
            const GAS f32x4* xr = (const GAS f32x4*)((m < MP) ? x_prompt + (size_t)m * DM : x_sample + (size_t)(m - MP) * DM) + lane;
#pragma unroll
            for (int j = 0; j < 4; ++j) v[j] = xr[64 * j];
        }
        if constexpr (MODE != 0) {
            const float rq = rsqrtf(SS[m] * (1.0f / DM) + EPS);
            const GAS u32x2* orow = (const GAS u32x2*)((const GAS bf16_t*)O + (size_t)m * DM) + lane;
#pragma unroll
            for (int j = 0; j < 4; ++j) { const u32x2 ov = orow[64 * j]; const f32x4 gp = *((const GAS f32x4*)gpost + lane + 64 * j);
                v[j][0] += bflo(ov.x) * rq * gp[0]; v[j][1] += bfhi(ov.x) * rq * gp[1]; v[j][2] += bflo(ov.y) * rq * gp[2]; v[j][3] += bfhi(ov.y) * rq * gp[3]; }
            if constexpr (MODE == 2) {
                GAS f32x4* orow2 = (GAS f32x4*)(out + (size_t)m * DM) + lane;
#pragma unroll
                for (int j = 0; j < 4; ++j) orow2[64 * j] = v[j];
            }
        }
        if constexpr (MODE != 2) {
            float s = 0.f;
#pragma unroll
            for (int j = 0; j < 4; ++j) s += (v[j][0] * v[j][0] + v[j][1] * v[j][1]) + (v[j][2] * v[j][2] + v[j][3] * v[j][3]);
            s = wave_sum(s);
            const float ms = s * (1.0f / DM) + EPS;
            const float rsv = rsqrtf(ms);
#pragma unroll
            for (int j = 0; j < 4; ++j) { u32x2 w; w.x = pk2(v[j][0] * rsv, v[j][1] * rsv); w.y = pk2(v[j][2] * rsv, v[j][3] * rsv); xbrow[64 * j] = w; }
            if (lane == 0) { RS[m] = sqrtf(ms); SS[m] = 0.f; }
        }
    }
}

__global__ void __launch_bounds__(NWAVES * 64, 2) fwd_kernel(Args args) {
    extern __shared__ __attribute__((aligned(16))) unsigned char lds_raw[];
    LAS unsigned char* lds = (LAS unsigned char*)lds_raw;
    const int G = gridDim.x, bx = blockIdx.x;
    for (int ph = args.ph_lo; ph < args.ph_hi; ++ph) {
        if (ph > args.ph_lo) { cg::this_grid().sync(); }
        int tid = threadIdx.x; asm volatile("" : "+v"(tid));
        const int lane = tid & 63, wave = __builtin_amdgcn_readfirstlane(tid >> 6);
        const int gw = bx * NWAVES + wave, NGW = G * NWAVES;
        unsigned char* ws = args.ws; asm volatile("" : "+s"(ws));
        const float* x_prompt = args.in[0]; const float* x_sample = args.in[1];
        float* out = args.out;
        bf16_t* XB = (bf16_t*)(ws + WS_XB); bf16_t* OB = XB;
        bf16_t* ZM = (bf16_t*)(ws + WS_ZM); bf16_t* PB = ZM;
        bf16_t* ZT = (bf16_t*)(ws + WS_ZT); bf16_t* MG = ZT;
        bf16_t* YQ = (bf16_t*)(ws + WS_YQ);
        bf16_t* Y = (bf16_t*)(ws + WS_Y);
        bf16_t* TT = (bf16_t*)(ws + WS_T);
        float* RS = (float*)(ws + WS_RS); float* SS = (float*)(ws + WS_SS);
        const int layer = (ph == 0) ? 0 : (ph - 1) / 6;
        const int sub = (ph == 0) ? -1 : (ph - 1) % 6;
        const bf16_t* WIN = (const bf16_t*)(ws + WS_WIN) + (size_t)layer * NG1 * DM;
        const bf16_t* WM = (const bf16_t*)(ws + WS_WM) + (size_t)layer * 3072 * DM;
        const bf16_t* WA = (const bf16_t*)(ws + WS_WA) + (size_t)layer * DM * 512;
        const bf16_t* WB = (const bf16_t*)(ws + WS_WB) + (size_t)layer * DM * 256;
        const bf16_t* WC = (const bf16_t*)(ws + WS_WC) + (size_t)layer * DM * 256;
        const bf16_t* WO = (const bf16_t*)(ws + WS_WO) + (size_t)layer * DM * DM;

        if (PHON(0) && ph == 0) {
            LAS float* scr = (LAS float*)(lds + wave * 16384);
            for (int l = 0; l < 2; ++l) {
                const float* w_in = args.in[4] + (size_t)l * DM * DIN;
                const float* gpre = args.in[2] + l * DM;
                bf16_t* win = (bf16_t*)(ws + WS_WIN) + (size_t)l * NG1 * DM;
                bf16_t* wm = (bf16_t*)(ws + WS_WM) + (size_t)l * 3072 * DM;
                for (int job = 0; job < 7; ++job) {
                    int c0, nc, ro; bf16_t* dst; float sc = 1.f;
                    switch (job) {
                        case 0: c0 = 0; nc = 512; dst = win; ro = 0; sc = 0.125f; break;
                        case 1: c0 = 512; nc = 1024; dst = win; ro = 512; break;
                        case 2: c0 = 2560; nc = 512; dst = win; ro = 2048; break;
                        case 3: c0 = 1536; nc = 512; dst = win; ro = 2560; break;
                        case 4: c0 = 2304; nc = 256; dst = win; ro = 3072; break;
                        case 5: c0 = 3072; nc = 256; dst = win; ro = 3328; break;
                        default: c0 = 3328; nc = 3072; dst = wm; ro = 0; break;
                    }
                    const int nitems = (DM / 64) * (nc / 32);
                    for (int it = gw; it < nitems; it += NGW) transpose_item(w_in, DM, DIN, c0, nc, dst, ro, gpre, sc, scr, it, lane);
                }
                {   const int ni = (512 / 64) * (DM / 32);
                    for (int it = gw; it < ni; it += NGW) transpose_item(args.in[10] + (size_t)l * 512 * DM, 512, DM, 0, DM, (bf16_t*)(ws + WS_WA) + (size_t)l * DM * 512, 0, nullptr, 1.f, scr, it, lane); }
                {   const int ni = (256 / 64) * (DM / 32);
                    for (int it = gw; it < ni; it += NGW) transpose_item(args.in[11] + (size_t)l * 256 * DM, 256, DM, 0, DM, (bf16_t*)(ws + WS_WB) + (size_t)l * DM * 256, 0, nullptr, 1.f, scr, it, lane);
                    for (int it = gw; it < ni; it += NGW) transpose_item(args.in[12] + (size_t)l * 256 * DM, 256, DM, 0, DM, (bf16_t*)(ws + WS_WC) + (size_t)l * DM * 256, 0, nullptr, 1.f, scr, it, lane); }
                {   const int ni = (DM / 64) * (DM / 32);
                    for (int it = gw; it < ni; it += NGW) transpose_item(args.in[13] + (size_t)l * DM * DM, DM, DM, 0, DM, (bf16_t*)(ws + WS_WO) + (size_t)l * DM * DM, 0, nullptr, 1.f, scr, it, lane); }
                LAS float* ctab = (LAS float*)(lds + 131072);
                if (l == 0) { if (tid < 64) { float sn, cs; sincospif((float)tid * (1.0f / 32.0f), &sn, &cs); ctab[tid] = cs; ctab[64 + tid] = sn; } __syncthreads(); }
                for (int idx = bx * 512 + tid; idx < DM * 256; idx += G * 512) {
                    const int k = idx >> 8, p = idx & 255, grp = p >> 6, mm = p & 63;
                    const f32x4* wrow = (const f32x4*)(w_in + (size_t)k * DIN + 2048 + grp * 64);
                    float are = 0.f, aim = 0.f;
#pragma unroll 4
                    for (int c4 = 0; c4 < 16; ++c4) { const f32x4 w = wrow[c4];
#pragma unroll
                        for (int e = 0; e < 4; ++e) { const int t = (mm * (4 * c4 + e)) & 63; are += w[e] * ctab[t]; aim -= w[e] * ctab[64 + t]; } }
                    const float gk = gpre[k];
                    win[(size_t)(1536 + p) * DM + k] = (bf16_t)f2bf(are * gk);
                    win[(size_t)(1536 + 256 + p) * DM + k] = (bf16_t)f2bf(aim * gk);
                }
            }
            for (int idx = bx * 512 + tid; idx < 512 * 512; idx += G * 512) {
                const int kp = idx >> 9, lp = idx & 511; float sn, cs; sincospif((float)((kp * lp) & 511) * (1.0f / 256.0f), &sn, &cs);
                TT[(size_t)kp * 1024 + lp] = (bf16_t)f2bf(cs); TT[(size_t)kp * 1024 + 512 + lp] = (bf16_t)f2bf(sn);
            }
        }
        if (PHON(1) && (ph == 0 || sub == 5)) {
            const float* gpost = args.in[3] + layer * DM;
            if (ph == 0) row_pass<0>(gw, NGW, lane, x_prompt, x_sample, out, XB, Y, RS, SS, gpost);
            else if (layer == 0) row_pass<1>(gw, NGW, lane, x_prompt, x_sample, out, XB, Y, RS, SS, gpost);
            else row_pass<2>(gw, NGW, lane, x_prompt, x_sample, out, XB, Y, RS, SS, gpost);
        } else if (PHON(2) && sub == 0) {
            pg8::Gemm g{XB, WIN, MTOK, NG1, DM, DM, DM}; pg8::StaticOrder S; S.init(MTOK, NG1, G, bx);
            pg8::EpiG1 E{RS, ZM, ZT, Y};
            pg8::gemm_phase<pg8::EpiG1, pg8::StaticOrder, true>(lds, g, S, E);
        } else if (sub == 1) {
            if (PHON(3)) {
                const float* rpb = args.in[5] + (size_t)layer * 8 * 15 * 31;
                for (int un = bx; un < 512; un += G) {
                    if (un < 256) attn_unit(lds, (un >> 3) * 2048, 32, 0, 32, un & 7, tid, lane, wave, ZM, ZT, Y, rpb);
                    else { const int v = un - 256, st = v & 7; attn_unit(lds, MP + (v >> 6) * 8192, 128, st * 16, st * 16 + 16, (v >> 3) & 7, tid, lane, wave, ZM, ZT, Y, rpb); }
                }
            }
            if (PHON(4)) {
                constexpr int CT = 64, HR = CT + 30, NIT = (HR * 32 + 511) / 512, TPH = CT / 2, NHV = TPH + 30, LNT = CT / 8;
                static_assert((HR + CT) * 1024 <= LDS_BYTES, "conv LDS map");
                LAS float* hbuf = (LAS float*)lds; LAS float* cbuf = (LAS float*)(lds + HR * 1024);
                const float* dww = args.in[6] + (size_t)layer * 31 * 256; const float* dwb = args.in[7] + layer * 256;
                const float* lng = args.in[8] + layer * 256; const float* lnb = args.in[9] + layer * 256;
                const int c = tid & 255, half = tid >> 8;
                float w[31];
#pragma unroll
                for (int j = 0; j < 31; ++j) w[j] = dww[j * 256 + c];
                const float bc = dwb[c];
                const f32x4 lg = *((const f32x4*)lng + lane), lb = *((const f32x4*)lnb + lane);
                u32x4 pa[NIT], pb[NIT];
#define CONV_ISSUE(cu_) do { const int t0g_ = (cu_) * CT; \
                    int sbeg_, send_; if (t0g_ < MP) { sbeg_ = t0g_ & ~2047; send_ = sbeg_ + 2048; } else { sbeg_ = MP + ((t0g_ - MP) & ~8191); send_ = sbeg_ + 8192; } \
                    _Pragma("unroll") for (int k = 0; k < NIT; ++k) { \
                        const int it = tid + k * 512, i = it >> 5, c8 = (it & 31) * 8; const int tok = t0g_ - 15 + i; \
                        int tokc = tok < sbeg_ ? sbeg_ : tok; tokc = tokc > send_ - 1 ? send_ - 1 : tokc;     \
                        const u32x4 la_ = *(const GAS u32x4*)((const GAS bf16_t*)ZM + (size_t)tokc * ZMW + 1024 + c8), lb_ = *(const GAS u32x4*)((const GAS bf16_t*)ZM + (size_t)tokc * ZMW + 1280 + c8); \
                        const unsigned keep_ = (tok >= sbeg_ && tok < send_) ? 0xffffffffu : 0u; \
                        pa[k].x = la_.x & keep_; pa[k].y = la_.y & keep_; pa[k].z = la_.z & keep_; pa[k].w = la_.w & keep_; pb[k] = lb_; \
                    } } while (0)
                for (int cu = bx; cu < MTOK / CT; cu += G) {
                    const int t0g = cu * CT;
                    CONV_ISSUE(cu);
#pragma unroll
                    for (int k = 0; k < NIT; ++k) {
                        const int it = tid + k * 512, i = it >> 5, c8 = (it & 31) * 8;
                        if (it < HR * 32) {
                            const u32x4 a = pa[k], b = pb[k]; f32x4 h0, h1;
                            h0[0] = bflo(a.x) * sigmoidf_(bflo(b.x)); h0[1] = bfhi(a.x) * sigmoidf_(bfhi(b.x)); h0[2] = bflo(a.y) * sigmoidf_(bflo(b.y)); h0[3] = bfhi(a.y) * sigmoidf_(bfhi(b.y));
                            h1[0] = bflo(a.z) * sigmoidf_(bflo(b.z)); h1[1] = bfhi(a.z) * sigmoidf_(bfhi(b.z)); h1[2] = bflo(a.w) * sigmoidf_(bflo(b.w)); h1[3] = bfhi(a.w) * sigmoidf_(bfhi(b.w));
                            *(LAS f32x4*)(hbuf + i * 256 + c8) = h0; *(LAS f32x4*)(hbuf + i * 256 + c8 + 4) = h1;
                        }
                    }
                    __syncthreads();
                    {   float hv[NHV];
#pragma unroll
                        for (int i = 0; i < NHV; ++i) hv[i] = hbuf[(half * TPH + i) * 256 + c];
#pragma unroll
                        for (int tt = 0; tt < TPH; ++tt) {
                            float a = bc;
#pragma unroll
                            for (int j = 0; j < 31; ++j) a += w[j] * hv[tt + j];
                            cbuf[(half * TPH + tt) * 256 + c] = a;
                        }
                    }
                    __syncthreads();
                    {
                        f32x4 xv[LNT], dv[LNT]; float sm[LNT]; u32x2 gq[LNT];
#pragma unroll
                        for (int tt = 0; tt < LNT; ++tt) {
                            const int t = wave * LNT + tt;
                            gq[tt] = *(const GAS u32x2*)((const GAS bf16_t*)Y + (size_t)(t0g + t) * DM + 768 + 4 * lane);
                            xv[tt] = *(const LAS f32x4*)(cbuf + t * 256 + 4 * lane);
                            sm[tt] = (xv[tt][0] + xv[tt][1]) + (xv[tt][2] + xv[tt][3]);
                        }
#pragma unroll
                        for (int o = 1; o < 64; o <<= 1)
#pragma unroll
                            for (int tt = 0; tt < LNT; ++tt) sm[tt] += __shfl_xor(sm[tt], o);
#pragma unroll
                        for (int tt = 0; tt < LNT; ++tt) {
                            dv[tt] = xv[tt] - sm[tt] * (1.0f / 256.0f);
                            sm[tt] = (dv[tt][0] * dv[tt][0] + dv[tt][1] * dv[tt][1]) + (dv[tt][2] * dv[tt][2] + dv[tt][3] * dv[tt][3]);
                        }
#pragma unroll
                        for (int o = 1; o < 64; o <<= 1)
#pragma unroll
                            for (int tt = 0; tt < LNT; ++tt) sm[tt] += __shfl_xor(sm[tt], o);
#pragma unroll
                        for (int tt = 0; tt < LNT; ++tt) {
                            const int t = wave * LNT + tt;
                            const float rstd = rsqrtf(sm[tt] * (1.0f / 256.0f) + EPS);
                            const f32x4 d = dv[tt];
                            const float y0 = siluf_(d[0] * rstd * lg[0] + lb[0]), y1 = siluf_(d[1] * rstd * lg[1] + lb[1]), y2 = siluf_(d[2] * rstd * lg[2] + lb[2]), y3 = siluf_(d[3] * rstd * lg[3] + lb[3]);
                            u32x2 wv; wv.x = pk2(y0 * bflo(gq[tt].x), y1 * bfhi(gq[tt].x)); wv.y = pk2(y2 * bflo(gq[tt].y), y3 * bfhi(gq[tt].y));
                            *(GAS u32x2*)((GAS bf16_t*)Y + (size_t)(t0g + t) * DM + 768 + 4 * lane) = wv;
                        }
                    }
                }
            }
            if (PHON(5)) {
                float t4r[2][4], t4i[2][4], t16r[2][16], t16i[2][16];
                const int bt = tid & 255, bh = tid >> 8;
                {   const float s4 = rsqrtf(64.0f * 2048.0f), s16 = rsqrtf(64.0f * 8192.0f);
#pragma unroll
                    for (int h = 0; h < 2; ++h) {
#pragma unroll
                        for (int q = 0; q < 4; ++q) { float sn, cs; sincospif(-2.0f * (float)(q * (2 * bt + h)) / 2048.0f, &sn, &cs); t4r[h][q] = cs * s4; t4i[h][q] = sn * s4; }
#pragma unroll
                        for (int q = 0; q < 16; ++q) { float sn, cs; sincospif(-2.0f * (float)(q * (2 * bt + h)) / 8192.0f, &sn, &cs); t16r[h][q] = cs * s16; t16i[h][q] = sn * s16; } } }
                for (int un = bx; un < 32 * 32; un += G) { const int seq = un >> 5, p = (un & 31) * 8 + bh * 4; butterfly_unit<4, 4>(seq * 2048, seq * 1024 + p, p, bt, ZT, YQ, t4r, t4i); }
                for (int un = bx; un < 4 * 128; un += G) { const int seq = un >> 7, p = (un & 127) * 2 + bh; butterfly_unit<16, 1>(MP + seq * 8192, 32768 + seq * 4096 + p, p, bt, ZT, YQ, t16r, t16i); }
            }
        } else if (PHON(6) && sub == 2) {
            pg8::Gemm g{YQ, TT, NYQ, 512, 1024, 1024, 1024}; pg8::StaticOrder S; S.init(NYQ, 512, G, bx);
            pg8::EpiDFT E{Y};
            pg8::gemm_phase<pg8::EpiDFT, pg8::StaticOrder, true>(lds, g, S, E);
        } else if (sub == 3) {
            pg8::ProgG34 PG; PG.S.init(MTOK, DM, G, bx); PG.Y = Y; PG.XB = XB; PG.wsb = (const char*)ws; PG.WM = WM; PG.layer = layer;
            pg8::EpiG34 EG{RS, PB + (size_t)bx * 65536, PB + (size_t)(256 + bx) * 65536, MG};
            pg8::gemm_multi<pg8::EpiG34, pg8::ProgG34>(lds, PG, EG);
        } else if (PHON(10) && sub == 4) {
            pg8::Gemm g{MG, WO, MTOK, DM, DM, DM, DM}; pg8::StaticOrder S; S.init(MTOK, DM, G, bx);
            pg8::EpiG5 E{Y, SS};
            pg8::gemm_phase<pg8::EpiG5, pg8::StaticOrder, true>(lds, g, S, E);
        }
    }
}

extern "C" void kernel_launch(void* const* d_in, const int* in_sizes, int n_in, void* d_out, int out_size, void* d_ws, size_t ws_size, hipStream_t stream) {
    static int grid = 0;
    if (grid == 0) {
        if (n_in != 14 || ws_size < WS_END) { fprintf(stderr, "kernel_launch: bad inputs (n_in %d, ws %zu < %zu)\n", n_in, ws_size, (size_t)WS_END); grid = -1; return; }
        int dev = 0, cus = 0, per_cu = 0;
        hipGetDevice(&dev); hipDeviceGetAttribute(&cus, hipDeviceAttributeMultiprocessorCount, dev);
        if (hipFuncSetAttribute((const void*)fwd_kernel, hipFuncAttributeMaxDynamicSharedMemorySize, LDS_BYTES) != hipSuccess) { fprintf(stderr, "hipFuncSetAttribute failed\n"); grid = -1; return; }
        hipOccupancyMaxActiveBlocksPerMultiprocessor(&per_cu, (const void*)fwd_kernel, NWAVES * 64, LDS_BYTES);
        (void)hipGetLastError();
        if (per_cu < 1) { fprintf(stderr, "occupancy query says 0 blocks per CU\n"); }
        grid = cus;
    }
    if (grid < 0) return;
    Args a{};
    for (int i = 0; i < 14; ++i) a.in[i] = (const float*)d_in[i];
    a.out = (float*)d_out; a.ws = (unsigned char*)d_ws;
#if MK_ONE_LAUNCH
    a.ph_lo = 0; a.ph_hi = 13;
    void* kargs[] = {&a};
    hipError_t e = hipLaunchCooperativeKernel((const void*)fwd_kernel, dim3(grid), dim3(NWAVES * 64), kargs, LDS_BYTES, stream);
    if (e != hipSuccess) fprintf(stderr, "cooperative launch failed: %s (grid %d)\n", hipGetErrorString(e), grid);
#else
    for (int ph = 0; ph < 13; ++ph) {
        a.ph_lo = ph; a.ph_hi = ph + 1;
        hipLaunchKernelGGL(fwd_kernel, dim3(grid), dim3(NWAVES * 64), LDS_BYTES, stream, a);
    }
#endif
}
```
